# Optimizing an MI355X kernel written in HIP

```python
import math
import jax, jax.numpy as jnp
from jax import lax
import numpy as np

D_MODEL = 1024
BATCH = 4
SEQ = 4096
DEPTH = 4

D_BRANCH = 512
N_BRANCHES = 3
EPS = 1e-6
GMLP_CHUNK = 128
GMLP_GROUPS = 4
GMLP_GDIM = D_BRANCH // GMLP_GROUPS
GLA_HEADS = 4
GLA_DK = D_BRANCH // 2 // GLA_HEADS
GLA_DV = D_BRANCH // GLA_HEADS
GLA_GATE_RANK = 16
GLA_GATE_TAU = 16.0
GLA_CHUNK = 64
DSA_HEADS = 4
DSA_HDIM = D_BRANCH // DSA_HEADS
DSA_IDX_HEADS = 4
DSA_IDX_DIM = 64
DSA_QBLOCK = 128
DSA_TOPK_MAX = 256
N_BUCKETS = 32
MAX_DISTANCE = 128
N_GROUPS = 4
EXPERTS_PER_GROUP = 4
N_EXPERTS = N_GROUPS * EXPERTS_PER_GROUP
D_EXPERT = 256
TOPK_IN_GROUP = 2

IN_SIZES = (
    D_BRANCH, D_BRANCH,
    GLA_HEADS * GLA_DK, GLA_HEADS * GLA_DK,
    GLA_HEADS * GLA_DV, GLA_HEADS * GLA_DV,
    GLA_GATE_RANK,
    DSA_HEADS * DSA_HDIM, DSA_HEADS * DSA_HDIM, DSA_HEADS * DSA_HDIM,
    DSA_IDX_HEADS * DSA_IDX_DIM, DSA_IDX_DIM, DSA_IDX_HEADS,
    N_BRANCHES * D_MODEL,
)
N_IN = sum(IN_SIZES)

kernel_name = "hybrid_gmlp_gla_dsa_hier_moe"


def rms_norm(x, g):
    xf = x.astype(jnp.float32)
    y = xf * lax.rsqrt(jnp.mean(xf * xf, axis=-1, keepdims=True) + EPS)
    return (y * g.astype(jnp.float32)).astype(x.dtype)


def layer_norm(x, g, b):
    xf = x.astype(jnp.float32)
    mu = jnp.mean(xf, axis=-1, keepdims=True)
    var = jnp.mean(jnp.square(xf - mu), axis=-1, keepdims=True)
    y = (xf - mu) * lax.rsqrt(var + EPS)
    return (y * g.astype(jnp.float32) + b.astype(jnp.float32)).astype(x.dtype)


def t5_bucket(rel):
    n = jnp.maximum(rel, 0)
    max_exact = N_BUCKETS // 2
    large = max_exact + (
        jnp.log(jnp.maximum(n, max_exact).astype(jnp.float32) / max_exact)
        / math.log(MAX_DISTANCE / max_exact) * (N_BUCKETS - max_exact)
    ).astype(jnp.int32)
    large = jnp.minimum(large, N_BUCKETS - 1)
    return jnp.where(n < max_exact, n, large)


def gmlp_branch(u, v, ln_g, ln_b, w_s, b_s):
    bsz, s, _ = v.shape
    v = layer_norm(v, ln_g, ln_b)
    vc = v.reshape(bsz, s // GMLP_CHUNK, GMLP_CHUNK, GMLP_GROUPS, GMLP_GDIM)
    causal = jnp.tril(jnp.ones((GMLP_CHUNK, GMLP_CHUNK), dtype=bool))
    w = jnp.where(causal[None], w_s, jnp.zeros_like(w_s))
    mixed = jnp.einsum('gts,bcsgd->bctgd', w, vc) + b_s.T[:, :, None]
    return u * mixed.reshape(bsz, s, D_BRANCH)


def gla_scan(q, k, v, g):
    bsz, s, h, _ = q.shape
    out_dtype = v.dtype
    q = q.astype(jnp.float32) * (GLA_DK ** -0.5)

    def to_chunks(t):
        t = t.astype(jnp.float32)
        return t.reshape(bsz, s // GLA_CHUNK, GLA_CHUNK, h, t.shape[-1]).transpose(1, 0, 3, 2, 4)

    causal = jnp.tril(jnp.ones((GLA_CHUNK, GLA_CHUNK), dtype=bool))[None, None, :, :, None]

    def step(state, inp):
        qc, kc, vc, gc = inp
        b = jnp.cumsum(gc, axis=2)
        b_last = b[:, :, -1:, :]
        o_inter = jnp.einsum('bhtd,bhde->bhte', qc * jnp.exp(b), state)
        diff = b[:, :, :, None, :] - b[:, :, None, :, :]
        decay = jnp.where(causal, jnp.exp(jnp.minimum(diff, 0.0)), 0.0)
        attn = jnp.einsum('bhtd,bhsd,bhtsd->bhts', qc, kc, decay)
        o = o_inter + jnp.einsum('bhts,bhse->bhte', attn, vc)
        new_state = (jnp.exp(b_last[:, :, 0, :])[..., None] * state
                     + jnp.einsum('bhsd,bhse->bhde', kc * jnp.exp(b_last - b), vc))
        return new_state, o

    state0 = jnp.zeros((bsz, h, GLA_DK, GLA_DV), jnp.float32)
    _, o = lax.scan(step, state0, (to_chunks(q), to_chunks(k), to_chunks(v), to_chunks(g)))
    return o.transpose(1, 0, 3, 2, 4).reshape(bsz, s, h, GLA_DV).astype(out_dtype)


def dsa_attention(q, k, v, iq, ik, iw, rel_bias):
    bsz, s, h, hd = q.shape
    n_blocks = s // DSA_QBLOCK
    topk = min(DSA_TOPK_MAX, s // 4)
    key_pos = jnp.arange(s, dtype=jnp.int32)
    gather = jax.vmap(lambda arr, idx: arr[idx])

    def block(i):
        start = i * DSA_QBLOCK
        qb = lax.dynamic_slice_in_dim(q, start, DSA_QBLOCK, axis=1)
        iqb = lax.dynamic_slice_in_dim(iq, start, DSA_QBLOCK, axis=1)
        iwb = lax.dynamic_slice_in_dim(iw, start, DSA_QBLOCK, axis=1)
        qpos = start + jnp.arange(DSA_QBLOCK, dtype=jnp.int32)
        raw = jnp.einsum('bthd,bsd->bths', iqb, ik)
        score = jnp.einsum('bths,bth->bts', jax.nn.relu(raw), iwb).astype(jnp.float32)
        admissible = key_pos[None, :] <= qpos[:, None]
        score = jnp.where(admissible[None], score, -jnp.inf)
        _, top_idx = lax.top_k(score, topk)
        valid = top_idx <= qpos[None, :, None]
        kg = gather(k, top_idx)
        vg = gather(v, top_idx)
        logits = jnp.einsum('bthd,btkhd->btkh', qb, kg).astype(jnp.float32) * (hd ** -0.5)
        bias = rel_bias[t5_bucket(qpos[None, :, None] - top_idx)].astype(jnp.float32)
        logits = jnp.where(valid[..., None], logits + bias, -1e30)
        p = jax.nn.softmax(logits, axis=2).astype(v.dtype)
        return jnp.einsum('btkh,btkhd->bthd', p, vg)

    out = lax.map(block, jnp.arange(n_blocks))
    return out.transpose(1, 0, 2, 3, 4).reshape(bsz, s, h * hd)


def hybrid_mixer(h, w_in, gmlp_ln_g, gmlp_ln_b, gmlp_w_s, gmlp_b_s, gla_w_gate2, gla_b_gate,
                 gla_norm_g, dsa_qnorm_g, dsa_knorm_g, rel_bias, w_branch, b_branch_gate, w_out):
    bsz, s, _ = h.shape
    proj = h @ w_in
    splits = np.cumsum(IN_SIZES)[:-1].tolist()
    (a_u, a_v, g_q, g_k, g_v, g_r, g_a, d_q, d_k, d_v, d_iq, d_ik, d_iw, gates) = jnp.split(
        proj, splits, axis=-1)

    y_a = gmlp_branch(jax.nn.gelu(a_u), jax.nn.gelu(a_v), gmlp_ln_g, gmlp_ln_b, gmlp_w_s, gmlp_b_s)

    log_alpha = jax.nn.log_sigmoid((g_a @ gla_w_gate2 + gla_b_gate).astype(jnp.float32)) / GLA_GATE_TAU
    o_b = gla_scan(g_q.reshape(bsz, s, GLA_HEADS, GLA_DK), g_k.reshape(bsz, s, GLA_HEADS, GLA_DK),
                   g_v.reshape(bsz, s, GLA_HEADS, GLA_DV),
                   log_alpha.reshape(bsz, s, GLA_HEADS, GLA_DK))
    o_b = rms_norm(o_b, gla_norm_g) * jax.nn.silu(g_r.reshape(bsz, s, GLA_HEADS, GLA_DV))
    y_b = o_b.reshape(bsz, s, D_BRANCH)

    q = rms_norm(d_q.reshape(bsz, s, DSA_HEADS, DSA_HDIM), dsa_qnorm_g)
    k = rms_norm(d_k.reshape(bsz, s, DSA_HEADS, DSA_HDIM), dsa_knorm_g)
    y_c = dsa_attention(q, k, d_v.reshape(bsz, s, DSA_HEADS, DSA_HDIM),
                        d_iq.reshape(bsz, s, DSA_IDX_HEADS, DSA_IDX_DIM), d_ik, d_iw, rel_bias)

    ys = jnp.stack([y_a, y_b.astype(y_a.dtype), y_c.astype(y_a.dtype)], axis=0)
    up = jnp.einsum('nbse,ned->bsnd', ys, w_branch)
    gate = jax.nn.sigmoid(gates.reshape(bsz, s, N_BRANCHES, D_MODEL) + b_branch_gate)
    merged = jnp.sum(gate * up, axis=2)
    return (merged @ w_out).astype(h.dtype)


def hier_moe(h, w_group, b_group, w_router, b_router, w_exp_gate, w_exp_up, w_exp_down):
    bsz, s, d = h.shape
    hf = h.reshape(-1, d)
    grp_prob = jax.nn.softmax((hf @ w_group + b_group).astype(jnp.float32), axis=-1)
    p_g, g_idx = lax.top_k(grp_prob, 1)
    g_onehot = jax.nn.one_hot(g_idx[:, 0], N_GROUPS, dtype=jnp.float32)
    exp_logits = (hf @ w_router + b_router).astype(jnp.float32).reshape(-1, N_GROUPS, EXPERTS_PER_GROUP)
    sel_logits = jnp.einsum('tge,tg->te', exp_logits, g_onehot)
    top_vals, e_idx = lax.top_k(sel_logits, TOPK_IN_GROUP)
    weights = p_g * jax.nn.softmax(top_vals, axis=-1)
    eid = g_idx * EXPERTS_PER_GROUP + e_idx
    combine = jnp.einsum('tk,tke->te', weights,
                         jax.nn.one_hot(eid, N_EXPERTS, dtype=jnp.float32)).astype(hf.dtype)
    y = jnp.zeros_like(hf)
    for gi in range(N_GROUPS):
        sl = slice(gi * EXPERTS_PER_GROUP, (gi + 1) * EXPERTS_PER_GROUP)
        hg = jnp.einsum('td,edf->etf', hf, w_exp_gate[sl])
        hu = jnp.einsum('td,edf->etf', hf, w_exp_up[sl])
        act = jax.nn.silu(hg) * hu * combine[:, sl].T[:, :, None]
        y = y + jnp.einsum('etf,efd->td', act, w_exp_down[sl]).astype(hf.dtype)
    return y.reshape(bsz, s, d)


def setup_inputs(seed: int = 0) -> dict:
    key = jax.random.key(seed)
    ks = jax.random.split(key, 28)
    L = DEPTH

    def nrm(k, shape, scale):
        return jax.random.normal(k, shape, jnp.float32) * scale

    return {
        "x": nrm(ks[0], (BATCH, SEQ, D_MODEL), 1.0),
        "c": nrm(ks[1], (BATCH, D_MODEL), 1.0),
        "w_mod": nrm(ks[2], (L, D_MODEL, 6 * D_MODEL), 0.5 * D_MODEL ** -0.5),
        "b_mod": nrm(ks[3], (L, 6 * D_MODEL), 0.02),
        "g_norm1": 1.0 + nrm(ks[4], (L, D_MODEL), 0.1),
        "g_norm2": 1.0 + nrm(ks[5], (L, D_MODEL), 0.1),
        "w_in": nrm(ks[6], (L, D_MODEL, N_IN), D_MODEL ** -0.5),
        "gmlp_ln_g": 1.0 + nrm(ks[7], (L, D_BRANCH), 0.1),
        "gmlp_ln_b": nrm(ks[8], (L, D_BRANCH), 0.02),
        "gmlp_w_s": nrm(ks[9], (L, GMLP_GROUPS, GMLP_CHUNK, GMLP_CHUNK), GMLP_CHUNK ** -0.5),
        "gmlp_b_s": 1.0 + nrm(ks[10], (L, GMLP_GROUPS, GMLP_CHUNK), 0.1),
        "gla_w_gate2": nrm(ks[11], (L, GLA_GATE_RANK, GLA_HEADS * GLA_DK), GLA_GATE_RANK ** -0.5),
        "gla_b_gate": nrm(ks[12], (L, GLA_HEADS * GLA_DK), 0.1),
        "gla_norm_g": 1.0 + nrm(ks[13], (L, GLA_DV), 0.1),
        "dsa_qnorm_g": 1.0 + nrm(ks[14], (L, DSA_HDIM), 0.1),
        "dsa_knorm_g": 1.0 + nrm(ks[15], (L, DSA_HDIM), 0.1),
        "rel_bias": nrm(ks[16], (N_BUCKETS, DSA_HEADS), 0.5),
        "w_branch": nrm(ks[17], (L, N_BRANCHES, D_BRANCH, D_MODEL), D_BRANCH ** -0.5),
        "b_branch_gate": nrm(ks[18], (L, N_BRANCHES, D_MODEL), 0.1),
        "w_out": nrm(ks[19], (L, D_MODEL, D_MODEL), D_MODEL ** -0.5),
        "w_group": nrm(ks[20], (L, D_MODEL, N_GROUPS), D_MODEL ** -0.5),
        "b_group": nrm(ks[21], (L, N_GROUPS), 0.01),
        "w_router": nrm(ks[22], (L, D_MODEL, N_EXPERTS), D_MODEL ** -0.5),
        "b_router": nrm(ks[23], (L, N_EXPERTS), 0.01),
        "w_exp_gate": nrm(ks[24], (L, N_EXPERTS, D_MODEL, D_EXPERT), D_MODEL ** -0.5),
        "w_exp_up": nrm(ks[25], (L, N_EXPERTS, D_MODEL, D_EXPERT), D_MODEL ** -0.5),
        "w_exp_down": nrm(ks[26], (L, N_EXPERTS, D_EXPERT, D_MODEL), D_EXPERT ** -0.5),
    }


def reference(x, c, w_mod, b_mod, g_norm1, g_norm2, w_in, gmlp_ln_g, gmlp_ln_b, gmlp_w_s, gmlp_b_s,
              gla_w_gate2, gla_b_gate, gla_norm_g, dsa_qnorm_g, dsa_knorm_g, rel_bias, w_branch,
              b_branch_gate, w_out, w_group, b_group, w_router, b_router, w_exp_gate, w_exp_up,
              w_exp_down):
    c_act = jax.nn.silu(c)
    for l in range(DEPTH):
        mod = c_act @ w_mod[l] + b_mod[l]
        sh1, sc1, gt1, sh2, sc2, gt2 = [m[:, None, :] for m in jnp.split(mod, 6, axis=-1)]
        h = rms_norm(x, g_norm1[l]) * (1.0 + sc1) + sh1
        mix = hybrid_mixer(h, w_in[l], gmlp_ln_g[l], gmlp_ln_b[l], gmlp_w_s[l], gmlp_b_s[l],
                           gla_w_gate2[l], gla_b_gate[l], gla_norm_g[l], dsa_qnorm_g[l],
                           dsa_knorm_g[l], rel_bias, w_branch[l], b_branch_gate[l], w_out[l])
        x = (x + gt1 * mix).astype(x.dtype)
        h2 = rms_norm(x, g_norm2[l]) * (1.0 + sc2) + sh2
        ffn = hier_moe(h2, w_group[l], b_group[l], w_router[l], b_router[l],
                       w_exp_gate[l], w_exp_up[l], w_exp_down[l])
        x = (x + gt2 * ffn).astype(x.dtype)
    return x
```

```cpp
#include <hip/hip_runtime.h>
#include <stdint.h>
#include <stdio.h>

#ifndef N_LAUNCH_MODE
#define N_LAUNCH_MODE 0
#endif

#define LAS __attribute__((address_space(3)))
#define CAS __attribute__((address_space(4)))
typedef unsigned short bf16_t;
typedef short bf16x8 __attribute__((ext_vector_type(8)));
typedef float f32x2 __attribute__((ext_vector_type(2)));
typedef float f32x4 __attribute__((ext_vector_type(4)));
typedef float f32x16 __attribute__((ext_vector_type(16)));
typedef unsigned u32x2 __attribute__((ext_vector_type(2)));
typedef unsigned u32x4 __attribute__((ext_vector_type(4)));

constexpr int NB = 4, SEQ = 4096, T = NB * SEQ, D = 1024, NL = 4;
constexpr int NIN = 7508, NP = 7680;
constexpr int C_AU = 0, C_AV = 512, C_GQ = 1024, C_GK = 1280, C_GV = 1536, C_GR = 2048, C_DQ = 2560, C_DK = 3072, C_DV = 3584,
              C_IQ = 4096, C_IK = 4352, C_GA = 4416, C_IW = 4432, C_GATE = 4608;
constexpr int YW = 1536;
constexpr int MOE_ROWS = 32768 + 16 * 256;
constexpr float EPS = 1e-6f;

constexpr size_t WS_CTL = 0;
constexpr size_t WS_CNT = 16384;
constexpr size_t WS_MOD = 65536;
constexpr size_t WS_WIN = WS_MOD + 524288;
constexpr size_t WS_WBR = WS_WIN + (size_t)NP * 1024 * 2;
constexpr size_t WS_WOUT = WS_WBR + (size_t)1024 * 1536 * 2;
constexpr size_t WS_WE1 = WS_WOUT + (size_t)1024 * 1024 * 2;
constexpr size_t WS_WE2 = WS_WE1 + (size_t)16 * 512 * 1024 * 2;
constexpr size_t WS_WS = WS_WE2 + (size_t)16 * 1024 * 256 * 2;
constexpr size_t WS_H = WS_WS + (size_t)4 * 128 * 128 * 2;
constexpr size_t WS_PROJ = WS_H + (size_t)T * 1024 * 2;
constexpr size_t WS_Y = WS_PROJ + (size_t)T * NP * 2;
constexpr size_t WS_SCR = WS_Y + (size_t)T * YW * 2;
constexpr size_t WS_MASK = WS_SCR + (size_t)T * 1024 * 4;
constexpr size_t WS_VT = WS_MASK + (size_t)T * 64 * 8;
constexpr size_t WS_TOKE = WS_VT + (size_t)16 * 128 * 4096 * 2;
constexpr size_t WS_TOKW = WS_TOKE + (size_t)T * 8;
constexpr size_t WS_TOKS = WS_TOKW + (size_t)T * 8;
constexpr size_t WS_DEC = WS_TOKS + (size_t)T * 8;
constexpr size_t WS_SW = WS_DEC + (size_t)1024 * 64 * 4;
constexpr size_t WS_END = WS_SW + (size_t)MOE_ROWS * 4;
constexpr size_t WS_H2S = WS_PROJ;
constexpr size_t WS_ACT = WS_H2S + (size_t)MOE_ROWS * 1024 * 2;
constexpr size_t WS_FFN = WS_ACT + (size_t)MOE_ROWS * 256 * 2;
static_assert(WS_FFN + (size_t)MOE_ROWS * 1024 * 2 <= WS_Y, "moe alias");

constexpr int LDS_BYTES = 147456;
constexpr int AUX_OFF = 131072;

__device__ __forceinline__ float bf2f(bf16_t v) { return __uint_as_float(((unsigned)v) << 16); }
__device__ __forceinline__ unsigned cvt_pk_bf16(float lo, float hi) { unsigned r; asm volatile("v_cvt_pk_bf16_f32 %0, %1, %2" : "=v"(r) : "v"(lo), "v"(hi)); return r; }
__device__ __forceinline__ bf16_t f2bf(float f) { return (bf16_t)(cvt_pk_bf16(f, 0.f) & 0xffffu); }
__device__ __forceinline__ float lo_bf(unsigned w) { return __uint_as_float(w << 16); }
__device__ __forceinline__ float hi_bf(unsigned w) { return __uint_as_float(w & 0xffff0000u); }
__device__ __forceinline__ float wave_sum(float v) {
#pragma unroll
    for (int o = 32; o >= 1; o >>= 1) v += __shfl_xor(v, o);
    return v;
}
__device__ __forceinline__ float fast_exp(float x) { return __builtin_amdgcn_exp2f(x * 1.4426950408889634f); }
__device__ __forceinline__ float sigmoidf_(float x) { return __builtin_amdgcn_rcpf(1.f + fast_exp(-x)); }
__device__ __forceinline__ float gelu_tanh(float x) { const float u = x + 0.044715f * x * x * x; return x * __builtin_amdgcn_rcpf(1.f + __builtin_amdgcn_exp2f(-2.3022082f * u)); }

#define XB_TMO      128
#define XB_XCNT(j)  (256  + 64 * (j))
#define XB_XSUB(j)  (1280 + 64 * (j))
#define XB_XGEN(j)  (2304 + 64 * (j))
#define XB_TOP      3328
#define XB_TOPGEN   3392
#define XCD_BAR_WORDS 3456
#define XB_SPIN_CAP (1u << 22)
__device__ __forceinline__ unsigned xb_ld(unsigned* p)              { return __hip_atomic_load(p, __ATOMIC_RELAXED, __HIP_MEMORY_SCOPE_AGENT); }
__device__ __forceinline__ unsigned xb_add(unsigned* p, unsigned v) { return __hip_atomic_fetch_add(p, v, __ATOMIC_RELAXED, __HIP_MEMORY_SCOPE_AGENT); }
__device__ __forceinline__ unsigned xb_xcc_id() { return (unsigned)__builtin_amdgcn_s_getreg((3 << 11) | 20) & 0xFu; }
#define XB_SPIN(cond, bar) do { unsigned _sp = 0; while (cond) { __builtin_amdgcn_s_sleep(1); \
    if ((++_sp & 255u) == 0u) { if (xb_ld(&(bar)[XB_TMO])) break; if (_sp > XB_SPIN_CAP) { atomicAdd(&(bar)[XB_TMO], 1u); break; } } } } while (0)
struct XcdBarrier { unsigned* bar; unsigned x; volatile LAS unsigned* st; };
__device__ __forceinline__ XcdBarrier xcd_barrier_post(unsigned* bar, volatile LAS unsigned* st) {
    XcdBarrier b; b.bar = bar; b.x = xb_xcc_id(); b.st = st;
    if (threadIdx.x == 0) (void)xb_add(&bar[XB_XCNT(b.x)], 1u);
    return b;
}
__device__ __forceinline__ void xcd_barrier_complete(unsigned* bar, unsigned x, unsigned& nloc, unsigned& nx) {
    const unsigned G = gridDim.x * gridDim.y * gridDim.z;
    unsigned sum, cnt, mine, sp = 0u;
    for (;;) {
        sum = 0u; cnt = 0u; mine = 0u;
#pragma unroll
        for (unsigned j = 0; j < 16; ++j) { const unsigned c = xb_ld(&bar[XB_XCNT(j)]); sum += c; cnt += (c > 0u) ? 1u : 0u; mine = (j == x) ? c : mine; }
        if (sum == G) break;
        __builtin_amdgcn_s_sleep(1);
        if ((++sp & 255u) == 0u) { if (xb_ld(&bar[XB_TMO])) break; if (sp > XB_SPIN_CAP) { atomicAdd(&bar[XB_TMO], 1u); break; } }
    }
    nloc = mine > 0u ? mine : 1u; nx = cnt > 0u ? cnt : 1u;
}
__device__ __forceinline__ void xcd_barrier(const XcdBarrier& b) {
    asm volatile("s_waitcnt vmcnt(0)" ::: "memory");
    __syncthreads();
    if (threadIdx.x == 0) {
        unsigned* bar = b.bar;
        __builtin_amdgcn_s_waitcnt(0);
        unsigned nloc = b.st[0], nx = b.st[1];
        if (nloc == 0u) { xcd_barrier_complete(bar, b.x, nloc, nx); b.st[0] = nloc; b.st[1] = nx; }
        const unsigned old = xb_add(&bar[XB_XSUB(b.x)], 1u);
        const unsigned gen = old / nloc;
        if (old + 1u == (gen + 1u) * nloc) {
            __builtin_amdgcn_fence(__ATOMIC_RELEASE, "agent");
            asm volatile("s_waitcnt vmcnt(0)" ::: "memory");
            const unsigned og = xb_add(&bar[XB_TOP], 1u);
            const unsigned tg = og / nx;
            if (og + 1u == (tg + 1u) * nx) xb_add(&bar[XB_TOPGEN], 1u);
            else XB_SPIN(xb_ld(&bar[XB_TOPGEN]) == tg, bar);
            __builtin_amdgcn_fence(__ATOMIC_ACQUIRE, "agent");
            xb_add(&bar[XB_XGEN(b.x)], 1u);
            asm volatile("s_waitcnt vmcnt(0)" ::: "memory");
        } else {
            XB_SPIN(xb_ld(&bar[XB_XGEN(b.x)]) == gen, bar);
            __builtin_amdgcn_fence(__ATOMIC_ACQUIRE, "agent");
            asm volatile("s_waitcnt vmcnt(0)" ::: "memory");
        }
    }
    __syncthreads();
}

namespace pg8 {
constexpr int BM = 256, BK = 64, HALF = 128, HTB = HALF * BK * 2, STAGE_BYTES = 8 * HTB, NXCD = 8, WGM = 8;
__device__ __forceinline__ int lds_byte(int r, int c) { const int st = (r >> 4) * 2 + (c >> 5), rr = r & 15, cc = c & 31, ob = rr * 64 + cc * 2; return st * 1024 + (ob ^ (((ob >> 9) & 1) << 5)); }
__device__ __forceinline__ void stage_rc(int b, int& R, int& C) { const int st = b / 1024, sb = b % 1024, swz = sb ^ (((sb >> 9) & 1) << 5); R = (st >> 1) * 16 + swz / 64; C = (st & 1) * 32 + (swz % 64) / 2; }
__device__ __forceinline__ int perm32(int rho) { const int n = rho >> 4, i = rho & 15; return 8 * (i >> 2) + 4 * n + (i & 3); }

struct Unit { int pm, pn, aux; const char* A; const char* B; };
__device__ __forceinline__ void tile_of(int L, int nM, int nN, int& pm, int& pn) {
    const int nwg = nM * nN; int wgid = L;
    { const int q = nwg / NXCD, r = nwg % NXCD, xcd = wgid % NXCD, off = wgid / NXCD; wgid = (xcd < r ? xcd * (q + 1) : r * (q + 1) + (xcd - r) * q) + off; }
    const int nig = WGM * nN, gid = wgid / nig, fm = gid * WGM, gsz = (nM - fm) < WGM ? (nM - fm) : WGM;
    pm = fm + ((wgid % nig) % gsz); pn = (wgid % nig) / gsz;
}

template <class Epi, class Sched>
__device__ __forceinline__ void gemm_phase(LAS unsigned char* lds, const int tid, const int lda, const int ldb, const int nt, const Sched& S, const Epi& E) {
    const int wid = __builtin_amdgcn_readfirstlane(tid >> 6), lane = tid & 63, wr = wid >> 2, wc = wid & 3, fr = lane & 15, fq = lane >> 4;
    unsigned voffA[2], voffB[2];
#pragma unroll
    for (int i = 0; i < 2; ++i) { int R, C; stage_rc(tid * 16 + i * 8192, R, C); const int Rb = Epi::PERM ? ((R & ~31) + perm32(R & 31)) : R;
        voffA[i] = (unsigned)(R * lda + C) * 2u; voffB[i] = (unsigned)(Rb * ldb + C) * 2u; }
    const size_t kstep = (size_t)(BK * 2);
    const size_t hstepA = (size_t)HALF * lda * 2, hstepB = (size_t)HALF * ldb * 2;
    const unsigned ldsw = (unsigned)wid * 1024u;
    const int aoff = lds_byte(wr * 64 + fr, fq * 8), boff = lds_byte(wc * 32 + fr, fq * 8);
#define PG8_SA(b, h) (((b) * 2 + (h)) * HTB)
#define PG8_SB(b, h) ((4 + (b) * 2 + (h)) * HTB)
#define PG8_STAGE(bufoff, gbase, voff) do { _Pragma("unroll") for (int _i = 0; _i < 2; ++_i) \
        __builtin_amdgcn_global_load_lds((const unsigned*)((const char*)(gbase) + (voff)[_i]), (LAS unsigned*)(lds + (bufoff) + ldsw + _i * 8192), 16, 0, 0); } while (0)
#define PG8_LDA(dst, b, h) do { _Pragma("unroll") for (int m = 0; m < 4; ++m) _Pragma("unroll") for (int k = 0; k < 2; ++k) dst[m][k] = *(const LAS bf16x8*)(lds + PG8_SA(b, h) + aoff + m * 2048 + k * 1024); } while (0)
#define PG8_LDB(dst, b, h) do { _Pragma("unroll") for (int n = 0; n < 2; ++n) _Pragma("unroll") for (int k = 0; k < 2; ++k) dst[n][k] = *(const LAS bf16x8*)(lds + PG8_SB(b, h) + boff + n * 2048 + k * 1024); } while (0)
#define PG8_MMA(ai, bj, At, Bt) do { __builtin_amdgcn_s_setprio(1); _Pragma("unroll") for (int m = 0; m < 4; ++m) _Pragma("unroll") for (int n = 0; n < 2; ++n) _Pragma("unroll") for (int k = 0; k < 2; ++k) \
        acc[ai][bj][m][n] = __builtin_amdgcn_mfma_f32_16x16x32_bf16(Bt[n][k], At[m][k], acc[ai][bj][m][n], 0, 0, 0); __builtin_amdgcn_s_setprio(0); } while (0)
#define PG8_WAIT_V(n) asm volatile("s_waitcnt vmcnt(" #n ")" ::: "memory")
#define PG8_WAIT_L(n) asm volatile("s_waitcnt lgkmcnt(" #n ")" ::: "memory")
#define PG8_BAR __builtin_amdgcn_s_barrier()
#define PG8_SCHED __builtin_amdgcn_sched_barrier(0)
    Unit cur, nxt; int ui = 0;
    if (!S.next(0, cur)) return;
    f32x4 acc[2][2][4][2];
#pragma unroll
    for (int a = 0; a < 2; ++a)
#pragma unroll
        for (int b = 0; b < 2; ++b)
#pragma unroll
            for (int m = 0; m < 4; ++m)
#pragma unroll
                for (int n = 0; n < 2; ++n) acc[a][b][m][n] = (f32x4){0.f, 0.f, 0.f, 0.f};
    bf16x8 At[4][2], B0[2][2], B1[2][2];
    const char* cA = cur.A; const char* cB = cur.B;
    PG8_STAGE(PG8_SB(0, 0), cB, voffB); PG8_STAGE(PG8_SA(0, 0), cA, voffA); PG8_STAGE(PG8_SB(0, 1), cB + hstepB, voffB); PG8_STAGE(PG8_SA(0, 1), cA + hstepA, voffA);
    if (wr == 1) PG8_BAR;
    PG8_WAIT_V(4); PG8_BAR;
    PG8_STAGE(PG8_SB(1, 0), cB + kstep, voffB); PG8_STAGE(PG8_SA(1, 0), cA + kstep, voffA); PG8_STAGE(PG8_SB(1, 1), cB + hstepB + kstep, voffB);
    PG8_WAIT_V(6); PG8_BAR;
    for (;;) {
        const bool has_next = S.next(ui + 1, nxt);
        const char* nA = has_next ? nxt.A : cA; const char* nB = has_next ? nxt.B : cB;
        for (int t = 0; t < nt; t += 2) {
            const bool last = (t == nt - 2);
            const char* a1 = cA + (size_t)(t + 1) * kstep;
            const char* a2 = last ? nA : cA + (size_t)(t + 2) * kstep; const char* b2 = last ? nB : cB + (size_t)(t + 2) * kstep;
            const char* a3 = a2 + kstep; const char* b3 = b2 + kstep;
            PG8_LDB(B0, 0, 0); PG8_SCHED; PG8_LDA(At, 0, 0); PG8_STAGE(PG8_SA(1, 1), a1 + hstepA, voffA);
            PG8_WAIT_L(8); PG8_BAR; PG8_WAIT_L(0); PG8_MMA(0, 0, At, B0); PG8_BAR; PG8_SCHED;
            PG8_LDB(B1, 0, 1); PG8_STAGE(PG8_SB(0, 0), b2, voffB);
            PG8_BAR; PG8_WAIT_L(0); PG8_MMA(0, 1, At, B1); PG8_BAR;
            PG8_LDA(At, 0, 1); PG8_STAGE(PG8_SA(0, 0), a2, voffA);
            PG8_BAR; PG8_WAIT_L(0); PG8_MMA(1, 0, At, B0); PG8_BAR; PG8_SCHED;
            PG8_STAGE(PG8_SB(0, 1), b2 + hstepB, voffB);
            PG8_WAIT_V(6); PG8_BAR; PG8_MMA(1, 1, At, B1); PG8_BAR;
            PG8_LDB(B0, 1, 0); PG8_SCHED; PG8_LDA(At, 1, 0); PG8_STAGE(PG8_SA(0, 1), a2 + hstepA, voffA);
            PG8_WAIT_L(8); PG8_BAR; PG8_WAIT_L(0); PG8_MMA(0, 0, At, B0); PG8_BAR; PG8_SCHED;
            PG8_LDB(B1, 1, 1); PG8_STAGE(PG8_SB(1, 0), b3, voffB);
            PG8_BAR; PG8_WAIT_L(0); PG8_MMA(0, 1, At, B1); PG8_BAR;
            PG8_LDA(At, 1, 1); PG8_STAGE(PG8_SA(1, 0), a3, voffA);
            PG8_BAR; PG8_WAIT_L(0); PG8_MMA(1, 0, At, B0); PG8_BAR; PG8_SCHED;
            PG8_STAGE(PG8_SB(1, 1), b3 + hstepB, voffB);
            PG8_WAIT_V(6); PG8_BAR; PG8_MMA(1, 1, At, B1); PG8_BAR;
        }
        E(acc, cur, wr, wc, fr, fq);
        if (!has_next) break;
#pragma unroll
        for (int a = 0; a < 2; ++a)
#pragma unroll
            for (int b = 0; b < 2; ++b)
#pragma unroll
                for (int m = 0; m < 4; ++m)
#pragma unroll
                    for (int n = 0; n < 2; ++n) acc[a][b][m][n] = (f32x4){0.f, 0.f, 0.f, 0.f};
        cur = nxt; cA = nA; cB = nB; ++ui;
    }
    PG8_WAIT_V(0);
    if (wr == 0) PG8_BAR;
    PG8_BAR;
#undef PG8_SA
#undef PG8_SB
#undef PG8_STAGE
#undef PG8_LDA
#undef PG8_LDB
#undef PG8_MMA
#undef PG8_WAIT_V
#undef PG8_WAIT_L
#undef PG8_BAR
#undef PG8_SCHED
}
}
using pg8::Unit;

struct Params { const float* in[27]; float* out; unsigned char* ws; int ph_lo, ph_hi; };
struct Ctx {
    const float* const CAS* in; float* out; unsigned char* ws; LAS unsigned char* lds;
    int tid, lane, wave, G, c;
};
#define WSP(T_, off) ((T_*)(X.ws + (off)))

struct SchedStatic {
    int nM, nN, G, c; const char* A; const char* B; size_t tA, tB;
    __device__ __forceinline__ bool next(int i, Unit& u) const {
        const long L = (long)i * G + c; if (L >= (long)nM * nN) return false;
        pg8::tile_of((int)L, nM, nN, u.pm, u.pn); u.aux = 0; u.A = A + (size_t)u.pm * tA; u.B = B + (size_t)u.pn * tB; return true;
    }
};
struct SchedMerge {
    int G, c; const char* A; const char* B;
    __device__ __forceinline__ bool next(int i, Unit& u) const {
        const int q = i / 3, n = i - 3 * q; const long L = (long)q * G + c; if (L >= 64 * 4) return false;
        pg8::tile_of((int)L, 64, 4, u.pm, u.pn); u.aux = n;
        u.A = A + ((size_t)u.pm * 256 * YW + 512 * n) * 2; u.B = B + ((size_t)u.pn * 256 * YW + 512 * n) * 2; return true;
    }
};
struct SchedMoe {
    int G, c, ncol_shift, nT; const LAS int* tile_e; const LAS int* tile_pm; const char* A; const char* B; size_t tA, eB, tB;
    __device__ __forceinline__ bool next(int i, Unit& u) const {
        const long L = (long)i * G + c; if (L >= ((long)nT << ncol_shift)) return false;
        const int rt = (int)(L >> ncol_shift); u.pn = (int)(L & ((1 << ncol_shift) - 1)); u.pm = tile_pm[rt]; u.aux = tile_e[rt];
        u.A = A + (size_t)u.pm * tA; u.B = B + (size_t)u.aux * eB + (size_t)u.pn * tB; return true;
    }
};

struct EpiProj { static constexpr bool PERM = true; bf16_t* O;
    __device__ __forceinline__ void operator()(const f32x4 (&acc)[2][2][4][2], const Unit& u, int wr, int wc, int fr, int fq) const {
        const int row0 = u.pm * 256 + wr * 64 + fr, col0 = u.pn * 256 + wc * 32 + 8 * fq; const bool act = u.pn < 4;
#pragma unroll
        for (int ai = 0; ai < 2; ++ai)
#pragma unroll
            for (int m = 0; m < 4; ++m) { bf16_t* rowp = O + (size_t)(row0 + ai * 128 + m * 16) * NP + col0;
#pragma unroll
                for (int bj = 0; bj < 2; ++bj) { f32x4 v0 = acc[ai][bj][m][0], v1 = acc[ai][bj][m][1];
                    if (act) {
#pragma unroll
                        for (int j = 0; j < 4; ++j) { v0[j] = gelu_tanh(v0[j]); v1[j] = gelu_tanh(v1[j]); } }
                    u32x4 w; w.x = cvt_pk_bf16(v0[0], v0[1]); w.y = cvt_pk_bf16(v0[2], v0[3]); w.z = cvt_pk_bf16(v1[0], v1[1]); w.w = cvt_pk_bf16(v1[2], v1[3]);
                    *(u32x4*)(rowp + bj * 128) = w; } }
    }
};
struct EpiMerge { static constexpr bool PERM = false; const bf16_t* proj; const float* bgate; float* mf; bf16_t* mb;
    __device__ __forceinline__ void operator()(const f32x4 (&acc)[2][2][4][2], const Unit& u, int wr, int wc, int fr, int fq) const {
        const int row0 = u.pm * 256 + wr * 64 + fr, col0 = u.pn * 256 + wc * 32 + 4 * fq, n3 = u.aux;
#pragma unroll
        for (int ai = 0; ai < 2; ++ai)
#pragma unroll
            for (int m = 0; m < 4; ++m) { const int r = row0 + ai * 128 + m * 16;
#pragma unroll
                for (int bj = 0; bj < 2; ++bj)
#pragma unroll
                    for (int n = 0; n < 2; ++n) { const int c = col0 + bj * 128 + n * 16;
                        const u32x2 gw = *(const u32x2*)(proj + (size_t)r * NP + C_GATE + n3 * 1024 + c);
                        const f32x4 bg = *(const f32x4*)(bgate + n3 * 1024 + c);
                        f32x4 g; g[0] = sigmoidf_(lo_bf(gw.x) + bg[0]); g[1] = sigmoidf_(hi_bf(gw.x) + bg[1]); g[2] = sigmoidf_(lo_bf(gw.y) + bg[2]); g[3] = sigmoidf_(hi_bf(gw.y) + bg[3]);
                        f32x4 v = g * acc[ai][bj][m][n];
                        float* p = mf + (size_t)r * 1024 + c;
                        if (n3 == 0) { *(f32x4*)p = v; }
                        else if (n3 == 1) { v += *(const f32x4*)p; *(f32x4*)p = v; }
                        else { v += *(const f32x4*)p; u32x2 w; w.x = cvt_pk_bf16(v[0], v[1]); w.y = cvt_pk_bf16(v[2], v[3]); *(u32x2*)(mb + (size_t)r * 1024 + c) = w; } } }
    }
};
struct EpiOut { static constexpr bool PERM = false; float* out; const float* gt;
    __device__ __forceinline__ void operator()(const f32x4 (&acc)[2][2][4][2], const Unit& u, int wr, int wc, int fr, int fq) const {
        const int row0 = u.pm * 256 + wr * 64 + fr, col0 = u.pn * 256 + wc * 32 + 4 * fq; const float* g = gt + (size_t)(u.pm >> 4) * 6144;
#pragma unroll
        for (int ai = 0; ai < 2; ++ai)
#pragma unroll
            for (int m = 0; m < 4; ++m) { const int r = row0 + ai * 128 + m * 16;
#pragma unroll
                for (int bj = 0; bj < 2; ++bj)
#pragma unroll
                    for (int n = 0; n < 2; ++n) { const int c = col0 + bj * 128 + n * 16; float* p = out + (size_t)r * 1024 + c;
                        const f32x4 gv = *(const f32x4*)(g + c); *(f32x4*)p = *(const f32x4*)p + gv * acc[ai][bj][m][n]; } }
    }
};
struct EpiMoe1 { static constexpr bool PERM = true; bf16_t* act; const float* sw;
    __device__ __forceinline__ void operator()(const f32x4 (&acc)[2][2][4][2], const Unit& u, int wr, int wc, int fr, int fq) const {
        const int row0 = u.pm * 256 + wr * 64 + fr, col0 = u.pn * 128 + wc * 32 + 8 * fq;
#pragma unroll
        for (int ai = 0; ai < 2; ++ai)
#pragma unroll
            for (int m = 0; m < 4; ++m) { const int r = row0 + ai * 128 + m * 16; const float w = sw[r]; float o[8];
#pragma unroll
                for (int n = 0; n < 2; ++n)
#pragma unroll
                    for (int j = 0; j < 4; ++j) { const float g = acc[ai][0][m][n][j], up = acc[ai][1][m][n][j]; o[4 * n + j] = g * sigmoidf_(g) * up * w; }
                u32x4 pk; pk.x = cvt_pk_bf16(o[0], o[1]); pk.y = cvt_pk_bf16(o[2], o[3]); pk.z = cvt_pk_bf16(o[4], o[5]); pk.w = cvt_pk_bf16(o[6], o[7]);
                *(u32x4*)(act + (size_t)r * 256 + col0) = pk; }
    }
};
struct EpiMoe2 { static constexpr bool PERM = true; bf16_t* O;
    __device__ __forceinline__ void operator()(const f32x4 (&acc)[2][2][4][2], const Unit& u, int wr, int wc, int fr, int fq) const {
        const int row0 = u.pm * 256 + wr * 64 + fr, col0 = u.pn * 256 + wc * 32 + 8 * fq;
#pragma unroll
        for (int ai = 0; ai < 2; ++ai)
#pragma unroll
            for (int m = 0; m < 4; ++m) { bf16_t* rowp = O + (size_t)(row0 + ai * 128 + m * 16) * 1024 + col0;
#pragma unroll
                for (int bj = 0; bj < 2; ++bj) { const f32x4 v0 = acc[ai][bj][m][0], v1 = acc[ai][bj][m][1];
                    u32x4 w; w.x = cvt_pk_bf16(v0[0], v0[1]); w.y = cvt_pk_bf16(v0[2], v0[3]); w.z = cvt_pk_bf16(v1[0], v1[1]); w.w = cvt_pk_bf16(v1[2], v1[3]);
                    *(u32x4*)(rowp + bj * 128) = w; } }
    }
};

__device__ __forceinline__ void phase_mod(const Ctx& X) {
    LAS float* sc = (LAS float*)X.lds;
    LAS float* red = (LAS float*)(X.lds + 16384);
    const float* c = X.in[1]; const float* wm = X.in[2]; const float* bm = X.in[3]; float* mod = WSP(float, WS_MOD);
    for (int i = X.tid; i < 4096; i += 512) { const float v = c[i]; sc[i] = v * sigmoidf_(v); }
    __syncthreads();
    const int jj = X.tid & 63, ks = X.tid >> 6;
    for (int u = X.c; u < NL * 96; u += X.G) {
        const int l = u / 96, j0 = (u % 96) * 64;
        float a0 = 0.f, a1 = 0.f, a2 = 0.f, a3 = 0.f;
        const float* wp = wm + ((size_t)l * 1024 + ks * 128) * 6144 + j0 + jj;
#pragma unroll 8
        for (int k = 0; k < 128; ++k) { const float w = wp[(size_t)k * 6144]; const int kk = ks * 128 + k;
            a0 += sc[kk] * w; a1 += sc[1024 + kk] * w; a2 += sc[2048 + kk] * w; a3 += sc[3072 + kk] * w; }
        red[(ks * 64 + jj) * 4 + 0] = a0; red[(ks * 64 + jj) * 4 + 1] = a1; red[(ks * 64 + jj) * 4 + 2] = a2; red[(ks * 64 + jj) * 4 + 3] = a3;
        __syncthreads();
        if (X.tid < 256) { const int b = X.tid >> 6; float s = bm[l * 6144 + j0 + jj];
#pragma unroll
            for (int q = 0; q < 8; ++q) s += red[(q * 64 + jj) * 4 + b];
            mod[((size_t)l * NB + b) * 6144 + j0 + jj] = s; }
        __syncthreads();
    }
}

__device__ __forceinline__ int wincol(int m) {
    if (m < 2560) return m;
    if (m < 4416) return m + 16;
    if (m < 4432) return 2560 + (m - 4416);
    if (m < 4436) return m;
    if (m < 4608) return -1;
    return 4436 + (m - 4608);
}
__device__ __forceinline__ void phase_conv(const Ctx& X, int l) {
    LAS float* tile = (LAS float*)X.lds;
    const int c = X.tid & 63, r0 = X.tid >> 6;
    constexpr int J0 = 1920, J1 = J0 + 384, J2 = J1 + 256, J3 = J2 + 2048, J4 = J3 + 1024, J5 = J4 + 16;
    for (int j = X.c; j < J5; j += X.G) {
        if (j >= J4) {
            const int q = j - J4; const float* src = X.in[9] + (size_t)l * 65536; bf16_t* dst = WSP(bf16_t, WS_WS);
            for (int i = X.tid; i < 4096; i += 512) { const int e = q * 4096 + i, t = (e >> 7) & 127, s = e & 127; dst[e] = f2bf(s <= t ? src[e] : 0.f); }
            continue;
        }
        const float* sp; int sld, scol; bf16_t* dp; int dld;
        if (j < J0) { const int nt = j >> 4, kt = j & 15; sp = X.in[6] + ((size_t)l * 1024 + kt * 64) * NIN; sld = NIN; scol = wincol(nt * 64 + c);
            dp = WSP(bf16_t, WS_WIN) + (size_t)(nt * 64) * 1024 + kt * 64; dld = 1024; }
        else if (j < J1) { const int q = j - J0, n = q >> 7, dt = (q >> 3) & 15, et = q & 7;
            sp = X.in[17] + (((size_t)l * 3 + n) * 512 + et * 64) * 1024; sld = 1024; scol = dt * 64 + c;
            dp = WSP(bf16_t, WS_WBR) + (size_t)(dt * 64) * YW + n * 512 + et * 64; dld = YW; }
        else if (j < J2) { const int q = j - J1, nt = q >> 4, kt = q & 15;
            sp = X.in[19] + ((size_t)l * 1024 + kt * 64) * 1024; sld = 1024; scol = nt * 64 + c;
            dp = WSP(bf16_t, WS_WOUT) + (size_t)(nt * 64) * 1024 + kt * 64; dld = 1024; }
        else if (j < J3) { const int q = j - J2, e = q >> 7, rt = (q >> 4) & 7, kt = q & 15; const int n0 = rt * 64, pn = n0 >> 8, half = (n0 >> 7) & 1;
            sp = (half ? X.in[25] : X.in[24]) + (((size_t)l * 16 + e) * 1024 + kt * 64) * 256; sld = 256; scol = 128 * pn + (n0 & 127) + c;
            dp = WSP(bf16_t, WS_WE1) + ((size_t)e * 512 + n0) * 1024 + kt * 64; dld = 1024; }
        else { const int q = j - J3, e = q >> 6, dt = (q >> 2) & 15, kt = q & 3;
            sp = X.in[26] + (((size_t)l * 16 + e) * 256 + kt * 64) * 1024; sld = 1024; scol = dt * 64 + c;
            dp = WSP(bf16_t, WS_WE2) + ((size_t)e * 1024 + dt * 64) * 256 + kt * 64; dld = 256; }
#pragma unroll
        for (int i = 0; i < 8; ++i) { const int k = r0 + 8 * i; tile[k * 65 + c] = scol >= 0 ? sp[(size_t)k * sld + scol] : 0.f; }
        __syncthreads();
#pragma unroll
        for (int i = 0; i < 8; ++i) { const int n = r0 + 8 * i; dp[(size_t)n * dld + c] = f2bf(tile[c * 65 + n]); }
        __syncthreads();
    }
}

__device__ __forceinline__ void phase_norm1(const Ctx& X, int l, int mode) {
    const float* xin = X.in[0]; float* out = X.out; const float* mod = WSP(float, WS_MOD);
    const bf16_t* ffn = WSP(bf16_t, WS_FFN); const int* toks = WSP(int, WS_TOKS); bf16_t* h = WSP(bf16_t, WS_H);
    const float* g1 = X.in[4] + (size_t)l * 1024;
    for (int r = X.c * 8 + X.wave; r < T; r += X.G * 8) {
        const int b = r >> 12;
        f32x4 xv[4];
        if (mode == 0) {
#pragma unroll
            for (int i = 0; i < 4; ++i) xv[i] = *(const f32x4*)(xin + (size_t)r * 1024 + 4 * X.lane + 256 * i);
        } else {
            const int s0 = toks[2 * r], s1 = toks[2 * r + 1];
            const float* gt2 = mod + ((size_t)(l - 1) * NB + b) * 6144 + 5120;
#pragma unroll
            for (int i = 0; i < 4; ++i) { const int col = 4 * X.lane + 256 * i;
                const f32x4 xo = *(const f32x4*)(out + (size_t)r * 1024 + col); const f32x4 g = *(const f32x4*)(gt2 + col);
                const u32x2 a = *(const u32x2*)(ffn + (size_t)s0 * 1024 + col), bb = *(const u32x2*)(ffn + (size_t)s1 * 1024 + col);
                f32x4 f; f[0] = lo_bf(a.x) + lo_bf(bb.x); f[1] = hi_bf(a.x) + hi_bf(bb.x); f[2] = lo_bf(a.y) + lo_bf(bb.y); f[3] = hi_bf(a.y) + hi_bf(bb.y);
                xv[i] = xo + g * f; }
        }
#pragma unroll
        for (int i = 0; i < 4; ++i) *(f32x4*)(out + (size_t)r * 1024 + 4 * X.lane + 256 * i) = xv[i];
        if (mode == 2) continue;
        float ss = 0.f;
#pragma unroll
        for (int i = 0; i < 4; ++i) ss += xv[i][0] * xv[i][0] + xv[i][1] * xv[i][1] + xv[i][2] * xv[i][2] + xv[i][3] * xv[i][3];
        ss = wave_sum(ss);
        const float rstd = __builtin_amdgcn_rsqf(ss * (1.f / 1024.f) + EPS);
        const float* md = mod + ((size_t)l * NB + b) * 6144;
#pragma unroll
        for (int i = 0; i < 4; ++i) { const int col = 4 * X.lane + 256 * i;
            const f32x4 g = *(const f32x4*)(g1 + col), sh = *(const f32x4*)(md + col), sc = *(const f32x4*)(md + 1024 + col);
            f32x4 y = xv[i] * rstd * g * (sc + 1.f) + sh;
            u32x2 w; w.x = cvt_pk_bf16(y[0], y[1]); w.y = cvt_pk_bf16(y[2], y[3]); *(u32x2*)(h + (size_t)r * 1024 + col) = w; }
    }
}

__device__ __forceinline__ void sub_qknorm(const Ctx& X, int l) {
    bf16_t* proj = WSP(bf16_t, WS_PROJ);
    const int j = X.lane >> 3, d0 = 16 * (X.lane & 7);
    const float* gp = (j < 4 ? X.in[14] : X.in[15]) + (size_t)l * 128 + d0;
    float g[16];
#pragma unroll
    for (int i = 0; i < 16; ++i) g[i] = gp[i];
    for (int r = X.c * 8 + X.wave; r < T; r += X.G * 8) {
        bf16_t* p = proj + (size_t)r * NP + C_DQ + 16 * X.lane;
        const u32x4 a = *(const u32x4*)p, b = *(const u32x4*)(p + 8);
        float v[16];
        v[0] = lo_bf(a.x); v[1] = hi_bf(a.x); v[2] = lo_bf(a.y); v[3] = hi_bf(a.y); v[4] = lo_bf(a.z); v[5] = hi_bf(a.z); v[6] = lo_bf(a.w); v[7] = hi_bf(a.w);
        v[8] = lo_bf(b.x); v[9] = hi_bf(b.x); v[10] = lo_bf(b.y); v[11] = hi_bf(b.y); v[12] = lo_bf(b.z); v[13] = hi_bf(b.z); v[14] = lo_bf(b.w); v[15] = hi_bf(b.w);
        float ss = 0.f;
#pragma unroll
        for (int i = 0; i < 16; ++i) ss += v[i] * v[i];
        ss += __shfl_xor(ss, 1); ss += __shfl_xor(ss, 2); ss += __shfl_xor(ss, 4);
        const float rstd = __builtin_amdgcn_rsqf(ss * (1.f / 128.f) + EPS);
#pragma unroll
        for (int i = 0; i < 16; ++i) v[i] = v[i] * rstd * g[i];
        u32x4 oa, ob;
        oa.x = cvt_pk_bf16(v[0], v[1]); oa.y = cvt_pk_bf16(v[2], v[3]); oa.z = cvt_pk_bf16(v[4], v[5]); oa.w = cvt_pk_bf16(v[6], v[7]);
        ob.x = cvt_pk_bf16(v[8], v[9]); ob.y = cvt_pk_bf16(v[10], v[11]); ob.z = cvt_pk_bf16(v[12], v[13]); ob.w = cvt_pk_bf16(v[14], v[15]);
        *(u32x4*)p = oa; *(u32x4*)(p + 8) = ob;
    }
}
__device__ __forceinline__ void sub_vtrans(const Ctx& X) {
    const bf16_t* proj = WSP(bf16_t, WS_PROJ); bf16_t* vt = WSP(bf16_t, WS_VT);
    LAS bf16_t* tile = (LAS bf16_t*)X.lds;
    for (int j = X.c; j < 2048; j += X.G) {
        const int bh = j >> 7, et = (j >> 6) & 1, st = j & 63, b = bh >> 2, hh = bh & 3;
        { const int s = X.tid >> 3, e8 = (X.tid & 7) * 8;
          const u32x4 v = *(const u32x4*)(proj + ((size_t)b * SEQ + st * 64 + s) * NP + C_DV + 128 * hh + et * 64 + e8);
          *(LAS u32x4*)(tile + s * 72 + e8) = v; }
        __syncthreads();
        { const int e = X.tid >> 3, s8 = (X.tid & 7) * 8; unsigned short q[8];
#pragma unroll
          for (int i = 0; i < 8; ++i) q[i] = tile[(s8 + i) * 72 + e];
          u32x4 w; w.x = q[0] | ((unsigned)q[1] << 16); w.y = q[2] | ((unsigned)q[3] << 16); w.z = q[4] | ((unsigned)q[5] << 16); w.w = q[6] | ((unsigned)q[7] << 16);
          *(u32x4*)(vt + ((size_t)bh * 128 + et * 64 + e) * SEQ + st * 64 + s8) = w; }
        __syncthreads();
    }
}

__device__ __forceinline__ void sub_gmlp(const Ctx& X, int l) {
    const bf16_t* proj = WSP(bf16_t, WS_PROJ); bf16_t* y = WSP(bf16_t, WS_Y); const bf16_t* wsb = WSP(bf16_t, WS_WS);
    LAS unsigned char* Wg = X.lds; LAS unsigned char* Vn = X.lds + 34816; LAS float* st = (LAS float*)(X.lds + 69632);
    const float* lng = X.in[7] + (size_t)l * 512; const float* lnb = X.in[8] + (size_t)l * 512; const float* bs = X.in[10] + (size_t)l * 512;
    const int r = X.lane & 31, hf = X.lane >> 5;
    for (int u = X.c; u < 512; u += X.G) {
        const int ch = u >> 2, g = u & 3; const size_t t0 = (size_t)ch * 128;
#pragma unroll
        for (int i = 0; i < 4; ++i) { const int q = X.tid + 512 * i, row = q >> 4, cc = q & 15;
            *(LAS u32x4*)(Wg + row * 272 + cc * 16) = *(const u32x4*)(wsb + ((size_t)g * 128 + row) * 128 + cc * 8); }
        for (int i = 0; i < 16; ++i) { const int tt = X.wave * 16 + i;
            const u32x4 a = *(const u32x4*)(proj + (t0 + tt) * NP + C_AV + 8 * X.lane);
            float v[8] = {lo_bf(a.x), hi_bf(a.x), lo_bf(a.y), hi_bf(a.y), lo_bf(a.z), hi_bf(a.z), lo_bf(a.w), hi_bf(a.w)};
            float s = 0.f;
#pragma unroll
            for (int k = 0; k < 8; ++k) s += v[k];
            const float mean = wave_sum(s) * (1.f / 512.f);
            float q2 = 0.f;
#pragma unroll
            for (int k = 0; k < 8; ++k) { const float d = v[k] - mean; q2 += d * d; }
            const float rstd = __builtin_amdgcn_rsqf(wave_sum(q2) * (1.f / 512.f) + EPS);
            if (X.lane == 0) { st[2 * tt] = mean; st[2 * tt + 1] = rstd; } }
        __syncthreads();
#pragma unroll
        for (int i = 0; i < 4; ++i) { const int q = X.tid + 512 * i, tt = q & 127, jb = q >> 7;
            const u32x4 a = *(const u32x4*)(proj + (t0 + tt) * NP + C_AV + 128 * g + 8 * jb);
            const float mean = st[2 * tt], rstd = st[2 * tt + 1];
            float v[8] = {lo_bf(a.x), hi_bf(a.x), lo_bf(a.y), hi_bf(a.y), lo_bf(a.z), hi_bf(a.z), lo_bf(a.w), hi_bf(a.w)};
#pragma unroll
            for (int e = 0; e < 8; ++e) { const int d = 8 * jb + e; const float o = (v[e] - mean) * rstd * lng[128 * g + d] + lnb[128 * g + d];
                *(LAS bf16_t*)(Vn + d * 272 + tt * 2) = f2bf(o); } }
        __syncthreads();
        { const int tb = X.wave >> 1, dh = X.wave & 1;
          f32x16 acc[2];
#pragma unroll
          for (int nb = 0; nb < 2; ++nb)
#pragma unroll
              for (int k = 0; k < 16; ++k) acc[nb][k] = 0.f;
          const int nks = 2 * (tb + 1);
          for (int ks = 0; ks < nks; ++ks) {
              const bf16x8 a = *(const LAS bf16x8*)(Wg + (32 * tb + r) * 272 + (16 * ks + 8 * hf) * 2);
#pragma unroll
              for (int nb = 0; nb < 2; ++nb) { const bf16x8 b = *(const LAS bf16x8*)(Vn + (64 * dh + 32 * nb + r) * 272 + (16 * ks + 8 * hf) * 2);
                  acc[nb] = __builtin_amdgcn_mfma_f32_32x32x16_bf16(a, b, acc[nb], 0, 0, 0); } }
#pragma unroll
          for (int nb = 0; nb < 2; ++nb)
#pragma unroll
              for (int k = 0; k < 16; ++k) { const int t = 32 * tb + (k & 3) + 8 * (k >> 2) + 4 * hf, d = 64 * dh + 32 * nb + r;
                  const float uu = bf2f(proj[(t0 + t) * NP + C_AU + 128 * g + d]);
                  y[(t0 + t) * YW + 128 * g + d] = f2bf((acc[nb][k] + bs[g * 128 + t]) * uu); } }
        __syncthreads();
    }
}

__device__ __forceinline__ float log_sigmoid_(float z) { return fminf(z, 0.f) - __logf(1.f + __expf(-fabsf(z))); }

__device__ __forceinline__ void sub_gla_local(const Ctx& X, int l) {
    const bf16_t* proj = WSP(bf16_t, WS_PROJ); float* U = WSP(float, WS_SCR); float* dec = WSP(float, WS_DEC);
    LAS float* ga = (LAS float*)X.lds; LAS float* seg = (LAS float*)(X.lds + 4096);
    LAS unsigned char* kkT = X.lds + 8192; LAS unsigned char* vT = X.lds + 17408;
    const int r = X.lane & 31, hf = X.lane >> 5;
    for (int u = X.c; u < 1024; u += X.G) {
        const int hh = u & 3, cch = (u >> 2) & 63, b = u >> 8; const size_t t0 = (size_t)b * SEQ + cch * 64;
        if (X.tid < 128) { const int tt = X.tid >> 1, half = X.tid & 1;
            const u32x4 a = *(const u32x4*)(proj + (t0 + tt) * NP + C_GA + 8 * half);
            LAS float* gp = ga + tt * 16 + 8 * half;
            gp[0] = lo_bf(a.x); gp[1] = hi_bf(a.x); gp[2] = lo_bf(a.y); gp[3] = hi_bf(a.y); gp[4] = lo_bf(a.z); gp[5] = hi_bf(a.z); gp[6] = lo_bf(a.w); gp[7] = hi_bf(a.w); }
#pragma unroll
        for (int i = 0; i < 2; ++i) { const int q = X.tid + 512 * i, s = q & 63, eb = q >> 6;
            const u32x4 a = *(const u32x4*)(proj + (t0 + s) * NP + C_GV + 128 * hh + 8 * eb);
            const unsigned w[4] = {a.x, a.y, a.z, a.w};
#pragma unroll
            for (int k = 0; k < 4; ++k) { *(LAS bf16_t*)(vT + (8 * eb + 2 * k) * 144 + s * 2) = (bf16_t)(w[k] & 0xffffu); *(LAS bf16_t*)(vT + (8 * eb + 2 * k + 1) * 144 + s * 2) = (bf16_t)(w[k] >> 16); } }
        __syncthreads();
        const int d = X.tid & 63, tq = X.tid >> 6;
        float cum[8];
        { float w2[16];
#pragma unroll
          for (int q = 0; q < 16; ++q) w2[q] = X.in[11][((size_t)l * 16 + q) * 256 + hh * 64 + d];
          const float bg = X.in[12][(size_t)l * 256 + hh * 64 + d];
          float run = 0.f;
#pragma unroll
          for (int i = 0; i < 8; ++i) { const int t = 8 * tq + i; float z = bg;
#pragma unroll
              for (int q = 0; q < 16; ++q) z += ga[t * 16 + q] * w2[q];
              run += log_sigmoid_(z) * (1.f / 16.f); cum[i] = run; }
          seg[tq * 64 + d] = run; }
        __syncthreads();
        { float pre = 0.f, tot = 0.f;
#pragma unroll
          for (int q = 0; q < 8; ++q) { const float s = seg[q * 64 + d]; tot += s; if (q < tq) pre += s; }
          float kk[8];
#pragma unroll
          for (int i = 0; i < 8; ++i) { const int t = 8 * tq + i; const float kv = bf2f(proj[(t0 + t) * NP + C_GK + 64 * hh + d]); kk[i] = kv * __expf(tot - (pre + cum[i])); }
          u32x4 w; w.x = cvt_pk_bf16(kk[0], kk[1]); w.y = cvt_pk_bf16(kk[2], kk[3]); w.z = cvt_pk_bf16(kk[4], kk[5]); w.w = cvt_pk_bf16(kk[6], kk[7]);
          *(LAS u32x4*)(kkT + d * 144 + 16 * tq) = w;
          if (tq == 0) dec[(size_t)u * 64 + d] = __expf(tot); }
        __syncthreads();
        { const int db = X.wave >> 2, eb = X.wave & 3; f32x16 acc;
#pragma unroll
          for (int k = 0; k < 16; ++k) acc[k] = 0.f;
#pragma unroll
          for (int ks = 0; ks < 4; ++ks) { const bf16x8 a = *(const LAS bf16x8*)(kkT + (32 * db + r) * 144 + (16 * ks + 8 * hf) * 2);
              const bf16x8 bb = *(const LAS bf16x8*)(vT + (32 * eb + r) * 144 + (16 * ks + 8 * hf) * 2);
              acc = __builtin_amdgcn_mfma_f32_32x32x16_bf16(a, bb, acc, 0, 0, 0); }
#pragma unroll
          for (int k = 0; k < 16; ++k) { const int dd = 32 * db + (k & 3) + 8 * (k >> 2) + 4 * hf; U[((size_t)u * 64 + dd) * 128 + 32 * eb + r] = acc[k]; } }
        __syncthreads();
    }
}

__device__ __forceinline__ void sub_gla_scan(const Ctx& X) {
    float* U = WSP(float, WS_SCR); const float* dec = WSP(float, WS_DEC);
    for (int gid = X.c * 512 + X.tid; gid < 16 * 8192; gid += X.G * 512) {
        const int bh = gid >> 13, de = gid & 8191, d = de >> 7, b = bh >> 2, hh = bh & 3;
        float S = 0.f;
#pragma unroll 8
        for (int c = 0; c < 64; ++c) { const size_t u = (size_t)b * 256 + c * 4 + hh; float* p = U + u * 8192 + de;
            const float uv = *p, dc = dec[u * 64 + d]; *p = S; S = dc * S + uv; }
    }
}

__device__ __forceinline__ void sub_gla_out(const Ctx& X, int l) {
    const bf16_t* proj = WSP(bf16_t, WS_PROJ); const float* Sg = WSP(float, WS_SCR); bf16_t* y = WSP(bf16_t, WS_Y);
    LAS float* ga = (LAS float*)X.lds; LAS float* seg = (LAS float*)(X.lds + 4096);
    LAS unsigned char* qq = X.lds + 8192; LAS unsigned char* qS = X.lds + 17408; LAS unsigned char* kk2 = X.lds + 26624;
    LAS unsigned char* vT = X.lds + 35840; LAS unsigned char* ST = X.lds + 54272; LAS unsigned char* at = X.lds + 72704; LAS float* ob = (LAS float*)(X.lds + 81920);
    const int r = X.lane & 31, hf = X.lane >> 5;
    for (int u = X.c; u < 1024; u += X.G) {
        const int hh = u & 3, cch = (u >> 2) & 63, b = u >> 8; const size_t t0 = (size_t)b * SEQ + cch * 64;
        if (X.tid < 128) { const int tt = X.tid >> 1, half = X.tid & 1;
            const u32x4 a = *(const u32x4*)(proj + (t0 + tt) * NP + C_GA + 8 * half);
            LAS float* gp = ga + tt * 16 + 8 * half;
            gp[0] = lo_bf(a.x); gp[1] = hi_bf(a.x); gp[2] = lo_bf(a.y); gp[3] = hi_bf(a.y); gp[4] = lo_bf(a.z); gp[5] = hi_bf(a.z); gp[6] = lo_bf(a.w); gp[7] = hi_bf(a.w); }
#pragma unroll
        for (int i = 0; i < 2; ++i) { const int q = X.tid + 512 * i, s = q & 63, eb = q >> 6;
            const u32x4 a = *(const u32x4*)(proj + (t0 + s) * NP + C_GV + 128 * hh + 8 * eb);
            const unsigned w[4] = {a.x, a.y, a.z, a.w};
#pragma unroll
            for (int k = 0; k < 4; ++k) { *(LAS bf16_t*)(vT + (8 * eb + 2 * k) * 144 + s * 2) = (bf16_t)(w[k] & 0xffffu); *(LAS bf16_t*)(vT + (8 * eb + 2 * k + 1) * 144 + s * 2) = (bf16_t)(w[k] >> 16); } }
#pragma unroll
        for (int i = 0; i < 16; ++i) { const int q = X.tid + 512 * i, dd = q >> 7, e = q & 127;
            *(LAS bf16_t*)(ST + e * 144 + dd * 2) = f2bf(Sg[(size_t)u * 8192 + q]); }
        __syncthreads();
        const int d = X.tid & 63, tq = X.tid >> 6;
        float cum[8];
        { float w2[16];
#pragma unroll
          for (int q = 0; q < 16; ++q) w2[q] = X.in[11][((size_t)l * 16 + q) * 256 + hh * 64 + d];
          const float bg = X.in[12][(size_t)l * 256 + hh * 64 + d];
          float run = 0.f;
#pragma unroll
          for (int i = 0; i < 8; ++i) { const int t = 8 * tq + i; float z = bg;
#pragma unroll
              for (int q = 0; q < 16; ++q) z += ga[t * 16 + q] * w2[q];
              run += log_sigmoid_(z) * (1.f / 16.f); cum[i] = run; }
          seg[tq * 64 + d] = run; }
        __syncthreads();
        { float pre = 0.f, bref = 0.f;
#pragma unroll
          for (int q = 0; q < 8; ++q) { const float s = seg[q * 64 + d]; if (q < tq) pre += s; if (q < 4) bref += s; }
#pragma unroll
          for (int i = 0; i < 8; ++i) { const int t = 8 * tq + i; const float bt = pre + cum[i];
              const float qv = bf2f(proj[(t0 + t) * NP + C_GQ + 64 * hh + d]) * 0.125f, kv = bf2f(proj[(t0 + t) * NP + C_GK + 64 * hh + d]);
              *(LAS bf16_t*)(qq + t * 144 + d * 2) = f2bf(qv * __expf(bt - bref));
              *(LAS bf16_t*)(qS + t * 144 + d * 2) = f2bf(qv * __expf(bt));
              *(LAS bf16_t*)(kk2 + t * 144 + d * 2) = f2bf(kv * __expf(bref - bt)); } }
        __syncthreads();
        if (X.wave < 4) { const int tb = X.wave >> 1, sb = X.wave & 1; f32x16 acc;
#pragma unroll
            for (int k = 0; k < 16; ++k) acc[k] = 0.f;
#pragma unroll
            for (int ks = 0; ks < 4; ++ks) { const bf16x8 a = *(const LAS bf16x8*)(qq + (32 * tb + r) * 144 + (16 * ks + 8 * hf) * 2);
                const bf16x8 bb = *(const LAS bf16x8*)(kk2 + (32 * sb + r) * 144 + (16 * ks + 8 * hf) * 2);
                acc = __builtin_amdgcn_mfma_f32_32x32x16_bf16(a, bb, acc, 0, 0, 0); }
#pragma unroll
            for (int k = 0; k < 16; ++k) { const int t = 32 * tb + (k & 3) + 8 * (k >> 2) + 4 * hf, s = 32 * sb + r;
                *(LAS bf16_t*)(at + t * 144 + s * 2) = f2bf(s <= t ? acc[k] : 0.f); } }
        __syncthreads();
        { const int tb = X.wave >> 2, eb = X.wave & 3; f32x16 acc;
#pragma unroll
          for (int k = 0; k < 16; ++k) acc[k] = 0.f;
#pragma unroll
          for (int ks = 0; ks < 4; ++ks) { const bf16x8 a = *(const LAS bf16x8*)(qS + (32 * tb + r) * 144 + (16 * ks + 8 * hf) * 2);
              const bf16x8 bb = *(const LAS bf16x8*)(ST + (32 * eb + r) * 144 + (16 * ks + 8 * hf) * 2);
              acc = __builtin_amdgcn_mfma_f32_32x32x16_bf16(a, bb, acc, 0, 0, 0); }
#pragma unroll
          for (int ks = 0; ks < 4; ++ks) { const bf16x8 a = *(const LAS bf16x8*)(at + (32 * tb + r) * 144 + (16 * ks + 8 * hf) * 2);
              const bf16x8 bb = *(const LAS bf16x8*)(vT + (32 * eb + r) * 144 + (16 * ks + 8 * hf) * 2);
              acc = __builtin_amdgcn_mfma_f32_32x32x16_bf16(a, bb, acc, 0, 0, 0); }
#pragma unroll
          for (int k = 0; k < 16; ++k) { const int t = 32 * tb + (k & 3) + 8 * (k >> 2) + 4 * hf; ob[t * 132 + 32 * eb + r] = acc[k]; } }
        __syncthreads();
        { const int t = X.tid >> 3, j = X.tid & 7; float o[16]; float ss = 0.f;
#pragma unroll
          for (int i = 0; i < 16; ++i) { o[i] = ob[t * 132 + 16 * j + i]; ss += o[i] * o[i]; }
          ss += __shfl_xor(ss, 1); ss += __shfl_xor(ss, 2); ss += __shfl_xor(ss, 4);
          const float rstd = __builtin_amdgcn_rsqf(ss * (1.f / 128.f) + EPS);
          const bf16_t* rp = proj + (t0 + t) * NP + C_GR + 128 * hh + 16 * j; const float* gn = X.in[13] + (size_t)l * 128 + 16 * j;
          const u32x4 ra = *(const u32x4*)rp, rb = *(const u32x4*)(rp + 8);
          const unsigned rw[8] = {ra.x, ra.y, ra.z, ra.w, rb.x, rb.y, rb.z, rb.w};
          unsigned pk[8];
#pragma unroll
          for (int i = 0; i < 8; ++i) { const float r0 = lo_bf(rw[i]), r1 = hi_bf(rw[i]);
              const float v0 = o[2 * i] * rstd * gn[2 * i] * (r0 * sigmoidf_(r0)), v1 = o[2 * i + 1] * rstd * gn[2 * i + 1] * (r1 * sigmoidf_(r1));
              pk[i] = cvt_pk_bf16(v0, v1); }
          bf16_t* yp = y + (t0 + t) * YW + 512 + 128 * hh + 16 * j;
          *(u32x4*)yp = (u32x4){pk[0], pk[1], pk[2], pk[3]}; *(u32x4*)(yp + 8) = (u32x4){pk[4], pk[5], pk[6], pk[7]}; }
        __syncthreads();
    }
}

__device__ __forceinline__ void find_digit(LAS unsigned* hist, int lane, unsigned K, unsigned& digit, unsigned& above) {
    const u32x4 h4 = *(const LAS u32x4*)(hist + 4 * lane);
    const unsigned s = h4.x + h4.y + h4.z + h4.w;
    unsigned v = s;
#pragma unroll
    for (int o = 1; o < 64; o <<= 1) { const unsigned t = __shfl_down(v, o); if (lane + o < 64) v += t; }
    unsigned run = v - s, dg = 0, ab = 0; bool found = false;
    { const unsigned hb[4] = {h4.x, h4.y, h4.z, h4.w};
#pragma unroll
      for (int bi = 3; bi >= 0; --bi) { if (!found && run < K && run + hb[bi] >= K) { found = true; dg = 4 * lane + bi; ab = run; } run += hb[bi]; } }
    const unsigned long long m = __ballot(found);
    const int src = m ? (int)__builtin_ctzll(m) : 0;
    digit = (unsigned)__shfl((int)dg, src); above = (unsigned)__shfl((int)ab, src);
}
__device__ __forceinline__ void sub_dsa_select(const Ctx& X) {
    const bf16_t* proj = WSP(bf16_t, WS_PROJ); unsigned long long* mask = WSP(unsigned long long, WS_MASK);
    LAS bf16_t* keys = (LAS bf16_t*)X.lds;
    LAS unsigned* hist = (LAS unsigned*)(X.lds + AUX_OFF + 1024) + X.wave * 256;
    const int lane = X.lane;
    for (int u = X.c; u < 1024; u += X.G) {
        const int b = u & 3, qb = 255 - (u >> 2); const size_t tg0 = (size_t)b * SEQ;
        if (qb < 16) {
#pragma unroll
            for (int rr = 0; rr < 2; ++rr) { const int t = 16 * qb + 2 * X.wave + rr; const int rem = t - 64 * lane;
                const unsigned long long w = rem >= 63 ? ~0ull : (rem < 0 ? 0ull : ((2ull << rem) - 1ull));
                mask[(tg0 + t) * 64 + lane] = w; }
            continue;
        }
        const int nk = 16 * (qb + 1), nkp = (nk + 63) & ~63, ntile = nkp >> 4, nwords = nkp >> 6;
        {
            const int q = lane & 15, kg = lane >> 4; const size_t qrow = (tg0 + 16 * qb + q) * NP;
            bf16x8 Bq[4][2]; float iw[4];
#pragma unroll
            for (int hh = 0; hh < 4; ++hh) { iw[hh] = bf2f(proj[qrow + C_IW + hh]);
#pragma unroll
                for (int ks = 0; ks < 2; ++ks) Bq[hh][ks] = *(const bf16x8*)(proj + qrow + C_IQ + 64 * hh + 32 * ks + 8 * kg); }
            const int tq = 16 * qb + q;
            for (int j = X.wave; j < ntile; j += 8) {
                const size_t krow = (tg0 + 16 * j + q) * NP + C_IK;
                const bf16x8 A0 = *(const bf16x8*)(proj + krow + 8 * kg), A1 = *(const bf16x8*)(proj + krow + 32 + 8 * kg);
                f32x4 sc = {0.f, 0.f, 0.f, 0.f};
#pragma unroll
                for (int hh = 0; hh < 4; ++hh) { f32x4 a = {0.f, 0.f, 0.f, 0.f};
                    a = __builtin_amdgcn_mfma_f32_16x16x32_bf16(A0, Bq[hh][0], a, 0, 0, 0);
                    a = __builtin_amdgcn_mfma_f32_16x16x32_bf16(A1, Bq[hh][1], a, 0, 0, 0);
#pragma unroll
                    for (int k = 0; k < 4; ++k) sc[k] += iw[hh] * fmaxf(a[k], 0.f); }
                unsigned kk[4];
#pragma unroll
                for (int k = 0; k < 4; ++k) { const int key = 16 * j + 4 * kg + k; const unsigned ub = __float_as_uint(sc[k]);
                    unsigned o = (ub & 0x80000000u) ? ~ub : (ub | 0x80000000u); o >>= 16; o = o < 1u ? 1u : o;
                    kk[k] = key <= tq ? o : 0u; }
                u32x2 w; w.x = kk[0] | (kk[1] << 16); w.y = kk[2] | (kk[3] << 16);
                *(LAS u32x2*)(keys + q * 4096 + 16 * j + 4 * kg) = w;
            }
        }
        __syncthreads();
        for (int rr = 0; rr < 2; ++rr) {
            const int row = 2 * X.wave + rr, t = 16 * qb + row; const bool active = lane < nwords;
            unsigned kw[32];
#pragma unroll
            for (int i = 0; i < 8; ++i) { u32x4 v = {0u, 0u, 0u, 0u}; if (active) v = *(const LAS u32x4*)(keys + row * 4096 + 64 * lane + 8 * i);
                kw[4 * i] = v.x; kw[4 * i + 1] = v.y; kw[4 * i + 2] = v.z; kw[4 * i + 3] = v.w; }
            *(LAS u32x4*)(hist + 4 * lane) = (u32x4){0u, 0u, 0u, 0u};
            __syncthreads();
            if (active) {
#pragma unroll
                for (int i = 0; i < 32; ++i) { atomicAdd((unsigned*)(hist + ((kw[i] >> 8) & 255u)), 1u); atomicAdd((unsigned*)(hist + (kw[i] >> 24)), 1u); } }
            __syncthreads();
            unsigned d1, ab1; find_digit(hist, lane, 256u, d1, ab1);
            __syncthreads();
            *(LAS u32x4*)(hist + 4 * lane) = (u32x4){0u, 0u, 0u, 0u};
            __syncthreads();
            if (active) {
#pragma unroll
                for (int i = 0; i < 32; ++i) { const unsigned k0 = kw[i] & 0xffffu, k1 = kw[i] >> 16;
                    if ((k0 >> 8) == d1) atomicAdd((unsigned*)(hist + (k0 & 255u)), 1u);
                    if ((k1 >> 8) == d1) atomicAdd((unsigned*)(hist + (k1 & 255u)), 1u); } }
            __syncthreads();
            unsigned d2, ab2; find_digit(hist, lane, 256u - ab1, d2, ab2);
            __syncthreads();
            const unsigned vstar = (d1 << 8) | d2, need = 256u - ab1 - ab2;
            unsigned ceq = 0;
#pragma unroll
            for (int i = 0; i < 32; ++i) { ceq += ((kw[i] & 0xffffu) == vstar) ? 1u : 0u; ceq += ((kw[i] >> 16) == vstar) ? 1u : 0u; }
            unsigned incl = ceq;
#pragma unroll
            for (int o = 1; o < 64; o <<= 1) { const unsigned tt = __shfl_up(incl, o); if (lane >= o) incl += tt; }
            unsigned base = incl - ceq;
            unsigned wlo = 0u, whi = 0u;
#pragma unroll
            for (int i = 0; i < 32; ++i) { const unsigned k = (i & 1) ? (kw[i >> 1] >> 16) : (kw[i >> 1] & 0xffffu);
                bool sel = k > vstar;
                if (k == vstar) { sel = base < need; ++base; }
                wlo = (wlo >> 1) | (sel ? 0x80000000u : 0u); }
#pragma unroll
            for (int i = 32; i < 64; ++i) { const unsigned k = (i & 1) ? (kw[i >> 1] >> 16) : (kw[i >> 1] & 0xffffu);
                bool sel = k > vstar;
                if (k == vstar) { sel = base < need; ++base; }
                whi = (whi >> 1) | (sel ? 0x80000000u : 0u); }
            const unsigned long long w = ((unsigned long long)whi << 32) | wlo;
            const int rem = t - 64 * lane;
            const unsigned long long cm = rem >= 63 ? ~0ull : (rem < 0 ? 0ull : ((2ull << rem) - 1ull));
            mask[(tg0 + t) * 64 + lane] = active ? (w & cm) : 0ull;
        }
        __syncthreads();
    }
}

__device__ __forceinline__ float t5_bias_idx(int n) { return 0.f; }
__device__ __forceinline__ void sub_dsa_attn(const Ctx& X) {
    const bf16_t* proj = WSP(bf16_t, WS_PROJ); const bf16_t* vtg = WSP(bf16_t, WS_VT); const unsigned long long* mask = WSP(unsigned long long, WS_MASK);
    bf16_t* y = WSP(bf16_t, WS_Y); const float* relb = X.in[16];
    LAS unsigned char* Ks = X.lds; LAS unsigned char* Vs = X.lds + 34816; LAS float* bt = (LAS float*)(X.lds + 69632);
    LAS float* Ox = (LAS float*)X.lds; LAS float* MLx = (LAS float*)(X.lds + 65536);
    const int lane = X.lane, r = lane & 31, hf = lane >> 5, g = X.wave >> 2, wq = X.wave & 3;
    const float scale = 0.08838834764831845f;
    for (int u = X.c; u < 512; u += X.G) {
        const int bh = u & 15, qt = u < 256 ? 31 - (u >> 4) : ((u - 256) >> 4), b = bh >> 2, hh = bh & 3;
        const size_t tg0 = (size_t)b * SEQ; const int q0 = 128 * qt, tq = q0 + 32 * wq + r;
        if (X.tid < 129) { const int n = X.tid; int bk;
            if (n < 16) bk = n; else { bk = 16 + (int)(__logf((float)n * (1.f / 16.f)) / 2.0794415416798357f * 16.f); bk = bk > 31 ? 31 : bk; }
            bt[n] = relb[bk * 4 + hh]; }
        bf16x8 Qf[8];
#pragma unroll
        for (int ks = 0; ks < 8; ++ks) Qf[ks] = *(const bf16x8*)(proj + (tg0 + tq) * NP + C_DQ + 128 * hh + 16 * ks + 8 * hf);
        f32x16 O[4];
#pragma unroll
        for (int eb = 0; eb < 4; ++eb)
#pragma unroll
            for (int k = 0; k < 16; ++k) O[eb][k] = 0.f;
        float mrun = -1e30f, lrun = 0.f;
        const int nst = qt + 1;
        for (int st = 0; st < nst; ++st) {
            __syncthreads();
#pragma unroll
            for (int i = 0; i < 4; ++i) { const int q = X.tid + 512 * i, row = q >> 4, ch = q & 15;
                *(LAS u32x4*)(Ks + row * 272 + ch * 16) = *(const u32x4*)(proj + (tg0 + 128 * st + row) * NP + C_DK + 128 * hh + 8 * ch);
                *(LAS u32x4*)(Vs + row * 272 + ch * 16) = *(const u32x4*)(vtg + ((size_t)bh * 128 + row) * SEQ + 128 * st + 8 * ch); }
            __syncthreads();
            const unsigned long long mw = mask[(tg0 + tq) * 64 + 2 * st + g] >> (4 * hf);
            const unsigned mlo = (unsigned)mw, mhi = (unsigned)(mw >> 32);
            f32x16 S[2];
#pragma unroll
            for (int kb = 0; kb < 2; ++kb) {
#pragma unroll
                for (int k = 0; k < 16; ++k) S[kb][k] = 0.f;
#pragma unroll
                for (int ks = 0; ks < 8; ++ks) { const bf16x8 a = *(const LAS bf16x8*)(Ks + (64 * g + 32 * kb + r) * 272 + (16 * ks + 8 * hf) * 2);
                    S[kb] = __builtin_amdgcn_mfma_f32_32x32x16_bf16(a, Qf[ks], S[kb], 0, 0, 0); } }
            const int kg0 = 128 * st + 64 * g;
            const bool far = (q0 + 32 * wq) - (kg0 + 63) >= 128;
            const float bfar = bt[128];
            float mx = -1e30f;
#pragma unroll
            for (int kb = 0; kb < 2; ++kb)
#pragma unroll
                for (int k = 0; k < 16; ++k) { const int ko = 32 * kb + (k & 3) + 8 * (k >> 2); const unsigned bit = ((kb ? mhi : mlo) >> ((k & 3) + 8 * (k >> 2))) & 1u;
                    float bias = bfar;
                    if (!far) { int rel = tq - (kg0 + ko + 4 * hf); rel = rel < 0 ? 0 : (rel > 128 ? 128 : rel); bias = bt[rel]; }
                    const float lg = bit ? S[kb][k] * scale + bias : -1e30f; S[kb][k] = lg; mx = fmaxf(mx, lg); }
            mx = fmaxf(mx, __shfl_xor(mx, 32));
            const float mnew = fmaxf(mrun, mx), alpha = __expf(mrun - mnew);
            float ps = 0.f;
#pragma unroll
            for (int kb = 0; kb < 2; ++kb)
#pragma unroll
                for (int k = 0; k < 16; ++k) { const float p = S[kb][k] > -1e29f ? __expf(S[kb][k] - mnew) : 0.f; S[kb][k] = p; ps += p; }
            ps += __shfl_xor(ps, 32);
            lrun = lrun * alpha + ps; mrun = mnew;
#pragma unroll
            for (int eb = 0; eb < 4; ++eb)
#pragma unroll
                for (int k = 0; k < 16; ++k) O[eb][k] *= alpha;
#pragma unroll
            for (int kb = 0; kb < 2; ++kb)
#pragma unroll
                for (int s = 0; s < 2; ++s) {
                    union { bf16x8 v; unsigned w[4]; } P;
#pragma unroll
                    for (int j = 0; j < 4; ++j) P.w[j] = cvt_pk_bf16(S[kb][8 * s + 2 * j], S[kb][8 * s + 2 * j + 1]);
#pragma unroll
                    for (int eb = 0; eb < 4; ++eb) {
                        union { bf16x8 v; u32x2 h[2]; } A;
                        LAS unsigned char* vp = Vs + (32 * eb + r) * 272 + (64 * g + 32 * kb + 16 * s + 4 * hf) * 2;
                        A.h[0] = *(const LAS u32x2*)vp; A.h[1] = *(const LAS u32x2*)(vp + 16);
                        O[eb] = __builtin_amdgcn_mfma_f32_32x32x16_bf16(A.v, P.v, O[eb], 0, 0, 0); } }
        }
        __syncthreads();
        if (g == 1) {
#pragma unroll
            for (int eb = 0; eb < 4; ++eb)
#pragma unroll
                for (int k = 0; k < 16; ++k) Ox[((wq * 4 + eb) * 16 + k) * 64 + lane] = O[eb][k];
            MLx[(wq * 64 + lane) * 2] = mrun; MLx[(wq * 64 + lane) * 2 + 1] = lrun; }
        __syncthreads();
        if (g == 0) {
            const float m1 = MLx[(wq * 64 + lane) * 2], l1 = MLx[(wq * 64 + lane) * 2 + 1];
            const float m = fmaxf(mrun, m1), a0 = __expf(mrun - m), a1 = __expf(m1 - m);
            const float inv = 1.f / (lrun * a0 + l1 * a1);
#pragma unroll
            for (int eb = 0; eb < 4; ++eb)
#pragma unroll
                for (int k4 = 0; k4 < 4; ++k4) { float o[4];
#pragma unroll
                    for (int j = 0; j < 4; ++j) { const int k = 4 * k4 + j; o[j] = (O[eb][k] * a0 + Ox[((wq * 4 + eb) * 16 + k) * 64 + lane] * a1) * inv; }
                    u32x2 w; w.x = cvt_pk_bf16(o[0], o[1]); w.y = cvt_pk_bf16(o[2], o[3]);
                    *(u32x2*)(y + (tg0 + tq) * YW + 1024 + 128 * hh + 32 * eb + 8 * k4 + 4 * hf) = w; } }
        __syncthreads();
    }
}

__device__ __forceinline__ void phase_norm2(const Ctx& X, int l) {
    const float* out = X.out; const float* mod = WSP(float, WS_MOD); bf16_t* h = WSP(bf16_t, WS_H);
    int* toke = WSP(int, WS_TOKE); float* tokw = WSP(float, WS_TOKW); unsigned* cntb = WSP(unsigned, WS_CNT);
    LAS float* WT = (LAS float*)X.lds;
    LAS unsigned* cnt = (LAS unsigned*)(X.lds + AUX_OFF + 1024);
    const float* wg = X.in[20] + (size_t)l * 4096; const float* wr = X.in[22] + (size_t)l * 16384;
    for (int i = X.tid; i < 4096; i += 512) WT[(i & 3) * 1024 + (i >> 2)] = wg[i];
    for (int i = X.tid; i < 16384; i += 512) WT[(4 + (i & 15)) * 1024 + (i >> 4)] = wr[i];
    if (X.tid < 16) cnt[X.tid] = 0u;
    __syncthreads();
    const float* g2 = X.in[5] + (size_t)l * 1024; const float* bgrp = X.in[21] + l * 4; const float* brt = X.in[23] + l * 16;
    const int rpb = (T + X.G - 1) / X.G;
    for (int i = X.wave; i < rpb; i += 8) {
        const int r = X.c * rpb + i; if (r >= T) break;
        const int b = r >> 12; const float* md = mod + ((size_t)l * NB + b) * 6144;
        f32x4 xv[4]; float ss = 0.f;
#pragma unroll
        for (int k = 0; k < 4; ++k) { xv[k] = *(const f32x4*)(out + (size_t)r * 1024 + 4 * X.lane + 256 * k); ss += xv[k][0] * xv[k][0] + xv[k][1] * xv[k][1] + xv[k][2] * xv[k][2] + xv[k][3] * xv[k][3]; }
        ss = wave_sum(ss);
        const float rstd = __builtin_amdgcn_rsqf(ss * (1.f / 1024.f) + EPS);
        float lg[20];
#pragma unroll
        for (int o = 0; o < 20; ++o) lg[o] = 0.f;
#pragma unroll
        for (int k = 0; k < 4; ++k) { const int col = 4 * X.lane + 256 * k;
            const f32x4 g = *(const f32x4*)(g2 + col), sh = *(const f32x4*)(md + 3072 + col), sc = *(const f32x4*)(md + 4096 + col);
            const f32x4 yv = xv[k] * rstd * g * (sc + 1.f) + sh;
            u32x2 w; w.x = cvt_pk_bf16(yv[0], yv[1]); w.y = cvt_pk_bf16(yv[2], yv[3]); *(u32x2*)(h + (size_t)r * 1024 + col) = w;
#pragma unroll
            for (int o = 0; o < 20; ++o) { const f32x4 wv = *(const LAS f32x4*)(WT + o * 1024 + col); lg[o] += yv[0] * wv[0] + yv[1] * wv[1] + yv[2] * wv[2] + yv[3] * wv[3]; } }
#pragma unroll
        for (int o = 0; o < 20; ++o) lg[o] = wave_sum(lg[o]);
        if (X.lane == 0) {
            float gl[4];
#pragma unroll
            for (int k = 0; k < 4; ++k) gl[k] = lg[k] + bgrp[k];
            int gi = 0; float gm = gl[0];
#pragma unroll
            for (int k = 1; k < 4; ++k) if (gl[k] > gm) { gm = gl[k]; gi = k; }
            float se = 0.f;
#pragma unroll
            for (int k = 0; k < 4; ++k) se += __expf(gl[k] - gm);
            const float pg = 1.f / se;
            float sl[4];
#pragma unroll
            for (int k = 0; k < 4; ++k) { sl[k] = lg[4 + k] + brt[k];
#pragma unroll
                for (int q = 1; q < 4; ++q) if (gi == q) sl[k] = lg[4 + 4 * q + k] + brt[4 * q + k]; }
            int i1 = 0; float v1 = sl[0];
#pragma unroll
            for (int k = 1; k < 4; ++k) if (sl[k] > v1) { v1 = sl[k]; i1 = k; }
            int i2 = -1; float v2 = -3.0e38f;
#pragma unroll
            for (int k = 0; k < 4; ++k) if (k != i1 && sl[k] > v2) { v2 = sl[k]; i2 = k; }
            const float w1 = 1.f / (1.f + __expf(v2 - v1));
            const int e1 = 4 * gi + i1, e2 = 4 * gi + i2;
            toke[2 * r] = e1; toke[2 * r + 1] = e2; tokw[2 * r] = pg * w1; tokw[2 * r + 1] = pg * (1.f - w1);
            atomicAdd((unsigned*)(cnt + e1), 1u); atomicAdd((unsigned*)(cnt + e2), 1u);
        }
    }
    __syncthreads();
    if (X.tid < 16) cntb[X.c * 16 + X.tid] = cnt[X.tid];
    __syncthreads();
}

__device__ __forceinline__ void build_tiles(const Ctx& X, LAS int* tb, LAS int* myoff  ) {
    const unsigned* cntb = WSP(unsigned, WS_CNT);
    LAS int* tot = tb + 32;
    if (X.tid < 16) { int s = 0, mine = 0; for (int c = 0; c < X.G; ++c) { const int v = (int)cntb[c * 16 + X.tid]; if (c < X.c) mine += v; s += v; } tot[X.tid] = s; myoff[X.tid] = mine; }
    __syncthreads();
    if (X.tid == 0) { int row = 0, nT = 0;
        for (int e = 0; e < 16; ++e) { const int nt = (tot[e] + 255) >> 8; tb[16 + e] = row; for (int k = 0; k < nt; ++k) { tb[64 + nT] = e; tb[256 + nT] = (row >> 8) + k; ++nT; } row += nt * 256; }
        tb[0] = nT; }
    __syncthreads();
    if (X.tid < 16) myoff[X.tid] += tb[16 + X.tid];
    __syncthreads();
}

__device__ __forceinline__ void phase_scatter(const Ctx& X) {
    const int* toke = WSP(int, WS_TOKE); const float* tokw = WSP(float, WS_TOKW); int* toks = WSP(int, WS_TOKS);
    const bf16_t* h = WSP(bf16_t, WS_H); bf16_t* h2s = WSP(bf16_t, WS_H2S); float* sw = WSP(float, WS_SW);
    LAS int* tb = (LAS int*)(X.lds + AUX_OFF + 2048); LAS int* myoff = (LAS int*)(X.lds + AUX_OFF + 1024);
    LAS int* slots = (LAS int*)X.lds;
    build_tiles(X, tb, myoff);
    const int rpb = (T + X.G - 1) / X.G, r0 = X.c * rpb;
    if (X.tid == 0) { for (int i = 0; i < rpb; ++i) { const int r = r0 + i; if (r >= T) break;
            for (int k = 0; k < 2; ++k) { const int e = toke[2 * r + k]; slots[2 * i + k] = myoff[e]; myoff[e] = myoff[e] + 1; } } }
    __syncthreads();
    for (int i = X.wave; i < rpb; i += 8) { const int r = r0 + i; if (r >= T) break;
        const u32x4 a = *(const u32x4*)(h + (size_t)r * 1024 + 16 * X.lane), bq = *(const u32x4*)(h + (size_t)r * 1024 + 16 * X.lane + 8);
#pragma unroll
        for (int k = 0; k < 2; ++k) { const int s = slots[2 * i + k];
            *(u32x4*)(h2s + (size_t)s * 1024 + 16 * X.lane) = a; *(u32x4*)(h2s + (size_t)s * 1024 + 16 * X.lane + 8) = bq;
            if (X.lane == 0) { sw[s] = tokw[2 * r + k]; toks[2 * r + k] = s; } } }
    __syncthreads();
}

__global__ void __launch_bounds__(512, 2) fwd_kernel(Params P) {
    extern __shared__ __attribute__((aligned(16))) unsigned char lds_raw[];
    Ctx X0; X0.in = (const float* const CAS*)__builtin_amdgcn_kernarg_segment_ptr(); X0.out = P.out; X0.ws = P.ws; X0.lds = (LAS unsigned char*)lds_raw;
    X0.tid = threadIdx.x; X0.lane = X0.tid & 63; X0.wave = __builtin_amdgcn_readfirstlane(X0.tid >> 6); X0.G = gridDim.x; X0.c = blockIdx.x;
    LAS unsigned* auxw = (LAS unsigned*)(X0.lds + AUX_OFF);
    if (X0.tid < 4) auxw[X0.tid] = 0u;
    __syncthreads();
#define FRESH() Ctx X = X0; { int wv_ = X0.wave; asm volatile("" : "+s"(wv_)); unsigned m_ = ~0u; asm volatile("" : "+s"(m_)); const int ln_ = __builtin_amdgcn_mbcnt_hi(m_, __builtin_amdgcn_mbcnt_lo(m_, 0u)); \
        X.wave = wv_; X.lane = ln_; X.tid = wv_ * 64 + ln_; \
        unsigned char* w_ = X0.ws; asm volatile("" : "+s"(w_)); X.ws = w_; int c_ = X0.c; asm volatile("" : "+s"(c_)); X.c = c_; \
        const float* const CAS* i_ = X0.in; asm volatile("" : "+s"(i_)); X.in = i_; }
#if N_LAUNCH_MODE == 1
    XcdBarrier bar = xcd_barrier_post((unsigned*)(X0.ws + WS_CTL), (volatile LAS unsigned*)auxw);
#define SEAM() do { if (gp >= lo && gp + 1 < hi) xcd_barrier(bar); ++gp; } while (0)
#else
#define SEAM() do { ++gp; } while (0)
#endif
    const int lo = P.ph_lo, hi = P.ph_hi; int gp = 0;
#define IN() (gp >= lo && gp < hi)
    if (IN()) { FRESH(); phase_mod(X); }
    SEAM();
#define LAYER_BODY(l) do { \
        if (IN()) { { FRESH(); phase_conv(X, l); } { FRESH(); if (l == 0) phase_norm1(X, l, 0); else phase_norm1(X, l, 1); } } \
        SEAM(); \
        if (IN()) { \
            FRESH(); \
            SchedStatic S{64, 30, X.G, X.c, (const char*)WSP(bf16_t, WS_H), (const char*)WSP(bf16_t, WS_WIN), (size_t)256 * 1024 * 2, (size_t)256 * 1024 * 2}; \
            EpiProj E{WSP(bf16_t, WS_PROJ)}; \
            pg8::gemm_phase(X.lds, X.tid, 1024, 1024, 16, S, E); \
        } \
        SEAM(); \
        if (IN()) { { FRESH(); sub_qknorm(X, l); } { FRESH(); sub_vtrans(X); } { FRESH(); sub_gmlp(X, l); } { FRESH(); sub_gla_local(X, l); } { FRESH(); sub_dsa_select(X); } } \
        SEAM(); \
        if (IN()) { { FRESH(); sub_gla_scan(X); } { FRESH(); sub_dsa_attn(X); } } \
        SEAM(); \
        if (IN()) { FRESH(); sub_gla_out(X, l); } \
        SEAM(); \
        if (IN()) { \
            FRESH(); \
            SchedMerge S{X.G, X.c, (const char*)WSP(bf16_t, WS_Y), (const char*)WSP(bf16_t, WS_WBR)}; \
            EpiMerge E{WSP(bf16_t, WS_PROJ), X.in[18] + (size_t)l * 3072, WSP(float, WS_SCR), WSP(bf16_t, WS_H)}; \
            pg8::gemm_phase(X.lds, X.tid, YW, YW, 8, S, E); \
        } \
        SEAM(); \
        if (IN()) { \
            FRESH(); \
            SchedStatic S{64, 4, X.G, X.c, (const char*)WSP(bf16_t, WS_H), (const char*)WSP(bf16_t, WS_WOUT), (size_t)256 * 1024 * 2, (size_t)256 * 1024 * 2}; \
            EpiOut E{X.out, WSP(float, WS_MOD) + (size_t)l * NB * 6144 + 2048}; \
            pg8::gemm_phase(X.lds, X.tid, 1024, 1024, 16, S, E); \
        } \
        SEAM(); \
        if (IN()) { FRESH(); phase_norm2(X, l); } \
        SEAM(); \
        if (IN()) { FRESH(); phase_scatter(X); } \
        SEAM(); \
        if (IN()) { \
            FRESH(); \
            LAS int* tb = (LAS int*)(X.lds + AUX_OFF + 2048); LAS int* myoff = (LAS int*)(X.lds + AUX_OFF + 1024); \
            build_tiles(X, tb, myoff); \
            SchedMoe S{X.G, X.c, 1, tb[0], tb + 64, tb + 256, (const char*)WSP(bf16_t, WS_H2S), (const char*)WSP(bf16_t, WS_WE1), (size_t)256 * 1024 * 2, (size_t)512 * 1024 * 2, (size_t)256 * 1024 * 2}; \
            EpiMoe1 E{WSP(bf16_t, WS_ACT), WSP(float, WS_SW)}; \
            pg8::gemm_phase(X.lds, X.tid, 1024, 1024, 16, S, E); \
        } \
        SEAM(); \
        if (IN()) { \
            FRESH(); \
            LAS int* tb = (LAS int*)(X.lds + AUX_OFF + 2048); LAS int* myoff = (LAS int*)(X.lds + AUX_OFF + 1024); \
            build_tiles(X, tb, myoff); \
            SchedMoe S{X.G, X.c, 2, tb[0], tb + 64, tb + 256, (const char*)WSP(bf16_t, WS_ACT), (const char*)WSP(bf16_t, WS_WE2), (size_t)256 * 256 * 2, (size_t)1024 * 256 * 2, (size_t)256 * 256 * 2}; \
            EpiMoe2 E{WSP(bf16_t, WS_FFN)}; \
            pg8::gemm_phase(X.lds, X.tid, 256, 256, 4, S, E); \
        } \
        SEAM(); \
 \
    } while (0)
    LAYER_BODY(0); LAYER_BODY(1); LAYER_BODY(2); LAYER_BODY(3);
    if (IN()) { FRESH(); phase_norm1(X, NL, 2); }
#undef IN
#undef SEAM
}

constexpr int N_PHASES = 1 + NL * 11 + 1;

extern "C" void kernel_launch(void* const* d_in, const int* in_sizes, int n_in, void* d_out, int out_size, void* d_ws, size_t ws_size, hipStream_t stream) {
    static int grid = 0;
    if (grid == 0) {
        if (n_in != 27 || out_size != T * D || ws_size < WS_END) { fprintf(stderr, "kernel_launch: unexpected problem (n_in %d, out %d, ws %zu, need %zu)\n", n_in, out_size, ws_size, (size_t)WS_END); grid = -1; return; }
        int dev = 0, cus = 0, per_cu = 0;
        if (hipGetDevice(&dev) != hipSuccess || hipDeviceGetAttribute(&cus, hipDeviceAttributeMultiprocessorCount, dev) != hipSuccess) { grid = -1; return; }
        if (hipFuncSetAttribute((const void*)fwd_kernel, hipFuncAttributeMaxDynamicSharedMemorySize, LDS_BYTES) != hipSuccess) { fprintf(stderr, "kernel_launch: hipFuncSetAttribute failed\n"); grid = -1; return; }
        if (hipOccupancyMaxActiveBlocksPerMultiprocessor(&per_cu, (const void*)fwd_kernel, 512, LDS_BYTES) != hipSuccess || per_cu < 1) fprintf(stderr, "kernel_launch: occupancy query says %d\n", per_cu);
        (void)hipGetLastError();
        grid = cus;
    }
    if (grid < 0) return;
    (void)hipMemsetAsync((char*)d_ws + WS_CTL, 0, XCD_BAR_WORDS * sizeof(unsigned), stream);
    Params p{};
    for (int i = 0; i < 27; ++i) p.in[i] = (const float*)d_in[i];
    p.out = (float*)d_out; p.ws = (unsigned char*)d_ws;
#if N_LAUNCH_MODE == 1
    p.ph_lo = 0; p.ph_hi = N_PHASES;
    hipLaunchKernelGGL(fwd_kernel, dim3(grid), dim3(512), LDS_BYTES, stream, p);
#else
    for (int ph = 0; ph < N_PHASES; ++ph) { p.ph_lo = ph; p.ph_hi = ph + 1; hipLaunchKernelGGL(fwd_kernel, dim3(grid), dim3(512), LDS_BYTES, stream, p); }
#endif
}
```

```cpp
#include <hip/hip_runtime.h>
#include <stdint.h>
#include <stdio.h>

#ifndef N_LAUNCH_MODE
#define N_LAUNCH_MODE 1
#endif

#define LAS __attribute__((address_space(3)))
#define CAS __attribute__((address_space(4)))
typedef unsigned short bf16_t;
typedef short bf16x8 __attribute__((ext_vector_type(8)));
typedef float f32x2 __attribute__((ext_vector_type(2)));
typedef float f32x4 __attribute__((ext_vector_type(4)));
typedef float f32x16 __attribute__((ext_vector_type(16)));
typedef unsigned u32x2 __attribute__((ext_vector_type(2)));
typedef unsigned u32x4 __attribute__((ext_vector_type(4)));

constexpr int NB = 4, SEQ = 4096, T = NB * SEQ, D = 1024, NL = 4;
constexpr int NIN = 7508, NP = 7680;
constexpr int C_AU = 0, C_AV = 512, C_GQ = 1024, C_GK = 1280, C_GV = 1536, C_GR = 2048, C_DQ = 2560, C_DK = 3072, C_DV = 3584,
              C_IQ = 4096, C_IK = 4352, C_GA = 4416, C_IW = 4432, C_GATE = 4608;
constexpr int YW = 1536;
constexpr int MOE_ROWS = 32768 + 16 * 256;
constexpr float EPS = 1e-6f;

constexpr size_t WS_CTL = 0;
constexpr size_t WS_CNT = 16384;
constexpr size_t WS_MOD = 65536;
constexpr size_t WS_WIN = WS_MOD + 524288;
constexpr size_t WS_WBR = WS_WIN + (size_t)NP * 1024 * 2;
constexpr size_t WS_WOUT = WS_WBR + (size_t)1024 * 1536 * 2;
constexpr size_t WS_WE1 = WS_WOUT + (size_t)1024 * 1024 * 2;
constexpr size_t WS_WE2 = WS_WE1 + (size_t)16 * 512 * 1024 * 2;
constexpr size_t WS_WS = WS_WE2 + (size_t)16 * 1024 * 256 * 2;
constexpr size_t WS_H = WS_WS + (size_t)4 * 128 * 128 * 2;
constexpr size_t WS_PROJ = WS_H + (size_t)T * 1024 * 2;
constexpr size_t WS_Y = WS_PROJ + (size_t)T * NP * 2;
constexpr size_t WS_SCR = WS_Y + (size_t)T * YW * 2;
constexpr size_t WS_MASK = WS_SCR + (size_t)T * 1024 * 4;
constexpr size_t WS_VT = WS_MASK + (size_t)T * 64 * 8;
constexpr size_t WS_TOKE = WS_VT + (size_t)16 * 128 * 4096 * 2;
constexpr size_t WS_TOKW = WS_TOKE + (size_t)T * 8;
constexpr size_t WS_TOKS = WS_TOKW + (size_t)T * 8;
constexpr size_t WS_DEC = WS_TOKS + (size_t)T * 8;
constexpr size_t WS_SW = WS_DEC + (size_t)1024 * 64 * 4;
constexpr size_t WS_END = WS_SW + (size_t)MOE_ROWS * 4;
constexpr size_t WS_H2S = WS_PROJ;
constexpr size_t WS_ACT = WS_H2S + (size_t)MOE_ROWS * 1024 * 2;
constexpr size_t WS_FFN = WS_ACT + (size_t)MOE_ROWS * 256 * 2;
static_assert(WS_FFN + (size_t)MOE_ROWS * 1024 * 2 <= WS_Y, "moe alias");

constexpr int LDS_BYTES = 147456;
constexpr int AUX_OFF = 131072;

__device__ __forceinline__ float bf2f(bf16_t v) { return __uint_as_float(((unsigned)v) << 16); }
__device__ __forceinline__ unsigned cvt_pk_bf16(float lo, float hi) { unsigned r; asm volatile("v_cvt_pk_bf16_f32 %0, %1, %2" : "=v"(r) : "v"(lo), "v"(hi)); return r; }
__device__ __forceinline__ bf16_t f2bf(float f) { return (bf16_t)(cvt_pk_bf16(f, 0.f) & 0xffffu); }
__device__ __forceinline__ float lo_bf(unsigned w) { return __uint_as_float(w << 16); }
__device__ __forceinline__ float hi_bf(unsigned w) { return __uint_as_float(w & 0xffff0000u); }
__device__ __forceinline__ float wave_sum(float v) {
#pragma unroll
    for (int o = 32; o >= 1; o >>= 1) v += __shfl_xor(v, o);
    return v;
}
__device__ __forceinline__ float fast_exp(float x) { return __builtin_amdgcn_exp2f(x * 1.4426950408889634f); }
__device__ __forceinline__ float sigmoidf_(float x) { return __builtin_amdgcn_rcpf(1.f + fast_exp(-x)); }
__device__ __forceinline__ float gelu_tanh(float x) { const float u = x + 0.044715f * x * x * x; return x * __builtin_amdgcn_rcpf(1.f + __builtin_amdgcn_exp2f(-2.3022082f * u)); }

#define XB_TMO      128
#define XB_XCNT(j)  (256  + 64 * (j))
#define XB_XSUB(j)  (1280 + 64 * (j))
#define XB_XGEN(j)  (2304 + 64 * (j))
#define XB_TOP      3328
#define XB_TOPGEN   3392
#define XCD_BAR_WORDS 3456
#define XB_SPIN_CAP (1u << 22)
__device__ __forceinline__ unsigned xb_ld(unsigned* p)              { return __hip_atomic_load(p, __ATOMIC_RELAXED, __HIP_MEMORY_SCOPE_AGENT); }
__device__ __forceinline__ unsigned xb_add(unsigned* p, unsigned v) { return __hip_atomic_fetch_add(p, v, __ATOMIC_RELAXED, __HIP_MEMORY_SCOPE_AGENT); }
__device__ __forceinline__ unsigned xb_xcc_id() { return (unsigned)__builtin_amdgcn_s_getreg((3 << 11) | 20) & 0xFu; }
#define XB_SPIN(cond, bar) do { unsigned _sp = 0; while (cond) { __builtin_amdgcn_s_sleep(1); \
    if ((++_sp & 255u) == 0u) { if (xb_ld(&(bar)[XB_TMO])) break; if (_sp > XB_SPIN_CAP) { atomicAdd(&(bar)[XB_TMO], 1u); break; } } } } while (0)
struct XcdBarrier { unsigned* bar; unsigned x; volatile LAS unsigned* st; };
__device__ __forceinline__ XcdBarrier xcd_barrier_post(unsigned* bar, volatile LAS unsigned* st) {
    XcdBarrier b; b.bar = bar; b.x = xb_xcc_id(); b.st = st;
    if (threadIdx.x == 0) (void)xb_add(&bar[XB_XCNT(b.x)], 1u);
    return b;
}
__device__ __forceinline__ void xcd_barrier_complete(unsigned* bar, unsigned x, unsigned& nloc, unsigned& nx) {
    const unsigned G = gridDim.x * gridDim.y * gridDim.z;
    unsigned sum, cnt, mine, sp = 0u;
    for (;;) {
        sum = 0u; cnt = 0u; mine = 0u;
#pragma unroll
        for (unsigned j = 0; j < 16; ++j) { const unsigned c = xb_ld(&bar[XB_XCNT(j)]); sum += c; cnt += (c > 0u) ? 1u : 0u; mine = (j == x) ? c : mine; }
        if (sum == G) break;
        __builtin_amdgcn_s_sleep(1);
        if ((++sp & 255u) == 0u) { if (xb_ld(&bar[XB_TMO])) break; if (sp > XB_SPIN_CAP) { atomicAdd(&bar[XB_TMO], 1u); break; } }
    }
    nloc = mine > 0u ? mine : 1u; nx = cnt > 0u ? cnt : 1u;
}
__device__ __forceinline__ void xcd_barrier(const XcdBarrier& b) {
    asm volatile("s_waitcnt vmcnt(0)" ::: "memory");
    __syncthreads();
    if (threadIdx.x == 0) {
        unsigned* bar = b.bar;
        __builtin_amdgcn_s_waitcnt(0);
        unsigned nloc = b.st[0], nx = b.st[1];
        if (nloc == 0u) { xcd_barrier_complete(bar, b.x, nloc, nx); b.st[0] = nloc; b.st[1] = nx; }
        const unsigned old = xb_add(&bar[XB_XSUB(b.x)], 1u);
        const unsigned gen = old / nloc;
        if (old + 1u == (gen + 1u) * nloc) {
            __builtin_amdgcn_fence(__ATOMIC_RELEASE, "agent");
            asm volatile("s_waitcnt vmcnt(0)" ::: "memory");
            const unsigned og = xb_add(&bar[XB_TOP], 1u);
            const unsigned tg = og / nx;
            if (og + 1u == (tg + 1u) * nx) xb_add(&bar[XB_TOPGEN], 1u);
            else XB_SPIN(xb_ld(&bar[XB_TOPGEN]) == tg, bar);
            __builtin_amdgcn_fence(__ATOMIC_ACQUIRE, "agent");
            xb_add(&bar[XB_XGEN(b.x)], 1u);
            asm volatile("s_waitcnt vmcnt(0)" ::: "memory");
        } else {
            XB_SPIN(xb_ld(&bar[XB_XGEN(b.x)]) == gen, bar);
            __builtin_amdgcn_fence(__ATOMIC_ACQUIRE, "agent");
            asm volatile("s_waitcnt vmcnt(0)" ::: "memory");
        }
    }
    __syncthreads();
}

namespace pg8 {
constexpr int BM = 256, BK = 64, HALF = 128, HTB = HALF * BK * 2, STAGE_BYTES = 8 * HTB, NXCD = 8, WGM = 8;
__device__ __forceinline__ int lds_byte(int r, int c) { const int st = (r >> 4) * 2 + (c >> 5), rr = r & 15, cc = c & 31, ob = rr * 64 + cc * 2; return st * 1024 + (ob ^ (((ob >> 9) & 1) << 5)); }
__device__ __forceinline__ void stage_rc(int b, int& R, int& C) { const int st = b / 1024, sb = b % 1024, swz = sb ^ (((sb >> 9) & 1) << 5); R = (st >> 1) * 16 + swz / 64; C = (st & 1) * 32 + (swz % 64) / 2; }
__device__ __forceinline__ int perm32(int rho) { const int n = rho >> 4, i = rho & 15; return 8 * (i >> 2) + 4 * n + (i & 3); }

struct Unit { int pm, pn, aux; const char* A; const char* B; };
__device__ __forceinline__ void tile_of(int L, int nM, int nN, int& pm, int& pn) {
    const int nwg = nM * nN; int wgid = L;
    { const int q = nwg / NXCD, r = nwg % NXCD, xcd = wgid % NXCD, off = wgid / NXCD; wgid = (xcd < r ? xcd * (q + 1) : r * (q + 1) + (xcd - r) * q) + off; }
    const int nig = WGM * nN, gid = wgid / nig, fm = gid * WGM, gsz = (nM - fm) < WGM ? (nM - fm) : WGM;
    pm = fm + ((wgid % nig) % gsz); pn = (wgid % nig) / gsz;
}

template <class Epi, class Sched>
__device__ __forceinline__ void gemm_phase(LAS unsigned char* lds, const int tid, const int lda, const int ldb, const int nt, const Sched& S, const Epi& E) {
    const int wid = __builtin_amdgcn_readfirstlane(tid >> 6), lane = tid & 63, wr = wid >> 2, wc = wid & 3, fr = lane & 15, fq = lane >> 4;
    unsigned voffA[2], voffB[2];
#pragma unroll
    for (int i = 0; i < 2; ++i) { int R, C; stage_rc(tid * 16 + i * 8192, R, C); const int Rb = Epi::PERM ? ((R & ~31) + perm32(R & 31)) : R;
        voffA[i] = (unsigned)(R * lda + C) * 2u; voffB[i] = (unsigned)(Rb * ldb + C) * 2u; }
    const size_t kstep = (size_t)(BK * 2);
    const size_t hstepA = (size_t)HALF * lda * 2, hstepB = (size_t)HALF * ldb * 2;
    const unsigned ldsw = (unsigned)wid * 1024u;
    const int aoff = lds_byte(wr * 64 + fr, fq * 8), boff = lds_byte(wc * 32 + fr, fq * 8);
#define PG8_SA(b, h) (((b) * 2 + (h)) * HTB)
#define PG8_SB(b, h) ((4 + (b) * 2 + (h)) * HTB)
#define PG8_STAGE(bufoff, gbase, voff) do { _Pragma("unroll") for (int _i = 0; _i < 2; ++_i) \
        __builtin_amdgcn_global_load_lds((const unsigned*)((const char*)(gbase) + (voff)[_i]), (LAS unsigned*)(lds + (bufoff) + ldsw + _i * 8192), 16, 0, 0); } while (0)
#define PG8_LDA(dst, b, h) do { _Pragma("unroll") for (int m = 0; m < 4; ++m) _Pragma("unroll") for (int k = 0; k < 2; ++k) dst[m][k] = *(const LAS bf16x8*)(lds + PG8_SA(b, h) + aoff + m * 2048 + k * 1024); } while (0)
#define PG8_LDB(dst, b, h) do { _Pragma("unroll") for (int n = 0; n < 2; ++n) _Pragma("unroll") for (int k = 0; k < 2; ++k) dst[n][k] = *(const LAS bf16x8*)(lds + PG8_SB(b, h) + boff + n * 2048 + k * 1024); } while (0)
#define PG8_MMA(ai, bj, At, Bt) do { __builtin_amdgcn_s_setprio(1); _Pragma("unroll") for (int m = 0; m < 4; ++m) _Pragma("unroll") for (int n = 0; n < 2; ++n) _Pragma("unroll") for (int k = 0; k < 2; ++k) \
        acc[ai][bj][m][n] = __builtin_amdgcn_mfma_f32_16x16x32_bf16(Bt[n][k], At[m][k], acc[ai][bj][m][n], 0, 0, 0); __builtin_amdgcn_s_setprio(0); } while (0)
#define PG8_WAIT_V(n) asm volatile("s_waitcnt vmcnt(" #n ")" ::: "memory")
#define PG8_WAIT_L(n) asm volatile("s_waitcnt lgkmcnt(" #n ")" ::: "memory")
#define PG8_BAR __builtin_amdgcn_s_barrier()
#define PG8_SCHED __builtin_amdgcn_sched_barrier(0)
    Unit cur, nxt; int ui = 0;
    if (!S.next(0, cur)) return;
    f32x4 acc[2][2][4][2];
#pragma unroll
    for (int a = 0; a < 2; ++a)
#pragma unroll
        for (int b = 0; b < 2; ++b)
#pragma unroll
            for (int m = 0; m < 4; ++m)
#pragma unroll
                for (int n = 0; n < 2; ++n) acc[a][b][m][n] = (f32x4){0.f, 0.f, 0.f, 0.f};
    bf16x8 At[4][2], B0[2][2], B1[2][2];
    const char* cA = cur.A; const char* cB = cur.B;
    PG8_STAGE(PG8_SB(0, 0), cB, voffB); PG8_STAGE(PG8_SA(0, 0), cA, voffA); PG8_STAGE(PG8_SB(0, 1), cB + hstepB, voffB); PG8_STAGE(PG8_SA(0, 1), cA + hstepA, voffA);
    if (wr == 1) PG8_BAR;
    PG8_WAIT_V(4); PG8_BAR;
    PG8_STAGE(PG8_SB(1, 0), cB + kstep, voffB); PG8_STAGE(PG8_SA(1, 0), cA + kstep, voffA); PG8_STAGE(PG8_SB(1, 1), cB + hstepB + kstep, voffB);
    PG8_WAIT_V(6); PG8_BAR;
    for (;;) {
        const bool has_next = S.next(ui + 1, nxt);
        const char* nA = has_next ? nxt.A : cA; const char* nB = has_next ? nxt.B : cB;
        for (int t = 0; t < nt; t += 2) {
            const bool last = (t == nt - 2);
            const char* a1 = cA + (size_t)(t + 1) * kstep;
            const char* a2 = last ? nA : cA + (size_t)(t + 2) * kstep; const char* b2 = last ? nB : cB + (size_t)(t + 2) * kstep;
            const char* a3 = a2 + kstep; const char* b3 = b2 + kstep;
            PG8_LDB(B0, 0, 0); PG8_SCHED; PG8_LDA(At, 0, 0); PG8_STAGE(PG8_SA(1, 1), a1 + hstepA, voffA);
            PG8_WAIT_L(8); PG8_BAR; PG8_WAIT_L(0); PG8_MMA(0, 0, At, B0); PG8_BAR; PG8_SCHED;
            PG8_LDB(B1, 0, 1); PG8_STAGE(PG8_SB(0, 0), b2, voffB);
            PG8_BAR; PG8_WAIT_L(0); PG8_MMA(0, 1, At, B1); PG8_BAR;
            PG8_LDA(At, 0, 1); PG8_STAGE(PG8_SA(0, 0), a2, voffA);
            PG8_BAR; PG8_WAIT_L(0); PG8_MMA(1, 0, At, B0); PG8_BAR; PG8_SCHED;
            PG8_STAGE(PG8_SB(0, 1), b2 + hstepB, voffB);
            PG8_WAIT_V(6); PG8_BAR; PG8_MMA(1, 1, At, B1); PG8_BAR;
            PG8_LDB(B0, 1, 0); PG8_SCHED; PG8_LDA(At, 1, 0); PG8_STAGE(PG8_SA(0, 1), a2 + hstepA, voffA);
            PG8_WAIT_L(8); PG8_BAR; PG8_WAIT_L(0); PG8_MMA(0, 0, At, B0); PG8_BAR; PG8_SCHED;
            PG8_LDB(B1, 1, 1); PG8_STAGE(PG8_SB(1, 0), b3, voffB);
            PG8_BAR; PG8_WAIT_L(0); PG8_MMA(0, 1, At, B1); PG8_BAR;
            PG8_LDA(At, 1, 1); PG8_STAGE(PG8_SA(1, 0), a3, voffA);
            PG8_BAR; PG8_WAIT_L(0); PG8_MMA(1, 0, At, B0); PG8_BAR; PG8_SCHED;
            PG8_STAGE(PG8_SB(1, 1), b3 + hstepB, voffB);
            PG8_WAIT_V(6); PG8_BAR; PG8_MMA(1, 1, At, B1); PG8_BAR;
        }
        E(acc, cur, wr, wc, fr, fq);
        if (!has_next) break;
#pragma unroll
        for (int a = 0; a < 2; ++a)
#pragma unroll
            for (int b = 0; b < 2; ++b)
#pragma unroll
                for (int m = 0; m < 4; ++m)
#pragma unroll
                    for (int n = 0; n < 2; ++n) acc[a][b][m][n] = (f32x4){0.f, 0.f, 0.f, 0.f};
        cur = nxt; cA = nA; cB = nB; ++ui;
    }
    PG8_WAIT_V(0);
    if (wr == 0) PG8_BAR;
    PG8_BAR;
#undef PG8_SA
#undef PG8_SB
#undef PG8_STAGE
#undef PG8_LDA
#undef PG8_LDB
#undef PG8_MMA
#undef PG8_WAIT_V
#undef PG8_WAIT_L
#undef PG8_BAR
#undef PG8_SCHED
}
}
using pg8::Unit;

struct Params { const float* in[27]; float* out; unsigned char* ws; int ph_lo, ph_hi; };
struct Ctx {
    const float* const CAS* in; float* out; unsigned char* ws; LAS unsigned char* lds;
    int tid, lane, wave, G, c;
};
#define WSP(T_, off) ((T_*)(X.ws + (off)))

struct SchedStatic {
    int nM, nN, G, c; const char* A; const char* B; size_t tA, tB;
    __device__ __forceinline__ bool next(int i, Unit& u) const {
        const long L = (long)i * G + c; if (L >= (long)nM * nN) return false;
        pg8::tile_of((int)L, nM, nN, u.pm, u.pn); u.aux = 0; u.A = A + (size_t)u.pm * tA; u.B = B + (size_t)u.pn * tB; return true;
    }
};
struct SchedMerge {
    int G, c; const char* A; const char* B;
    __device__ __forceinline__ bool next(int i, Unit& u) const {
        const int q = i / 3, n = i - 3 * q; const long L = (long)q * G + c; if (L >= 64 * 4) return false;
        pg8::tile_of((int)L, 64, 4, u.pm, u.pn); u.aux = n;
        u.A = A + ((size_t)u.pm * 256 * YW + 512 * n) * 2; u.B = B + ((size_t)u.pn * 256 * YW + 512 * n) * 2; return true;
    }
};
struct SchedMoe {
    int G, c, ncol_shift, nT; const LAS int* tile_e; const LAS int* tile_pm; const char* A; const char* B; size_t tA, eB, tB;
    __device__ __forceinline__ bool next(int i, Unit& u) const {
        const long L = (long)i * G + c; if (L >= ((long)nT << ncol_shift)) return false;
        const int rt = (int)(L >> ncol_shift); u.pn = (int)(L & ((1 << ncol_shift) - 1)); u.pm = tile_pm[rt]; u.aux = tile_e[rt];
        u.A = A + (size_t)u.pm * tA; u.B = B + (size_t)u.aux * eB + (size_t)u.pn * tB; return true;
    }
};

struct EpiProj { static constexpr bool PERM = true; bf16_t* O;
    __device__ __forceinline__ void operator()(const f32x4 (&acc)[2][2][4][2], const Unit& u, int wr, int wc, int fr, int fq) const {
        const int row0 = u.pm * 256 + wr * 64 + fr, col0 = u.pn * 256 + wc * 32 + 8 * fq; const bool act = u.pn < 4;
#pragma unroll
        for (int ai = 0; ai < 2; ++ai)
#pragma unroll
            for (int m = 0; m < 4; ++m) { bf16_t* rowp = O + (size_t)(row0 + ai * 128 + m * 16) * NP + col0;
#pragma unroll
                for (int bj = 0; bj < 2; ++bj) { f32x4 v0 = acc[ai][bj][m][0], v1 = acc[ai][bj][m][1];
                    if (act) {
#pragma unroll
                        for (int j = 0; j < 4; ++j) { v0[j] = gelu_tanh(v0[j]); v1[j] = gelu_tanh(v1[j]); } }
                    u32x4 w; w.x = cvt_pk_bf16(v0[0], v0[1]); w.y = cvt_pk_bf16(v0[2], v0[3]); w.z = cvt_pk_bf16(v1[0], v1[1]); w.w = cvt_pk_bf16(v1[2], v1[3]);
                    *(u32x4*)(rowp + bj * 128) = w; } }
    }
};
struct EpiMerge { static constexpr bool PERM = false; const bf16_t* proj; const float* bgate; float* mf; bf16_t* mb;
    __device__ __forceinline__ void operator()(const f32x4 (&acc)[2][2][4][2], const Unit& u, int wr, int wc, int fr, int fq) const {
        const int row0 = u.pm * 256 + wr * 64 + fr, col0 = u.pn * 256 + wc * 32 + 4 * fq, n3 = u.aux;
#pragma unroll
        for (int ai = 0; ai < 2; ++ai)
#pragma unroll
            for (int m = 0; m < 4; ++m) { const int r = row0 + ai * 128 + m * 16;
#pragma unroll
                for (int bj = 0; bj < 2; ++bj)
#pragma unroll
                    for (int n = 0; n < 2; ++n) { const int c = col0 + bj * 128 + n * 16;
                        const u32x2 gw = *(const u32x2*)(proj + (size_t)r * NP + C_GATE + n3 * 1024 + c);
                        const f32x4 bg = *(const f32x4*)(bgate + n3 * 1024 + c);
                        f32x4 g; g[0] = sigmoidf_(lo_bf(gw.x) + bg[0]); g[1] = sigmoidf_(hi_bf(gw.x) + bg[1]); g[2] = sigmoidf_(lo_bf(gw.y) + bg[2]); g[3] = sigmoidf_(hi_bf(gw.y) + bg[3]);
                        f32x4 v = g * acc[ai][bj][m][n];
                        float* p = mf + (size_t)r * 1024 + c;
                        if (n3 == 0) { *(f32x4*)p = v; }
                        else if (n3 == 1) { v += *(const f32x4*)p; *(f32x4*)p = v; }
                        else { v += *(const f32x4*)p; u32x2 w; w.x = cvt_pk_bf16(v[0], v[1]); w.y = cvt_pk_bf16(v[2], v[3]); *(u32x2*)(mb + (size_t)r * 1024 + c) = w; } } }
    }
};
struct EpiOut { static constexpr bool PERM = false; float* out; const float* gt;
    __device__ __forceinline__ void operator()(const f32x4 (&acc)[2][2][4][2], const Unit& u, int wr, int wc, int fr, int fq) const {
        const int row0 = u.pm * 256 + wr * 64 + fr, col0 = u.pn * 256 + wc * 32 + 4 * fq; const float* g = gt + (size_t)(u.pm >> 4) * 6144;
#pragma unroll
        for (int ai = 0; ai < 2; ++ai)
#pragma unroll
            for (int m = 0; m < 4; ++m) { const int r = row0 + ai * 128 + m * 16;
#pragma unroll
                for (int bj = 0; bj < 2; ++bj)
#pragma unroll
                    for (int n = 0; n < 2; ++n) { const int c = col0 + bj * 128 + n * 16; float* p = out + (size_t)r * 1024 + c;
                        const f32x4 gv = *(const f32x4*)(g + c); *(f32x4*)p = *(const f32x4*)p + gv * acc[ai][bj][m][n]; } }
    }
};
struct EpiMoe1 { static constexpr bool PERM = true; bf16_t* act; const float* sw;
    __device__ __forceinline__ void operator()(const f32x4 (&acc)[2][2][4][2], const Unit& u, int wr, int wc, int fr, int fq) const {
        const int row0 = u.pm * 256 + wr * 64 + fr, col0 = u.pn * 128 + wc * 32 + 8 * fq;
#pragma unroll
        for (int ai = 0; ai < 2; ++ai)
#pragma unroll
            for (int m = 0; m < 4; ++m) { const int r = row0 + ai * 128 + m * 16; const float w = sw[r]; float o[8];
#pragma unroll
                for (int n = 0; n < 2; ++n)
#pragma unroll
                    for (int j = 0; j < 4; ++j) { const float g = acc[ai][0][m][n][j], up = acc[ai][1][m][n][j]; o[4 * n + j] = g * sigmoidf_(g) * up * w; }
                u32x4 pk; pk.x = cvt_pk_bf16(o[0], o[1]); pk.y = cvt_pk_bf16(o[2], o[3]); pk.z = cvt_pk_bf16(o[4], o[5]); pk.w = cvt_pk_bf16(o[6], o[7]);
                *(u32x4*)(act + (size_t)r * 256 + col0) = pk; }
    }
};
struct EpiMoe2 { static constexpr bool PERM = true; bf16_t* O;
    __device__ __forceinline__ void operator()(const f32x4 (&acc)[2][2][4][2], const Unit& u, int wr, int wc, int fr, int fq) const {
        const int row0 = u.pm * 256 + wr * 64 + fr, col0 = u.pn * 256 + wc * 32 + 8 * fq;
#pragma unroll
        for (int ai = 0; ai < 2; ++ai)
#pragma unroll
            for (int m = 0; m < 4; ++m) { bf16_t* rowp = O + (size_t)(row0 + ai * 128 + m * 16) * 1024 + col0;
#pragma unroll
                for (int bj = 0; bj < 2; ++bj) { const f32x4 v0 = acc[ai][bj][m][0], v1 = acc[ai][bj][m][1];
                    u32x4 w; w.x = cvt_pk_bf16(v0[0], v0[1]); w.y = cvt_pk_bf16(v0[2], v0[3]); w.z = cvt_pk_bf16(v1[0], v1[1]); w.w = cvt_pk_bf16(v1[2], v1[3]);
                    *(u32x4*)(rowp + bj * 128) = w; } }
    }
};

__device__ __forceinline__ void phase_mod(const Ctx& X) {
    LAS float* sc = (LAS float*)X.lds;
    LAS float* red = (LAS float*)(X.lds + 16384);
    const float* c = X.in[1]; const float* wm = X.in[2]; const float* bm = X.in[3]; float* mod = WSP(float, WS_MOD);
    for (int i = X.tid; i < 4096; i += 512) { const float v = c[i]; sc[i] = v * sigmoidf_(v); }
    __syncthreads();
    const int jj = X.tid & 63, ks = X.tid >> 6;
    for (int u = X.c; u < NL * 96; u += X.G) {
        const int l = u / 96, j0 = (u % 96) * 64;
        float a0 = 0.f, a1 = 0.f, a2 = 0.f, a3 = 0.f;
        const float* wp = wm + ((size_t)l * 1024 + ks * 128) * 6144 + j0 + jj;
#pragma unroll 8
        for (int k = 0; k < 128; ++k) { const float w = wp[(size_t)k * 6144]; const int kk = ks * 128 + k;
            a0 += sc[kk] * w; a1 += sc[1024 + kk] * w; a2 += sc[2048 + kk] * w; a3 += sc[3072 + kk] * w; }
        red[(ks * 64 + jj) * 4 + 0] = a0; red[(ks * 64 + jj) * 4 + 1] = a1; red[(ks * 64 + jj) * 4 + 2] = a2; red[(ks * 64 + jj) * 4 + 3] = a3;
        __syncthreads();
        if (X.tid < 256) { const int b = X.tid >> 6; float s = bm[l * 6144 + j0 + jj];
#pragma unroll
            for (int q = 0; q < 8; ++q) s += red[(q * 64 + jj) * 4 + b];
            mod[((size_t)l * NB + b) * 6144 + j0 + jj] = s; }
        __syncthreads();
    }
}

__device__ __forceinline__ int wincol(int m) {
    if (m < 2560) return m;
    if (m < 4416) return m + 16;
    if (m < 4432) return 2560 + (m - 4416);
    if (m < 4436) return m;
    if (m < 4608) return -1;
    return 4436 + (m - 4608);
}
__device__ __forceinline__ void phase_conv(const Ctx& X, int l) {
    LAS float* tile = (LAS float*)X.lds;
    const int c = X.tid & 63, r0 = X.tid >> 6;
    constexpr int J0 = 1920, J1 = J0 + 384, J2 = J1 + 256, J3 = J2 + 2048, J4 = J3 + 1024, J5 = J4 + 16;
    for (int j = X.c; j < J5; j += X.G) {
        if (j >= J4) {
            const int q = j - J4; const float* src = X.in[9] + (size_t)l * 65536; bf16_t* dst = WSP(bf16_t, WS_WS);
            for (int i = X.tid; i < 4096; i += 512) { const int e = q * 4096 + i, t = (e >> 7) & 127, s = e & 127; dst[e] = f2bf(s <= t ? src[e] : 0.f); }
            continue;
        }
        const float* sp; int sld, scol; bf16_t* dp; int dld;
        if (j < J0) { const int nt = j >> 4, kt = j & 15; sp = X.in[6] + ((size_t)l * 1024 + kt * 64) * NIN; sld = NIN; scol = wincol(nt * 64 + c);
            dp = WSP(bf16_t, WS_WIN) + (size_t)(nt * 64) * 1024 + kt * 64; dld = 1024; }
        else if (j < J1) { const int q = j - J0, n = q >> 7, dt = (q >> 3) & 15, et = q & 7;
            sp = X.in[17] + (((size_t)l * 3 + n) * 512 + et * 64) * 1024; sld = 1024; scol = dt * 64 + c;
            dp = WSP(bf16_t, WS_WBR) + (size_t)(dt * 64) * YW + n * 512 + et * 64; dld = YW; }
        else if (j < J2) { const int q = j - J1, nt = q >> 4, kt = q & 15;
            sp = X.in[19] + ((size_t)l * 1024 + kt * 64) * 1024; sld = 1024; scol = nt * 64 + c;
            dp = WSP(bf16_t, WS_WOUT) + (size_t)(nt * 64) * 1024 + kt * 64; dld = 1024; }
        else if (j < J3) { const int q = j - J2, e = q >> 7, rt = (q >> 4) & 7, kt = q & 15; const int n0 = rt * 64, pn = n0 >> 8, half = (n0 >> 7) & 1;
            sp = (half ? X.in[25] : X.in[24]) + (((size_t)l * 16 + e) * 1024 + kt * 64) * 256; sld = 256; scol = 128 * pn + (n0 & 127) + c;
            dp = WSP(bf16_t, WS_WE1) + ((size_t)e * 512 + n0) * 1024 + kt * 64; dld = 1024; }
        else { const int q = j - J3, e = q >> 6, dt = (q >> 2) & 15, kt = q & 3;
            sp = X.in[26] + (((size_t)l * 16 + e) * 256 + kt * 64) * 1024; sld = 1024; scol = dt * 64 + c;
            dp = WSP(bf16_t, WS_WE2) + ((size_t)e * 1024 + dt * 64) * 256 + kt * 64; dld = 256; }
#pragma unroll
        for (int i = 0; i < 8; ++i) { const int k = r0 + 8 * i; tile[k * 65 + c] = scol >= 0 ? sp[(size_t)k * sld + scol] : 0.f; }
        __syncthreads();
#pragma unroll
        for (int i = 0; i < 8; ++i) { const int n = r0 + 8 * i; dp[(size_t)n * dld + c] = f2bf(tile[c * 65 + n]); }
        __syncthreads();
    }
}

__device__ __forceinline__ void phase_norm1(const Ctx& X, int l, int mode) {
    const float* xin = X.in[0]; float* out = X.out; const float* mod = WSP(float, WS_MOD);
    const bf16_t* ffn = WSP(bf16_t, WS_FFN); const int* toks = WSP(int, WS_TOKS); bf16_t* h = WSP(bf16_t, WS_H);
    const float* g1 = X.in[4] + (size_t)l * 1024;
    for (int r = X.c * 8 + X.wave; r < T; r += X.G * 8) {
        const int b = r >> 12;
        f32x4 xv[4];
        if (mode == 0) {
#pragma unroll
            for (int i = 0; i < 4; ++i) xv[i] = *(const f32x4*)(xin + (size_t)r * 1024 + 4 * X.lane + 256 * i);
        } else {
            const int s0 = toks[2 * r], s1 = toks[2 * r + 1];
            const float* gt2 = mod + ((size_t)(l - 1) * NB + b) * 6144 + 5120;
#pragma unroll
            for (int i = 0; i < 4; ++i) { const int col = 4 * X.lane + 256 * i;
                const f32x4 xo = *(const f32x4*)(out + (size_t)r * 1024 + col); const f32x4 g = *(const f32x4*)(gt2 + col);
                const u32x2 a = *(const u32x2*)(ffn + (size_t)s0 * 1024 + col), bb = *(const u32x2*)(ffn + (size_t)s1 * 1024 + col);
                f32x4 f; f[0] = lo_bf(a.x) + lo_bf(bb.x); f[1] = hi_bf(a.x) + hi_bf(bb.x); f[2] = lo_bf(a.y) + lo_bf(bb.y); f[3] = hi_bf(a.y) + hi_bf(bb.y);
                xv[i] = xo + g * f; }
        }
#pragma unroll
        for (int i = 0; i < 4; ++i) *(f32x4*)(out + (size_t)r * 1024 + 4 * X.lane + 256 * i) = xv[i];
        if (mode == 2) continue;
        float ss = 0.f;
#pragma unroll
        for (int i = 0; i < 4; ++i) ss += xv[i][0] * xv[i][0] + xv[i][1] * xv[i][1] + xv[i][2] * xv[i][2] + xv[i][3] * xv[i][3];
        ss = wave_sum(ss);
        const float rstd = __builtin_amdgcn_rsqf(ss * (1.f / 1024.f) + EPS);
        const float* md = mod + ((size_t)l * NB + b) * 6144;
#pragma unroll
        for (int i = 0; i < 4; ++i) { const int col = 4 * X.lane + 256 * i;
            const f32x4 g = *(const f32x4*)(g1 + col), sh = *(const f32x4*)(md + col), sc = *(const f32x4*)(md + 1024 + col);
            f32x4 y = xv[i] * rstd * g * (sc + 1.f) + sh;
            u32x2 w; w.x = cvt_pk_bf16(y[0], y[1]); w.y = cvt_pk_bf16(y[2], y[3]); *(u32x2*)(h + (size_t)r * 1024 + col) = w; }
    }
}

__device__ __forceinline__ void sub_qknorm(const Ctx& X, int l) {
    bf16_t* proj = WSP(bf16_t, WS_PROJ);
    const int j = X.lane >> 3, d0 = 16 * (X.lane & 7);
    const float* gp = (j < 4 ? X.in[14] : X.in[15]) + (size_t)l * 128 + d0;
    float g[16];
#pragma unroll
    for (int i = 0; i < 16; ++i) g[i] = gp[i];
    for (int r = X.c * 8 + X.wave; r < T; r += X.G * 8) {
        bf16_t* p = proj + (size_t)r * NP + C_DQ + 16 * X.lane;
        const u32x4 a = *(const u32x4*)p, b = *(const u32x4*)(p + 8);
        float v[16];
        v[0] = lo_bf(a.x); v[1] = hi_bf(a.x); v[2] = lo_bf(a.y); v[3] = hi_bf(a.y); v[4] = lo_bf(a.z); v[5] = hi_bf(a.z); v[6] = lo_bf(a.w); v[7] = hi_bf(a.w);
        v[8] = lo_bf(b.x); v[9] = hi_bf(b.x); v[10] = lo_bf(b.y); v[11] = hi_bf(b.y); v[12] = lo_bf(b.z); v[13] = hi_bf(b.z); v[14] = lo_bf(b.w); v[15] = hi_bf(b.w);
        float ss = 0.f;
#pragma unroll
        for (int i = 0; i < 16; ++i) ss += v[i] * v[i];
        ss += __shfl_xor(ss, 1); ss += __shfl_xor(ss, 2); ss += __shfl_xor(ss, 4);
        const float rstd = __builtin_amdgcn_rsqf(ss * (1.f / 128.f) + EPS);
#pragma unroll
        for (int i = 0; i < 16; ++i) v[i] = v[i] * rstd * g[i];
        u32x4 oa, ob;
        oa.x = cvt_pk_bf16(v[0], v[1]); oa.y = cvt_pk_bf16(v[2], v[3]); oa.z = cvt_pk_bf16(v[4], v[5]); oa.w = cvt_pk_bf16(v[6], v[7]);
        ob.x = cvt_pk_bf16(v[8], v[9]); ob.y = cvt_pk_bf16(v[10], v[11]); ob.z = cvt_pk_bf16(v[12], v[13]); ob.w = cvt_pk_bf16(v[14], v[15]);
        *(u32x4*)p = oa; *(u32x4*)(p + 8) = ob;
    }
}
__device__ __forceinline__ void sub_vtrans(const Ctx& X) {
    const bf16_t* proj = WSP(bf16_t, WS_PROJ); bf16_t* vt = WSP(bf16_t, WS_VT);
    LAS bf16_t* tile = (LAS bf16_t*)X.lds;
    for (int j = X.c; j < 2048; j += X.G) {
        const int bh = j >> 7, et = (j >> 6) & 1, st = j & 63, b = bh >> 2, hh = bh & 3;
        { const int s = X.tid >> 3, e8 = (X.tid & 7) * 8;
          const u32x4 v = *(const u32x4*)(proj + ((size_t)b * SEQ + st * 64 + s) * NP + C_DV + 128 * hh + et * 64 + e8);
          *(LAS u32x4*)(tile + s * 72 + e8) = v; }
        __syncthreads();
        { const int e = X.tid >> 3, s8 = (X.tid & 7) * 8; unsigned short q[8];
#pragma unroll
          for (int i = 0; i < 8; ++i) q[i] = tile[(s8 + i) * 72 + e];
          u32x4 w; w.x = q[0] | ((unsigned)q[1] << 16); w.y = q[2] | ((unsigned)q[3] << 16); w.z = q[4] | ((unsigned)q[5] << 16); w.w = q[6] | ((unsigned)q[7] << 16);
          *(u32x4*)(vt + ((size_t)bh * 128 + et * 64 + e) * SEQ + st * 64 + s8) = w; }
        __syncthreads();
    }
}

__device__ __forceinline__ void sub_gmlp(const Ctx& X, int l) {
    const bf16_t* proj = WSP(bf16_t, WS_PROJ); bf16_t* y = WSP(bf16_t, WS_Y); const bf16_t* wsb = WSP(bf16_t, WS_WS);
    LAS unsigned char* Wg = X.lds; LAS unsigned char* Vn = X.lds + 34816; LAS float* st = (LAS float*)(X.lds + 69632);
    const float* lng = X.in[7] + (size_t)l * 512; const float* lnb = X.in[8] + (size_t)l * 512; const float* bs = X.in[10] + (size_t)l * 512;
    const int r = X.lane & 31, hf = X.lane >> 5;
    for (int u = X.c; u < 512; u += X.G) {
        const int ch = u >> 2, g = u & 3; const size_t t0 = (size_t)ch * 128;
#pragma unroll
        for (int i = 0; i < 4; ++i) { const int q = X.tid + 512 * i, row = q >> 4, cc = q & 15;
            *(LAS u32x4*)(Wg + row * 272 + cc * 16) = *(const u32x4*)(wsb + ((size_t)g * 128 + row) * 128 + cc * 8); }
        for (int i = 0; i < 16; ++i) { const int tt = X.wave * 16 + i;
            const u32x4 a = *(const u32x4*)(proj + (t0 + tt) * NP + C_AV + 8 * X.lane);
            float v[8] = {lo_bf(a.x), hi_bf(a.x), lo_bf(a.y), hi_bf(a.y), lo_bf(a.z), hi_bf(a.z), lo_bf(a.w), hi_bf(a.w)};
            float s = 0.f;
#pragma unroll
            for (int k = 0; k < 8; ++k) s += v[k];
            const float mean = wave_sum(s) * (1.f / 512.f);
            float q2 = 0.f;
#pragma unroll
            for (int k = 0; k < 8; ++k) { const float d = v[k] - mean; q2 += d * d; }
            const float rstd = __builtin_amdgcn_rsqf(wave_sum(q2) * (1.f / 512.f) + EPS);
            if (X.lane == 0) { st[2 * tt] = mean; st[2 * tt + 1] = rstd; } }
        __syncthreads();
#pragma unroll
        for (int i = 0; i < 4; ++i) { const int q = X.tid + 512 * i, tt = q & 127, jb = q >> 7;
            const u32x4 a = *(const u32x4*)(proj + (t0 + tt) * NP + C_AV + 128 * g + 8 * jb);
            const float mean = st[2 * tt], rstd = st[2 * tt + 1];
            float v[8] = {lo_bf(a.x), hi_bf(a.x), lo_bf(a.y), hi_bf(a.y), lo_bf(a.z), hi_bf(a.z), lo_bf(a.w), hi_bf(a.w)};
#pragma unroll
            for (int e = 0; e < 8; ++e) { const int d = 8 * jb + e; const float o = (v[e] - mean) * rstd * lng[128 * g + d] + lnb[128 * g + d];
                *(LAS bf16_t*)(Vn + d * 272 + tt * 2) = f2bf(o); } }
        __syncthreads();
        { const int tb = X.wave >> 1, dh = X.wave & 1;
          f32x16 acc[2];
#pragma unroll
          for (int nb = 0; nb < 2; ++nb)
#pragma unroll
              for (int k = 0; k < 16; ++k) acc[nb][k] = 0.f;
          const int nks = 2 * (tb + 1);
          for (int ks = 0; ks < nks; ++ks) {
              const bf16x8 a = *(const LAS bf16x8*)(Wg + (32 * tb + r) * 272 + (16 * ks + 8 * hf) * 2);
#pragma unroll
              for (int nb = 0; nb < 2; ++nb) { const bf16x8 b = *(const LAS bf16x8*)(Vn + (64 * dh + 32 * nb + r) * 272 + (16 * ks + 8 * hf) * 2);
                  acc[nb] = __builtin_amdgcn_mfma_f32_32x32x16_bf16(a, b, acc[nb], 0, 0, 0); } }
#pragma unroll
          for (int nb = 0; nb < 2; ++nb)
#pragma unroll
              for (int k = 0; k < 16; ++k) { const int t = 32 * tb + (k & 3) + 8 * (k >> 2) + 4 * hf, d = 64 * dh + 32 * nb + r;
                  const float uu = bf2f(proj[(t0 + t) * NP + C_AU + 128 * g + d]);
                  y[(t0 + t) * YW + 128 * g + d] = f2bf((acc[nb][k] + bs[g * 128 + t]) * uu); } }
        __syncthreads();
    }
}

__device__ __forceinline__ float log_sigmoid_(float z) { return fminf(z, 0.f) - __logf(1.f + __expf(-fabsf(z))); }

__device__ __forceinline__ void sub_gla_local(const Ctx& X, int l) {
    const bf16_t* proj = WSP(bf16_t, WS_PROJ); float* U = WSP(float, WS_SCR); float* dec = WSP(float, WS_DEC);
    LAS float* ga = (LAS float*)X.lds; LAS float* seg = (LAS float*)(X.lds + 4096);
    LAS unsigned char* kkT = X.lds + 8192; LAS unsigned char* vT = X.lds + 17408;
    const int r = X.lane & 31, hf = X.lane >> 5;
    for (int u = X.c; u < 1024; u += X.G) {
        const int hh = u & 3, cch = (u >> 2) & 63, b = u >> 8; const size_t t0 = (size_t)b * SEQ + cch * 64;
        if (X.tid < 128) { const int tt = X.tid >> 1, half = X.tid & 1;
            const u32x4 a = *(const u32x4*)(proj + (t0 + tt) * NP + C_GA + 8 * half);
            LAS float* gp = ga + tt * 16 + 8 * half;
            gp[0] = lo_bf(a.x); gp[1] = hi_bf(a.x); gp[2] = lo_bf(a.y); gp[3] = hi_bf(a.y); gp[4] = lo_bf(a.z); gp[5] = hi_bf(a.z); gp[6] = lo_bf(a.w); gp[7] = hi_bf(a.w); }
#pragma unroll
        for (int i = 0; i < 2; ++i) { const int q = X.tid + 512 * i, s = q & 63, eb = q >> 6;
            const u32x4 a = *(const u32x4*)(proj + (t0 + s) * NP + C_GV + 128 * hh + 8 * eb);
            const unsigned w[4] = {a.x, a.y, a.z, a.w};
#pragma unroll
            for (int k = 0; k < 4; ++k) { *(LAS bf16_t*)(vT + (8 * eb + 2 * k) * 144 + s * 2) = (bf16_t)(w[k] & 0xffffu); *(LAS bf16_t*)(vT + (8 * eb + 2 * k + 1) * 144 + s * 2) = (bf16_t)(w[k] >> 16); } }
        __syncthreads();
        const int d = X.tid & 63, tq = X.tid >> 6;
        float cum[8];
        { float w2[16];
#pragma unroll
          for (int q = 0; q < 16; ++q) w2[q] = X.in[11][((size_t)l * 16 + q) * 256 + hh * 64 + d];
          const float bg = X.in[12][(size_t)l * 256 + hh * 64 + d];
          float run = 0.f;
#pragma unroll
          for (int i = 0; i < 8; ++i) { const int t = 8 * tq + i; float z = bg;
#pragma unroll
              for (int q = 0; q < 16; ++q) z += ga[t * 16 + q] * w2[q];
              run += log_sigmoid_(z) * (1.f / 16.f); cum[i] = run; }
          seg[tq * 64 + d] = run; }
        __syncthreads();
        { float pre = 0.f, tot = 0.f;
#pragma unroll
          for (int q = 0; q < 8; ++q) { const float s = seg[q * 64 + d]; tot += s; if (q < tq) pre += s; }
          float kk[8];
#pragma unroll
          for (int i = 0; i < 8; ++i) { const int t = 8 * tq + i; const float kv = bf2f(proj[(t0 + t) * NP + C_GK + 64 * hh + d]); kk[i] = kv * __expf(tot - (pre + cum[i])); }
          u32x4 w; w.x = cvt_pk_bf16(kk[0], kk[1]); w.y = cvt_pk_bf16(kk[2], kk[3]); w.z = cvt_pk_bf16(kk[4], kk[5]); w.w = cvt_pk_bf16(kk[6], kk[7]);
          *(LAS u32x4*)(kkT + d * 144 + 16 * tq) = w;
          if (tq == 0) dec[(size_t)u * 64 + d] = __expf(tot); }
        __syncthreads();
        { const int db = X.wave >> 2, eb = X.wave & 3; f32x16 acc;
#pragma unroll
          for (int k = 0; k < 16; ++k) acc[k] = 0.f;
#pragma unroll
          for (int ks = 0; ks < 4; ++ks) { const bf16x8 a = *(const LAS bf16x8*)(kkT + (32 * db + r) * 144 + (16 * ks + 8 * hf) * 2);
              const bf16x8 bb = *(const LAS bf16x8*)(vT + (32 * eb + r) * 144 + (16 * ks + 8 * hf) * 2);
              acc = __builtin_amdgcn_mfma_f32_32x32x16_bf16(a, bb, acc, 0, 0, 0); }
#pragma unroll
          for (int k = 0; k < 16; ++k) { const int dd = 32 * db + (k & 3) + 8 * (k >> 2) + 4 * hf; U[((size_t)u * 64 + dd) * 128 + 32 * eb + r] = acc[k]; } }
        __syncthreads();
    }
}

__device__ __forceinline__ void sub_gla_scan(const Ctx& X) {
    float* U = WSP(float, WS_SCR); const float* dec = WSP(float, WS_DEC);
    for (int gid = X.c * 512 + X.tid; gid < 16 * 8192; gid += X.G * 512) {
        const int bh = gid >> 13, de = gid & 8191, d = de >> 7, b = bh >> 2, hh = bh & 3;
        float S = 0.f;
#pragma unroll 8
        for (int c = 0; c < 64; ++c) { const size_t u = (size_t)b * 256 + c * 4 + hh; float* p = U + u * 8192 + de;
            const float uv = *p, dc = dec[u * 64 + d]; *p = S; S = dc * S + uv; }
    }
}

__device__ __forceinline__ void sub_gla_out(const Ctx& X, int l) {
    const bf16_t* proj = WSP(bf16_t, WS_PROJ); const float* Sg = WSP(float, WS_SCR); bf16_t* y = WSP(bf16_t, WS_Y);
    LAS float* ga = (LAS float*)X.lds; LAS float* seg = (LAS float*)(X.lds + 4096);
    LAS unsigned char* qq = X.lds + 8192; LAS unsigned char* qS = X.lds + 17408; LAS unsigned char* kk2 = X.lds + 26624;
    LAS unsigned char* vT = X.lds + 35840; LAS unsigned char* ST = X.lds + 54272; LAS unsigned char* at = X.lds + 72704; LAS float* ob = (LAS float*)(X.lds + 81920);
    const int r = X.lane & 31, hf = X.lane >> 5;
    for (int u = X.c; u < 1024; u += X.G) {
        const int hh = u & 3, cch = (u >> 2) & 63, b = u >> 8; const size_t t0 = (size_t)b * SEQ + cch * 64;
        if (X.tid < 128) { const int tt = X.tid >> 1, half = X.tid & 1;
            const u32x4 a = *(const u32x4*)(proj + (t0 + tt) * NP + C_GA + 8 * half);
            LAS float* gp = ga + tt * 16 + 8 * half;
            gp[0] = lo_bf(a.x); gp[1] = hi_bf(a.x); gp[2] = lo_bf(a.y); gp[3] = hi_bf(a.y); gp[4] = lo_bf(a.z); gp[5] = hi_bf(a.z); gp[6] = lo_bf(a.w); gp[7] = hi_bf(a.w); }
#pragma unroll
        for (int i = 0; i < 2; ++i) { const int q = X.tid + 512 * i, s = q & 63, eb = q >> 6;
            const u32x4 a = *(const u32x4*)(proj + (t0 + s) * NP + C_GV + 128 * hh + 8 * eb);
            const unsigned w[4] = {a.x, a.y, a.z, a.w};
#pragma unroll
            for (int k = 0; k < 4; ++k) { *(LAS bf16_t*)(vT + (8 * eb + 2 * k) * 144 + s * 2) = (bf16_t)(w[k] & 0xffffu); *(LAS bf16_t*)(vT + (8 * eb + 2 * k + 1) * 144 + s * 2) = (bf16_t)(w[k] >> 16); } }
#pragma unroll
        for (int i = 0; i < 16; ++i) { const int q = X.tid + 512 * i, dd = q >> 7, e = q & 127;
            *(LAS bf16_t*)(ST + e * 144 + dd * 2) = f2bf(Sg[(size_t)u * 8192 + q]); }
        __syncthreads();
        const int d = X.tid & 63, tq = X.tid >> 6;
        float cum[8];
        { float w2[16];
#pragma unroll
          for (int q = 0; q < 16; ++q) w2[q] = X.in[11][((size_t)l * 16 + q) * 256 + hh * 64 + d];
          const float bg = X.in[12][(size_t)l * 256 + hh * 64 + d];
          float run = 0.f;
#pragma unroll
          for (int i = 0; i < 8; ++i) { const int t = 8 * tq + i; float z = bg;
#pragma unroll
              for (int q = 0; q < 16; ++q) z += ga[t * 16 + q] * w2[q];
              run += log_sigmoid_(z) * (1.f / 16.f); cum[i] = run; }
          seg[tq * 64 + d] = run; }
        __syncthreads();
        { float pre = 0.f, bref = 0.f;
#pragma unroll
          for (int q = 0; q < 8; ++q) { const float s = seg[q * 64 + d]; if (q < tq) pre += s; if (q < 4) bref += s; }
#pragma unroll
          for (int i = 0; i < 8; ++i) { const int t = 8 * tq + i; const float bt = pre + cum[i];
              const float qv = bf2f(proj[(t0 + t) * NP + C_GQ + 64 * hh + d]) * 0.125f, kv = bf2f(proj[(t0 + t) * NP + C_GK + 64 * hh + d]);
              *(LAS bf16_t*)(qq + t * 144 + d * 2) = f2bf(qv * __expf(bt - bref));
              *(LAS bf16_t*)(qS + t * 144 + d * 2) = f2bf(qv * __expf(bt));
              *(LAS bf16_t*)(kk2 + t * 144 + d * 2) = f2bf(kv * __expf(bref - bt)); } }
        __syncthreads();
        if (X.wave < 4) { const int tb = X.wave >> 1, sb = X.wave & 1; f32x16 acc;
#pragma unroll
            for (int k = 0; k < 16; ++k) acc[k] = 0.f;
#pragma unroll
            for (int ks = 0; ks < 4; ++ks) { const bf16x8 a = *(const LAS bf16x8*)(qq + (32 * tb + r) * 144 + (16 * ks + 8 * hf) * 2);
                const bf16x8 bb = *(const LAS bf16x8*)(kk2 + (32 * sb + r) * 144 + (16 * ks + 8 * hf) * 2);
                acc = __builtin_amdgcn_mfma_f32_32x32x16_bf16(a, bb, acc, 0, 0, 0); }
#pragma unroll
            for (int k = 0; k < 16; ++k) { const int t = 32 * tb + (k & 3) + 8 * (k >> 2) + 4 * hf, s = 32 * sb + r;
                *(LAS bf16_t*)(at + t * 144 + s * 2) = f2bf(s <= t ? acc[k] : 0.f); } }
        __syncthreads();
        { const int tb = X.wave >> 2, eb = X.wave & 3; f32x16 acc;
#pragma unroll
          for (int k = 0; k < 16; ++k) acc[k] = 0.f;
#pragma unroll
          for (int ks = 0; ks < 4; ++ks) { const bf16x8 a = *(const LAS bf16x8*)(qS + (32 * tb + r) * 144 + (16 * ks + 8 * hf) * 2);
              const bf16x8 bb = *(const LAS bf16x8*)(ST + (32 * eb + r) * 144 + (16 * ks + 8 * hf) * 2);
              acc = __builtin_amdgcn_mfma_f32_32x32x16_bf16(a, bb, acc, 0, 0, 0); }
#pragma unroll
          for (int ks = 0; ks < 4; ++ks) { const bf16x8 a = *(const LAS bf16x8*)(at + (32 * tb + r) * 144 + (16 * ks + 8 * hf) * 2);
              const bf16x8 bb = *(const LAS bf16x8*)(vT + (32 * eb + r) * 144 + (16 * ks + 8 * hf) * 2);
              acc = __builtin_amdgcn_mfma_f32_32x32x16_bf16(a, bb, acc, 0, 0, 0); }
#pragma unroll
          for (int k = 0; k < 16; ++k) { const int t = 32 * tb + (k & 3) + 8 * (k >> 2) + 4 * hf; ob[t * 132 + 32 * eb + r] = acc[k]; } }
        __syncthreads();
        { const int t = X.tid >> 3, j = X.tid & 7; float o[16]; float ss = 0.f;
#pragma unroll
          for (int i = 0; i < 16; ++i) { o[i] = ob[t * 132 + 16 * j + i]; ss += o[i] * o[i]; }
          ss += __shfl_xor(ss, 1); ss += __shfl_xor(ss, 2); ss += __shfl_xor(ss, 4);
          const float rstd = __builtin_amdgcn_rsqf(ss * (1.f / 128.f) + EPS);
          const bf16_t* rp = proj + (t0 + t) * NP + C_GR + 128 * hh + 16 * j; const float* gn = X.in[13] + (size_t)l * 128 + 16 * j;
          const u32x4 ra = *(const u32x4*)rp, rb = *(const u32x4*)(rp + 8);
          const unsigned rw[8] = {ra.x, ra.y, ra.z, ra.w, rb.x, rb.y, rb.z, rb.w};
          unsigned pk[8];
#pragma unroll
          for (int i = 0; i < 8; ++i) { const float r0 = lo_bf(rw[i]), r1 = hi_bf(rw[i]);
              const float v0 = o[2 * i] * rstd * gn[2 * i] * (r0 * sigmoidf_(r0)), v1 = o[2 * i + 1] * rstd * gn[2 * i + 1] * (r1 * sigmoidf_(r1));
              pk[i] = cvt_pk_bf16(v0, v1); }
          bf16_t* yp = y + (t0 + t) * YW + 512 + 128 * hh + 16 * j;
          *(u32x4*)yp = (u32x4){pk[0], pk[1], pk[2], pk[3]}; *(u32x4*)(yp + 8) = (u32x4){pk[4], pk[5], pk[6], pk[7]}; }
        __syncthreads();
    }
}

__device__ __forceinline__ void find_digit(LAS unsigned* hist, int lane, unsigned K, unsigned& digit, unsigned& above) {
    const u32x4 h4 = *(const LAS u32x4*)(hist + 4 * lane);
    const unsigned s = h4.x + h4.y + h4.z + h4.w;
    unsigned v = s;
#pragma unroll
    for (int o = 1; o < 64; o <<= 1) { const unsigned t = __shfl_down(v, o); if (lane + o < 64) v += t; }
    unsigned run = v - s, dg = 0, ab = 0; bool found = false;
    { const unsigned hb[4] = {h4.x, h4.y, h4.z, h4.w};
#pragma unroll
      for (int bi = 3; bi >= 0; --bi) { if (!found && run < K && run + hb[bi] >= K) { found = true; dg = 4 * lane + bi; ab = run; } run += hb[bi]; } }
    const unsigned long long m = __ballot(found);
    const int src = m ? (int)__builtin_ctzll(m) : 0;
    digit = (unsigned)__shfl((int)dg, src); above = (unsigned)__shfl((int)ab, src);
}
__device__ __forceinline__ void sub_dsa_select(const Ctx& X) {
    const bf16_t* proj = WSP(bf16_t, WS_PROJ); unsigned long long* mask = WSP(unsigned long long, WS_MASK);
    LAS bf16_t* keys = (LAS bf16_t*)X.lds;
    LAS unsigned* hist = (LAS unsigned*)(X.lds + AUX_OFF + 1024) + X.wave * 256;
    const int lane = X.lane;
    for (int u = X.c; u < 1024; u += X.G) {
        const int b = u & 3, qb = 255 - (u >> 2); const size_t tg0 = (size_t)b * SEQ;
        if (qb < 16) {
#pragma unroll
            for (int rr = 0; rr < 2; ++rr) { const int t = 16 * qb + 2 * X.wave + rr; const int rem = t - 64 * lane;
                const unsigned long long w = rem >= 63 ? ~0ull : (rem < 0 ? 0ull : ((2ull << rem) - 1ull));
                mask[(tg0 + t) * 64 + lane] = w; }
            continue;
        }
        const int nk = 16 * (qb + 1), nkp = (nk + 63) & ~63, ntile = nkp >> 4, nwords = nkp >> 6;
        {
            const int q = lane & 15, kg = lane >> 4; const size_t qrow = (tg0 + 16 * qb + q) * NP;
            bf16x8 Bq[4][2]; float iw[4];
#pragma unroll
            for (int hh = 0; hh < 4; ++hh) { iw[hh] = bf2f(proj[qrow + C_IW + hh]);
#pragma unroll
                for (int ks = 0; ks < 2; ++ks) Bq[hh][ks] = *(const bf16x8*)(proj + qrow + C_IQ + 64 * hh + 32 * ks + 8 * kg); }
            const int tq = 16 * qb + q;
            for (int j = X.wave; j < ntile; j += 8) {
                const size_t krow = (tg0 + 16 * j + q) * NP + C_IK;
                const bf16x8 A0 = *(const bf16x8*)(proj + krow + 8 * kg), A1 = *(const bf16x8*)(proj + krow + 32 + 8 * kg);
                f32x4 sc = {0.f, 0.f, 0.f, 0.f};
#pragma unroll
                for (int hh = 0; hh < 4; ++hh) { f32x4 a = {0.f, 0.f, 0.f, 0.f};
                    a = __builtin_amdgcn_mfma_f32_16x16x32_bf16(A0, Bq[hh][0], a, 0, 0, 0);
                    a = __builtin_amdgcn_mfma_f32_16x16x32_bf16(A1, Bq[hh][1], a, 0, 0, 0);
#pragma unroll
                    for (int k = 0; k < 4; ++k) sc[k] += iw[hh] * fmaxf(a[k], 0.f); }
                unsigned kk[4];
#pragma unroll
                for (int k = 0; k < 4; ++k) { const int key = 16 * j + 4 * kg + k; const unsigned ub = __float_as_uint(sc[k]);
                    unsigned o = (ub & 0x80000000u) ? ~ub : (ub | 0x80000000u); o >>= 16; o = o < 1u ? 1u : o;
                    kk[k] = key <= tq ? o : 0u; }
                u32x2 w; w.x = kk[0] | (kk[1] << 16); w.y = kk[2] | (kk[3] << 16);
                *(LAS u32x2*)(keys + q * 4096 + 16 * j + 4 * kg) = w;
            }
        }
        __syncthreads();
        for (int rr = 0; rr < 2; ++rr) {
            const int row = 2 * X.wave + rr, t = 16 * qb + row; const bool active = lane < nwords;
            unsigned kw[32];
#pragma unroll
            for (int i = 0; i < 8; ++i) { u32x4 v = {0u, 0u, 0u, 0u}; if (active) v = *(const LAS u32x4*)(keys + row * 4096 + 64 * lane + 8 * i);
                kw[4 * i] = v.x; kw[4 * i + 1] = v.y; kw[4 * i + 2] = v.z; kw[4 * i + 3] = v.w; }
            *(LAS u32x4*)(hist + 4 * lane) = (u32x4){0u, 0u, 0u, 0u};
            __syncthreads();
            if (active) {
#pragma unroll
                for (int i = 0; i < 32; ++i) { atomicAdd((unsigned*)(hist + ((kw[i] >> 8) & 255u)), 1u); atomicAdd((unsigned*)(hist + (kw[i] >> 24)), 1u); } }
            __syncthreads();
            unsigned d1, ab1; find_digit(hist, lane, 256u, d1, ab1);
            __syncthreads();
            *(LAS u32x4*)(hist + 4 * lane) = (u32x4){0u, 0u, 0u, 0u};
            __syncthreads();
            if (active) {
#pragma unroll
                for (int i = 0; i < 32; ++i) { const unsigned k0 = kw[i] & 0xffffu, k1 = kw[i] >> 16;
                    if ((k0 >> 8) == d1) atomicAdd((unsigned*)(hist + (k0 & 255u)), 1u);
                    if ((k1 >> 8) == d1) atomicAdd((unsigned*)(hist + (k1 & 255u)), 1u); } }
            __syncthreads();
            unsigned d2, ab2; find_digit(hist, lane, 256u - ab1, d2, ab2);
            __syncthreads();
            const unsigned vstar = (d1 << 8) | d2, need = 256u - ab1 - ab2;
            unsigned ceq = 0;
#pragma unroll
            for (int i = 0; i < 32; ++i) { ceq += ((kw[i] & 0xffffu) == vstar) ? 1u : 0u; ceq += ((kw[i] >> 16) == vstar) ? 1u : 0u; }
            unsigned incl = ceq;
#pragma unroll
            for (int o = 1; o < 64; o <<= 1) { const unsigned tt = __shfl_up(incl, o); if (lane >= o) incl += tt; }
            unsigned base = incl - ceq;
            unsigned wlo = 0u, whi = 0u;
#pragma unroll
            for (int i = 0; i < 32; ++i) { const unsigned k = (i & 1) ? (kw[i >> 1] >> 16) : (kw[i >> 1] & 0xffffu);
                bool sel = k > vstar;
                if (k == vstar) { sel = base < need; ++base; }
                wlo = (wlo >> 1) | (sel ? 0x80000000u : 0u); }
#pragma unroll
            for (int i = 32; i < 64; ++i) { const unsigned k = (i & 1) ? (kw[i >> 1] >> 16) : (kw[i >> 1] & 0xffffu);
                bool sel = k > vstar;
                if (k == vstar) { sel = base < need; ++base; }
                whi = (whi >> 1) | (sel ? 0x80000000u : 0u); }
            const unsigned long long w = ((unsigned long long)whi << 32) | wlo;
            const int rem = t - 64 * lane;
            const unsigned long long cm = rem >= 63 ? ~0ull : (rem < 0 ? 0ull : ((2ull << rem) - 1ull));
            mask[(tg0 + t) * 64 + lane] = active ? (w & cm) : 0ull;
        }
        __syncthreads();
    }
}

__device__ __forceinline__ float t5_bias_idx(int n) { return 0.f; }
__device__ __forceinline__ void sub_dsa_attn(const Ctx& X) {
    const bf16_t* proj = WSP(bf16_t, WS_PROJ); const bf16_t* vtg = WSP(bf16_t, WS_VT); const unsigned long long* mask = WSP(unsigned long long, WS_MASK);
    bf16_t* y = WSP(bf16_t, WS_Y); const float* relb = X.in[16];
    LAS unsigned char* Ks = X.lds; LAS unsigned char* Vs = X.lds + 34816; LAS float* bt = (LAS float*)(X.lds + 69632);
    LAS float* Ox = (LAS float*)X.lds; LAS float* MLx = (LAS float*)(X.lds + 65536);
    const int lane = X.lane, r = lane & 31, hf = lane >> 5, g = X.wave >> 2, wq = X.wave & 3;
    const float scale = 0.08838834764831845f;
    for (int u = X.c; u < 512; u += X.G) {
        const int bh = u & 15, qt = u < 256 ? 31 - (u >> 4) : ((u - 256) >> 4), b = bh >> 2, hh = bh & 3;
        const size_t tg0 = (size_t)b * SEQ; const int q0 = 128 * qt, tq = q0 + 32 * wq + r;
        if (X.tid < 129) { const int n = X.tid; int bk;
            if (n < 16) bk = n; else { bk = 16 + (int)(__logf((float)n * (1.f / 16.f)) / 2.0794415416798357f * 16.f); bk = bk > 31 ? 31 : bk; }
            bt[n] = relb[bk * 4 + hh]; }
        bf16x8 Qf[8];
#pragma unroll
        for (int ks = 0; ks < 8; ++ks) Qf[ks] = *(const bf16x8*)(proj + (tg0 + tq) * NP + C_DQ + 128 * hh + 16 * ks + 8 * hf);
        f32x16 O[4];
#pragma unroll
        for (int eb = 0; eb < 4; ++eb)
#pragma unroll
            for (int k = 0; k < 16; ++k) O[eb][k] = 0.f;
        float mrun = -1e30f, lrun = 0.f;
        const int nst = qt + 1;
        for (int st = 0; st < nst; ++st) {
            __syncthreads();
#pragma unroll
            for (int i = 0; i < 4; ++i) { const int q = X.tid + 512 * i, row = q >> 4, ch = q & 15;
                *(LAS u32x4*)(Ks + row * 272 + ch * 16) = *(const u32x4*)(proj + (tg0 + 128 * st + row) * NP + C_DK + 128 * hh + 8 * ch);
                *(LAS u32x4*)(Vs + row * 272 + ch * 16) = *(const u32x4*)(vtg + ((size_t)bh * 128 + row) * SEQ + 128 * st + 8 * ch); }
            __syncthreads();
            const unsigned long long mw = mask[(tg0 + tq) * 64 + 2 * st + g] >> (4 * hf);
            const unsigned mlo = (unsigned)mw, mhi = (unsigned)(mw >> 32);
            f32x16 S[2];
#pragma unroll
            for (int kb = 0; kb < 2; ++kb) {
#pragma unroll
                for (int k = 0; k < 16; ++k) S[kb][k] = 0.f;
#pragma unroll
                for (int ks = 0; ks < 8; ++ks) { const bf16x8 a = *(const LAS bf16x8*)(Ks + (64 * g + 32 * kb + r) * 272 + (16 * ks + 8 * hf) * 2);
                    S[kb] = __builtin_amdgcn_mfma_f32_32x32x16_bf16(a, Qf[ks], S[kb], 0, 0, 0); } }
            const int kg0 = 128 * st + 64 * g;
            const bool far = (q0 + 32 * wq) - (kg0 + 63) >= 128;
            const float bfar = bt[128];
            float mx = -1e30f;
#pragma unroll
            for (int kb = 0; kb < 2; ++kb)
#pragma unroll
                for (int k = 0; k < 16; ++k) { const int ko = 32 * kb + (k & 3) + 8 * (k >> 2); const unsigned bit = ((kb ? mhi : mlo) >> ((k & 3) + 8 * (k >> 2))) & 1u;
                    float bias = bfar;
                    if (!far) { int rel = tq - (kg0 + ko + 4 * hf); rel = rel < 0 ? 0 : (rel > 128 ? 128 : rel); bias = bt[rel]; }
                    const float lg = bit ? S[kb][k] * scale + bias : -1e30f; S[kb][k] = lg; mx = fmaxf(mx, lg); }
            mx = fmaxf(mx, __shfl_xor(mx, 32));
            const float mnew = fmaxf(mrun, mx), alpha = __expf(mrun - mnew);
            float ps = 0.f;
#pragma unroll
            for (int kb = 0; kb < 2; ++kb)
#pragma unroll
                for (int k = 0; k < 16; ++k) { const float p = S[kb][k] > -1e29f ? __expf(S[kb][k] - mnew) : 0.f; S[kb][k] = p; ps += p; }
            ps += __shfl_xor(ps, 32);
            lrun = lrun * alpha + ps; mrun = mnew;
#pragma unroll
            for (int eb = 0; eb < 4; ++eb)
#pragma unroll
                for (int k = 0; k < 16; ++k) O[eb][k] *= alpha;
#pragma unroll
            for (int kb = 0; kb < 2; ++kb)
#pragma unroll
                for (int s = 0; s < 2; ++s) {
                    union { bf16x8 v; unsigned w[4]; } P;
#pragma unroll
                    for (int j = 0; j < 4; ++j) P.w[j] = cvt_pk_bf16(S[kb][8 * s + 2 * j], S[kb][8 * s + 2 * j + 1]);
#pragma unroll
                    for (int eb = 0; eb < 4; ++eb) {
                        union { bf16x8 v; u32x2 h[2]; } A;
                        LAS unsigned char* vp = Vs + (32 * eb + r) * 272 + (64 * g + 32 * kb + 16 * s + 4 * hf) * 2;
                        A.h[0] = *(const LAS u32x2*)vp; A.h[1] = *(const LAS u32x2*)(vp + 16);
                        O[eb] = __builtin_amdgcn_mfma_f32_32x32x16_bf16(A.v, P.v, O[eb], 0, 0, 0); } }
        }
        __syncthreads();
        if (g == 1) {
#pragma unroll
            for (int eb = 0; eb < 4; ++eb)
#pragma unroll
                for (int k = 0; k < 16; ++k) Ox[((wq * 4 + eb) * 16 + k) * 64 + lane] = O[eb][k];
            MLx[(wq * 64 + lane) * 2] = mrun; MLx[(wq * 64 + lane) * 2 + 1] = lrun; }
        __syncthreads();
        if (g == 0) {
            const float m1 = MLx[(wq * 64 + lane) * 2], l1 = MLx[(wq * 64 + lane) * 2 + 1];
            const float m = fmaxf(mrun, m1), a0 = __expf(mrun - m), a1 = __expf(m1 - m);
            const float inv = 1.f / (lrun * a0 + l1 * a1);
#pragma unroll
            for (int eb = 0; eb < 4; ++eb)
#pragma unroll
                for (int k4 = 0; k4 < 4; ++k4) { float o[4];
#pragma unroll
                    for (int j = 0; j < 4; ++j) { const int k = 4 * k4 + j; o[j] = (O[eb][k] * a0 + Ox[((wq * 4 + eb) * 16 + k) * 64 + lane] * a1) * inv; }
                    u32x2 w; w.x = cvt_pk_bf16(o[0], o[1]); w.y = cvt_pk_bf16(o[2], o[3]);
                    *(u32x2*)(y + (tg0 + tq) * YW + 1024 + 128 * hh + 32 * eb + 8 * k4 + 4 * hf) = w; } }
        __syncthreads();
    }
}

__device__ __forceinline__ void phase_norm2(const Ctx& X, int l) {
    const float* out = X.out; const float* mod = WSP(float, WS_MOD); bf16_t* h = WSP(bf16_t, WS_H);
    int* toke = WSP(int, WS_TOKE); float* tokw = WSP(float, WS_TOKW); unsigned* cntb = WSP(unsigned, WS_CNT);
    LAS float* WT = (LAS float*)X.lds;
    LAS unsigned* cnt = (LAS unsigned*)(X.lds + AUX_OFF + 1024);
    const float* wg = X.in[20] + (size_t)l * 4096; const float* wr = X.in[22] + (size_t)l * 16384;
    for (int i = X.tid; i < 4096; i += 512) WT[(i & 3) * 1024 + (i >> 2)] = wg[i];
    for (int i = X.tid; i < 16384; i += 512) WT[(4 + (i & 15)) * 1024 + (i >> 4)] = wr[i];
    if (X.tid < 16) cnt[X.tid] = 0u;
    __syncthreads();
    const float* g2 = X.in[5] + (size_t)l * 1024; const float* bgrp = X.in[21] + l * 4; const float* brt = X.in[23] + l * 16;
    const int rpb = (T + X.G - 1) / X.G;
    for (int i = X.wave; i < rpb; i += 8) {
        const int r = X.c * rpb + i; if (r >= T) break;
        const int b = r >> 12; const float* md = mod + ((size_t)l * NB + b) * 6144;
        f32x4 xv[4]; float ss = 0.f;
#pragma unroll
        for (int k = 0; k < 4; ++k) { xv[k] = *(const f32x4*)(out + (size_t)r * 1024 + 4 * X.lane + 256 * k); ss += xv[k][0] * xv[k][0] + xv[k][1] * xv[k][1] + xv[k][2] * xv[k][2] + xv[k][3] * xv[k][3]; }
        ss = wave_sum(ss);
        const float rstd = __builtin_amdgcn_rsqf(ss * (1.f / 1024.f) + EPS);
        float lg[20];
#pragma unroll
        for (int o = 0; o < 20; ++o) lg[o] = 0.f;
#pragma unroll
        for (int k = 0; k < 4; ++k) { const int col = 4 * X.lane + 256 * k;
            const f32x4 g = *(const f32x4*)(g2 + col), sh = *(const f32x4*)(md + 3072 + col), sc = *(const f32x4*)(md + 4096 + col);
            const f32x4 yv = xv[k] * rstd * g * (sc + 1.f) + sh;
            u32x2 w; w.x = cvt_pk_bf16(yv[0], yv[1]); w.y = cvt_pk_bf16(yv[2], yv[3]); *(u32x2*)(h + (size_t)r * 1024 + col) = w;
#pragma unroll
            for (int o = 0; o < 20; ++o) { const f32x4 wv = *(const LAS f32x4*)(WT + o * 1024 + col); lg[o] += yv[0] * wv[0] + yv[1] * wv[1] + yv[2] * wv[2] + yv[3] * wv[3]; } }
#pragma unroll
        for (int o = 0; o < 20; ++o) lg[o] = wave_sum(lg[o]);
        if (X.lane == 0) {
            float gl[4];
#pragma unroll
            for (int k = 0; k < 4; ++k) gl[k] = lg[k] + bgrp[k];
            int gi = 0; float gm = gl[0];
#pragma unroll
            for (int k = 1; k < 4; ++k) if (gl[k] > gm) { gm = gl[k]; gi = k; }
            float se = 0.f;
#pragma unroll
            for (int k = 0; k < 4; ++k) se += __expf(gl[k] - gm);
            const float pg = 1.f / se;
            float sl[4];
#pragma unroll
            for (int k = 0; k < 4; ++k) { sl[k] = lg[4 + k] + brt[k];
#pragma unroll
                for (int q = 1; q < 4; ++q) if (gi == q) sl[k] = lg[4 + 4 * q + k] + brt[4 * q + k]; }
            int i1 = 0; float v1 = sl[0];
#pragma unroll
            for (int k = 1; k < 4; ++k) if (sl[k] > v1) { v1 = sl[k]; i1 = k; }
            int i2 = -1; float v2 = -3.0e38f;
#pragma unroll
            for (int k = 0; k < 4; ++k) if (k != i1 && sl[k] > v2) { v2 = sl[k]; i2 = k; }
            const float w1 = 1.f / (1.f + __expf(v2 - v1));
            const int e1 = 4 * gi + i1, e2 = 4 * gi + i2;
            toke[2 * r] = e1; toke[2 * r + 1] = e2; tokw[2 * r] = pg * w1; tokw[2 * r + 1] = pg * (1.f - w1);
            atomicAdd((unsigned*)(cnt + e1), 1u); atomicAdd((unsigned*)(cnt + e2), 1u);
        }
    }
    __syncthreads();
    if (X.tid < 16) cntb[X.c * 16 + X.tid] = cnt[X.tid];
    __syncthreads();
}

__device__ __forceinline__ void build_tiles(const Ctx& X, LAS int* tb, LAS int* myoff  ) {
    const unsigned* cntb = WSP(unsigned, WS_CNT);
    LAS int* tot = tb + 32;
    if (X.tid < 16) { int s = 0, mine = 0; for (int c = 0; c < X.G; ++c) { const int v = (int)cntb[c * 16 + X.tid]; if (c < X.c) mine += v; s += v; } tot[X.tid] = s; myoff[X.tid] = mine; }
    __syncthreads();
    if (X.tid == 0) { int row = 0, nT = 0;
        for (int e = 0; e < 16; ++e) { const int nt = (tot[e] + 255) >> 8; tb[16 + e] = row; for (int k = 0; k < nt; ++k) { tb[64 + nT] = e; tb[256 + nT] = (row >> 8) + k; ++nT; } row += nt * 256; }
        tb[0] = nT; }
    __syncthreads();
    if (X.tid < 16) myoff[X.tid] += tb[16 + X.tid];
    __syncthreads();
}

__device__ __forceinline__ void phase_scatter(const Ctx& X) {
    const int* toke = WSP(int, WS_TOKE); const float* tokw = WSP(float, WS_TOKW); int* toks = WSP(int, WS_TOKS);
    const bf16_t* h = WSP(bf16_t, WS_H); bf16_t* h2s = WSP(bf16_t, WS_H2S); float* sw = WSP(float, WS_SW);
    LAS int* tb = (LAS int*)(X.lds + AUX_OFF + 2048); LAS int* myoff = (LAS int*)(X.lds + AUX_OFF + 1024);
    LAS int* slots = (LAS int*)X.lds;
    build_tiles(X, tb, myoff);
    const int rpb = (T + X.G - 1) / X.G, r0 = X.c * rpb;
    if (X.tid == 0) { for (int i = 0; i < rpb; ++i) { const int r = r0 + i; if (r >= T) break;
            for (int k = 0; k < 2; ++k) { const int e = toke[2 * r + k]; slots[2 * i + k] = myoff[e]; myoff[e] = myoff[e] + 1; } } }
    __syncthreads();
    for (int i = X.wave; i < rpb; i += 8) { const int r = r0 + i; if (r >= T) break;
        const u32x4 a = *(const u32x4*)(h + (size_t)r * 1024 + 16 * X.lane), bq = *(const u32x4*)(h + (size_t)r * 1024 + 16 * X.lane + 8);
#pragma unroll
        for (int k = 0; k < 2; ++k) { const int s = slots[2 * i + k];
            *(u32x4*)(h2s + (size_t)s * 1024 + 16 * X.lane) = a; *(u32x4*)(h2s + (size_t)s * 1024 + 16 * X.lane + 8) = bq;
            if (X.lane == 0) { sw[s] = tokw[2 * r + k]; toks[2 * r + k] = s; } } }
    __syncthreads();
}

__global__ void __launch_bounds__(512, 2) fwd_kernel(Params P) {
    extern __shared__ __attribute__((aligned(16))) unsigned char lds_raw[];
    Ctx X0; X0.in = (const float* const CAS*)__builtin_amdgcn_kernarg_segment_ptr(); X0.out = P.out; X0.ws = P.ws; X0.lds = (LAS unsigned char*)lds_raw;
    X0.tid = threadIdx.x; X0.lane = X0.tid & 63; X0.wave = __builtin_amdgcn_readfirstlane(X0.tid >> 6); X0.G = gridDim.x; X0.c = blockIdx.x;
    LAS unsigned* auxw = (LAS unsigned*)(X0.lds + AUX_OFF);
    if (X0.tid < 4) auxw[X0.tid] = 0u;
    __syncthreads();
#define FRESH() Ctx X = X0; { int wv_ = X0.wave; asm volatile("" : "+s"(wv_)); unsigned m_ = ~0u; asm volatile("" : "+s"(m_)); const int ln_ = __builtin_amdgcn_mbcnt_hi(m_, __builtin_amdgcn_mbcnt_lo(m_, 0u)); \
        X.wave = wv_; X.lane = ln_; X.tid = wv_ * 64 + ln_; \
        unsigned char* w_ = X0.ws; asm volatile("" : "+s"(w_)); X.ws = w_; int c_ = X0.c; asm volatile("" : "+s"(c_)); X.c = c_; \
        const float* const CAS* i_ = X0.in; asm volatile("" : "+s"(i_)); X.in = i_; }
#if N_LAUNCH_MODE == 1
    XcdBarrier bar = xcd_barrier_post((unsigned*)(X0.ws + WS_CTL), (volatile LAS unsigned*)auxw);
#define SEAM() do { if (gp >= lo && gp + 1 < hi) xcd_barrier(bar); ++gp; } while (0)
#else
#define SEAM() do { ++gp; } while (0)
#endif
    const int lo = P.ph_lo, hi = P.ph_hi; int gp = 0;
#define IN() (gp >= lo && gp < hi)
    if (IN()) { FRESH(); phase_mod(X); }
    SEAM();
#define LAYER_BODY(l) do { \
        if (IN()) { { FRESH(); phase_conv(X, l); } { FRESH(); if (l == 0) phase_norm1(X, l, 0); else phase_norm1(X, l, 1); } } \
        SEAM(); \
        if (IN()) { \
            FRESH(); \
            SchedStatic S{64, 30, X.G, X.c, (const char*)WSP(bf16_t, WS_H), (const char*)WSP(bf16_t, WS_WIN), (size_t)256 * 1024 * 2, (size_t)256 * 1024 * 2}; \
            EpiProj E{WSP(bf16_t, WS_PROJ)}; \
            pg8::gemm_phase(X.lds, X.tid, 1024, 1024, 16, S, E); \
        } \
        SEAM(); \
        if (IN()) { { FRESH(); sub_qknorm(X, l); } { FRESH(); sub_vtrans(X); } { FRESH(); sub_gmlp(X, l); } { FRESH(); sub_gla_local(X, l); } { FRESH(); sub_dsa_select(X); } } \
        SEAM(); \
        if (IN()) { { FRESH(); sub_gla_scan(X); } { FRESH(); sub_dsa_attn(X); } } \
        SEAM(); \
        if (IN()) { FRESH(); sub_gla_out(X, l); } \
        SEAM(); \
        if (IN()) { \
            FRESH(); \
            SchedMerge S{X.G, X.c, (const char*)WSP(bf16_t, WS_Y), (const char*)WSP(bf16_t, WS_WBR)}; \
            EpiMerge E{WSP(bf16_t, WS_PROJ), X.in[18] + (size_t)l * 3072, WSP(float, WS_SCR), WSP(bf16_t, WS_H)}; \
            pg8::gemm_phase(X.lds, X.tid, YW, YW, 8, S, E); \
        } \
        SEAM(); \
        if (IN()) { \
            FRESH(); \
            SchedStatic S{64, 4, X.G, X.c, (const char*)WSP(bf16_t, WS_H), (const char*)WSP(bf16_t, WS_WOUT), (size_t)256 * 1024 * 2, (size_t)256 * 1024 * 2}; \
            EpiOut E{X.out, WSP(float, WS_MOD) + (size_t)l * NB * 6144 + 2048}; \
            pg8::gemm_phase(X.lds, X.tid, 1024, 1024, 16, S, E); \
        } \
        SEAM(); \
        if (IN()) { FRESH(); phase_norm2(X, l); } \
        SEAM(); \
        if (IN()) { FRESH(); phase_scatter(X); } \
        SEAM(); \
        if (IN()) { \
            FRESH(); \
            LAS int* tb = (LAS int*)(X.lds + AUX_OFF + 2048); LAS int* myoff = (LAS int*)(X.lds + AUX_OFF + 1024); \
            build_tiles(X, tb, myoff); \
            SchedMoe S{X.G, X.c, 1, tb[0], tb + 64, tb + 256, (const char*)WSP(bf16_t, WS_H2S), (const char*)WSP(bf16_t, WS_WE1), (size_t)256 * 1024 * 2, (size_t)512 * 1024 * 2, (size_t)256 * 1024 * 2}; \
            EpiMoe1 E{WSP(bf16_t, WS_ACT), WSP(float, WS_SW)}; \
            pg8::gemm_phase(X.lds, X.tid, 1024, 1024, 16, S, E); \
        } \
        SEAM(); \
        if (IN()) { \
            FRESH(); \
            LAS int* tb = (LAS int*)(X.lds + AUX_OFF + 2048); LAS int* myoff = (LAS int*)(X.lds + AUX_OFF + 1024); \
            build_tiles(X, tb, myoff); \
            SchedMoe S{X.G, X.c, 2, tb[0], tb + 64, tb + 256, (const char*)WSP(bf16_t, WS_ACT), (const char*)WSP(bf16_t, WS_WE2), (size_t)256 * 256 * 2, (size_t)1024 * 256 * 2, (size_t)256 * 256 * 2}; \
            EpiMoe2 E{WSP(bf16_t, WS_FFN)}; \
            pg8::gemm_phase(X.lds, X.tid, 256, 256, 4, S, E); \
        } \
        SEAM(); \
 \
    } while (0)
    LAYER_BODY(0); LAYER_BODY(1); LAYER_BODY(2); LAYER_BODY(3);
    if (IN()) { FRESH(); phase_norm1(X, NL, 2); }
#undef IN
#undef SEAM
}

constexpr int N_PHASES = 1 + NL * 11 + 1;

extern "C" void kernel_launch(void* const* d_in, const int* in_sizes, int n_in, void* d_out, int out_size, void* d_ws, size_t ws_size, hipStream_t stream) {
    static int grid = 0;
    if (grid == 0) {
        if (n_in != 27 || out_size != T * D || ws_size < WS_END) { fprintf(stderr, "kernel_launch: unexpected problem (n_in %d, out %d, ws %zu, need %zu)\n", n_in, out_size, ws_size, (size_t)WS_END); grid = -1; return; }
        int dev = 0, cus = 0, per_cu = 0;
        if (hipGetDevice(&dev) != hipSuccess || hipDeviceGetAttribute(&cus, hipDeviceAttributeMultiprocessorCount, dev) != hipSuccess) { grid = -1; return; }
        if (hipFuncSetAttribute((const void*)fwd_kernel, hipFuncAttributeMaxDynamicSharedMemorySize, LDS_BYTES) != hipSuccess) { fprintf(stderr, "kernel_launch: hipFuncSetAttribute failed\n"); grid = -1; return; }
        if (hipOccupancyMaxActiveBlocksPerMultiprocessor(&per_cu, (const void*)fwd_kernel, 512, LDS_BYTES) != hipSuccess || per_cu < 1) fprintf(stderr, "kernel_launch: occupancy query says %d\n", per_cu);
        (void)hipGetLastError();
        grid = cus;
    }
    if (grid < 0) return;
    (void)hipMemsetAsync((char*)d_ws + WS_CTL, 0, XCD_BAR_WORDS * sizeof(unsigned), stream);
    Params p{};
    for (int i = 0; i < 27; ++i) p.in[i] = (const float*)d_in[i];
    p.out = (float*)d_out; p.ws = (unsigned char*)d_ws;
#if N_LAUNCH_MODE == 1
    p.ph_lo = 0; p.ph_hi = N_PHASES;
    hipLaunchKernelGGL(fwd_kernel, dim3(grid), dim3(512), LDS_BYTES, stream, p);
#else
    for (int ph = 0; ph < N_PHASES; ++ph) { p.ph_lo = ph; p.ph_hi = ph + 1; hipLaunchKernelGGL(fwd_kernel, dim3(grid), dim3(512), LDS_BYTES, stream, p); }
#endif
}
```

```cpp
#include <hip/hip_runtime.h>
#include <stdint.h>
#include <stdio.h>

#ifndef N_LAUNCH_MODE
#define N_LAUNCH_MODE 1
#endif

#ifndef PROBE_DUP
#define PROBE_DUP 0
#endif
#define REP(id) for (int rep_ = 0; rep_ < ((PROBE_DUP == (id)) ? 2 : 1); ++rep_)
#define LAS __attribute__((address_space(3)))
#define CAS __attribute__((address_space(4)))
typedef unsigned short bf16_t;
typedef short bf16x8 __attribute__((ext_vector_type(8)));
typedef float f32x2 __attribute__((ext_vector_type(2)));
typedef float f32x4 __attribute__((ext_vector_type(4)));
typedef float f32x16 __attribute__((ext_vector_type(16)));
typedef unsigned u32x2 __attribute__((ext_vector_type(2)));
typedef unsigned u32x4 __attribute__((ext_vector_type(4)));

constexpr int NB = 4, SEQ = 4096, T = NB * SEQ, D = 1024, NL = 4;
constexpr int NIN = 7508, NP = 7680;
constexpr int C_AU = 0, C_AV = 512, C_GQ = 1024, C_GK = 1280, C_GV = 1536, C_GR = 2048, C_DQ = 2560, C_DK = 3072, C_DV = 3584,
              C_IQ = 4096, C_IK = 4352, C_GA = 4416, C_IW = 4432, C_GATE = 4608;
constexpr int YW = 1536;
constexpr int MOE_ROWS = 32768 + 16 * 256;
constexpr float EPS = 1e-6f;

constexpr size_t WS_CTL = 0;
constexpr size_t WS_CNT = 16384;
constexpr size_t WS_MOD = 65536;
constexpr size_t WS_WIN = WS_MOD + 524288;
constexpr size_t WS_WBR = WS_WIN + (size_t)NP * 1024 * 2;
constexpr size_t WS_WOUT = WS_WBR + (size_t)1024 * 1536 * 2;
constexpr size_t WS_WE1 = WS_WOUT + (size_t)1024 * 1024 * 2;
constexpr size_t WS_WE2 = WS_WE1 + (size_t)16 * 512 * 1024 * 2;
constexpr size_t WS_WS = WS_WE2 + (size_t)16 * 1024 * 256 * 2;
constexpr size_t WS_H = WS_WS + (size_t)4 * 128 * 128 * 2;
constexpr size_t WS_PROJ = WS_H + (size_t)T * 1024 * 2;
constexpr size_t WS_Y = WS_PROJ + (size_t)T * NP * 2;
constexpr size_t WS_SCR = WS_Y + (size_t)T * YW * 2;
constexpr size_t WS_MASK = WS_SCR + (size_t)T * 1024 * 4;
constexpr size_t WS_VT = WS_MASK + (size_t)T * 64 * 8;
constexpr size_t WS_TOKE = WS_VT + (size_t)16 * 128 * 4096 * 2;
constexpr size_t WS_TOKW = WS_TOKE + (size_t)T * 8;
constexpr size_t WS_TOKS = WS_TOKW + (size_t)T * 8;
constexpr size_t WS_DEC = WS_TOKS + (size_t)T * 8;
constexpr size_t WS_SW = WS_DEC + (size_t)1024 * 64 * 4;
constexpr size_t WS_END = WS_SW + (size_t)MOE_ROWS * 4;
constexpr size_t WS_H2S = WS_PROJ;
constexpr size_t WS_ACT = WS_H2S + (size_t)MOE_ROWS * 1024 * 2;
constexpr size_t WS_FFN = WS_ACT + (size_t)MOE_ROWS * 256 * 2;
static_assert(WS_FFN + (size_t)MOE_ROWS * 1024 * 2 <= WS_Y, "moe alias");

constexpr int LDS_BYTES = 147456;
constexpr int AUX_OFF = 131072;

__device__ __forceinline__ float bf2f(bf16_t v) { return __uint_as_float(((unsigned)v) << 16); }
__device__ __forceinline__ unsigned cvt_pk_bf16(float lo, float hi) { unsigned r; asm volatile("v_cvt_pk_bf16_f32 %0, %1, %2" : "=v"(r) : "v"(lo), "v"(hi)); return r; }
__device__ __forceinline__ bf16_t f2bf(float f) { return (bf16_t)(cvt_pk_bf16(f, 0.f) & 0xffffu); }
__device__ __forceinline__ float lo_bf(unsigned w) { return __uint_as_float(w << 16); }
__device__ __forceinline__ float hi_bf(unsigned w) { return __uint_as_float(w & 0xffff0000u); }
__device__ __forceinline__ float wave_sum(float v) {
#pragma unroll
    for (int o = 32; o >= 1; o >>= 1) v += __shfl_xor(v, o);
    return v;
}
__device__ __forceinline__ float fast_exp(float x) { return __builtin_amdgcn_exp2f(x * 1.4426950408889634f); }
__device__ __forceinline__ float sigmoidf_(float x) { return __builtin_amdgcn_rcpf(1.f + fast_exp(-x)); }
__device__ __forceinline__ float gelu_tanh(float x) { const float u = x + 0.044715f * x * x * x; return x * __builtin_amdgcn_rcpf(1.f + __builtin_amdgcn_exp2f(-2.3022082f * u)); }

#define XB_TMO      128
#define XB_XCNT(j)  (256  + 64 * (j))
#define XB_XSUB(j)  (1280 + 64 * (j))
#define XB_XGEN(j)  (2304 + 64 * (j))
#define XB_TOP      3328
#define XB_TOPGEN   3392
#define XCD_BAR_WORDS 3456
#define XB_SPIN_CAP (1u << 22)
__device__ __forceinline__ unsigned xb_ld(unsigned* p)              { return __hip_atomic_load(p, __ATOMIC_RELAXED, __HIP_MEMORY_SCOPE_AGENT); }
__device__ __forceinline__ unsigned xb_add(unsigned* p, unsigned v) { return __hip_atomic_fetch_add(p, v, __ATOMIC_RELAXED, __HIP_MEMORY_SCOPE_AGENT); }
__device__ __forceinline__ unsigned xb_xcc_id() { return (unsigned)__builtin_amdgcn_s_getreg((3 << 11) | 20) & 0xFu; }
#define XB_SPIN(cond, bar) do { unsigned _sp = 0; while (cond) { __builtin_amdgcn_s_sleep(1); \
    if ((++_sp & 255u) == 0u) { if (xb_ld(&(bar)[XB_TMO])) break; if (_sp > XB_SPIN_CAP) { atomicAdd(&(bar)[XB_TMO], 1u); break; } } } } while (0)
struct XcdBarrier { unsigned* bar; unsigned x; volatile LAS unsigned* st; };
__device__ __forceinline__ XcdBarrier xcd_barrier_post(unsigned* bar, volatile LAS unsigned* st) {
    XcdBarrier b; b.bar = bar; b.x = xb_xcc_id(); b.st = st;
    if (threadIdx.x == 0) (void)xb_add(&bar[XB_XCNT(b.x)], 1u);
    return b;
}
__device__ __forceinline__ void xcd_barrier_complete(unsigned* bar, unsigned x, unsigned& nloc, unsigned& nx) {
    const unsigned G = gridDim.x * gridDim.y * gridDim.z;
    unsigned sum, cnt, mine, sp = 0u;
    for (;;) {
        sum = 0u; cnt = 0u; mine = 0u;
#pragma unroll
        for (unsigned j = 0; j < 16; ++j) { const unsigned c = xb_ld(&bar[XB_XCNT(j)]); sum += c; cnt += (c > 0u) ? 1u : 0u; mine = (j == x) ? c : mine; }
        if (sum == G) break;
        __builtin_amdgcn_s_sleep(1);
        if ((++sp & 255u) == 0u) { if (xb_ld(&bar[XB_TMO])) break; if (sp > XB_SPIN_CAP) { atomicAdd(&bar[XB_TMO], 1u); break; } }
    }
    nloc = mine > 0u ? mine : 1u; nx = cnt > 0u ? cnt : 1u;
}
__device__ __forceinline__ void xcd_barrier(const XcdBarrier& b) {
    asm volatile("s_waitcnt vmcnt(0)" ::: "memory");
    __syncthreads();
    if (threadIdx.x == 0) {
        unsigned* bar = b.bar;
        __builtin_amdgcn_s_waitcnt(0);
        unsigned nloc = b.st[0], nx = b.st[1];
        if (nloc == 0u) { xcd_barrier_complete(bar, b.x, nloc, nx); b.st[0] = nloc; b.st[1] = nx; }
        const unsigned old = xb_add(&bar[XB_XSUB(b.x)], 1u);
        const unsigned gen = old / nloc;
        if (old + 1u == (gen + 1u) * nloc) {
            __builtin_amdgcn_fence(__ATOMIC_RELEASE, "agent");
            asm volatile("s_waitcnt vmcnt(0)" ::: "memory");
            const unsigned og = xb_add(&bar[XB_TOP], 1u);
            const unsigned tg = og / nx;
            if (og + 1u == (tg + 1u) * nx) xb_add(&bar[XB_TOPGEN], 1u);
            else XB_SPIN(xb_ld(&bar[XB_TOPGEN]) == tg, bar);
            __builtin_amdgcn_fence(__ATOMIC_ACQUIRE, "agent");
            xb_add(&bar[XB_XGEN(b.x)], 1u);
            asm volatile("s_waitcnt vmcnt(0)" ::: "memory");
        } else {
            XB_SPIN(xb_ld(&bar[XB_XGEN(b.x)]) == gen, bar);
            __builtin_amdgcn_fence(__ATOMIC_ACQUIRE, "agent");
            asm volatile("s_waitcnt vmcnt(0)" ::: "memory");
        }
    }
    __syncthreads();
}

namespace pg8 {
constexpr int BM = 256, BK = 64, HALF = 128, HTB = HALF * BK * 2, STAGE_BYTES = 8 * HTB, NXCD = 8, WGM = 8;
__device__ __forceinline__ int lds_byte(int r, int c) { const int st = (r >> 4) * 2 + (c >> 5), rr = r & 15, cc = c & 31, ob = rr * 64 + cc * 2; return st * 1024 + (ob ^ (((ob >> 9) & 1) << 5)); }
__device__ __forceinline__ void stage_rc(int b, int& R, int& C) { const int st = b / 1024, sb = b % 1024, swz = sb ^ (((sb >> 9) & 1) << 5); R = (st >> 1) * 16 + swz / 64; C = (st & 1) * 32 + (swz % 64) / 2; }
__device__ __forceinline__ int perm32(int rho) { const int n = rho >> 4, i = rho & 15; return 8 * (i >> 2) + 4 * n + (i & 3); }

struct Unit { int pm, pn, aux; const char* A; const char* B; };
__device__ __forceinline__ void tile_of(int L, int nM, int nN, int& pm, int& pn) {
    const int nwg = nM * nN; int wgid = L;
    { const int q = nwg / NXCD, r = nwg % NXCD, xcd = wgid % NXCD, off = wgid / NXCD; wgid = (xcd < r ? xcd * (q + 1) : r * (q + 1) + (xcd - r) * q) + off; }
    const int nig = WGM * nN, gid = wgid / nig, fm = gid * WGM, gsz = (nM - fm) < WGM ? (nM - fm) : WGM;
    pm = fm + ((wgid % nig) % gsz); pn = (wgid % nig) / gsz;
}

template <class Epi, class Sched>
__device__ __forceinline__ void gemm_phase(LAS unsigned char* lds, const int tid, const int lda, const int ldb, const int nt, const Sched& S, const Epi& E) {
    const int wid = __builtin_amdgcn_readfirstlane(tid >> 6), lane = tid & 63, wr = wid >> 2, wc = wid & 3, fr = lane & 15, fq = lane >> 4;
    unsigned voffA[2], voffB[2];
#pragma unroll
    for (int i = 0; i < 2; ++i) { int R, C; stage_rc(tid * 16 + i * 8192, R, C); const int Rb = Epi::PERM ? ((R & ~31) + perm32(R & 31)) : R;
        voffA[i] = (unsigned)(R * lda + C) * 2u; voffB[i] = (unsigned)(Rb * ldb + C) * 2u; }
    const size_t kstep = (size_t)(BK * 2);
    const size_t hstepA = (size_t)HALF * lda * 2, hstepB = (size_t)HALF * ldb * 2;
    const unsigned ldsw = (unsigned)wid * 1024u;
    const int aoff = lds_byte(wr * 64 + fr, fq * 8), boff = lds_byte(wc * 32 + fr, fq * 8);
#define PG8_SA(b, h) (((b) * 2 + (h)) * HTB)
#define PG8_SB(b, h) ((4 + (b) * 2 + (h)) * HTB)
#define PG8_STAGE(bufoff, gbase, voff) do { _Pragma("unroll") for (int _i = 0; _i < 2; ++_i) \
        __builtin_amdgcn_global_load_lds((const unsigned*)((const char*)(gbase) + (voff)[_i]), (LAS unsigned*)(lds + (bufoff) + ldsw + _i * 8192), 16, 0, 0); } while (0)
#define PG8_LDA(dst, b, h) do { _Pragma("unroll") for (int m = 0; m < 4; ++m) _Pragma("unroll") for (int k = 0; k < 2; ++k) dst[m][k] = *(const LAS bf16x8*)(lds + PG8_SA(b, h) + aoff + m * 2048 + k * 1024); } while (0)
#define PG8_LDB(dst, b, h) do { _Pragma("unroll") for (int n = 0; n < 2; ++n) _Pragma("unroll") for (int k = 0; k < 2; ++k) dst[n][k] = *(const LAS bf16x8*)(lds + PG8_SB(b, h) + boff + n * 2048 + k * 1024); } while (0)
#define PG8_MMA(ai, bj, At, Bt) do { __builtin_amdgcn_s_setprio(1); _Pragma("unroll") for (int m = 0; m < 4; ++m) _Pragma("unroll") for (int n = 0; n < 2; ++n) _Pragma("unroll") for (int k = 0; k < 2; ++k) \
        acc[ai][bj][m][n] = __builtin_amdgcn_mfma_f32_16x16x32_bf16(Bt[n][k], At[m][k], acc[ai][bj][m][n], 0, 0, 0); __builtin_amdgcn_s_setprio(0); } while (0)
#define PG8_WAIT_V(n) asm volatile("s_waitcnt vmcnt(" #n ")" ::: "memory")
#define PG8_WAIT_L(n) asm volatile("s_waitcnt lgkmcnt(" #n ")" ::: "memory")
#define PG8_BAR __builtin_amdgcn_s_barrier()
#define PG8_SCHED __builtin_amdgcn_sched_barrier(0)
    Unit cur, nxt; int ui = 0;
    if (!S.next(0, cur)) return;
    f32x4 acc[2][2][4][2];
#pragma unroll
    for (int a = 0; a < 2; ++a)
#pragma unroll
        for (int b = 0; b < 2; ++b)
#pragma unroll
            for (int m = 0; m < 4; ++m)
#pragma unroll
                for (int n = 0; n < 2; ++n) acc[a][b][m][n] = (f32x4){0.f, 0.f, 0.f, 0.f};
    bf16x8 At[4][2], B0[2][2], B1[2][2];
    const char* cA = cur.A; const char* cB = cur.B;
    PG8_STAGE(PG8_SB(0, 0), cB, voffB); PG8_STAGE(PG8_SA(0, 0), cA, voffA); PG8_STAGE(PG8_SB(0, 1), cB + hstepB, voffB); PG8_STAGE(PG8_SA(0, 1), cA + hstepA, voffA);
    if (wr == 1) PG8_BAR;
    PG8_WAIT_V(4); PG8_BAR;
    PG8_STAGE(PG8_SB(1, 0), cB + kstep, voffB); PG8_STAGE(PG8_SA(1, 0), cA + kstep, voffA); PG8_STAGE(PG8_SB(1, 1), cB + hstepB + kstep, voffB);
    PG8_WAIT_V(6); PG8_BAR;
    for (;;) {
        const bool has_next = S.next(ui + 1, nxt);
        const char* nA = has_next ? nxt.A : cA; const char* nB = has_next ? nxt.B : cB;
        for (int t = 0; t < nt; t += 2) {
            const bool last = (t == nt - 2);
            const char* a1 = cA + (size_t)(t + 1) * kstep;
            const char* a2 = last ? nA : cA + (size_t)(t + 2) * kstep; const char* b2 = last ? nB : cB + (size_t)(t + 2) * kstep;
            const char* a3 = a2 + kstep; const char* b3 = b2 + kstep;
            if constexpr (Epi::MID != 0) { if (t != 0 && (t % Epi::MID) == 0) E.mid(acc, cur, t / Epi::MID, wr, wc, fr, fq); }
            PG8_LDB(B0, 0, 0); PG8_SCHED; PG8_LDA(At, 0, 0); PG8_STAGE(PG8_SA(1, 1), a1 + hstepA, voffA);
            PG8_WAIT_L(8); PG8_BAR; PG8_WAIT_L(0); PG8_MMA(0, 0, At, B0); PG8_BAR; PG8_SCHED;
            PG8_LDB(B1, 0, 1); PG8_STAGE(PG8_SB(0, 0), b2, voffB);
            PG8_BAR; PG8_WAIT_L(0); PG8_MMA(0, 1, At, B1); PG8_BAR;
            PG8_LDA(At, 0, 1); PG8_STAGE(PG8_SA(0, 0), a2, voffA);
            PG8_BAR; PG8_WAIT_L(0); PG8_MMA(1, 0, At, B0); PG8_BAR; PG8_SCHED;
            PG8_STAGE(PG8_SB(0, 1), b2 + hstepB, voffB);
            PG8_WAIT_V(6); PG8_BAR; PG8_MMA(1, 1, At, B1); PG8_BAR;
            PG8_LDB(B0, 1, 0); PG8_SCHED; PG8_LDA(At, 1, 0); PG8_STAGE(PG8_SA(0, 1), a2 + hstepA, voffA);
            PG8_WAIT_L(8); PG8_BAR; PG8_WAIT_L(0); PG8_MMA(0, 0, At, B0); PG8_BAR; PG8_SCHED;
            PG8_LDB(B1, 1, 1); PG8_STAGE(PG8_SB(1, 0), b3, voffB);
            PG8_BAR; PG8_WAIT_L(0); PG8_MMA(0, 1, At, B1); PG8_BAR;
            PG8_LDA(At, 1, 1); PG8_STAGE(PG8_SA(1, 0), a3, voffA);
            PG8_BAR; PG8_WAIT_L(0); PG8_MMA(1, 0, At, B0); PG8_BAR; PG8_SCHED;
            PG8_STAGE(PG8_SB(1, 1), b3 + hstepB, voffB);
            PG8_WAIT_V(6); PG8_BAR; PG8_MMA(1, 1, At, B1); PG8_BAR;
        }
        E(acc, cur, wr, wc, fr, fq);
        if (!has_next) break;
#pragma unroll
        for (int a = 0; a < 2; ++a)
#pragma unroll
            for (int b = 0; b < 2; ++b)
#pragma unroll
                for (int m = 0; m < 4; ++m)
#pragma unroll
                    for (int n = 0; n < 2; ++n) acc[a][b][m][n] = (f32x4){0.f, 0.f, 0.f, 0.f};
        cur = nxt; cA = nA; cB = nB; ++ui;
    }
    PG8_WAIT_V(0);
    if (wr == 0) PG8_BAR;
    PG8_BAR;
#undef PG8_SA
#undef PG8_SB
#undef PG8_STAGE
#undef PG8_LDA
#undef PG8_LDB
#undef PG8_MMA
#undef PG8_WAIT_V
#undef PG8_WAIT_L
#undef PG8_BAR
#undef PG8_SCHED
}
}
using pg8::Unit;

struct Params { const float* in[27]; float* out; unsigned char* ws; int ph_lo, ph_hi; };
struct Ctx {
    const float* const CAS* in; float* out; unsigned char* ws; LAS unsigned char* lds;
    int tid, lane, wave, G, c;
};
#define WSP(T_, off) ((T_*)(X.ws + (off)))

struct SchedStatic {
    int nM, nN, G, c; const char* A; const char* B; size_t tA, tB;
    __device__ __forceinline__ bool next(int i, Unit& u) const {
        const long L = (long)i * G + c; if (L >= (long)nM * nN) return false;
        pg8::tile_of((int)L, nM, nN, u.pm, u.pn); u.aux = 0; u.A = A + (size_t)u.pm * tA; u.B = B + (size_t)u.pn * tB; return true;
    }
};
struct SchedMerge {
    int G, c; const char* A; const char* B;
    __device__ __forceinline__ bool next(int i, Unit& u) const {
        const int q = i / 3, n = i - 3 * q; const long L = (long)q * G + c; if (L >= 64 * 4) return false;
        pg8::tile_of((int)L, 64, 4, u.pm, u.pn); u.aux = n;
        u.A = A + ((size_t)u.pm * 256 * YW + 512 * n) * 2; u.B = B + ((size_t)u.pn * 256 * YW + 512 * n) * 2; return true;
    }
};
struct SchedMoe {
    int G, c, ncol_shift, nT; const LAS int* tile_e; const LAS int* tile_pm; const char* A; const char* B; size_t tA, eB, tB;
    __device__ __forceinline__ bool next(int i, Unit& u) const {
        const long L = (long)i * G + c; if (L >= ((long)nT << ncol_shift)) return false;
        const int rt = (int)(L >> ncol_shift); u.pn = (int)(L & ((1 << ncol_shift) - 1)); u.pm = tile_pm[rt]; u.aux = tile_e[rt];
        u.A = A + (size_t)u.pm * tA; u.B = B + (size_t)u.aux * eB + (size_t)u.pn * tB; return true;
    }
};

struct EpiProj { static constexpr int MID = 0; static constexpr bool PERM = true; bf16_t* O;
    __device__ __forceinline__ void operator()(const f32x4 (&acc)[2][2][4][2], const Unit& u, int wr, int wc, int fr, int fq) const {
        const int row0 = u.pm * 256 + wr * 64 + fr, col0 = u.pn * 256 + wc * 32 + 8 * fq; const bool act = u.pn < 4;
#pragma unroll
        for (int ai = 0; ai < 2; ++ai)
#pragma unroll
            for (int m = 0; m < 4; ++m) { bf16_t* rowp = O + (size_t)(row0 + ai * 128 + m * 16) * NP + col0;
#pragma unroll
                for (int bj = 0; bj < 2; ++bj) { f32x4 v0 = acc[ai][bj][m][0], v1 = acc[ai][bj][m][1];
                    if (act) {
#pragma unroll
                        for (int j = 0; j < 4; ++j) { v0[j] = gelu_tanh(v0[j]); v1[j] = gelu_tanh(v1[j]); } }
                    u32x4 w; w.x = cvt_pk_bf16(v0[0], v0[1]); w.y = cvt_pk_bf16(v0[2], v0[3]); w.z = cvt_pk_bf16(v1[0], v1[1]); w.w = cvt_pk_bf16(v1[2], v1[3]);
                    *(u32x4*)(rowp + bj * 128) = w; } }
    }
};
struct EpiMerge { static constexpr int MID = 8; static constexpr bool PERM = true; const bf16_t* proj; const float* bgate; bf16_t* mb;
    __device__ __forceinline__ void eneg(int r, int c, int n3, float (&e)[8]) const {
        const u32x4 gw = *(const u32x4*)(proj + (size_t)r * NP + C_GATE + n3 * 1024 + c);
        const f32x4 b0 = *(const f32x4*)(bgate + n3 * 1024 + c), b1 = *(const f32x4*)(bgate + n3 * 1024 + c + 4);
        float x[8] = {lo_bf(gw.x) + b0[0], hi_bf(gw.x) + b0[1], lo_bf(gw.y) + b0[2], hi_bf(gw.y) + b0[3], lo_bf(gw.z) + b1[0], hi_bf(gw.z) + b1[1], lo_bf(gw.w) + b1[2], hi_bf(gw.w) + b1[3]};
#pragma unroll
        for (int i = 0; i < 8; ++i) { const float xc = fminf(fmaxf(x[i], -30.f), 30.f); e[i] = fast_exp(-xc); }
    }
    __device__ __forceinline__ void mid(f32x4 (&acc)[2][2][4][2], const Unit& u, int j, int wr, int wc, int fr, int fq) const {
        const int row0 = u.pm * 256 + wr * 64 + fr, col0 = u.pn * 256 + wc * 32 + 8 * fq;
#pragma unroll
        for (int ai = 0; ai < 2; ++ai)
#pragma unroll
            for (int m = 0; m < 4; ++m) { const int r = row0 + ai * 128 + m * 16;
#pragma unroll
                for (int bj = 0; bj < 2; ++bj) { const int c = col0 + bj * 128; float ep[8], ec[8]; eneg(r, c, j - 1, ep); eneg(r, c, j, ec);
#pragma unroll
                    for (int n = 0; n < 2; ++n)
#pragma unroll
                        for (int k = 0; k < 4; ++k) acc[ai][bj][m][n][k] *= (1.f + ec[4 * n + k]) * __builtin_amdgcn_rcpf(1.f + ep[4 * n + k]); } }
    }
    __device__ __forceinline__ void operator()(const f32x4 (&acc)[2][2][4][2], const Unit& u, int wr, int wc, int fr, int fq) const {
        const int row0 = u.pm * 256 + wr * 64 + fr, col0 = u.pn * 256 + wc * 32 + 8 * fq;
#pragma unroll
        for (int ai = 0; ai < 2; ++ai)
#pragma unroll
            for (int m = 0; m < 4; ++m) { const int r = row0 + ai * 128 + m * 16;
#pragma unroll
                for (int bj = 0; bj < 2; ++bj) { const int c = col0 + bj * 128; float e2[8], o[8]; eneg(r, c, 2, e2);
#pragma unroll
                    for (int n = 0; n < 2; ++n)
#pragma unroll
                        for (int k = 0; k < 4; ++k) o[4 * n + k] = acc[ai][bj][m][n][k] * __builtin_amdgcn_rcpf(1.f + e2[4 * n + k]);
                    u32x4 w; w.x = cvt_pk_bf16(o[0], o[1]); w.y = cvt_pk_bf16(o[2], o[3]); w.z = cvt_pk_bf16(o[4], o[5]); w.w = cvt_pk_bf16(o[6], o[7]);
                    *(u32x4*)(mb + (size_t)r * 1024 + c) = w; } }
    }
};
struct EpiOut { static constexpr int MID = 0; static constexpr bool PERM = false; float* out; const float* gt;
    __device__ __forceinline__ void operator()(const f32x4 (&acc)[2][2][4][2], const Unit& u, int wr, int wc, int fr, int fq) const {
        const int row0 = u.pm * 256 + wr * 64 + fr, col0 = u.pn * 256 + wc * 32 + 4 * fq; const float* g = gt + (size_t)(u.pm >> 4) * 6144;
#pragma unroll
        for (int ai = 0; ai < 2; ++ai)
#pragma unroll
            for (int m = 0; m < 4; ++m) { const int r = row0 + ai * 128 + m * 16;
#pragma unroll
                for (int bj = 0; bj < 2; ++bj)
#pragma unroll
                    for (int n = 0; n < 2; ++n) { const int c = col0 + bj * 128 + n * 16; float* p = out + (size_t)r * 1024 + c;
                        const f32x4 gv = *(const f32x4*)(g + c); *(f32x4*)p = *(const f32x4*)p + gv * acc[ai][bj][m][n]; } }
    }
};
struct EpiMoe1 { static constexpr int MID = 0; static constexpr bool PERM = true; bf16_t* act; const float* sw;
    __device__ __forceinline__ void operator()(const f32x4 (&acc)[2][2][4][2], const Unit& u, int wr, int wc, int fr, int fq) const {
        const int row0 = u.pm * 256 + wr * 64 + fr, col0 = u.pn * 128 + wc * 32 + 8 * fq;
#pragma unroll
        for (int ai = 0; ai < 2; ++ai)
#pragma unroll
            for (int m = 0; m < 4; ++m) { const int r = row0 + ai * 128 + m * 16; const float w = sw[r]; float o[8];
#pragma unroll
                for (int n = 0; n < 2; ++n)
#pragma unroll
                    for (int j = 0; j < 4; ++j) { const float g = acc[ai][0][m][n][j], up = acc[ai][1][m][n][j]; o[4 * n + j] = g * sigmoidf_(g) * up * w; }
                u32x4 pk; pk.x = cvt_pk_bf16(o[0], o[1]); pk.y = cvt_pk_bf16(o[2], o[3]); pk.z = cvt_pk_bf16(o[4], o[5]); pk.w = cvt_pk_bf16(o[6], o[7]);
                *(u32x4*)(act + (size_t)r * 256 + col0) = pk; }
    }
};
struct EpiMoe2 { static constexpr int MID = 0; static constexpr bool PERM = true; bf16_t* O;
    __device__ __forceinline__ void operator()(const f32x4 (&acc)[2][2][4][2], const Unit& u, int wr, int wc, int fr, int fq) const {
        const int row0 = u.pm * 256 + wr * 64 + fr, col0 = u.pn * 256 + wc * 32 + 8 * fq;
#pragma unroll
        for (int ai = 0; ai < 2; ++ai)
#pragma unroll
            for (int m = 0; m < 4; ++m) { bf16_t* rowp = O + (size_t)(row0 + ai * 128 + m * 16) * 1024 + col0;
#pragma unroll
                for (int bj = 0; bj < 2; ++bj) { const f32x4 v0 = acc[ai][bj][m][0], v1 = acc[ai][bj][m][1];
                    u32x4 w; w.x = cvt_pk_bf16(v0[0], v0[1]); w.y = cvt_pk_bf16(v0[2], v0[3]); w.z = cvt_pk_bf16(v1[0], v1[1]); w.w = cvt_pk_bf16(v1[2], v1[3]);
                    *(u32x4*)(rowp + bj * 128) = w; } }
    }
};

__device__ __forceinline__ void phase_mod(const Ctx& X) {
    LAS float* sc = (LAS float*)X.lds;
    LAS float* red = (LAS float*)(X.lds + 16384);
    const float* c = X.in[1]; const float* wm = X.in[2]; const float* bm = X.in[3]; float* mod = WSP(float, WS_MOD);
    for (int i = X.tid; i < 4096; i += 512) { const float v = c[i]; sc[i] = v * sigmoidf_(v); }
    __syncthreads();
    const int jj = X.tid & 63, ks = X.tid >> 6;
    for (int u = X.c; u < NL * 96; u += X.G) {
        const int l = u / 96, j0 = (u % 96) * 64;
        float a0 = 0.f, a1 = 0.f, a2 = 0.f, a3 = 0.f;
        const float* wp = wm + ((size_t)l * 1024 + ks * 128) * 6144 + j0 + jj;
#pragma unroll 8
        for (int k = 0; k < 128; ++k) { const float w = wp[(size_t)k * 6144]; const int kk = ks * 128 + k;
            a0 += sc[kk] * w; a1 += sc[1024 + kk] * w; a2 += sc[2048 + kk] * w; a3 += sc[3072 + kk] * w; }
        red[(ks * 64 + jj) * 4 + 0] = a0; red[(ks * 64 + jj) * 4 + 1] = a1; red[(ks * 64 + jj) * 4 + 2] = a2; red[(ks * 64 + jj) * 4 + 3] = a3;
        __syncthreads();
        if (X.tid < 256) { const int b = X.tid >> 6; float s = bm[l * 6144 + j0 + jj];
#pragma unroll
            for (int q = 0; q < 8; ++q) s += red[(q * 64 + jj) * 4 + b];
            mod[((size_t)l * NB + b) * 6144 + j0 + jj] = s; }
        __syncthreads();
    }
}

__device__ __forceinline__ int wincol(int m) {
    if (m < 2560) return m;
    if (m < 4416) return m + 16;
    if (m < 4432) return 2560 + (m - 4416);
    if (m < 4436) return m;
    if (m < 4608) return -1;
    return 4436 + (m - 4608);
}
__device__ __forceinline__ void phase_conv(const Ctx& X, int l) {
    LAS float* tile = (LAS float*)X.lds;
    const int c = X.tid & 63, r0 = X.tid >> 6;
    constexpr int J0 = 1920, J1 = J0 + 384, J2 = J1 + 256, J3 = J2 + 2048, J4 = J3 + 1024, J5 = J4 + 16;
    for (int j = X.c; j < J5; j += X.G) {
        if (j >= J4) {
            const int q = j - J4; const float* src = X.in[9] + (size_t)l * 65536; bf16_t* dst = WSP(bf16_t, WS_WS);
            for (int i = X.tid; i < 4096; i += 512) { const int e = q * 4096 + i, t = (e >> 7) & 127, s = e & 127; dst[e] = f2bf(s <= t ? src[e] : 0.f); }
            continue;
        }
        const float* sp; int sld, scol; bf16_t* dp; int dld;
        if (j < J0) { const int nt = j >> 4, kt = j & 15; sp = X.in[6] + ((size_t)l * 1024 + kt * 64) * NIN; sld = NIN; scol = wincol(nt * 64 + c);
            dp = WSP(bf16_t, WS_WIN) + (size_t)(nt * 64) * 1024 + kt * 64; dld = 1024; }
        else if (j < J1) { const int q = j - J0, n = q >> 7, dt = (q >> 3) & 15, et = q & 7;
            sp = X.in[17] + (((size_t)l * 3 + n) * 512 + et * 64) * 1024; sld = 1024; scol = dt * 64 + c;
            dp = WSP(bf16_t, WS_WBR) + (size_t)(dt * 64) * YW + n * 512 + et * 64; dld = YW; }
        else if (j < J2) { const int q = j - J1, nt = q >> 4, kt = q & 15;
            sp = X.in[19] + ((size_t)l * 1024 + kt * 64) * 1024; sld = 1024; scol = nt * 64 + c;
            dp = WSP(bf16_t, WS_WOUT) + (size_t)(nt * 64) * 1024 + kt * 64; dld = 1024; }
        else if (j < J3) { const int q = j - J2, e = q >> 7, rt = (q >> 4) & 7, kt = q & 15; const int n0 = rt * 64, pn = n0 >> 8, half = (n0 >> 7) & 1;
            sp = (half ? X.in[25] : X.in[24]) + (((size_t)l * 16 + e) * 1024 + kt * 64) * 256; sld = 256; scol = 128 * pn + (n0 & 127) + c;
            dp = WSP(bf16_t, WS_WE1) + ((size_t)e * 512 + n0) * 1024 + kt * 64; dld = 1024; }
        else { const int q = j - J3, e = q >> 6, dt = (q >> 2) & 15, kt = q & 3;
            sp = X.in[26] + (((size_t)l * 16 + e) * 256 + kt * 64) * 1024; sld = 1024; scol = dt * 64 + c;
            dp = WSP(bf16_t, WS_WE2) + ((size_t)e * 1024 + dt * 64) * 256 + kt * 64; dld = 256; }
#pragma unroll
        for (int i = 0; i < 8; ++i) { const int k = r0 + 8 * i; tile[k * 65 + c] = scol >= 0 ? sp[(size_t)k * sld + scol] : 0.f; }
        __syncthreads();
#pragma unroll
        for (int i = 0; i < 8; ++i) { const int n = r0 + 8 * i; dp[(size_t)n * dld + c] = f2bf(tile[c * 65 + n]); }
        __syncthreads();
    }
}

__device__ __forceinline__ void phase_norm1(const Ctx& X, int l, int mode) {
    const float* xin = X.in[0]; float* out = X.out; const float* mod = WSP(float, WS_MOD);
    const bf16_t* ffn = WSP(bf16_t, WS_FFN); const int* toks = WSP(int, WS_TOKS); bf16_t* h = WSP(bf16_t, WS_H);
    const float* g1 = X.in[4] + (size_t)l * 1024;
    for (int r = X.c * 8 + X.wave; r < T; r += X.G * 8) {
        const int b = r >> 12;
        f32x4 xv[4];
        if (mode == 0) {
#pragma unroll
            for (int i = 0; i < 4; ++i) xv[i] = *(const f32x4*)(xin + (size_t)r * 1024 + 4 * X.lane + 256 * i);
        } else {
            const int s0 = toks[2 * r], s1 = toks[2 * r + 1];
            const float* gt2 = mod + ((size_t)(l - 1) * NB + b) * 6144 + 5120;
#pragma unroll
            for (int i = 0; i < 4; ++i) { const int col = 4 * X.lane + 256 * i;
                const f32x4 xo = *(const f32x4*)(out + (size_t)r * 1024 + col); const f32x4 g = *(const f32x4*)(gt2 + col);
                const u32x2 a = *(const u32x2*)(ffn + (size_t)s0 * 1024 + col), bb = *(const u32x2*)(ffn + (size_t)s1 * 1024 + col);
                f32x4 f; f[0] = lo_bf(a.x) + lo_bf(bb.x); f[1] = hi_bf(a.x) + hi_bf(bb.x); f[2] = lo_bf(a.y) + lo_bf(bb.y); f[3] = hi_bf(a.y) + hi_bf(bb.y);
                xv[i] = xo + g * f; }
        }
#pragma unroll
        for (int i = 0; i < 4; ++i) *(f32x4*)(out + (size_t)r * 1024 + 4 * X.lane + 256 * i) = xv[i];
        if (mode == 2) continue;
        float ss = 0.f;
#pragma unroll
        for (int i = 0; i < 4; ++i) ss += xv[i][0] * xv[i][0] + xv[i][1] * xv[i][1] + xv[i][2] * xv[i][2] + xv[i][3] * xv[i][3];
        ss = wave_sum(ss);
        const float rstd = __builtin_amdgcn_rsqf(ss * (1.f / 1024.f) + EPS);
        const float* md = mod + ((size_t)l * NB + b) * 6144;
#pragma unroll
        for (int i = 0; i < 4; ++i) { const int col = 4 * X.lane + 256 * i;
            const f32x4 g = *(const f32x4*)(g1 + col), sh = *(const f32x4*)(md + col), sc = *(const f32x4*)(md + 1024 + col);
            f32x4 y = xv[i] * rstd * g * (sc + 1.f) + sh;
            u32x2 w; w.x = cvt_pk_bf16(y[0], y[1]); w.y = cvt_pk_bf16(y[2], y[3]); *(u32x2*)(h + (size_t)r * 1024 + col) = w; }
    }
}

__device__ __forceinline__ void sub_qknorm(const Ctx& X, int l) {
    bf16_t* proj = WSP(bf16_t, WS_PROJ);
    const int j = X.lane >> 3, d0 = 16 * (X.lane & 7);
    const float* gp = (j < 4 ? X.in[14] : X.in[15]) + (size_t)l * 128 + d0;
    float g[16];
#pragma unroll
    for (int i = 0; i < 16; ++i) g[i] = gp[i];
    for (int r = X.c * 8 + X.wave; r < T; r += X.G * 8) {
        bf16_t* p = proj + (size_t)r * NP + C_DQ + 16 * X.lane;
        const u32x4 a = *(const u32x4*)p, b = *(const u32x4*)(p + 8);
        float v[16];
        v[0] = lo_bf(a.x); v[1] = hi_bf(a.x); v[2] = lo_bf(a.y); v[3] = hi_bf(a.y); v[4] = lo_bf(a.z); v[5] = hi_bf(a.z); v[6] = lo_bf(a.w); v[7] = hi_bf(a.w);
        v[8] = lo_bf(b.x); v[9] = hi_bf(b.x); v[10] = lo_bf(b.y); v[11] = hi_bf(b.y); v[12] = lo_bf(b.z); v[13] = hi_bf(b.z); v[14] = lo_bf(b.w); v[15] = hi_bf(b.w);
        float ss = 0.f;
#pragma unroll
        for (int i = 0; i < 16; ++i) ss += v[i] * v[i];
        ss += __shfl_xor(ss, 1); ss += __shfl_xor(ss, 2); ss += __shfl_xor(ss, 4);
        const float rstd = __builtin_amdgcn_rsqf(ss * (1.f / 128.f) + EPS);
#pragma unroll
        for (int i = 0; i < 16; ++i) v[i] = v[i] * rstd * g[i];
        u32x4 oa, ob;
        oa.x = cvt_pk_bf16(v[0], v[1]); oa.y = cvt_pk_bf16(v[2], v[3]); oa.z = cvt_pk_bf16(v[4], v[5]); oa.w = cvt_pk_bf16(v[6], v[7]);
        ob.x = cvt_pk_bf16(v[8], v[9]); ob.y = cvt_pk_bf16(v[10], v[11]); ob.z = cvt_pk_bf16(v[12], v[13]); ob.w = cvt_pk_bf16(v[14], v[15]);
        *(u32x4*)p = oa; *(u32x4*)(p + 8) = ob;
    }
}
__device__ __forceinline__ void sub_vtrans(const Ctx& X) {
    const bf16_t* proj = WSP(bf16_t, WS_PROJ); bf16_t* vt = WSP(bf16_t, WS_VT);
    LAS bf16_t* tile = (LAS bf16_t*)X.lds;
    for (int j = X.c; j < 2048; j += X.G) {
        const int bh = j >> 7, et = (j >> 6) & 1, st = j & 63, b = bh >> 2, hh = bh & 3;
        { const int s = X.tid >> 3, e8 = (X.tid & 7) * 8;
          const u32x4 v = *(const u32x4*)(proj + ((size_t)b * SEQ + st * 64 + s) * NP + C_DV + 128 * hh + et * 64 + e8);
          *(LAS u32x4*)(tile + s * 72 + e8) = v; }
        __syncthreads();
        { const int e = X.tid >> 3, s8 = (X.tid & 7) * 8; unsigned short q[8];
#pragma unroll
          for (int i = 0; i < 8; ++i) q[i] = tile[(s8 + i) * 72 + e];
          u32x4 w; w.x = q[0] | ((unsigned)q[1] << 16); w.y = q[2] | ((unsigned)q[3] << 16); w.z = q[4] | ((unsigned)q[5] << 16); w.w = q[6] | ((unsigned)q[7] << 16);
          *(u32x4*)(vt + ((size_t)bh * 128 + et * 64 + e) * SEQ + st * 64 + s8) = w; }
        __syncthreads();
    }
}

__device__ __forceinline__ void sub_gmlp(const Ctx& X, int l) {
    const bf16_t* proj = WSP(bf16_t, WS_PROJ); bf16_t* y = WSP(bf16_t, WS_Y); const bf16_t* wsb = WSP(bf16_t, WS_WS);
    LAS unsigned char* Wg = X.lds; LAS unsigned char* Vn = X.lds + 34816; LAS float* st = (LAS float*)(X.lds + 69632);
    const float* lng = X.in[7] + (size_t)l * 512; const float* lnb = X.in[8] + (size_t)l * 512; const float* bs = X.in[10] + (size_t)l * 512;
    const int r = X.lane & 31, hf = X.lane >> 5;
    for (int u = X.c; u < 512; u += X.G) {
        const int ch = u >> 2, g = u & 3; const size_t t0 = (size_t)ch * 128;
#pragma unroll
        for (int i = 0; i < 4; ++i) { const int q = X.tid + 512 * i, row = q >> 4, cc = q & 15;
            *(LAS u32x4*)(Wg + row * 272 + cc * 16) = *(const u32x4*)(wsb + ((size_t)g * 128 + row) * 128 + cc * 8); }
        for (int i = 0; i < 16; ++i) { const int tt = X.wave * 16 + i;
            const u32x4 a = *(const u32x4*)(proj + (t0 + tt) * NP + C_AV + 8 * X.lane);
            float v[8] = {lo_bf(a.x), hi_bf(a.x), lo_bf(a.y), hi_bf(a.y), lo_bf(a.z), hi_bf(a.z), lo_bf(a.w), hi_bf(a.w)};
            float s = 0.f;
#pragma unroll
            for (int k = 0; k < 8; ++k) s += v[k];
            const float mean = wave_sum(s) * (1.f / 512.f);
            float q2 = 0.f;
#pragma unroll
            for (int k = 0; k < 8; ++k) { const float d = v[k] - mean; q2 += d * d; }
            const float rstd = __builtin_amdgcn_rsqf(wave_sum(q2) * (1.f / 512.f) + EPS);
            if (X.lane == 0) { st[2 * tt] = mean; st[2 * tt + 1] = rstd; } }
        __syncthreads();
#pragma unroll
        for (int i = 0; i < 4; ++i) { const int q = X.tid + 512 * i, tt = q & 127, jb = q >> 7;
            const u32x4 a = *(const u32x4*)(proj + (t0 + tt) * NP + C_AV + 128 * g + 8 * jb);
            const float mean = st[2 * tt], rstd = st[2 * tt + 1];
            float v[8] = {lo_bf(a.x), hi_bf(a.x), lo_bf(a.y), hi_bf(a.y), lo_bf(a.z), hi_bf(a.z), lo_bf(a.w), hi_bf(a.w)};
#pragma unroll
            for (int e = 0; e < 8; ++e) { const int d = 8 * jb + e; const float o = (v[e] - mean) * rstd * lng[128 * g + d] + lnb[128 * g + d];
                *(LAS bf16_t*)(Vn + d * 272 + tt * 2) = f2bf(o); } }
        __syncthreads();
        { const int tb = X.wave >> 1, dh = X.wave & 1;
          f32x16 acc[2];
#pragma unroll
          for (int nb = 0; nb < 2; ++nb)
#pragma unroll
              for (int k = 0; k < 16; ++k) acc[nb][k] = 0.f;
          const int nks = 2 * (tb + 1);
          for (int ks = 0; ks < nks; ++ks) {
              const bf16x8 a = *(const LAS bf16x8*)(Wg + (32 * tb + r) * 272 + (16 * ks + 8 * hf) * 2);
#pragma unroll
              for (int nb = 0; nb < 2; ++nb) { const bf16x8 b = *(const LAS bf16x8*)(Vn + (64 * dh + 32 * nb + r) * 272 + (16 * ks + 8 * hf) * 2);
                  acc[nb] = __builtin_amdgcn_mfma_f32_32x32x16_bf16(a, b, acc[nb], 0, 0, 0); } }
#pragma unroll
          for (int nb = 0; nb < 2; ++nb)
#pragma unroll
              for (int k = 0; k < 16; ++k) { const int t = 32 * tb + (k & 3) + 8 * (k >> 2) + 4 * hf, d = 64 * dh + 32 * nb + r;
                  const float uu = bf2f(proj[(t0 + t) * NP + C_AU + 128 * g + d]);
                  y[(t0 + t) * YW + 128 * g + d] = f2bf((acc[nb][k] + bs[g * 128 + t]) * uu); } }
        __syncthreads();
    }
}

__device__ __forceinline__ float log_sigmoid_(float z) { return fminf(z, 0.f) - __logf(1.f + __expf(-fabsf(z))); }

__device__ __forceinline__ void sub_gla_local(const Ctx& X, int l) {
    const bf16_t* proj = WSP(bf16_t, WS_PROJ); float* U = WSP(float, WS_SCR); float* dec = WSP(float, WS_DEC);
    LAS float* ga = (LAS float*)X.lds; LAS float* seg = (LAS float*)(X.lds + 4096);
    LAS unsigned char* kkT = X.lds + 8192; LAS unsigned char* vT = X.lds + 17408;
    const int r = X.lane & 31, hf = X.lane >> 5;
    for (int u = X.c; u < 1024; u += X.G) {
        const int hh = u & 3, cch = (u >> 2) & 63, b = u >> 8; const size_t t0 = (size_t)b * SEQ + cch * 64;
        if (X.tid < 128) { const int tt = X.tid >> 1, half = X.tid & 1;
            const u32x4 a = *(const u32x4*)(proj + (t0 + tt) * NP + C_GA + 8 * half);
            LAS float* gp = ga + tt * 16 + 8 * half;
            gp[0] = lo_bf(a.x); gp[1] = hi_bf(a.x); gp[2] = lo_bf(a.y); gp[3] = hi_bf(a.y); gp[4] = lo_bf(a.z); gp[5] = hi_bf(a.z); gp[6] = lo_bf(a.w); gp[7] = hi_bf(a.w); }
#pragma unroll
        for (int i = 0; i < 2; ++i) { const int q = X.tid + 512 * i, s = q & 63, eb = q >> 6;
            const u32x4 a = *(const u32x4*)(proj + (t0 + s) * NP + C_GV + 128 * hh + 8 * eb);
            const unsigned w[4] = {a.x, a.y, a.z, a.w};
#pragma unroll
            for (int k = 0; k < 4; ++k) { *(LAS bf16_t*)(vT + (8 * eb + 2 * k) * 144 + s * 2) = (bf16_t)(w[k] & 0xffffu); *(LAS bf16_t*)(vT + (8 * eb + 2 * k + 1) * 144 + s * 2) = (bf16_t)(w[k] >> 16); } }
        __syncthreads();
        const int d = X.tid & 63, tq = X.tid >> 6;
        float cum[8];
        { float w2[16];
#pragma unroll
          for (int q = 0; q < 16; ++q) w2[q] = X.in[11][((size_t)l * 16 + q) * 256 + hh * 64 + d];
          const float bg = X.in[12][(size_t)l * 256 + hh * 64 + d];
          float run = 0.f;
#pragma unroll
          for (int i = 0; i < 8; ++i) { const int t = 8 * tq + i; float z = bg;
#pragma unroll
              for (int q = 0; q < 16; ++q) z += ga[t * 16 + q] * w2[q];
              run += log_sigmoid_(z) * (1.f / 16.f); cum[i] = run; }
          seg[tq * 64 + d] = run; }
        __syncthreads();
        { float pre = 0.f, tot = 0.f;
#pragma unroll
          for (int q = 0; q < 8; ++q) { const float s = seg[q * 64 + d]; tot += s; if (q < tq) pre += s; }
          float kk[8];
#pragma unroll
          for (int i = 0; i < 8; ++i) { const int t = 8 * tq + i; const float kv = bf2f(proj[(t0 + t) * NP + C_GK + 64 * hh + d]); kk[i] = kv * __expf(tot - (pre + cum[i])); }
          u32x4 w; w.x = cvt_pk_bf16(kk[0], kk[1]); w.y = cvt_pk_bf16(kk[2], kk[3]); w.z = cvt_pk_bf16(kk[4], kk[5]); w.w = cvt_pk_bf16(kk[6], kk[7]);
          *(LAS u32x4*)(kkT + d * 144 + 16 * tq) = w;
          if (tq == 0) dec[(size_t)u * 64 + d] = __expf(tot); }
        __syncthreads();
        { const int db = X.wave >> 2, eb = X.wave & 3; f32x16 acc;
#pragma unroll
          for (int k = 0; k < 16; ++k) acc[k] = 0.f;
#pragma unroll
          for (int ks = 0; ks < 4; ++ks) { const bf16x8 a = *(const LAS bf16x8*)(kkT + (32 * db + r) * 144 + (16 * ks + 8 * hf) * 2);
              const bf16x8 bb = *(const LAS bf16x8*)(vT + (32 * eb + r) * 144 + (16 * ks + 8 * hf) * 2);
              acc = __builtin_amdgcn_mfma_f32_32x32x16_bf16(a, bb, acc, 0, 0, 0); }
#pragma unroll
          for (int k = 0; k < 16; ++k) { const int dd = 32 * db + (k & 3) + 8 * (k >> 2) + 4 * hf; U[((size_t)u * 64 + dd) * 128 + 32 * eb + r] = acc[k]; } }
        __syncthreads();
    }
}

__device__ __forceinline__ void sub_gla_scan(const Ctx& X) {
    float* U = WSP(float, WS_SCR); const float* dec = WSP(float, WS_DEC);
    for (int gid = X.c * 512 + X.tid; gid < 16 * 8192; gid += X.G * 512) {
        const int bh = gid >> 13, de = gid & 8191, d = de >> 7, b = bh >> 2, hh = bh & 3;
        float S = 0.f;
        for (int cb = 0; cb < 4; ++cb) {
            float uv[16], dc[16];
#pragma unroll
            for (int j = 0; j < 16; ++j) { const size_t u = (size_t)b * 256 + (cb * 16 + j) * 4 + hh; uv[j] = U[u * 8192 + de]; dc[j] = dec[u * 64 + d]; }
#pragma unroll
            for (int j = 0; j < 16; ++j) { const size_t u = (size_t)b * 256 + (cb * 16 + j) * 4 + hh; U[u * 8192 + de] = S; S = dc[j] * S + uv[j]; }
        }
    }
}

__device__ __forceinline__ void sub_gla_out(const Ctx& X, int l) {
    const bf16_t* proj = WSP(bf16_t, WS_PROJ); const float* Sg = WSP(float, WS_SCR); bf16_t* y = WSP(bf16_t, WS_Y);
    LAS float* ga = (LAS float*)X.lds; LAS float* seg = (LAS float*)(X.lds + 4096);
    LAS unsigned char* qq = X.lds + 8192; LAS unsigned char* qS = X.lds + 17408; LAS unsigned char* kk2 = X.lds + 26624;
    LAS unsigned char* vT = X.lds + 35840; LAS unsigned char* ST = X.lds + 54272; LAS unsigned char* at = X.lds + 72704; LAS float* ob = (LAS float*)(X.lds + 81920);
    const int r = X.lane & 31, hf = X.lane >> 5;
    for (int u = X.c; u < 1024; u += X.G) {
        const int hh = u & 3, cch = (u >> 2) & 63, b = u >> 8; const size_t t0 = (size_t)b * SEQ + cch * 64;
        if (X.tid < 128) { const int tt = X.tid >> 1, half = X.tid & 1;
            const u32x4 a = *(const u32x4*)(proj + (t0 + tt) * NP + C_GA + 8 * half);
            LAS float* gp = ga + tt * 16 + 8 * half;
            gp[0] = lo_bf(a.x); gp[1] = hi_bf(a.x); gp[2] = lo_bf(a.y); gp[3] = hi_bf(a.y); gp[4] = lo_bf(a.z); gp[5] = hi_bf(a.z); gp[6] = lo_bf(a.w); gp[7] = hi_bf(a.w); }
#pragma unroll
        for (int i = 0; i < 2; ++i) { const int q = X.tid + 512 * i, s = q & 63, eb = q >> 6;
            const u32x4 a = *(const u32x4*)(proj + (t0 + s) * NP + C_GV + 128 * hh + 8 * eb);
            const unsigned w[4] = {a.x, a.y, a.z, a.w};
#pragma unroll
            for (int k = 0; k < 4; ++k) { *(LAS bf16_t*)(vT + (8 * eb + 2 * k) * 144 + s * 2) = (bf16_t)(w[k] & 0xffffu); *(LAS bf16_t*)(vT + (8 * eb + 2 * k + 1) * 144 + s * 2) = (bf16_t)(w[k] >> 16); } }
#pragma unroll
        for (int i = 0; i < 16; ++i) { const int q = X.tid + 512 * i, dd = q >> 7, e = q & 127;
            *(LAS bf16_t*)(ST + e * 144 + dd * 2) = f2bf(Sg[(size_t)u * 8192 + q]); }
        __syncthreads();
        const int d = X.tid & 63, tq = X.tid >> 6;
        float cum[8];
        { float w2[16];
#pragma unroll
          for (int q = 0; q < 16; ++q) w2[q] = X.in[11][((size_t)l * 16 + q) * 256 + hh * 64 + d];
          const float bg = X.in[12][(size_t)l * 256 + hh * 64 + d];
          float run = 0.f;
#pragma unroll
          for (int i = 0; i < 8; ++i) { const int t = 8 * tq + i; float z = bg;
#pragma unroll
              for (int q = 0; q < 16; ++q) z += ga[t * 16 + q] * w2[q];
              run += log_sigmoid_(z) * (1.f / 16.f); cum[i] = run; }
          seg[tq * 64 + d] = run; }
        __syncthreads();
        { float pre = 0.f, bref = 0.f;
#pragma unroll
          for (int q = 0; q < 8; ++q) { const float s = seg[q * 64 + d]; if (q < tq) pre += s; if (q < 4) bref += s; }
#pragma unroll
          for (int i = 0; i < 8; ++i) { const int t = 8 * tq + i; const float bt = pre + cum[i];
              const float qv = bf2f(proj[(t0 + t) * NP + C_GQ + 64 * hh + d]) * 0.125f, kv = bf2f(proj[(t0 + t) * NP + C_GK + 64 * hh + d]);
              *(LAS bf16_t*)(qq + t * 144 + d * 2) = f2bf(qv * __expf(bt - bref));
              *(LAS bf16_t*)(qS + t * 144 + d * 2) = f2bf(qv * __expf(bt));
              *(LAS bf16_t*)(kk2 + t * 144 + d * 2) = f2bf(kv * __expf(bref - bt)); } }
        __syncthreads();
        if (X.wave < 4) { const int tb = X.wave >> 1, sb = X.wave & 1; f32x16 acc;
#pragma unroll
            for (int k = 0; k < 16; ++k) acc[k] = 0.f;
#pragma unroll
            for (int ks = 0; ks < 4; ++ks) { const bf16x8 a = *(const LAS bf16x8*)(qq + (32 * tb + r) * 144 + (16 * ks + 8 * hf) * 2);
                const bf16x8 bb = *(const LAS bf16x8*)(kk2 + (32 * sb + r) * 144 + (16 * ks + 8 * hf) * 2);
                acc = __builtin_amdgcn_mfma_f32_32x32x16_bf16(a, bb, acc, 0, 0, 0); }
#pragma unroll
            for (int k = 0; k < 16; ++k) { const int t = 32 * tb + (k & 3) + 8 * (k >> 2) + 4 * hf, s = 32 * sb + r;
                *(LAS bf16_t*)(at + t * 144 + s * 2) = f2bf(s <= t ? acc[k] : 0.f); } }
        __syncthreads();
        { const int tb = X.wave >> 2, eb = X.wave & 3; f32x16 acc;
#pragma unroll
          for (int k = 0; k < 16; ++k) acc[k] = 0.f;
#pragma unroll
          for (int ks = 0; ks < 4; ++ks) { const bf16x8 a = *(const LAS bf16x8*)(qS + (32 * tb + r) * 144 + (16 * ks + 8 * hf) * 2);
              const bf16x8 bb = *(const LAS bf16x8*)(ST + (32 * eb + r) * 144 + (16 * ks + 8 * hf) * 2);
              acc = __builtin_amdgcn_mfma_f32_32x32x16_bf16(a, bb, acc, 0, 0, 0); }
#pragma unroll
          for (int ks = 0; ks < 4; ++ks) { const bf16x8 a = *(const LAS bf16x8*)(at + (32 * tb + r) * 144 + (16 * ks + 8 * hf) * 2);
              const bf16x8 bb = *(const LAS bf16x8*)(vT + (32 * eb + r) * 144 + (16 * ks + 8 * hf) * 2);
              acc = __builtin_amdgcn_mfma_f32_32x32x16_bf16(a, bb, acc, 0, 0, 0); }
#pragma unroll
          for (int k = 0; k < 16; ++k) { const int t = 32 * tb + (k & 3) + 8 * (k >> 2) + 4 * hf; ob[t * 132 + 32 * eb + r] = acc[k]; } }
        __syncthreads();
        { const int t = X.tid >> 3, j = X.tid & 7; float o[16]; float ss = 0.f;
#pragma unroll
          for (int i = 0; i < 16; ++i) { o[i] = ob[t * 132 + 16 * j + i]; ss += o[i] * o[i]; }
          ss += __shfl_xor(ss, 1); ss += __shfl_xor(ss, 2); ss += __shfl_xor(ss, 4);
          const float rstd = __builtin_amdgcn_rsqf(ss * (1.f / 128.f) + EPS);
          const bf16_t* rp = proj + (t0 + t) * NP + C_GR + 128 * hh + 16 * j; const float* gn = X.in[13] + (size_t)l * 128 + 16 * j;
          const u32x4 ra = *(const u32x4*)rp, rb = *(const u32x4*)(rp + 8);
          const unsigned rw[8] = {ra.x, ra.y, ra.z, ra.w, rb.x, rb.y, rb.z, rb.w};
          unsigned pk[8];
#pragma unroll
          for (int i = 0; i < 8; ++i) { const float r0 = lo_bf(rw[i]), r1 = hi_bf(rw[i]);
              const float v0 = o[2 * i] * rstd * gn[2 * i] * (r0 * sigmoidf_(r0)), v1 = o[2 * i + 1] * rstd * gn[2 * i + 1] * (r1 * sigmoidf_(r1));
              pk[i] = cvt_pk_bf16(v0, v1); }
          bf16_t* yp = y + (t0 + t) * YW + 512 + 128 * hh + 16 * j;
          *(u32x4*)yp = (u32x4){pk[0], pk[1], pk[2], pk[3]}; *(u32x4*)(yp + 8) = (u32x4){pk[4], pk[5], pk[6], pk[7]}; }
        __syncthreads();
    }
}

__device__ __forceinline__ void find_digit(LAS unsigned* hist, int lane, unsigned K, unsigned& digit, unsigned& above) {
    const u32x4 h4 = *(const LAS u32x4*)(hist + 4 * lane);
    const unsigned s = h4.x + h4.y + h4.z + h4.w;
    unsigned v = s;
#pragma unroll
    for (int o = 1; o < 64; o <<= 1) { const unsigned t = __shfl_down(v, o); if (lane + o < 64) v += t; }
    unsigned run = v - s, dg = 0, ab = 0; bool found = false;
    { const unsigned hb[4] = {h4.x, h4.y, h4.z, h4.w};
#pragma unroll
      for (int bi = 3; bi >= 0; --bi) { if (!found && run < K && run + hb[bi] >= K) { found = true; dg = 4 * lane + bi; ab = run; } run += hb[bi]; } }
    const unsigned long long m = __ballot(found);
    const int src = m ? (int)__builtin_ctzll(m) : 0;
    digit = (unsigned)__shfl((int)dg, src); above = (unsigned)__shfl((int)ab, src);
}
__device__ __forceinline__ void sub_dsa_select(const Ctx& X) {
    const bf16_t* proj = WSP(bf16_t, WS_PROJ); unsigned long long* mask = WSP(unsigned long long, WS_MASK);
    LAS bf16_t* keys = (LAS bf16_t*)X.lds;
    LAS unsigned* hist = (LAS unsigned*)(X.lds + AUX_OFF + 1024) + X.wave * 256;
    const int lane = X.lane;
    for (int u = X.c; u < 1024; u += X.G) {
        const int b = u & 3, qb = 255 - (u >> 2); const size_t tg0 = (size_t)b * SEQ;
        if (qb < 16) {
#pragma unroll
            for (int rr = 0; rr < 2; ++rr) { const int t = 16 * qb + 2 * X.wave + rr; const int rem = t - 64 * lane;
                const unsigned long long w = rem >= 63 ? ~0ull : (rem < 0 ? 0ull : ((2ull << rem) - 1ull));
                mask[(tg0 + t) * 64 + lane] = w; }
            continue;
        }
        const int nk = 16 * (qb + 1), nkp = (nk + 63) & ~63, ntile = nkp >> 4, nwords = nkp >> 6;
        {
            const int q = lane & 15, kg = lane >> 4; const size_t qrow = (tg0 + 16 * qb + q) * NP;
            bf16x8 Bq[4][2]; float iw[4];
#pragma unroll
            for (int hh = 0; hh < 4; ++hh) { iw[hh] = bf2f(proj[qrow + C_IW + hh]);
#pragma unroll
                for (int ks = 0; ks < 2; ++ks) Bq[hh][ks] = *(const bf16x8*)(proj + qrow + C_IQ + 64 * hh + 32 * ks + 8 * kg); }
            const int tq = 16 * qb + q;
            for (int j = X.wave; j < ntile; j += 8) {
                const size_t krow = (tg0 + 16 * j + q) * NP + C_IK;
                const bf16x8 A0 = *(const bf16x8*)(proj + krow + 8 * kg), A1 = *(const bf16x8*)(proj + krow + 32 + 8 * kg);
                f32x4 sc = {0.f, 0.f, 0.f, 0.f};
#pragma unroll
                for (int hh = 0; hh < 4; ++hh) { f32x4 a = {0.f, 0.f, 0.f, 0.f};
                    a = __builtin_amdgcn_mfma_f32_16x16x32_bf16(A0, Bq[hh][0], a, 0, 0, 0);
                    a = __builtin_amdgcn_mfma_f32_16x16x32_bf16(A1, Bq[hh][1], a, 0, 0, 0);
#pragma unroll
                    for (int k = 0; k < 4; ++k) sc[k] += iw[hh] * fmaxf(a[k], 0.f); }
                unsigned kk[4];
#pragma unroll
                for (int k = 0; k < 4; ++k) { const int key = 16 * j + 4 * kg + k; const unsigned ub = __float_as_uint(sc[k]);
                    unsigned o = (ub & 0x80000000u) ? ~ub : (ub | 0x80000000u); o >>= 16; o = o < 1u ? 1u : o;
                    kk[k] = key <= tq ? o : 0u; }
                u32x2 w; w.x = kk[0] | (kk[1] << 16); w.y = kk[2] | (kk[3] << 16);
                *(LAS u32x2*)(keys + q * 4096 + 16 * j + 4 * kg) = w;
            }
        }
        __syncthreads();
        for (int rr = 0; rr < 2; ++rr) {
            const int row = 2 * X.wave + rr, t = 16 * qb + row; const bool active = lane < nwords;
            unsigned kw[32];
#pragma unroll
            for (int i = 0; i < 8; ++i) { u32x4 v = {0u, 0u, 0u, 0u}; if (active) v = *(const LAS u32x4*)(keys + row * 4096 + 64 * lane + 8 * i);
                kw[4 * i] = v.x; kw[4 * i + 1] = v.y; kw[4 * i + 2] = v.z; kw[4 * i + 3] = v.w; }
            *(LAS u32x4*)(hist + 4 * lane) = (u32x4){0u, 0u, 0u, 0u};
            __syncthreads();
            if (active) {
#pragma unroll
                for (int i = 0; i < 32; ++i) { atomicAdd((unsigned*)(hist + ((kw[i] >> 8) & 255u)), 1u); atomicAdd((unsigned*)(hist + (kw[i] >> 24)), 1u); } }
            __syncthreads();
            unsigned d1, ab1; find_digit(hist, lane, 256u, d1, ab1);
            __syncthreads();
            *(LAS u32x4*)(hist + 4 * lane) = (u32x4){0u, 0u, 0u, 0u};
            __syncthreads();
            if (active) {
#pragma unroll
                for (int i = 0; i < 32; ++i) { const unsigned k0 = kw[i] & 0xffffu, k1 = kw[i] >> 16;
                    if ((k0 >> 8) == d1) atomicAdd((unsigned*)(hist + (k0 & 255u)), 1u);
                    if ((k1 >> 8) == d1) atomicAdd((unsigned*)(hist + (k1 & 255u)), 1u); } }
            __syncthreads();
            unsigned d2, ab2; find_digit(hist, lane, 256u - ab1, d2, ab2);
            __syncthreads();
            const unsigned vstar = (d1 << 8) | d2, need = 256u - ab1 - ab2;
            unsigned ceq = 0;
#pragma unroll
            for (int i = 0; i < 32; ++i) { ceq += ((kw[i] & 0xffffu) == vstar) ? 1u : 0u; ceq += ((kw[i] >> 16) == vstar) ? 1u : 0u; }
            unsigned incl = ceq;
#pragma unroll
            for (int o = 1; o < 64; o <<= 1) { const unsigned tt = __shfl_up(incl, o); if (lane >= o) incl += tt; }
            unsigned base = incl - ceq;
            unsigned wlo = 0u, whi = 0u;
#pragma unroll
            for (int i = 0; i < 32; ++i) { const unsigned k = (i & 1) ? (kw[i >> 1] >> 16) : (kw[i >> 1] & 0xffffu);
                bool sel = k > vstar;
                if (k == vstar) { sel = base < need; ++base; }
                wlo = (wlo >> 1) | (sel ? 0x80000000u : 0u); }
#pragma unroll
            for (int i = 32; i < 64; ++i) { const unsigned k = (i & 1) ? (kw[i >> 1] >> 16) : (kw[i >> 1] & 0xffffu);
                bool sel = k > vstar;
                if (k == vstar) { sel = base < need; ++base; }
                whi = (whi >> 1) | (sel ? 0x80000000u : 0u); }
            const unsigned long long w = ((unsigned long long)whi << 32) | wlo;
            const int rem = t - 64 * lane;
            const unsigned long long cm = rem >= 63 ? ~0ull : (rem < 0 ? 0ull : ((2ull << rem) - 1ull));
            mask[(tg0 + t) * 64 + lane] = active ? (w & cm) : 0ull;
        }
        __syncthreads();
    }
}

__device__ __forceinline__ float t5_bias_idx(int n) { return 0.f; }
__device__ __forceinline__ void sub_dsa_attn(const Ctx& X) {
    const bf16_t* proj = WSP(bf16_t, WS_PROJ); const bf16_t* vtg = WSP(bf16_t, WS_VT); const unsigned long long* mask = WSP(unsigned long long, WS_MASK);
    bf16_t* y = WSP(bf16_t, WS_Y); const float* relb = X.in[16];
    LAS unsigned char* Ks = X.lds; LAS unsigned char* Vs = X.lds + 34816; LAS float* bt = (LAS float*)(X.lds + 69632);
    LAS float* Ox = (LAS float*)X.lds; LAS float* MLx = (LAS float*)(X.lds + 65536);
    const int lane = X.lane, r = lane & 31, hf = lane >> 5, g = X.wave >> 2, wq = X.wave & 3;
    const float scale = 0.08838834764831845f;
    for (int u = X.c; u < 512; u += X.G) {
        const int bh = u & 15, qt = u < 256 ? 31 - (u >> 4) : ((u - 256) >> 4), b = bh >> 2, hh = bh & 3;
        const size_t tg0 = (size_t)b * SEQ; const int q0 = 128 * qt, tq = q0 + 32 * wq + r;
        if (X.tid < 129) { const int n = X.tid; int bk;
            if (n < 16) bk = n; else { bk = 16 + (int)(__logf((float)n * (1.f / 16.f)) / 2.0794415416798357f * 16.f); bk = bk > 31 ? 31 : bk; }
            bt[n] = relb[bk * 4 + hh]; }
        bf16x8 Qf[8];
#pragma unroll
        for (int ks = 0; ks < 8; ++ks) Qf[ks] = *(const bf16x8*)(proj + (tg0 + tq) * NP + C_DQ + 128 * hh + 16 * ks + 8 * hf);
        f32x16 O[4];
#pragma unroll
        for (int eb = 0; eb < 4; ++eb)
#pragma unroll
            for (int k = 0; k < 16; ++k) O[eb][k] = 0.f;
        float mrun = -1e30f, lrun = 0.f;
        const int nst = qt + 1;
        for (int st = 0; st < nst; ++st) {
            __syncthreads();
#pragma unroll
            for (int i = 0; i < 4; ++i) { const int q = X.tid + 512 * i, row = q >> 4, ch = q & 15;
                *(LAS u32x4*)(Ks + row * 272 + ch * 16) = *(const u32x4*)(proj + (tg0 + 128 * st + row) * NP + C_DK + 128 * hh + 8 * ch);
                *(LAS u32x4*)(Vs + row * 272 + ch * 16) = *(const u32x4*)(vtg + ((size_t)bh * 128 + row) * SEQ + 128 * st + 8 * ch); }
            __syncthreads();
            const unsigned long long mw = mask[(tg0 + tq) * 64 + 2 * st + g] >> (4 * hf);
            const unsigned mlo = (unsigned)mw, mhi = (unsigned)(mw >> 32);
            f32x16 S[2];
#pragma unroll
            for (int kb = 0; kb < 2; ++kb) {
#pragma unroll
                for (int k = 0; k < 16; ++k) S[kb][k] = 0.f;
#pragma unroll
                for (int ks = 0; ks < 8; ++ks) { const bf16x8 a = *(const LAS bf16x8*)(Ks + (64 * g + 32 * kb + r) * 272 + (16 * ks + 8 * hf) * 2);
                    S[kb] = __builtin_amdgcn_mfma_f32_32x32x16_bf16(a, Qf[ks], S[kb], 0, 0, 0); } }
            const int kg0 = 128 * st + 64 * g;
            const bool far = (q0 + 32 * wq) - (kg0 + 63) >= 128;
            const float bfar = bt[128];
            float mx = -1e30f;
#pragma unroll
            for (int kb = 0; kb < 2; ++kb)
#pragma unroll
                for (int k = 0; k < 16; ++k) { const int ko = 32 * kb + (k & 3) + 8 * (k >> 2); const unsigned bit = ((kb ? mhi : mlo) >> ((k & 3) + 8 * (k >> 2))) & 1u;
                    float bias = bfar;
                    if (!far) { int rel = tq - (kg0 + ko + 4 * hf); rel = rel < 0 ? 0 : (rel > 128 ? 128 : rel); bias = bt[rel]; }
                    const float lg = bit ? S[kb][k] * scale + bias : -1e30f; S[kb][k] = lg; mx = fmaxf(mx, lg); }
            mx = fmaxf(mx, __shfl_xor(mx, 32));
            const float mnew = fmaxf(mrun, mx), alpha = __expf(mrun - mnew);
            float ps = 0.f;
#pragma unroll
            for (int kb = 0; kb < 2; ++kb)
#pragma unroll
                for (int k = 0; k < 16; ++k) { const float p = S[kb][k] > -1e29f ? __expf(S[kb][k] - mnew) : 0.f; S[kb][k] = p; ps += p; }
            ps += __shfl_xor(ps, 32);
            lrun = lrun * alpha + ps; mrun = mnew;
#pragma unroll
            for (int eb = 0; eb < 4; ++eb)
#pragma unroll
                for (int k = 0; k < 16; ++k) O[eb][k] *= alpha;
#pragma unroll
            for (int kb = 0; kb < 2; ++kb)
#pragma unroll
                for (int s = 0; s < 2; ++s) {
                    union { bf16x8 v; unsigned w[4]; } P;
#pragma unroll
                    for (int j = 0; j < 4; ++j) P.w[j] = cvt_pk_bf16(S[kb][8 * s + 2 * j], S[kb][8 * s + 2 * j + 1]);
#pragma unroll
                    for (int eb = 0; eb < 4; ++eb) {
                        union { bf16x8 v; u32x2 h[2]; } A;
                        LAS unsigned char* vp = Vs + (32 * eb + r) * 272 + (64 * g + 32 * kb + 16 * s + 4 * hf) * 2;
                        A.h[0] = *(const LAS u32x2*)vp; A.h[1] = *(const LAS u32x2*)(vp + 16);
                        O[eb] = __builtin_amdgcn_mfma_f32_32x32x16_bf16(A.v, P.v, O[eb], 0, 0, 0); } }
        }
        __syncthreads();
        if (g == 1) {
#pragma unroll
            for (int eb = 0; eb < 4; ++eb)
#pragma unroll
                for (int k = 0; k < 16; ++k) Ox[((wq * 4 + eb) * 16 + k) * 64 + lane] = O[eb][k];
            MLx[(wq * 64 + lane) * 2] = mrun; MLx[(wq * 64 + lane) * 2 + 1] = lrun; }
        __syncthreads();
        if (g == 0) {
            const float m1 = MLx[(wq * 64 + lane) * 2], l1 = MLx[(wq * 64 + lane) * 2 + 1];
            const float m = fmaxf(mrun, m1), a0 = __expf(mrun - m), a1 = __expf(m1 - m);
            const float inv = 1.f / (lrun * a0 + l1 * a1);
#pragma unroll
            for (int eb = 0; eb < 4; ++eb)
#pragma unroll
                for (int k4 = 0; k4 < 4; ++k4) { float o[4];
#pragma unroll
                    for (int j = 0; j < 4; ++j) { const int k = 4 * k4 + j; o[j] = (O[eb][k] * a0 + Ox[((wq * 4 + eb) * 16 + k) * 64 + lane] * a1) * inv; }
                    u32x2 w; w.x = cvt_pk_bf16(o[0], o[1]); w.y = cvt_pk_bf16(o[2], o[3]);
                    *(u32x2*)(y + (tg0 + tq) * YW + 1024 + 128 * hh + 32 * eb + 8 * k4 + 4 * hf) = w; } }
        __syncthreads();
    }
}

__device__ __forceinline__ void phase_norm2(const Ctx& X, int l) {
    const float* out = X.out; const float* mod = WSP(float, WS_MOD); bf16_t* h = WSP(bf16_t, WS_H);
    int* toke = WSP(int, WS_TOKE); float* tokw = WSP(float, WS_TOKW); unsigned* cntb = WSP(unsigned, WS_CNT);
    LAS float* WT = (LAS float*)X.lds;
    LAS unsigned* cnt = (LAS unsigned*)(X.lds + AUX_OFF + 1024);
    const float* wg = X.in[20] + (size_t)l * 4096; const float* wr = X.in[22] + (size_t)l * 16384;
    for (int i = X.tid; i < 4096; i += 512) WT[(i & 3) * 1024 + (i >> 2)] = wg[i];
    for (int i = X.tid; i < 16384; i += 512) WT[(4 + (i & 15)) * 1024 + (i >> 4)] = wr[i];
    if (X.tid < 16) cnt[X.tid] = 0u;
    __syncthreads();
    const float* g2 = X.in[5] + (size_t)l * 1024; const float* bgrp = X.in[21] + l * 4; const float* brt = X.in[23] + l * 16;
    const int rpb = (T + X.G - 1) / X.G;
    for (int i = X.wave; i < rpb; i += 8) {
        const int r = X.c * rpb + i; if (r >= T) break;
        const int b = r >> 12; const float* md = mod + ((size_t)l * NB + b) * 6144;
        f32x4 xv[4]; float ss = 0.f;
#pragma unroll
        for (int k = 0; k < 4; ++k) { xv[k] = *(const f32x4*)(out + (size_t)r * 1024 + 4 * X.lane + 256 * k); ss += xv[k][0] * xv[k][0] + xv[k][1] * xv[k][1] + xv[k][2] * xv[k][2] + xv[k][3] * xv[k][3]; }
        ss = wave_sum(ss);
        const float rstd = __builtin_amdgcn_rsqf(ss * (1.f / 1024.f) + EPS);
        float lg[20];
#pragma unroll
        for (int o = 0; o < 20; ++o) lg[o] = 0.f;
#pragma unroll
        for (int k = 0; k < 4; ++k) { const int col = 4 * X.lane + 256 * k;
            const f32x4 g = *(const f32x4*)(g2 + col), sh = *(const f32x4*)(md + 3072 + col), sc = *(const f32x4*)(md + 4096 + col);
            const f32x4 yv = xv[k] * rstd * g * (sc + 1.f) + sh;
            u32x2 w; w.x = cvt_pk_bf16(yv[0], yv[1]); w.y = cvt_pk_bf16(yv[2], yv[3]); *(u32x2*)(h + (size_t)r * 1024 + col) = w;
#pragma unroll
            for (int o = 0; o < 20; ++o) { const f32x4 wv = *(const LAS f32x4*)(WT + o * 1024 + col); lg[o] += yv[0] * wv[0] + yv[1] * wv[1] + yv[2] * wv[2] + yv[3] * wv[3]; } }
#pragma unroll
        for (int o = 0; o < 20; ++o) lg[o] = wave_sum(lg[o]);
        if (X.lane == 0) {
            float gl[4];
#pragma unroll
            for (int k = 0; k < 4; ++k) gl[k] = lg[k] + bgrp[k];
            int gi = 0; float gm = gl[0];
#pragma unroll
            for (int k = 1; k < 4; ++k) if (gl[k] > gm) { gm = gl[k]; gi = k; }
            float se = 0.f;
#pragma unroll
            for (int k = 0; k < 4; ++k) se += __expf(gl[k] - gm);
            const float pg = 1.f / se;
            float sl[4];
#pragma unroll
            for (int k = 0; k < 4; ++k) { sl[k] = lg[4 + k] + brt[k];
#pragma unroll
                for (int q = 1; q < 4; ++q) if (gi == q) sl[k] = lg[4 + 4 * q + k] + brt[4 * q + k]; }
            int i1 = 0; float v1 = sl[0];
#pragma unroll
            for (int k = 1; k < 4; ++k) if (sl[k] > v1) { v1 = sl[k]; i1 = k; }
            int i2 = -1; float v2 = -3.0e38f;
#pragma unroll
            for (int k = 0; k < 4; ++k) if (k != i1 && sl[k] > v2) { v2 = sl[k]; i2 = k; }
            const float w1 = 1.f / (1.f + __expf(v2 - v1));
            const int e1 = 4 * gi + i1, e2 = 4 * gi + i2;
            toke[2 * r] = e1; toke[2 * r + 1] = e2; tokw[2 * r] = pg * w1; tokw[2 * r + 1] = pg * (1.f - w1);
            atomicAdd((unsigned*)(cnt + e1), 1u); atomicAdd((unsigned*)(cnt + e2), 1u);
        }
    }
    __syncthreads();
    if (X.tid < 16) cntb[X.c * 16 + X.tid] = cnt[X.tid];
    __syncthreads();
}

__device__ __forceinline__ void build_tiles(const Ctx& X, LAS int* tb, LAS int* myoff  ) {
    const unsigned* cntb = WSP(unsigned, WS_CNT);
    LAS int* tot = tb + 32;
    LAS int* part = tb + 512;
    { const int e = X.tid & 15, p = X.tid >> 4, per = (X.G + 31) >> 5; int s = 0, mine = 0;
      for (int k = 0; k < per; ++k) { const int c = p * per + k; if (c < X.G) { const int v = (int)cntb[c * 16 + e]; s += v; if (c < X.c) mine += v; } }
      part[p * 16 + e] = s; if (X.c >= p * per && X.c < (p + 1) * per) part[512 + e] = mine; }
    __syncthreads();
    if (X.tid < 16) { const int per = (X.G + 31) >> 5, mp = X.c / per; int s = 0, mine = part[512 + X.tid];
        for (int p = 0; p < 32; ++p) { const int v = part[p * 16 + X.tid]; s += v; if (p < mp) mine += v; }
        tot[X.tid] = s; myoff[X.tid] = mine; }
    __syncthreads();
    if (X.tid == 0) { int row = 0, nT = 0;
        for (int e = 0; e < 16; ++e) { const int nt = (tot[e] + 255) >> 8; tb[16 + e] = row; for (int k = 0; k < nt; ++k) { tb[64 + nT] = e; tb[256 + nT] = (row >> 8) + k; ++nT; } row += nt * 256; }
        tb[0] = nT; }
    __syncthreads();
    if (X.tid < 16) myoff[X.tid] += tb[16 + X.tid];
    __syncthreads();
}

__device__ __forceinline__ void phase_scatter(const Ctx& X) {
    const int* toke = WSP(int, WS_TOKE); const float* tokw = WSP(float, WS_TOKW); int* toks = WSP(int, WS_TOKS);
    const bf16_t* h = WSP(bf16_t, WS_H); bf16_t* h2s = WSP(bf16_t, WS_H2S); float* sw = WSP(float, WS_SW);
    LAS int* tb = (LAS int*)(X.lds + AUX_OFF + 2048); LAS int* myoff = (LAS int*)(X.lds + AUX_OFF + 1024);
    LAS int* slots = (LAS int*)X.lds;
    build_tiles(X, tb, myoff);
    const int rpb = (T + X.G - 1) / X.G, r0 = X.c * rpb;
    LAS int* te = slots + 2 * rpb;
    const int nent = 2 * ((r0 + rpb <= T) ? rpb : (T > r0 ? T - r0 : 0));
    for (int i = X.tid; i < nent; i += 512) te[i] = toke[2 * r0 + i];
    __syncthreads();
    if (X.tid < 16) { int pos = myoff[X.tid]; for (int i = 0; i < nent; ++i) if (te[i] == X.tid) { slots[i] = pos; ++pos; } }
    __syncthreads();
    for (int i = X.wave; i < rpb; i += 8) { const int r = r0 + i; if (r >= T) break;
        const u32x4 a = *(const u32x4*)(h + (size_t)r * 1024 + 16 * X.lane), bq = *(const u32x4*)(h + (size_t)r * 1024 + 16 * X.lane + 8);
#pragma unroll
        for (int k = 0; k < 2; ++k) { const int s = slots[2 * i + k];
            *(u32x4*)(h2s + (size_t)s * 1024 + 16 * X.lane) = a; *(u32x4*)(h2s + (size_t)s * 1024 + 16 * X.lane + 8) = bq;
            if (X.lane == 0) { sw[s] = tokw[2 * r + k]; toks[2 * r + k] = s; } } }
    __syncthreads();
}

__global__ void __launch_bounds__(512, 2) fwd_kernel(Params P) {
    extern __shared__ __attribute__((aligned(16))) unsigned char lds_raw[];
    Ctx X0; X0.in = (const float* const CAS*)__builtin_amdgcn_kernarg_segment_ptr(); X0.out = P.out; X0.ws = P.ws; X0.lds = (LAS unsigned char*)lds_raw;
    X0.tid = threadIdx.x; X0.lane = X0.tid & 63; X0.wave = __builtin_amdgcn_readfirstlane(X0.tid >> 6); X0.G = gridDim.x; X0.c = blockIdx.x;
    LAS unsigned* auxw = (LAS unsigned*)(X0.lds + AUX_OFF);
    if (X0.tid < 4) auxw[X0.tid] = 0u;
    __syncthreads();
#define FRESH() Ctx X = X0; { int wv_ = X0.wave; asm volatile("" : "+s"(wv_)); unsigned m_ = ~0u; asm volatile("" : "+s"(m_)); const int ln_ = __builtin_amdgcn_mbcnt_hi(m_, __builtin_amdgcn_mbcnt_lo(m_, 0u)); \
        X.wave = wv_; X.lane = ln_; X.tid = wv_ * 64 + ln_; \
        unsigned char* w_ = X0.ws; asm volatile("" : "+s"(w_)); X.ws = w_; int c_ = X0.c; asm volatile("" : "+s"(c_)); X.c = c_; \
        const float* const CAS* i_ = X0.in; asm volatile("" : "+s"(i_)); X.in = i_; }
#if N_LAUNCH_MODE == 1
    XcdBarrier bar = xcd_barrier_post((unsigned*)(X0.ws + WS_CTL), (volatile LAS unsigned*)auxw);
#define SEAM() do { if (gp >= lo && gp + 1 < hi) xcd_barrier(bar); ++gp; } while (0)
#else
#define SEAM() do { ++gp; } while (0)
#endif
    const int lo = P.ph_lo, hi = P.ph_hi; int gp = 0;
#define IN() (gp >= lo && gp < hi)
    if (IN()) REP(13) { FRESH(); phase_mod(X); }
    SEAM();
#define LAYER_BODY(l) do { \
        if (IN()) { REP(1) { FRESH(); phase_conv(X, l); } { FRESH(); if (l == 0) phase_norm1(X, l, 0); else phase_norm1(X, l, 1); } } \
        SEAM(); \
        if (IN()) REP(3) { \
            FRESH(); \
            SchedStatic S{64, 30, X.G, X.c, (const char*)WSP(bf16_t, WS_H), (const char*)WSP(bf16_t, WS_WIN), (size_t)256 * 1024 * 2, (size_t)256 * 1024 * 2}; \
            EpiProj E{WSP(bf16_t, WS_PROJ)}; \
            pg8::gemm_phase(X.lds, X.tid, 1024, 1024, 16, S, E); \
        } \
        SEAM(); \
        if (IN()) { { FRESH(); sub_qknorm(X, l); } REP(4) { FRESH(); sub_vtrans(X); } REP(5) { FRESH(); sub_gmlp(X, l); } REP(6) { FRESH(); sub_gla_local(X, l); } REP(7) { FRESH(); sub_dsa_select(X); } } \
        SEAM(); \
        if (IN()) { { FRESH(); sub_gla_scan(X); } REP(8) { FRESH(); sub_dsa_attn(X); } } \
        SEAM(); \
        if (IN()) REP(9) { FRESH(); sub_gla_out(X, l); } \
        SEAM(); \
        if (IN()) REP(10) { \
            FRESH(); \
            SchedStatic S{64, 4, X.G, X.c, (const char*)WSP(bf16_t, WS_Y), (const char*)WSP(bf16_t, WS_WBR), (size_t)256 * YW * 2, (size_t)256 * YW * 2}; \
            EpiMerge E{WSP(bf16_t, WS_PROJ), X.in[18] + (size_t)l * 3072, WSP(bf16_t, WS_H)}; \
            pg8::gemm_phase(X.lds, X.tid, YW, YW, 24, S, E); \
        } \
        SEAM(); \
        if (IN()) { \
            FRESH(); \
            SchedStatic S{64, 4, X.G, X.c, (const char*)WSP(bf16_t, WS_H), (const char*)WSP(bf16_t, WS_WOUT), (size_t)256 * 1024 * 2, (size_t)256 * 1024 * 2}; \
            EpiOut E{X.out, WSP(float, WS_MOD) + (size_t)l * NB * 6144 + 2048}; \
            pg8::gemm_phase(X.lds, X.tid, 1024, 1024, 16, S, E); \
        } \
        SEAM(); \
        if (IN()) REP(14) { FRESH(); phase_norm2(X, l); } \
        SEAM(); \
        if (IN()) REP(15) { FRESH(); phase_scatter(X); } \
        SEAM(); \
        if (IN()) REP(11) { \
            FRESH(); \
            LAS int* tb = (LAS int*)(X.lds + AUX_OFF + 2048); LAS int* myoff = (LAS int*)(X.lds + AUX_OFF + 1024); \
            build_tiles(X, tb, myoff); \
            SchedMoe S{X.G, X.c, 1, tb[0], tb + 64, tb + 256, (const char*)WSP(bf16_t, WS_H2S), (const char*)WSP(bf16_t, WS_WE1), (size_t)256 * 1024 * 2, (size_t)512 * 1024 * 2, (size_t)256 * 1024 * 2}; \
            EpiMoe1 E{WSP(bf16_t, WS_ACT), WSP(float, WS_SW)}; \
            pg8::gemm_phase(X.lds, X.tid, 1024, 1024, 16, S, E); \
        } \
        SEAM(); \
        if (IN()) REP(12) { \
            FRESH(); \
            LAS int* tb = (LAS int*)(X.lds + AUX_OFF + 2048); LAS int* myoff = (LAS int*)(X.lds + AUX_OFF + 1024); \
            build_tiles(X, tb, myoff); \
            SchedMoe S{X.G, X.c, 2, tb[0], tb + 64, tb + 256, (const char*)WSP(bf16_t, WS_ACT), (const char*)WSP(bf16_t, WS_WE2), (size_t)256 * 256 * 2, (size_t)1024 * 256 * 2, (size_t)256 * 256 * 2}; \
            EpiMoe2 E{WSP(bf16_t, WS_FFN)}; \
            pg8::gemm_phase(X.lds, X.tid, 256, 256, 4, S, E); \
        } \
        SEAM(); \
 \
    } while (0)
    LAYER_BODY(0); LAYER_BODY(1); LAYER_BODY(2); LAYER_BODY(3);
    if (IN()) { FRESH(); phase_norm1(X, NL, 2); }
#undef IN
#undef SEAM
}

constexpr int N_PHASES = 1 + NL * 11 + 1;

extern "C" void kernel_launch(void* const* d_in, const int* in_sizes, int n_in, void* d_out, int out_size, void* d_ws, size_t ws_size, hipStream_t stream) {
    static int grid = 0;
    if (grid == 0) {
        if (n_in != 27 || out_size != T * D || ws_size < WS_END) { fprintf(stderr, "kernel_launch: unexpected problem (n_in %d, out %d, ws %zu, need %zu)\n", n_in, out_size, ws_size, (size_t)WS_END); grid = -1; return; }
        int dev = 0, cus = 0, per_cu = 0;
        if (hipGetDevice(&dev) != hipSuccess || hipDeviceGetAttribute(&cus, hipDeviceAttributeMultiprocessorCount, dev) != hipSuccess) { grid = -1; return; }
        if (hipFuncSetAttribute((const void*)fwd_kernel, hipFuncAttributeMaxDynamicSharedMemorySize, LDS_BYTES) != hipSuccess) { fprintf(stderr, "kernel_launch: hipFuncSetAttribute failed\n"); grid = -1; return; }
        if (hipOccupancyMaxActiveBlocksPerMultiprocessor(&per_cu, (const void*)fwd_kernel, 512, LDS_BYTES) != hipSuccess || per_cu < 1) fprintf(stderr, "kernel_launch: occupancy query says %d\n", per_cu);
        (void)hipGetLastError();
        grid = cus;
    }
    if (grid < 0) return;
    (void)hipMemsetAsync((char*)d_ws + WS_CTL, 0, XCD_BAR_WORDS * sizeof(unsigned), stream);
    Params p{};
    for (int i = 0; i < 27; ++i) p.in[i] = (const float*)d_in[i];
    p.out = (float*)d_out; p.ws = (unsigned char*)d_ws;
#if N_LAUNCH_MODE == 1
    p.ph_lo = 0; p.ph_hi = N_PHASES;
    hipLaunchKernelGGL(fwd_kernel, dim3(grid), dim3(512), LDS_BYTES, stream, p);
#else
    for (int ph = 0; ph < N_PHASES; ++ph) { p.ph_lo = ph; p.ph_hi = ph + 1; hipLaunchKernelGGL(fwd_kernel, dim3(grid), dim3(512), LDS_BYTES, stream, p); }
#endif
}
```

```cpp
#include <hip/hip_runtime.h>
#include <stdint.h>
#include <stdio.h>

#ifndef N_LAUNCH_MODE
#define N_LAUNCH_MODE 1
#endif

#ifndef PROBE_DUP
#define PROBE_DUP 0
#endif
#ifndef PROBE_STAMP
#define PROBE_STAMP 0
#endif
#define REP(id) for (int rep_ = 0; rep_ < ((PROBE_DUP == (id)) ? 2 : 1); ++rep_)
#define LAS __attribute__((address_space(3)))
#define CAS __attribute__((address_space(4)))
typedef unsigned short bf16_t;
typedef short bf16x8 __attribute__((ext_vector_type(8)));
typedef float f32x2 __attribute__((ext_vector_type(2)));
typedef float f32x4 __attribute__((ext_vector_type(4)));
typedef float f32x16 __attribute__((ext_vector_type(16)));
typedef unsigned u32x2 __attribute__((ext_vector_type(2)));
typedef unsigned u32x4 __attribute__((ext_vector_type(4)));

constexpr int NB = 4, SEQ = 4096, T = NB * SEQ, D = 1024, NL = 4;
constexpr int NIN = 7508, NP = 7680;
constexpr int C_AU = 0, C_AV = 512, C_GQ = 1024, C_GK = 1280, C_GV = 1536, C_GR = 2048, C_DQ = 2560, C_DK = 3072, C_DV = 3584,
              C_IQ = 4096, C_IK = 4352, C_GA = 4416, C_IW = 4432, C_GATE = 4608;
constexpr int YW = 1536;
constexpr int MOE_ROWS = 32768 + 16 * 256;
constexpr float EPS = 1e-6f;

constexpr size_t WS_CTL = 0;
constexpr size_t WS_CNT = 16384;
constexpr size_t WS_MOD = 65536;
constexpr size_t WS_WIN = WS_MOD + 524288;
constexpr size_t WS_WBR = WS_WIN + (size_t)NP * 1024 * 2;
constexpr size_t WS_WOUT = WS_WBR + (size_t)1024 * 1536 * 2;
constexpr size_t WS_WE1 = WS_WOUT + (size_t)1024 * 1024 * 2;
constexpr size_t WS_WE2 = WS_WE1 + (size_t)16 * 512 * 1024 * 2;
constexpr size_t WS_WS = WS_WE2 + (size_t)16 * 1024 * 256 * 2;
constexpr size_t WS_W2 = WS_WS + (size_t)4 * 128 * 128 * 2;
constexpr size_t WSET = WS_W2 - WS_WIN;
constexpr size_t WS_H = WS_W2 + WSET;
constexpr size_t WS_PROJ = WS_H + (size_t)T * 1024 * 2;
constexpr size_t WS_Y = WS_PROJ + (size_t)T * NP * 2;
constexpr size_t WS_SCR = WS_Y + (size_t)T * YW * 2;
constexpr size_t WS_MASK = WS_SCR + (size_t)T * 1024 * 4;
constexpr size_t WS_VT = WS_MASK + (size_t)T * 64 * 8;
constexpr size_t WS_TOKE = WS_VT + (size_t)16 * 128 * 4096 * 2;
constexpr size_t WS_TOKW = WS_TOKE + (size_t)T * 8;
constexpr size_t WS_TOKS = WS_TOKW + (size_t)T * 8;
constexpr size_t WS_DEC = WS_TOKS + (size_t)T * 8;
constexpr size_t WS_SW = WS_DEC + (size_t)1024 * 64 * 4;
constexpr size_t WS_END = WS_SW + (size_t)MOE_ROWS * 4;
constexpr size_t WS_H2S = WS_PROJ;
constexpr size_t WS_ACT = WS_H2S + (size_t)MOE_ROWS * 1024 * 2;
constexpr size_t WS_FFN = WS_ACT + (size_t)MOE_ROWS * 256 * 2;
static_assert(WS_FFN + (size_t)MOE_ROWS * 1024 * 2 <= WS_Y, "moe alias");

constexpr int LDS_BYTES = 158720;
constexpr int AUX_OFF = 132096;

__device__ __forceinline__ float bf2f(bf16_t v) { return __uint_as_float(((unsigned)v) << 16); }
__device__ __forceinline__ unsigned cvt_pk_bf16(float lo, float hi) { unsigned r; asm volatile("v_cvt_pk_bf16_f32 %0, %1, %2" : "=v"(r) : "v"(lo), "v"(hi)); return r; }
__device__ __forceinline__ bf16_t f2bf(float f) { return (bf16_t)(cvt_pk_bf16(f, 0.f) & 0xffffu); }
__device__ __forceinline__ float lo_bf(unsigned w) { return __uint_as_float(w << 16); }
__device__ __forceinline__ float hi_bf(unsigned w) { return __uint_as_float(w & 0xffff0000u); }
__device__ __forceinline__ float max_x32(float v) { const auto r = __builtin_amdgcn_permlane32_swap(__float_as_uint(v), __float_as_uint(v), false, false); return fmaxf(__uint_as_float(r[0]), __uint_as_float(r[1])); }
__device__ __forceinline__ float sum_x32(float v) { const auto r = __builtin_amdgcn_permlane32_swap(__float_as_uint(v), __float_as_uint(v), false, false); return __uint_as_float(r[0]) + __uint_as_float(r[1]); }
template <int CTRL> __device__ __forceinline__ float dpp_f(float v) { return __int_as_float(__builtin_amdgcn_update_dpp(0, __float_as_int(v), CTRL, 0xf, 0xf, true)); }
__device__ __forceinline__ float sum8(float v) { v += dpp_f<0xB1>(v); v += dpp_f<0x4E>(v); v += dpp_f<0x141>(v); return v; }
__device__ __forceinline__ float sum16(float v) { v = sum8(v); v += dpp_f<0x140>(v); return v; }
__device__ __forceinline__ float wave_sum(float v) {
    v = sum16(v);
    const float a = __int_as_float(__builtin_amdgcn_readlane(__float_as_int(v), 0)), b = __int_as_float(__builtin_amdgcn_readlane(__float_as_int(v), 16));
    const float c = __int_as_float(__builtin_amdgcn_readlane(__float_as_int(v), 32)), d = __int_as_float(__builtin_amdgcn_readlane(__float_as_int(v), 48));
    return (a + b) + (c + d);
}
__device__ __forceinline__ float fast_exp(float x) { return __builtin_amdgcn_exp2f(x * 1.4426950408889634f); }
__device__ __forceinline__ float sigmoidf_(float x) { return __builtin_amdgcn_rcpf(1.f + fast_exp(-x)); }
__device__ __forceinline__ float gelu_tanh(float x) { const float u = x + 0.044715f * x * x * x; return x * __builtin_amdgcn_rcpf(1.f + __builtin_amdgcn_exp2f(-2.3022082f * u)); }

#define XB_TMO      128
#define XB_XCNT(j)  (256  + 64 * (j))
#define XB_XSUB(j)  (1280 + 64 * (j))
#define XB_XGEN(j)  (2304 + 64 * (j))
#define XB_TOP      3328
#define XB_TOPGEN   3392
#define XCD_BAR_WORDS 3456
#define XB_SPIN_CAP (1u << 22)
__device__ __forceinline__ unsigned xb_ld(unsigned* p)              { return __hip_atomic_load(p, __ATOMIC_RELAXED, __HIP_MEMORY_SCOPE_AGENT); }
__device__ __forceinline__ unsigned xb_add(unsigned* p, unsigned v) { return __hip_atomic_fetch_add(p, v, __ATOMIC_RELAXED, __HIP_MEMORY_SCOPE_AGENT); }
__device__ __forceinline__ unsigned xb_xcc_id() { return (unsigned)__builtin_amdgcn_s_getreg((3 << 11) | 20) & 0xFu; }
#define XB_SPIN(cond, bar) do { unsigned _sp = 0; while (cond) { __builtin_amdgcn_s_sleep(1); \
    if ((++_sp & 255u) == 0u) { if (xb_ld(&(bar)[XB_TMO])) break; if (_sp > XB_SPIN_CAP) { atomicAdd(&(bar)[XB_TMO], 1u); break; } } } } while (0)
struct XcdBarrier { unsigned* bar; unsigned x; volatile LAS unsigned* st; };
__device__ __forceinline__ XcdBarrier xcd_barrier_post(unsigned* bar, volatile LAS unsigned* st) {
    XcdBarrier b; b.bar = bar; b.x = xb_xcc_id(); b.st = st;
    if (threadIdx.x == 0) (void)xb_add(&bar[XB_XCNT(b.x)], 1u);
    return b;
}
__device__ __forceinline__ void xcd_barrier_complete(unsigned* bar, unsigned x, unsigned& nloc, unsigned& nx) {
    const unsigned G = gridDim.x * gridDim.y * gridDim.z;
    unsigned sum, cnt, mine, sp = 0u;
    for (;;) {
        sum = 0u; cnt = 0u; mine = 0u;
#pragma unroll
        for (unsigned j = 0; j < 16; ++j) { const unsigned c = xb_ld(&bar[XB_XCNT(j)]); sum += c; cnt += (c > 0u) ? 1u : 0u; mine = (j == x) ? c : mine; }
        if (sum == G) break;
        __builtin_amdgcn_s_sleep(1);
        if ((++sp & 255u) == 0u) { if (xb_ld(&bar[XB_TMO])) break; if (sp > XB_SPIN_CAP) { atomicAdd(&bar[XB_TMO], 1u); break; } }
    }
    nloc = mine > 0u ? mine : 1u; nx = cnt > 0u ? cnt : 1u;
}
__device__ __forceinline__ void xcd_barrier(const XcdBarrier& b) {
    asm volatile("s_waitcnt vmcnt(0)" ::: "memory");
    __syncthreads();
    if (threadIdx.x == 0) {
        unsigned* bar = b.bar;
        __builtin_amdgcn_s_waitcnt(0);
        unsigned nloc = b.st[0], nx = b.st[1];
        if (nloc == 0u) { xcd_barrier_complete(bar, b.x, nloc, nx); b.st[0] = nloc; b.st[1] = nx; }
        const unsigned old = xb_add(&bar[XB_XSUB(b.x)], 1u);
        const unsigned gen = old / nloc;
        if (old + 1u == (gen + 1u) * nloc) {
            __builtin_amdgcn_fence(__ATOMIC_RELEASE, "agent");
            asm volatile("s_waitcnt vmcnt(0)" ::: "memory");
            const unsigned og = xb_add(&bar[XB_TOP], 1u);
            const unsigned tg = og / nx;
            if (og + 1u == (tg + 1u) * nx) xb_add(&bar[XB_TOPGEN], 1u);
            else XB_SPIN(xb_ld(&bar[XB_TOPGEN]) == tg, bar);
            __builtin_amdgcn_fence(__ATOMIC_ACQUIRE, "agent");
            xb_add(&bar[XB_XGEN(b.x)], 1u);
            asm volatile("s_waitcnt vmcnt(0)" ::: "memory");
        } else {
            XB_SPIN(xb_ld(&bar[XB_XGEN(b.x)]) == gen, bar);
            __builtin_amdgcn_fence(__ATOMIC_ACQUIRE, "agent");
            asm volatile("s_waitcnt vmcnt(0)" ::: "memory");
        }
    }
    __syncthreads();
}

namespace pg8 {
constexpr int BM = 256, BK = 64, HALF = 128, HTB = HALF * BK * 2, STAGE_BYTES = 8 * HTB, NXCD = 8, WGM = 8;
__device__ __forceinline__ int lds_byte(int r, int c) { const int st = (r >> 4) * 2 + (c >> 5), rr = r & 15, cc = c & 31, ob = rr * 64 + cc * 2; return st * 1024 + (ob ^ (((ob >> 9) & 1) << 5)); }
__device__ __forceinline__ void stage_rc(int b, int& R, int& C) { const int st = b / 1024, sb = b % 1024, swz = sb ^ (((sb >> 9) & 1) << 5); R = (st >> 1) * 16 + swz / 64; C = (st & 1) * 32 + (swz % 64) / 2; }
__device__ __forceinline__ int perm32(int rho) { const int n = rho >> 4, i = rho & 15; return 8 * (i >> 2) + 4 * n + (i & 3); }

struct Unit { int pm, pn, aux, ord; const char* A; const char* B; };
__device__ __forceinline__ void tile_of(int L, int nM, int nN, int& pm, int& pn) {
    const int nwg = nM * nN; int wgid = L;
    { const int q = nwg / NXCD, r = nwg % NXCD, xcd = wgid % NXCD, off = wgid / NXCD; wgid = (xcd < r ? xcd * (q + 1) : r * (q + 1) + (xcd - r) * q) + off; }
    const int nig = WGM * nN, gid = wgid / nig, fm = gid * WGM, gsz = (nM - fm) < WGM ? (nM - fm) : WGM;
    pm = fm + ((wgid % nig) % gsz); pn = (wgid % nig) / gsz;
}

template <class Epi, class Sched>
__device__ __forceinline__ void gemm_phase(LAS unsigned char* lds, const int tid, const int lda, const int ldb, const int nt, const Sched& S, const Epi& E) {
    const int wid = __builtin_amdgcn_readfirstlane(tid >> 6), lane = tid & 63, wr = wid >> 2, wc = wid & 3, fr = lane & 15, fq = lane >> 4;
    unsigned voffA[2], voffB[2]; int stR[2], stC[2];
#pragma unroll
    for (int i = 0; i < 2; ++i) { int R, C; stage_rc(tid * 16 + i * 8192, R, C); const int Rb = Epi::PERM ? ((R & ~31) + perm32(R & 31)) : R; stR[i] = R; stC[i] = C;
        voffA[i] = (unsigned)(R * lda + C) * 2u; voffB[i] = (unsigned)(Rb * ldb + C) * 2u; }
    unsigned gC[2][2], gN[2][2];
#define PG8_GROWS(dst, un) do { if constexpr (Sched::GATHER) { _Pragma("unroll") for (int _h = 0; _h < 2; ++_h) _Pragma("unroll") for (int _i = 0; _i < 2; ++_i) \
        dst[_h][_i] = (unsigned)(S.row(un, _h * HALF + stR[_i]) * lda + stC[_i]) * 2u; } } while (0)
#define PG8_STAGEA(bufoff, kidx, h, nx) do { if constexpr (Sched::GATHER) { const char* _b = cA + (size_t)(kidx) * kstep; if (nx) PG8_STAGE(bufoff, _b, gN[h]); else PG8_STAGE(bufoff, _b, gC[h]); } \
        else { const char* _b = ((nx) ? nA : cA) + (size_t)(kidx) * kstep + (size_t)(h) * hstepA; PG8_STAGE(bufoff, _b, voffA); } } while (0)
    const size_t kstep = (size_t)(BK * 2);
    const size_t hstepA = (size_t)HALF * lda * 2, hstepB = (size_t)HALF * ldb * 2;
    const unsigned ldsw = (unsigned)wid * 1024u;
    const int aoff = lds_byte(wr * 64 + fr, fq * 8), boff = lds_byte(wc * 32 + fr, fq * 8);
#define PG8_SA(b, h) (((b) * 2 + (h)) * HTB)
#define PG8_SB(b, h) ((4 + (b) * 2 + (h)) * HTB)
#define PG8_STAGE(bufoff, gbase, voff) do { _Pragma("unroll") for (int _i = 0; _i < 2; ++_i) \
        __builtin_amdgcn_global_load_lds((const unsigned*)((const char*)(gbase) + (voff)[_i]), (LAS unsigned*)(lds + (bufoff) + ldsw + _i * 8192), 16, 0, 0); } while (0)
#define PG8_LDA(dst, b, h) do { _Pragma("unroll") for (int m = 0; m < 4; ++m) _Pragma("unroll") for (int k = 0; k < 2; ++k) dst[m][k] = *(const LAS bf16x8*)(lds + PG8_SA(b, h) + aoff + m * 2048 + k * 1024); } while (0)
#define PG8_LDB(dst, b, h) do { _Pragma("unroll") for (int n = 0; n < 2; ++n) _Pragma("unroll") for (int k = 0; k < 2; ++k) dst[n][k] = *(const LAS bf16x8*)(lds + PG8_SB(b, h) + boff + n * 2048 + k * 1024); } while (0)
#define PG8_MMA(ai, bj, At, Bt) do { __builtin_amdgcn_s_setprio(1); _Pragma("unroll") for (int m = 0; m < 4; ++m) _Pragma("unroll") for (int n = 0; n < 2; ++n) _Pragma("unroll") for (int k = 0; k < 2; ++k) \
        acc[ai][bj][m][n] = __builtin_amdgcn_mfma_f32_16x16x32_bf16(Bt[n][k], At[m][k], acc[ai][bj][m][n], 0, 0, 0); __builtin_amdgcn_s_setprio(0); } while (0)
#define PG8_WAIT_V(n) asm volatile("s_waitcnt vmcnt(" #n ")" ::: "memory")
#define PG8_WAIT_L(n) asm volatile("s_waitcnt lgkmcnt(" #n ")" ::: "memory")
#define PG8_BAR __builtin_amdgcn_s_barrier()
#define PG8_SCHED __builtin_amdgcn_sched_barrier(0)
    Unit cur, nxt; int ui = 0;
    if (!S.next(0, cur)) return;
    f32x4 acc[2][2][4][2];
#pragma unroll
    for (int a = 0; a < 2; ++a)
#pragma unroll
        for (int b = 0; b < 2; ++b)
#pragma unroll
            for (int m = 0; m < 4; ++m)
#pragma unroll
                for (int n = 0; n < 2; ++n) acc[a][b][m][n] = (f32x4){0.f, 0.f, 0.f, 0.f};
    bf16x8 At[4][2], B0[2][2], B1[2][2];
    const char* cA = cur.A; const char* cB = cur.B; const char* nA = cA;
    PG8_GROWS(gC, cur);
    PG8_STAGE(PG8_SB(0, 0), cB, voffB); PG8_STAGEA(PG8_SA(0, 0), 0, 0, false); PG8_STAGE(PG8_SB(0, 1), cB + hstepB, voffB); PG8_STAGEA(PG8_SA(0, 1), 0, 1, false);
    if (wr == 1) PG8_BAR;
    PG8_WAIT_V(4); PG8_BAR;
    PG8_STAGE(PG8_SB(1, 0), cB + kstep, voffB); PG8_STAGEA(PG8_SA(1, 0), 1, 0, false); PG8_STAGE(PG8_SB(1, 1), cB + hstepB + kstep, voffB);
    PG8_WAIT_V(6); PG8_BAR;
    for (;;) {
        const bool has_next = S.next(ui + 1, nxt);
        nA = has_next ? nxt.A : cA; const char* nB = has_next ? nxt.B : cB;
        if constexpr (Sched::GATHER) { if (has_next) PG8_GROWS(gN, nxt); else { _Pragma("unroll") for (int _h = 0; _h < 2; ++_h) _Pragma("unroll") for (int _i = 0; _i < 2; ++_i) gN[_h][_i] = gC[_h][_i]; } }
        for (int t = 0; t < nt; t += 2) {
            const bool last = (t == nt - 2);
            const int k2 = last ? 0 : t + 2;
            const char* b2 = last ? nB : cB + (size_t)(t + 2) * kstep;
            const char* b3 = b2 + kstep;
            if constexpr (Epi::MID != 0) { if (t != 0 && (t % Epi::MID) == 0) E.mid(acc, cur, t / Epi::MID, wr, wc, fr, fq); }
            PG8_LDB(B0, 0, 0); PG8_SCHED; PG8_LDA(At, 0, 0); PG8_STAGEA(PG8_SA(1, 1), t + 1, 1, false);
            PG8_WAIT_L(8); PG8_BAR; PG8_WAIT_L(0); PG8_MMA(0, 0, At, B0); PG8_BAR; PG8_SCHED;
            PG8_LDB(B1, 0, 1); PG8_STAGE(PG8_SB(0, 0), b2, voffB);
            PG8_BAR; PG8_WAIT_L(0); PG8_MMA(0, 1, At, B1); PG8_BAR;
            PG8_LDA(At, 0, 1); PG8_STAGEA(PG8_SA(0, 0), k2, 0, last);
            PG8_BAR; PG8_WAIT_L(0); PG8_MMA(1, 0, At, B0); PG8_BAR; PG8_SCHED;
            PG8_STAGE(PG8_SB(0, 1), b2 + hstepB, voffB);
            PG8_WAIT_V(6); PG8_BAR; PG8_MMA(1, 1, At, B1); PG8_BAR;
            PG8_LDB(B0, 1, 0); PG8_SCHED; PG8_LDA(At, 1, 0); PG8_STAGEA(PG8_SA(0, 1), k2, 1, last);
            PG8_WAIT_L(8); PG8_BAR; PG8_WAIT_L(0); PG8_MMA(0, 0, At, B0); PG8_BAR; PG8_SCHED;
            PG8_LDB(B1, 1, 1); PG8_STAGE(PG8_SB(1, 0), b3, voffB);
            PG8_BAR; PG8_WAIT_L(0); PG8_MMA(0, 1, At, B1); PG8_BAR;
            PG8_LDA(At, 1, 1); PG8_STAGEA(PG8_SA(1, 0), k2 + 1, 0, last);
            PG8_BAR; PG8_WAIT_L(0); PG8_MMA(1, 0, At, B0); PG8_BAR; PG8_SCHED;
            PG8_STAGE(PG8_SB(1, 1), b3 + hstepB, voffB);
            PG8_WAIT_V(6); PG8_BAR; PG8_MMA(1, 1, At, B1); PG8_BAR;
        }
        E(acc, cur, wr, wc, fr, fq);
        if (!has_next) break;
#pragma unroll
        for (int a = 0; a < 2; ++a)
#pragma unroll
            for (int b = 0; b < 2; ++b)
#pragma unroll
                for (int m = 0; m < 4; ++m)
#pragma unroll
                    for (int n = 0; n < 2; ++n) acc[a][b][m][n] = (f32x4){0.f, 0.f, 0.f, 0.f};
        cur = nxt; cA = nA; cB = nB; ++ui;
        if constexpr (Sched::GATHER) { _Pragma("unroll") for (int _h = 0; _h < 2; ++_h) _Pragma("unroll") for (int _i = 0; _i < 2; ++_i) gC[_h][_i] = gN[_h][_i]; }
    }
    PG8_WAIT_V(0);
    if (wr == 0) PG8_BAR;
    PG8_BAR;
#undef PG8_SA
#undef PG8_SB
#undef PG8_STAGE
#undef PG8_STAGEA
#undef PG8_GROWS
#undef PG8_LDA
#undef PG8_LDB
#undef PG8_MMA
#undef PG8_WAIT_V
#undef PG8_WAIT_L
#undef PG8_BAR
#undef PG8_SCHED
}
}
using pg8::Unit;

struct Params { const float* in[27]; float* out; unsigned char* ws; int ph_lo, ph_hi; };
struct Ctx {
    const float* const CAS* in; float* out; unsigned char* ws; LAS unsigned char* lds;
    int tid, lane, wave, G, c;
};
#define WSP(T_, off) ((T_*)(X.ws + (off)))
#define WSW(T_, off, l_) ((T_*)(X.ws + (off) + (size_t)((l_) & 1) * WSET))

struct SchedStatic {
    static constexpr bool GATHER = false; __device__ __forceinline__ int row(const Unit&, int) const { return 0; }
    int nM, nN, G, c; const char* A; const char* B; size_t tA, tB;
    __device__ __forceinline__ bool next(int i, Unit& u) const {
        const long L = (long)i * G + c; if (L >= (long)nM * nN) return false;
        pg8::tile_of((int)L, nM, nN, u.pm, u.pn); u.aux = 0; u.ord = i; u.A = A + (size_t)u.pm * tA; u.B = B + (size_t)u.pn * tB; return true;
    }
};
struct SchedMoe {
    static constexpr bool GATHER = false; __device__ __forceinline__ int row(const Unit&, int) const { return 0; }
    int G, c, ncol_shift, nT; const LAS int* tile_e; const LAS int* tile_pm; const char* A; const char* B; size_t tA, eB, tB;
    __device__ __forceinline__ bool next(int i, Unit& u) const {
        const long L = (long)i * G + c; if (L >= ((long)nT << ncol_shift)) return false;
        const int rt = (int)(L >> ncol_shift); u.pn = (int)(L & ((1 << ncol_shift) - 1)); u.pm = tile_pm[rt]; u.aux = tile_e[rt]; u.ord = i;
        u.A = A + (size_t)u.pm * tA; u.B = B + (size_t)u.aux * eB + (size_t)u.pn * tB; return true;
    }
};

struct SchedMoeG {
    static constexpr bool GATHER = true;
    int G, c, nT; const LAS int* tile_e; const LAS int* tile_pm; const LAS int* rows; const char* A; const char* B; size_t eB, tB;
    __device__ __forceinline__ bool next(int i, Unit& u) const {
        const long L = (long)i * G + c; if (L >= ((long)nT << 1)) return false;
        const int rt = (int)(L >> 1); u.pn = (int)(L & 1); u.pm = tile_pm[rt]; u.aux = tile_e[rt]; u.ord = i;
        u.A = A; u.B = B + (size_t)u.aux * eB + (size_t)u.pn * tB; return true;
    }
    __device__ __forceinline__ int row(const Unit& u, int r) const { return rows[(u.ord & 1) * 256 + r]; }
};

struct EpiProj { static constexpr int MID = 0; static constexpr bool PERM = true; bf16_t* O; const float* bgate;
    __device__ __forceinline__ void operator()(const f32x4 (&acc)[2][2][4][2], const Unit& u, int wr, int wc, int fr, int fq) const {
        const int row0 = u.pm * 256 + wr * 64 + fr, col0 = u.pn * 256 + wc * 32 + 8 * fq; const bool act = u.pn < 4, gate = u.pn >= 18;
        for (int rep_ = 0; rep_ < (PROBE_DUP == 22 ? 2 : 1); ++rep_) {
        f32x4 bv[2][2];
#pragma unroll
        for (int bj = 0; bj < 2; ++bj)
#pragma unroll
            for (int n = 0; n < 2; ++n) bv[bj][n] = gate ? *(const f32x4*)(bgate + (col0 - C_GATE) + bj * 128 + 4 * n) : (f32x4){0.f, 0.f, 0.f, 0.f};
#pragma unroll
        for (int ai = 0; ai < 2; ++ai)
#pragma unroll
            for (int m = 0; m < 4; ++m) { bf16_t* rowp = O + (size_t)(row0 + ai * 128 + m * 16) * NP + col0;
#pragma unroll
                for (int bj = 0; bj < 2; ++bj) { f32x4 v0 = acc[ai][bj][m][0], v1 = acc[ai][bj][m][1];
                    if (act) {
#pragma unroll
                        for (int j = 0; j < 4; ++j) { v0[j] = gelu_tanh(v0[j]); v1[j] = gelu_tanh(v1[j]); } }
                    if (gate) {
                        v0 += bv[bj][0]; v1 += bv[bj][1];
#pragma unroll
                        for (int j = 0; j < 4; ++j) { v0[j] = sigmoidf_(fminf(fmaxf(v0[j], -30.f), 30.f)); v1[j] = sigmoidf_(fminf(fmaxf(v1[j], -30.f), 30.f)); } }
                    u32x4 w; w.x = cvt_pk_bf16(v0[0], v0[1]); w.y = cvt_pk_bf16(v0[2], v0[3]); w.z = cvt_pk_bf16(v1[0], v1[1]); w.w = cvt_pk_bf16(v1[2], v1[3]);
                    *(u32x4*)(rowp + bj * 128) = w; } }
        }
    }
};
struct EpiMerge { static constexpr int MID = 8; static constexpr bool PERM = true; const bf16_t* proj; bf16_t* mb;
    __device__ __forceinline__ void mid(f32x4 (&acc)[2][2][4][2], const Unit& u, int j, int wr, int wc, int fr, int fq) const {
        const int row0 = u.pm * 256 + wr * 64 + fr, col0 = u.pn * 256 + wc * 32 + 8 * fq;
        const bf16_t* gp = proj + (size_t)row0 * NP + C_GATE + (j - 1) * 1024 + col0;
#pragma unroll
        for (int ai = 0; ai < 2; ++ai) {
            u32x4 gprev[4][2], gcur[4][2];
#pragma unroll
            for (int m = 0; m < 4; ++m)
#pragma unroll
                for (int bj = 0; bj < 2; ++bj) { const bf16_t* p = gp + (size_t)(ai * 128 + m * 16) * NP + bj * 128; gprev[m][bj] = *(const u32x4*)p; gcur[m][bj] = *(const u32x4*)(p + 1024); }
#pragma unroll
            for (int m = 0; m < 4; ++m)
#pragma unroll
                for (int bj = 0; bj < 2; ++bj) { const unsigned pw[4] = {gprev[m][bj].x, gprev[m][bj].y, gprev[m][bj].z, gprev[m][bj].w}, cw[4] = {gcur[m][bj].x, gcur[m][bj].y, gcur[m][bj].z, gcur[m][bj].w};
#pragma unroll
                    for (int n = 0; n < 2; ++n)
#pragma unroll
                        for (int k = 0; k < 4; ++k) { const int e = 4 * n + k; const float gpv = (e & 1) ? hi_bf(pw[e >> 1]) : lo_bf(pw[e >> 1]), gcv = (e & 1) ? hi_bf(cw[e >> 1]) : lo_bf(cw[e >> 1]);
                            acc[ai][bj][m][n][k] *= gpv * __builtin_amdgcn_rcpf(gcv); } }
        }
    }
    __device__ __forceinline__ void operator()(const f32x4 (&acc)[2][2][4][2], const Unit& u, int wr, int wc, int fr, int fq) const {
        const int row0 = u.pm * 256 + wr * 64 + fr, col0 = u.pn * 256 + wc * 32 + 8 * fq;
        const bf16_t* gp = proj + (size_t)row0 * NP + C_GATE + 2 * 1024 + col0;
#pragma unroll
        for (int ai = 0; ai < 2; ++ai) {
            u32x4 g2[4][2];
#pragma unroll
            for (int m = 0; m < 4; ++m)
#pragma unroll
                for (int bj = 0; bj < 2; ++bj) g2[m][bj] = *(const u32x4*)(gp + (size_t)(ai * 128 + m * 16) * NP + bj * 128);
#pragma unroll
            for (int m = 0; m < 4; ++m)
#pragma unroll
                for (int bj = 0; bj < 2; ++bj) { const unsigned gw[4] = {g2[m][bj].x, g2[m][bj].y, g2[m][bj].z, g2[m][bj].w}; float o[8];
#pragma unroll
                    for (int n = 0; n < 2; ++n)
#pragma unroll
                        for (int k = 0; k < 4; ++k) { const int e = 4 * n + k; o[e] = acc[ai][bj][m][n][k] * ((e & 1) ? hi_bf(gw[e >> 1]) : lo_bf(gw[e >> 1])); }
                    u32x4 w; w.x = cvt_pk_bf16(o[0], o[1]); w.y = cvt_pk_bf16(o[2], o[3]); w.z = cvt_pk_bf16(o[4], o[5]); w.w = cvt_pk_bf16(o[6], o[7]);
                    *(u32x4*)(mb + (size_t)(row0 + ai * 128 + m * 16) * 1024 + col0 + bj * 128) = w; }
        }
    }
};
struct EpiOut { static constexpr int MID = 0; static constexpr bool PERM = false; float* out; const float* xsrc; const float* gt; float scl;
    __device__ __forceinline__ void operator()(const f32x4 (&acc)[2][2][4][2], const Unit& u, int wr, int wc, int fr, int fq) const {
        const int row0 = u.pm * 256 + wr * 64 + fr, col0 = u.pn * 256 + wc * 32 + 4 * fq; const float* g = gt + (size_t)(u.pm >> 4) * 6144;
        f32x4 gv[2][2];
#pragma unroll
        for (int bj = 0; bj < 2; ++bj)
#pragma unroll
            for (int n = 0; n < 2; ++n) gv[bj][n] = *(const f32x4*)(g + col0 + bj * 128 + n * 16) * scl;
#pragma unroll
        for (int ai = 0; ai < 2; ++ai) {
            f32x4 xv[4][2][2];
#pragma unroll
            for (int m = 0; m < 4; ++m)
#pragma unroll
                for (int bj = 0; bj < 2; ++bj)
#pragma unroll
                    for (int n = 0; n < 2; ++n) xv[m][bj][n] = *(const f32x4*)(xsrc + (size_t)(row0 + ai * 128 + m * 16) * 1024 + col0 + bj * 128 + n * 16);
#pragma unroll
            for (int m = 0; m < 4; ++m)
#pragma unroll
                for (int bj = 0; bj < 2; ++bj)
#pragma unroll
                    for (int n = 0; n < 2; ++n) *(f32x4*)(out + (size_t)(row0 + ai * 128 + m * 16) * 1024 + col0 + bj * 128 + n * 16) = xv[m][bj][n] + gv[bj][n] * acc[ai][bj][m][n];
        }
    }
};
struct EpiMoe1 { static constexpr int MID = 0; static constexpr bool PERM = true; bf16_t* act; const LAS float* lw;
    __device__ __forceinline__ void operator()(const f32x4 (&acc)[2][2][4][2], const Unit& u, int wr, int wc, int fr, int fq) const {
        const int row0 = u.pm * 256 + wr * 64 + fr, col0 = u.pn * 128 + wc * 32 + 8 * fq;
        float wv[2][4];
#pragma unroll
        for (int ai = 0; ai < 2; ++ai)
#pragma unroll
            for (int m = 0; m < 4; ++m) wv[ai][m] = lw[(u.ord & 1) * 256 + wr * 64 + fr + ai * 128 + m * 16];
#pragma unroll
        for (int ai = 0; ai < 2; ++ai)
#pragma unroll
            for (int m = 0; m < 4; ++m) { const int r = row0 + ai * 128 + m * 16; const float w = wv[ai][m]; float o[8];
#pragma unroll
                for (int n = 0; n < 2; ++n)
#pragma unroll
                    for (int j = 0; j < 4; ++j) { const float g = acc[ai][0][m][n][j], up = acc[ai][1][m][n][j]; o[4 * n + j] = g * sigmoidf_(g) * up * w; }
                u32x4 pk; pk.x = cvt_pk_bf16(o[0], o[1]); pk.y = cvt_pk_bf16(o[2], o[3]); pk.z = cvt_pk_bf16(o[4], o[5]); pk.w = cvt_pk_bf16(o[6], o[7]);
                *(u32x4*)(act + (size_t)r * 256 + col0) = pk; }
    }
};
struct EpiMoe2 { static constexpr int MID = 0; static constexpr bool PERM = true; bf16_t* O;
    __device__ __forceinline__ void operator()(const f32x4 (&acc)[2][2][4][2], const Unit& u, int wr, int wc, int fr, int fq) const {
        const int row0 = u.pm * 256 + wr * 64 + fr, col0 = u.pn * 256 + wc * 32 + 8 * fq;
#pragma unroll
        for (int ai = 0; ai < 2; ++ai)
#pragma unroll
            for (int m = 0; m < 4; ++m) { bf16_t* rowp = O + (size_t)(row0 + ai * 128 + m * 16) * 1024 + col0;
#pragma unroll
                for (int bj = 0; bj < 2; ++bj) { const f32x4 v0 = acc[ai][bj][m][0], v1 = acc[ai][bj][m][1];
                    u32x4 w; w.x = cvt_pk_bf16(v0[0], v0[1]); w.y = cvt_pk_bf16(v0[2], v0[3]); w.z = cvt_pk_bf16(v1[0], v1[1]); w.w = cvt_pk_bf16(v1[2], v1[3]);
                    *(u32x4*)(rowp + bj * 128) = w; } }
    }
};

__device__ __forceinline__ void phase_mod(const Ctx& X) {
    LAS float* sc = (LAS float*)X.lds;
    LAS float* red = (LAS float*)(X.lds + 16384);
    const float* c = X.in[1]; const float* wm = X.in[2]; const float* bm = X.in[3]; float* mod = WSP(float, WS_MOD);
    for (int i = X.tid; i < 4096; i += 512) { const float v = c[i]; sc[i] = v * sigmoidf_(v); }
    __syncthreads();
    const int jj = X.tid & 63, ks = X.tid >> 6;
    for (int u = X.c; u < NL * 96; u += X.G) {
        const int l = u / 96, j0 = (u % 96) * 64;
        float a0 = 0.f, a1 = 0.f, a2 = 0.f, a3 = 0.f;
        const float* wp = wm + ((size_t)l * 1024 + ks * 128) * 6144 + j0 + jj;
        for (int k0 = 0; k0 < 128; k0 += 32) { float w[32];
#pragma unroll
            for (int k = 0; k < 32; ++k) w[k] = __builtin_nontemporal_load(wp + (size_t)(k0 + k) * 6144);
#pragma unroll
            for (int k = 0; k < 32; ++k) { const int kk = ks * 128 + k0 + k;
                a0 += sc[kk] * w[k]; a1 += sc[1024 + kk] * w[k]; a2 += sc[2048 + kk] * w[k]; a3 += sc[3072 + kk] * w[k]; } }
        red[(ks * 64 + jj) * 4 + 0] = a0; red[(ks * 64 + jj) * 4 + 1] = a1; red[(ks * 64 + jj) * 4 + 2] = a2; red[(ks * 64 + jj) * 4 + 3] = a3;
        __syncthreads();
        if (X.tid < 256) { const int b = X.tid >> 6; float s = bm[l * 6144 + j0 + jj];
#pragma unroll
            for (int q = 0; q < 8; ++q) s += red[(q * 64 + jj) * 4 + b];
            mod[((size_t)l * NB + b) * 6144 + j0 + jj] = s; }
        __syncthreads();
    }
}

__device__ __forceinline__ int wincol(int m) {
    if (m < 2560) return m;
    if (m < 4416) return m + 16;
    if (m < 4432) return 2560 + (m - 4416);
    if (m < 4436) return m;
    if (m < 4608) return -1;
    return 4436 + (m - 4608);
}
constexpr int CJ0 = 480, CJ1 = CJ0 + 96, CJ2 = CJ1 + 64, CJ3 = CJ2 + 512, CJ4 = CJ3 + 256, CJ5 = CJ4 + 16;
__device__ __forceinline__ void conv_job(const Ctx& X, int l, int j) {
    LAS float* tile = (LAS float*)X.lds;
    const int c = X.tid & 63, r0 = X.tid >> 6;
    if (j >= CJ4) {
        const int q = j - CJ4; const float* src = X.in[9] + (size_t)l * 65536; bf16_t* dst = WSW(bf16_t, WS_WS, l);
        for (int i = X.tid; i < 4096; i += 512) { const int e = q * 4096 + i, t = (e >> 7) & 127, s = e & 127; dst[e] = f2bf(s <= t ? src[e] : 0.f); }
        return;
    }
    const float* sp; int sld, scol; bf16_t* dp; int dld;
    if (j < CJ0) { const int nt = j >> 2, kt = j & 3; sp = X.in[6] + ((size_t)l * 1024 + kt * 256) * NIN; sld = NIN; scol = wincol(nt * 64 + c);
        dp = WSW(bf16_t, WS_WIN, l) + (size_t)(nt * 64) * 1024 + kt * 256; dld = 1024; }
    else if (j < CJ1) { const int q = j - CJ0, n = q >> 5, dt = (q >> 1) & 15, et = q & 1;
        sp = X.in[17] + (((size_t)l * 3 + n) * 512 + et * 256) * 1024; sld = 1024; scol = dt * 64 + c;
        dp = WSW(bf16_t, WS_WBR, l) + (size_t)(dt * 64) * YW + n * 512 + et * 256; dld = YW; }
    else if (j < CJ2) { const int q = j - CJ1, nt = q >> 2, kt = q & 3;
        sp = X.in[19] + ((size_t)l * 1024 + kt * 256) * 1024; sld = 1024; scol = nt * 64 + c;
        dp = WSW(bf16_t, WS_WOUT, l) + (size_t)(nt * 64) * 1024 + kt * 256; dld = 1024; }
    else if (j < CJ3) { const int q = j - CJ2, e = q >> 5, rt = (q >> 2) & 7, kt = q & 3; const int n0 = rt * 64, pn = n0 >> 8, half = (n0 >> 7) & 1;
        sp = (half ? X.in[25] : X.in[24]) + (((size_t)l * 16 + e) * 1024 + kt * 256) * 256; sld = 256; scol = 128 * pn + (n0 & 127) + c;
        dp = WSW(bf16_t, WS_WE1, l) + ((size_t)e * 512 + n0) * 1024 + kt * 256; dld = 1024; }
    else { const int q = j - CJ3, e = q >> 4, dt = q & 15;
        sp = X.in[26] + ((size_t)l * 16 + e) * 256 * 1024; sld = 1024; scol = dt * 64 + c;
        dp = WSW(bf16_t, WS_WE2, l) + ((size_t)e * 1024 + dt * 64) * 256; dld = 256; }
#pragma unroll
    for (int i = 0; i < 32; ++i) { const int k = r0 + 8 * i; tile[k * 65 + c] = scol >= 0 ? __builtin_nontemporal_load(sp + (size_t)k * sld + scol) : 0.f; }
    __syncthreads();
    { const int kc = X.tid & 127, nr = X.tid >> 7;
#pragma unroll
      for (int i = 0; i < 16; ++i) { const int n = nr + 4 * i; *(unsigned*)(dp + (size_t)n * dld + 2 * kc) = cvt_pk_bf16(tile[(2 * kc) * 65 + n], tile[(2 * kc + 1) * 65 + n]); } }
    __syncthreads();
}
__device__ __forceinline__ void phase_conv(const Ctx& X, int l) {
    for (int j = X.c; j < CJ5; j += X.G) conv_job(X, l, j);
}
__device__ __forceinline__ void phase_conv_dyn(const Ctx& X, int l, unsigned* q, int maxjobs) {
    LAS int* jslot = (LAS int*)(X.lds + AUX_OFF + 64);
    for (int nj = 0; nj < maxjobs; ++nj) {
        if (X.tid == 0) *jslot = (int)__hip_atomic_fetch_add(q, 1u, __ATOMIC_RELAXED, __HIP_MEMORY_SCOPE_AGENT);
        __syncthreads();
        const int j = *jslot;
        __syncthreads();
        if (j >= CJ5) break;
        conv_job(X, l, j);
    }
}

__device__ __forceinline__ void phase_norm1(const Ctx& X, int l, int mode, float fscale = 1.f) {
    const float* xin = X.in[0]; float* out = X.out; const float* mod = WSP(float, WS_MOD);
    const bf16_t* ffn = WSP(bf16_t, WS_FFN); const int* toks = WSP(int, WS_TOKS); bf16_t* h = WSP(bf16_t, WS_H);
    const float* g1 = X.in[4] + (size_t)l * 1024;
    constexpr int NBATCH = 4;
    const int rstride = X.G * 8;
    for (int r0 = X.c * 8 + X.wave; r0 < T; r0 += rstride * NBATCH) {
        f32x4 xv[NBATCH][4]; u32x2 fa[NBATCH][4], fb[NBATCH][4]; int sl[NBATCH][2];
        if (mode != 0) {
#pragma unroll
            for (int j = 0; j < NBATCH; ++j) { const int r = r0 + j * rstride; sl[j][0] = r < T ? toks[2 * r] : 0; sl[j][1] = r < T ? toks[2 * r + 1] : 0; }
        }
#pragma unroll
        for (int j = 0; j < NBATCH; ++j) { const int r = r0 + j * rstride < T ? r0 + j * rstride : r0;
#pragma unroll
            for (int i = 0; i < 4; ++i) { const int col = 4 * X.lane + 256 * i;
                xv[j][i] = *(const f32x4*)((mode == 0 ? xin : out) + (size_t)r * 1024 + col);
                if (mode != 0) { fa[j][i] = *(const u32x2*)(ffn + (size_t)sl[j][0] * 1024 + col); fb[j][i] = *(const u32x2*)(ffn + (size_t)sl[j][1] * 1024 + col); } } }
#pragma unroll
        for (int j = 0; j < NBATCH; ++j) { const int r = r0 + j * rstride; if (r >= T) break;
            const int b = r >> 12;
            if (mode != 0) { const float* gt2 = mod + ((size_t)(l - 1) * NB + b) * 6144 + 5120;
#pragma unroll
                for (int i = 0; i < 4; ++i) { const int col = 4 * X.lane + 256 * i; const f32x4 g = *(const f32x4*)(gt2 + col); const u32x2 a = fa[j][i], bb = fb[j][i];
                    f32x4 f; f[0] = lo_bf(a.x) + lo_bf(bb.x); f[1] = hi_bf(a.x) + hi_bf(bb.x); f[2] = lo_bf(a.y) + lo_bf(bb.y); f[3] = hi_bf(a.y) + hi_bf(bb.y);
                    xv[j][i] = xv[j][i] + g * f * fscale; } }
            if (mode != 0) {
#pragma unroll
                for (int i = 0; i < 4; ++i) *(f32x4*)(out + (size_t)r * 1024 + 4 * X.lane + 256 * i) = xv[j][i]; }
            if (mode == 2) continue;
            float ss = 0.f;
#pragma unroll
            for (int i = 0; i < 4; ++i) ss += xv[j][i][0] * xv[j][i][0] + xv[j][i][1] * xv[j][i][1] + xv[j][i][2] * xv[j][i][2] + xv[j][i][3] * xv[j][i][3];
            ss = wave_sum(ss);
            const float rstd = __builtin_amdgcn_rsqf(ss * (1.f / 1024.f) + EPS);
            const float* md = mod + ((size_t)l * NB + b) * 6144;
#pragma unroll
            for (int i = 0; i < 4; ++i) { const int col = 4 * X.lane + 256 * i;
                const f32x4 g = *(const f32x4*)(g1 + col), sh = *(const f32x4*)(md + col), sc = *(const f32x4*)(md + 1024 + col);
                f32x4 yv = xv[j][i] * rstd * g * (sc + 1.f) + sh;
                u32x2 w; w.x = cvt_pk_bf16(yv[0], yv[1]); w.y = cvt_pk_bf16(yv[2], yv[3]); *(u32x2*)(h + (size_t)r * 1024 + col) = w; }
        }
    }
}

__device__ __forceinline__ void sub_qknorm(const Ctx& X, int l) {
    bf16_t* proj = WSP(bf16_t, WS_PROJ);
    const float* gp = X.in[15] + (size_t)l * 128 + 8 * (X.lane & 15);
    float g[8];
#pragma unroll
    for (int i = 0; i < 8; ++i) g[i] = gp[i];
    const int rstride = X.G * 8;
    for (int r0 = X.c * 8 + X.wave; r0 < T; r0 += 4 * rstride) {
        u32x4 lk[4];
#pragma unroll
        for (int q = 0; q < 4; ++q) { const int r = r0 + q * rstride < T ? r0 + q * rstride : r0; lk[q] = *(const u32x4*)(proj + (size_t)r * NP + C_DK + 8 * X.lane); }
#pragma unroll
        for (int q = 0; q < 4; ++q) { const int r = r0 + q * rstride; if (r >= T) break;
            const u32x4 a = lk[q]; float v[8] = {lo_bf(a.x), hi_bf(a.x), lo_bf(a.y), hi_bf(a.y), lo_bf(a.z), hi_bf(a.z), lo_bf(a.w), hi_bf(a.w)};
            float ss = 0.f;
#pragma unroll
            for (int i = 0; i < 8; ++i) ss += v[i] * v[i];
            ss = sum16(ss);
            const float rstd = __builtin_amdgcn_rsqf(ss * (1.f / 128.f) + EPS);
#pragma unroll
            for (int i = 0; i < 8; ++i) v[i] = v[i] * rstd * g[i];
            u32x4 o; o.x = cvt_pk_bf16(v[0], v[1]); o.y = cvt_pk_bf16(v[2], v[3]); o.z = cvt_pk_bf16(v[4], v[5]); o.w = cvt_pk_bf16(v[6], v[7]);
            *(u32x4*)(proj + (size_t)r * NP + C_DK + 8 * X.lane) = o; }
    }
}
__device__ __forceinline__ void sub_vtrans(const Ctx& X) {
    const bf16_t* proj = WSP(bf16_t, WS_PROJ); bf16_t* vt = WSP(bf16_t, WS_VT);
    LAS bf16_t* tile = (LAS bf16_t*)X.lds;
    for (int j0 = X.c; j0 < 2048; j0 += 2 * X.G) {
        u32x4 v[2];
#pragma unroll
        for (int q = 0; q < 2; ++q) { const int j = j0 + q * X.G < 2048 ? j0 + q * X.G : j0; const int bh = j >> 7, et = (j >> 6) & 1, st = j & 63, b = bh >> 2, hh = bh & 3;
            v[q] = *(const u32x4*)(proj + ((size_t)b * SEQ + st * 64 + (X.tid >> 3)) * NP + C_DV + 128 * hh + et * 64 + (X.tid & 7) * 8); }
#pragma unroll
        for (int q = 0; q < 2; ++q) *(LAS u32x4*)(tile + q * 4608 + (X.tid >> 3) * 72 + (X.tid & 7) * 8) = v[q];
        __syncthreads();
#pragma unroll
        for (int q = 0; q < 2; ++q) { const int j = j0 + q * X.G; if (j >= 2048) break; const int bh = j >> 7, et = (j >> 6) & 1, st = j & 63;
          const int e = X.tid >> 3, s8 = (X.tid & 7) * 8; unsigned short w8[8];
#pragma unroll
          for (int i = 0; i < 8; ++i) w8[i] = tile[q * 4608 + ((s8 & ~15) + 4 * ((s8 >> 3) & 1) + (i & 3) + 8 * (i >> 2)) * 72 + e];
          u32x4 w; w.x = w8[0] | ((unsigned)w8[1] << 16); w.y = w8[2] | ((unsigned)w8[3] << 16); w.z = w8[4] | ((unsigned)w8[5] << 16); w.w = w8[6] | ((unsigned)w8[7] << 16);
          *(u32x4*)(vt + ((size_t)bh * 128 + et * 64 + e) * SEQ + st * 64 + s8) = w; }
        __syncthreads();
    }
}

__device__ __forceinline__ void sub_gmlp(const Ctx& X, int l) {
    const bf16_t* proj = WSP(bf16_t, WS_PROJ); bf16_t* y = WSP(bf16_t, WS_Y); const bf16_t* wsb = WSW(bf16_t, WS_WS, l);
    LAS unsigned char* Wg = X.lds; LAS unsigned char* Vn = X.lds + 34816; LAS float* st = (LAS float*)(X.lds + 69632);
    const float* lng = X.in[7] + (size_t)l * 512; const float* lnb = X.in[8] + (size_t)l * 512; const float* bs = X.in[10] + (size_t)l * 512;
    const int r = X.lane & 31, hf = X.lane >> 5;
    for (int u = X.c; u < 512; u += X.G) {
        const int ch = u >> 2, g = u & 3; const size_t t0 = (size_t)ch * 128;
#pragma unroll
        for (int i = 0; i < 4; ++i) { const int q = X.tid + 512 * i, row = q >> 4, cc = q & 15;
            *(LAS u32x4*)(Wg + row * 272 + cc * 16) = *(const u32x4*)(wsb + ((size_t)g * 128 + row) * 128 + cc * 8); }
        { u32x4 av[16];
#pragma unroll
          for (int i = 0; i < 16; ++i) av[i] = *(const u32x4*)(proj + (t0 + X.wave * 16 + i) * NP + C_AV + 8 * X.lane);
#pragma unroll
          for (int i = 0; i < 16; ++i) { const int tt = X.wave * 16 + i; const u32x4 a = av[i];
            float v[8] = {lo_bf(a.x), hi_bf(a.x), lo_bf(a.y), hi_bf(a.y), lo_bf(a.z), hi_bf(a.z), lo_bf(a.w), hi_bf(a.w)};
            float s = 0.f;
#pragma unroll
            for (int k = 0; k < 8; ++k) s += v[k];
            const float mean = wave_sum(s) * (1.f / 512.f);
            float q2 = 0.f;
#pragma unroll
            for (int k = 0; k < 8; ++k) { const float d = v[k] - mean; q2 += d * d; }
            const float rstd = __builtin_amdgcn_rsqf(wave_sum(q2) * (1.f / 512.f) + EPS);
            if (X.lane == 0) { st[2 * tt] = mean; st[2 * tt + 1] = rstd; } } }
        __syncthreads();
#pragma unroll
        for (int i = 0; i < 4; ++i) { const int q = X.tid + 512 * i, tt = q & 127, jb = q >> 7;
            const u32x4 a = *(const u32x4*)(proj + (t0 + tt) * NP + C_AV + 128 * g + 8 * jb);
            const float mean = st[2 * tt], rstd = st[2 * tt + 1];
            float v[8] = {lo_bf(a.x), hi_bf(a.x), lo_bf(a.y), hi_bf(a.y), lo_bf(a.z), hi_bf(a.z), lo_bf(a.w), hi_bf(a.w)};
#pragma unroll
            for (int e = 0; e < 8; ++e) { const int d = 8 * jb + e; const float o = (v[e] - mean) * rstd * lng[128 * g + d] + lnb[128 * g + d];
                *(LAS bf16_t*)(Vn + d * 272 + tt * 2) = f2bf(o); } }
        __syncthreads();
        { const int tb = X.wave >> 1, dh = X.wave & 1;
          f32x16 acc[2]; bf16_t uu[2][16];
#pragma unroll
          for (int nb = 0; nb < 2; ++nb)
#pragma unroll
              for (int k = 0; k < 16; ++k) { acc[nb][k] = 0.f; uu[nb][k] = proj[(t0 + 32 * tb + (k & 3) + 8 * (k >> 2) + 4 * hf) * NP + C_AU + 128 * g + 64 * dh + 32 * nb + r]; }
          const int nks = 2 * (tb + 1);
          for (int ks = 0; ks < nks; ++ks) {
              const bf16x8 a = *(const LAS bf16x8*)(Wg + (32 * tb + r) * 272 + (16 * ks + 8 * hf) * 2);
#pragma unroll
              for (int nb = 0; nb < 2; ++nb) { const bf16x8 b = *(const LAS bf16x8*)(Vn + (64 * dh + 32 * nb + r) * 272 + (16 * ks + 8 * hf) * 2);
                  acc[nb] = __builtin_amdgcn_mfma_f32_32x32x16_bf16(a, b, acc[nb], 0, 0, 0); } }
#pragma unroll
          for (int nb = 0; nb < 2; ++nb)
#pragma unroll
              for (int k = 0; k < 16; ++k) { const int t = 32 * tb + (k & 3) + 8 * (k >> 2) + 4 * hf, d = 64 * dh + 32 * nb + r;
                  y[(t0 + t) * YW + 128 * g + d] = f2bf((acc[nb][k] + bs[g * 128 + t]) * bf2f(uu[nb][k])); } }
        __syncthreads();
    }
}

__device__ __forceinline__ float log_sigmoid_(float z) { return fminf(z, 0.f) - __logf(1.f + __expf(-fabsf(z))); }

__device__ __forceinline__ void sub_gla_local(const Ctx& X, int l) {
    const bf16_t* proj = WSP(bf16_t, WS_PROJ); float* U = WSP(float, WS_SCR); float* dec = WSP(float, WS_DEC);
    LAS float* ga = (LAS float*)X.lds; LAS float* seg = (LAS float*)(X.lds + 4096);
    LAS unsigned char* kkT = X.lds + 8192; LAS unsigned char* vT = X.lds + 17408; LAS unsigned char* kraw = X.lds + 36864;
    const int r = X.lane & 31, hf = X.lane >> 5;
    for (int u = X.c; u < 1024; u += X.G) {
        const int hh = u & 3, cch = (u >> 2) & 63, b = u >> 8; const size_t t0 = (size_t)b * SEQ + cch * 64;
        const int d = X.tid & 63, tq = X.tid >> 6;
        u32x4 lga = {0u, 0u, 0u, 0u}; if (X.tid < 128) lga = *(const u32x4*)(proj + (t0 + (X.tid >> 1)) * NP + C_GA + 8 * (X.tid & 1));
        u32x4 lv[2];
#pragma unroll
        for (int i = 0; i < 2; ++i) { const int q = X.tid + 512 * i, s = q & 63, eb = q >> 6; lv[i] = *(const u32x4*)(proj + (t0 + s) * NP + C_GV + 128 * hh + 8 * eb); }
        const u32x4 lk = *(const u32x4*)(proj + (t0 + (X.tid >> 3)) * NP + C_GK + 64 * hh + 8 * (X.tid & 7));
        float w2[16];
#pragma unroll
        for (int q = 0; q < 16; ++q) w2[q] = X.in[11][((size_t)l * 16 + q) * 256 + hh * 64 + d];
        const float bg = X.in[12][(size_t)l * 256 + hh * 64 + d];
        if (X.tid < 128) { LAS float* gp = ga + (X.tid >> 1) * 16 + 8 * (X.tid & 1);
            gp[0] = lo_bf(lga.x); gp[1] = hi_bf(lga.x); gp[2] = lo_bf(lga.y); gp[3] = hi_bf(lga.y); gp[4] = lo_bf(lga.z); gp[5] = hi_bf(lga.z); gp[6] = lo_bf(lga.w); gp[7] = hi_bf(lga.w); }
#pragma unroll
        for (int i = 0; i < 2; ++i) { const int q = X.tid + 512 * i, s = q & 63, eb = q >> 6; const unsigned w[4] = {lv[i].x, lv[i].y, lv[i].z, lv[i].w};
#pragma unroll
            for (int k = 0; k < 4; ++k) { *(LAS bf16_t*)(vT + (8 * eb + 2 * k) * 144 + s * 2) = (bf16_t)(w[k] & 0xffffu); *(LAS bf16_t*)(vT + (8 * eb + 2 * k + 1) * 144 + s * 2) = (bf16_t)(w[k] >> 16); } }
        *(LAS u32x4*)(kraw + (X.tid >> 3) * 144 + 16 * (X.tid & 7)) = lk;
        __syncthreads();
        float cum[8];
        { float run = 0.f;
#pragma unroll
          for (int i = 0; i < 8; ++i) { const int t = 8 * tq + i; float z = bg;
#pragma unroll
              for (int q = 0; q < 16; ++q) z += ga[t * 16 + q] * w2[q];
              run += log_sigmoid_(z) * (1.f / 16.f); cum[i] = run; }
          seg[tq * 64 + d] = run; }
        __syncthreads();
        { float pre = 0.f, tot = 0.f;
#pragma unroll
          for (int q = 0; q < 8; ++q) { const float s = seg[q * 64 + d]; tot += s; if (q < tq) pre += s; }
          float kk[8];
#pragma unroll
          for (int i = 0; i < 8; ++i) { const int t = 8 * tq + i; const float kv = bf2f(*(const LAS bf16_t*)(kraw + t * 144 + d * 2)); kk[i] = kv * __expf(tot - (pre + cum[i])); }
          u32x4 w; w.x = cvt_pk_bf16(kk[0], kk[1]); w.y = cvt_pk_bf16(kk[2], kk[3]); w.z = cvt_pk_bf16(kk[4], kk[5]); w.w = cvt_pk_bf16(kk[6], kk[7]);
          *(LAS u32x4*)(kkT + d * 144 + 16 * tq) = w;
          if (tq == 0) dec[(size_t)u * 64 + d] = __expf(tot); }
        __syncthreads();
        { const int db = X.wave >> 2, eb = X.wave & 3; f32x16 acc;
#pragma unroll
          for (int k = 0; k < 16; ++k) acc[k] = 0.f;
#pragma unroll
          for (int ks = 0; ks < 4; ++ks) { const bf16x8 a = *(const LAS bf16x8*)(kkT + (32 * db + r) * 144 + (16 * ks + 8 * hf) * 2);
              const bf16x8 bb = *(const LAS bf16x8*)(vT + (32 * eb + r) * 144 + (16 * ks + 8 * hf) * 2);
              acc = __builtin_amdgcn_mfma_f32_32x32x16_bf16(a, bb, acc, 0, 0, 0); }
#pragma unroll
          for (int k = 0; k < 16; ++k) { const int dd = 32 * db + (k & 3) + 8 * (k >> 2) + 4 * hf; U[((size_t)u * 64 + dd) * 128 + 32 * eb + r] = acc[k]; } }
        __syncthreads();
    }
}

__device__ __forceinline__ void sub_gla_scan(const Ctx& X) {
    float* U = WSP(float, WS_SCR); const float* dec = WSP(float, WS_DEC);
    for (int gid = X.c * 512 + X.tid; gid < 16 * 8192; gid += X.G * 512) {
        const int bh = gid >> 13, de = gid & 8191, d = de >> 7, b = bh >> 2, hh = bh & 3;
        float S = 0.f;
        for (int cb = 0; cb < 4; ++cb) {
            float uv[16], dc[16];
#pragma unroll
            for (int j = 0; j < 16; ++j) { const size_t u = (size_t)b * 256 + (cb * 16 + j) * 4 + hh; uv[j] = U[u * 8192 + de]; dc[j] = dec[u * 64 + d]; }
#pragma unroll
            for (int j = 0; j < 16; ++j) { const size_t u = (size_t)b * 256 + (cb * 16 + j) * 4 + hh; U[u * 8192 + de] = S; S = dc[j] * S + uv[j]; }
        }
    }
}

__device__ __forceinline__ void sub_gla_out(const Ctx& X, int l) {
    const bf16_t* proj = WSP(bf16_t, WS_PROJ); const float* Sg = WSP(float, WS_SCR); bf16_t* y = WSP(bf16_t, WS_Y);
    LAS float* ga = (LAS float*)X.lds; LAS float* seg = (LAS float*)(X.lds + 4096);
    LAS unsigned char* qq = X.lds + 8192; LAS unsigned char* qS = X.lds + 17408; LAS unsigned char* kk2 = X.lds + 26624;
    LAS unsigned char* vT = X.lds + 35840; LAS unsigned char* ST = X.lds + 54272; LAS unsigned char* at = X.lds + 72704; LAS float* ob = (LAS float*)(X.lds + 81920);
    LAS unsigned char* qraw = at; LAS unsigned char* kraw = X.lds + 81920;
    const int r = X.lane & 31, hf = X.lane >> 5;
    for (int u = X.c; u < 1024; u += X.G) {
        const int hh = u & 3, cch = (u >> 2) & 63, b = u >> 8; const size_t t0 = (size_t)b * SEQ + cch * 64;
        const int d = X.tid & 63, tq = X.tid >> 6;
        u32x4 lga = {0u, 0u, 0u, 0u}; if (X.tid < 128) lga = *(const u32x4*)(proj + (t0 + (X.tid >> 1)) * NP + C_GA + 8 * (X.tid & 1));
        u32x4 lv[2]; f32x4 ls[4];
#pragma unroll
        for (int i = 0; i < 2; ++i) { const int q = X.tid + 512 * i, s = q & 63, eb = q >> 6; lv[i] = *(const u32x4*)(proj + (t0 + s) * NP + C_GV + 128 * hh + 8 * eb); }
#pragma unroll
        for (int i = 0; i < 4; ++i) ls[i] = *(const f32x4*)(Sg + (size_t)u * 8192 + 4 * X.tid + 2048 * i);
        const u32x4 lq = *(const u32x4*)(proj + (t0 + (X.tid >> 3)) * NP + C_GQ + 64 * hh + 8 * (X.tid & 7));
        const u32x4 lk = *(const u32x4*)(proj + (t0 + (X.tid >> 3)) * NP + C_GK + 64 * hh + 8 * (X.tid & 7));
        const bf16_t* rp = proj + (t0 + (X.tid >> 3)) * NP + C_GR + 128 * hh + 16 * (X.tid & 7);
        const u32x4 ra = *(const u32x4*)rp, rb = *(const u32x4*)(rp + 8);
        float w2[16];
#pragma unroll
        for (int q = 0; q < 16; ++q) w2[q] = X.in[11][((size_t)l * 16 + q) * 256 + hh * 64 + d];
        const float bg = X.in[12][(size_t)l * 256 + hh * 64 + d];
        if (X.tid < 128) { LAS float* gp = ga + (X.tid >> 1) * 16 + 8 * (X.tid & 1);
            gp[0] = lo_bf(lga.x); gp[1] = hi_bf(lga.x); gp[2] = lo_bf(lga.y); gp[3] = hi_bf(lga.y); gp[4] = lo_bf(lga.z); gp[5] = hi_bf(lga.z); gp[6] = lo_bf(lga.w); gp[7] = hi_bf(lga.w); }
#pragma unroll
        for (int i = 0; i < 2; ++i) { const int q = X.tid + 512 * i, s = q & 63, eb = q >> 6; const unsigned w[4] = {lv[i].x, lv[i].y, lv[i].z, lv[i].w};
#pragma unroll
            for (int k = 0; k < 4; ++k) { *(LAS bf16_t*)(vT + (8 * eb + 2 * k) * 144 + s * 2) = (bf16_t)(w[k] & 0xffffu); *(LAS bf16_t*)(vT + (8 * eb + 2 * k + 1) * 144 + s * 2) = (bf16_t)(w[k] >> 16); } }
#pragma unroll
        for (int i = 0; i < 4; ++i) { const int q = 4 * X.tid + 2048 * i, dd = q >> 7, e = q & 127;
#pragma unroll
            for (int k = 0; k < 4; ++k) *(LAS bf16_t*)(ST + (e + k) * 144 + dd * 2) = f2bf(ls[i][k]); }
        *(LAS u32x4*)(qraw + (X.tid >> 3) * 144 + 16 * (X.tid & 7)) = lq; *(LAS u32x4*)(kraw + (X.tid >> 3) * 144 + 16 * (X.tid & 7)) = lk;
        __syncthreads();
        float cum[8];
        { float run = 0.f;
#pragma unroll
          for (int i = 0; i < 8; ++i) { const int t = 8 * tq + i; float z = bg;
#pragma unroll
              for (int q = 0; q < 16; ++q) z += ga[t * 16 + q] * w2[q];
              run += log_sigmoid_(z) * (1.f / 16.f); cum[i] = run; }
          seg[tq * 64 + d] = run; }
        __syncthreads();
        { float pre = 0.f, bref = 0.f;
#pragma unroll
          for (int q = 0; q < 8; ++q) { const float s = seg[q * 64 + d]; if (q < tq) pre += s; if (q < 4) bref += s; }
          float qv[8], kv[8];
#pragma unroll
          for (int i = 0; i < 8; ++i) { const int t = 8 * tq + i; qv[i] = bf2f(*(const LAS bf16_t*)(qraw + t * 144 + d * 2)) * 0.125f; kv[i] = bf2f(*(const LAS bf16_t*)(kraw + t * 144 + d * 2)); }
#pragma unroll
          for (int i = 0; i < 8; ++i) { const int t = 8 * tq + i; const float bt = pre + cum[i];
              *(LAS bf16_t*)(qq + t * 144 + d * 2) = f2bf(qv[i] * __expf(bt - bref));
              *(LAS bf16_t*)(qS + t * 144 + d * 2) = f2bf(qv[i] * __expf(bt));
              *(LAS bf16_t*)(kk2 + t * 144 + d * 2) = f2bf(kv[i] * __expf(bref - bt)); } }
        __syncthreads();
        if (X.wave < 4) { const int tb = X.wave >> 1, sb = X.wave & 1; f32x16 acc;
#pragma unroll
            for (int k = 0; k < 16; ++k) acc[k] = 0.f;
#pragma unroll
            for (int ks = 0; ks < 4; ++ks) { const bf16x8 a = *(const LAS bf16x8*)(qq + (32 * tb + r) * 144 + (16 * ks + 8 * hf) * 2);
                const bf16x8 bb = *(const LAS bf16x8*)(kk2 + (32 * sb + r) * 144 + (16 * ks + 8 * hf) * 2);
                acc = __builtin_amdgcn_mfma_f32_32x32x16_bf16(a, bb, acc, 0, 0, 0); }
#pragma unroll
            for (int k = 0; k < 16; ++k) { const int t = 32 * tb + (k & 3) + 8 * (k >> 2) + 4 * hf, s = 32 * sb + r;
                *(LAS bf16_t*)(at + t * 144 + s * 2) = f2bf(s <= t ? acc[k] : 0.f); } }
        __syncthreads();
        { const int tb = X.wave >> 2, eb = X.wave & 3; f32x16 acc;
#pragma unroll
          for (int k = 0; k < 16; ++k) acc[k] = 0.f;
#pragma unroll
          for (int ks = 0; ks < 4; ++ks) { const bf16x8 a = *(const LAS bf16x8*)(qS + (32 * tb + r) * 144 + (16 * ks + 8 * hf) * 2);
              const bf16x8 bb = *(const LAS bf16x8*)(ST + (32 * eb + r) * 144 + (16 * ks + 8 * hf) * 2);
              acc = __builtin_amdgcn_mfma_f32_32x32x16_bf16(a, bb, acc, 0, 0, 0); }
#pragma unroll
          for (int ks = 0; ks < 4; ++ks) { const bf16x8 a = *(const LAS bf16x8*)(at + (32 * tb + r) * 144 + (16 * ks + 8 * hf) * 2);
              const bf16x8 bb = *(const LAS bf16x8*)(vT + (32 * eb + r) * 144 + (16 * ks + 8 * hf) * 2);
              acc = __builtin_amdgcn_mfma_f32_32x32x16_bf16(a, bb, acc, 0, 0, 0); }
#pragma unroll
          for (int k = 0; k < 16; ++k) { const int t = 32 * tb + (k & 3) + 8 * (k >> 2) + 4 * hf; ob[t * 132 + 32 * eb + r] = acc[k]; } }
        __syncthreads();
        { const int t = X.tid >> 3, j = X.tid & 7; float o[16]; float ss = 0.f;
#pragma unroll
          for (int i = 0; i < 16; ++i) { o[i] = ob[t * 132 + 16 * j + i]; ss += o[i] * o[i]; }
          ss = sum8(ss);
          const float rstd = __builtin_amdgcn_rsqf(ss * (1.f / 128.f) + EPS);
          const float* gn = X.in[13] + (size_t)l * 128 + 16 * j;
          const unsigned rw[8] = {ra.x, ra.y, ra.z, ra.w, rb.x, rb.y, rb.z, rb.w};
          unsigned pk[8];
#pragma unroll
          for (int i = 0; i < 8; ++i) { const float r0 = lo_bf(rw[i]), r1 = hi_bf(rw[i]);
              const float v0 = o[2 * i] * rstd * gn[2 * i] * (r0 * sigmoidf_(r0)), v1 = o[2 * i + 1] * rstd * gn[2 * i + 1] * (r1 * sigmoidf_(r1));
              pk[i] = cvt_pk_bf16(v0, v1); }
          bf16_t* yp = y + (t0 + t) * YW + 512 + 128 * hh + 16 * j;
          *(u32x4*)yp = (u32x4){pk[0], pk[1], pk[2], pk[3]}; *(u32x4*)(yp + 8) = (u32x4){pk[4], pk[5], pk[6], pk[7]}; }
        __syncthreads();
    }
}

__device__ __forceinline__ unsigned score_code(float sc) {
    const unsigned ub = __float_as_uint(sc); unsigned t = (ub & 0x7fffffffu) >> 13;
    t = t < (107u << 10) ? (107u << 10) : t; t -= (107u << 10); t = t > 32766u ? 32766u : t;
    return (ub >> 31) ? (0x7fffu - t) : (0x8000u | t);
}
template <bool PACKED16>
__device__ __forceinline__ void find_digit(const LAS unsigned* hist, int lane, unsigned K, unsigned& digit, unsigned& above) {
    unsigned hb[4];
    if (PACKED16) { const unsigned h0 = hist[(2 * lane) * 16], h1 = hist[(2 * lane + 1) * 16]; hb[0] = h0 & 0xffffu; hb[1] = h0 >> 16; hb[2] = h1 & 0xffffu; hb[3] = h1 >> 16; }
    else { const u32x4 h4 = *(const LAS u32x4*)(hist + 4 * lane); hb[0] = h4.x; hb[1] = h4.y; hb[2] = h4.z; hb[3] = h4.w; }
    const unsigned s = hb[0] + hb[1] + hb[2] + hb[3];
    int v = (int)s;
    v += __builtin_amdgcn_update_dpp(0, v, 0x111, 0xf, 0xf, true); v += __builtin_amdgcn_update_dpp(0, v, 0x112, 0xf, 0xf, true);
    v += __builtin_amdgcn_update_dpp(0, v, 0x114, 0xf, 0xf, true); v += __builtin_amdgcn_update_dpp(0, v, 0x118, 0xf, 0xf, true);
    v += __builtin_amdgcn_update_dpp(0, v, 0x142, 0xa, 0xf, false); v += __builtin_amdgcn_update_dpp(0, v, 0x143, 0xc, 0xf, false);
    const unsigned total = (unsigned)__builtin_amdgcn_readlane(v, 63);
    unsigned run = total - (unsigned)v, dg = 0, ab = 0; bool found = false;
#pragma unroll
    for (int bi = 3; bi >= 0; --bi) { if (!found && run < K && run + hb[bi] >= K) { found = true; dg = 4 * lane + bi; ab = run; } run += hb[bi]; }
    const unsigned long long m = __ballot(found);
    const int src = m ? (int)__builtin_ctzll(m) : 0;
    digit = (unsigned)__builtin_amdgcn_readlane((int)dg, src); above = (unsigned)__builtin_amdgcn_readlane((int)ab, src);
}
template <bool FULL>
__device__ __forceinline__ void select_trip(const bf16x8 (&Ax)[4][2], const bf16x8 (&Ay)[4][2], const bf16x8 (&Bq)[4][2], const float (&iw)[4], const int jb, const int ntile,
                                            const int q, const int kg, const int tq, LAS unsigned* hist1, LAS bf16_t* keys) {
#pragma unroll
    for (int i2 = 0; i2 < 8; ++i2) { const int i = i2 & 3; const int j = jb + 8 * i2;
        const bf16x8 A0 = i2 < 4 ? Ax[i][0] : Ay[i][0], A1 = i2 < 4 ? Ax[i][1] : Ay[i][1];
        f32x4 sc = {0.f, 0.f, 0.f, 0.f};
#pragma unroll
        for (int hh = 0; hh < 4; ++hh) { f32x4 a = {0.f, 0.f, 0.f, 0.f};
            a = __builtin_amdgcn_mfma_f32_16x16x32_bf16(A0, Bq[hh][0], a, 0, 0, 0);
            a = __builtin_amdgcn_mfma_f32_16x16x32_bf16(A1, Bq[hh][1], a, 0, 0, 0);
#pragma unroll
            for (int k = 0; k < 4; ++k) sc[k] += iw[hh] * fmaxf(a[k], 0.f); }
        unsigned kk[4];
#pragma unroll
        for (int k = 0; k < 4; ++k) { const unsigned code = score_code(sc[k]);
            if (FULL) { kk[k] = code; atomicAdd((unsigned*)(hist1 + (code >> 9) * 16 + q), (code & 0x100u) ? 0x10000u : 1u); }
            else { const int key = 16 * j + 4 * kg + k; const bool adm = key <= tq; kk[k] = adm ? code : 0u;
                if (adm) atomicAdd((unsigned*)(hist1 + (code >> 9) * 16 + q), (code & 0x100u) ? 0x10000u : 1u); } }
        u32x2 w; w.x = kk[0] | (kk[1] << 16); w.y = kk[2] | (kk[3] << 16);
        if (FULL || j < ntile) *(LAS u32x2*)(keys + q * 4104 + 16 * j + 4 * kg) = w; }
}
__device__ __forceinline__ void sub_dsa_select(const Ctx& X) {
    const bf16_t* proj = WSP(bf16_t, WS_PROJ); unsigned long long* mask = WSP(unsigned long long, WS_MASK);
    LAS bf16_t* keys = (LAS bf16_t*)X.lds;
    LAS unsigned* hist1 = (LAS unsigned*)(X.lds + AUX_OFF + 1024);
    LAS unsigned* hist2 = (LAS unsigned*)(X.lds + AUX_OFF + 1024 + 8192) + X.wave * 512;
    const int lane = X.lane;
    for (int u0 = X.c; u0 < 1024; u0 += X.G) {
        const int rnd = u0 / X.G, u = (rnd & 1) ? (rnd + 1) * X.G - 1 - (u0 - rnd * X.G) : u0;
        if (u >= 1024) continue;
        const int b = u & 3, qb = 255 - (u >> 2); const size_t tg0 = (size_t)b * SEQ;
        if (qb < 16) {
#pragma unroll
            for (int rr = 0; rr < 2; ++rr) { const int t = 16 * qb + 2 * X.wave + rr; const int rem = t - 64 * lane;
                const unsigned long long w = rem >= 63 ? ~0ull : (rem < 0 ? 0ull : ((2ull << rem) - 1ull));
                mask[(tg0 + t) * 64 + lane] = w; }
            continue;
        }
        const int nk = 16 * (qb + 1), nkp = (nk + 63) & ~63, ntile = nkp >> 4, nwords = nkp >> 6;
        REP(21) {
        *(LAS u32x4*)(hist1 + 4 * X.tid) = (u32x4){0u, 0u, 0u, 0u};
        __syncthreads();
        {
            const int q = lane & 15, kg = lane >> 4; const size_t qrow = (tg0 + 16 * qb + q) * NP;
            bf16x8 Bq[4][2]; float iw[4];
#pragma unroll
            for (int hh = 0; hh < 4; ++hh) { iw[hh] = bf2f(proj[qrow + C_IW + hh]);
#pragma unroll
                for (int ks = 0; ks < 2; ++ks) Bq[hh][ks] = *(const bf16x8*)(proj + qrow + C_IQ + 64 * hh + 32 * ks + 8 * kg); }
            const int tq = 16 * qb + q;
            const bf16_t* kbase = proj + (tg0 + q) * NP + C_IK + 8 * kg;
            for (int jb = X.wave; jb < ntile; jb += 64) {
                bf16x8 Ax[4][2], Ay[4][2];
#pragma unroll
                for (int i = 0; i < 4; ++i) { int j = jb + 8 * i; j = j > 255 ? 255 : j; Ax[i][0] = *(const bf16x8*)(kbase + (size_t)(16 * j) * NP); Ax[i][1] = *(const bf16x8*)(kbase + (size_t)(16 * j) * NP + 32); }
#pragma unroll
                for (int i = 0; i < 4; ++i) { int j = jb + 32 + 8 * i; j = j > 255 ? 255 : j; Ay[i][0] = *(const bf16x8*)(kbase + (size_t)(16 * j) * NP); Ay[i][1] = *(const bf16x8*)(kbase + (size_t)(16 * j) * NP + 32); }
                if (jb + 56 < qb) select_trip<true>(Ax, Ay, Bq, iw, jb, ntile, q, kg, tq, hist1, keys);
                else select_trip<false>(Ax, Ay, Bq, iw, jb, ntile, q, kg, tq, hist1, keys);
            }
        }
        __syncthreads();
        }
        {
            const int t0r = 16 * qb + 2 * X.wave;
            const LAS bf16_t* krow[2] = {keys + (2 * X.wave) * 4104 + lane, keys + (2 * X.wave + 1) * 4104 + lane};
            LAS unsigned* h2[2] = {hist2, hist2 + 256};
            unsigned d1[2], ab1[2], d2[2], ab2[2];
#pragma unroll
            for (int q = 0; q < 2; ++q) { find_digit<true>(hist1 + 2 * X.wave + q, lane, 256u, d1[q], ab1[q]); *(LAS u32x4*)(h2[q] + 4 * lane) = (u32x4){0u, 0u, 0u, 0u}; }
            asm volatile("s_waitcnt lgkmcnt(0)" ::: "memory");
            for (int w0 = 0; w0 < nwords; w0 += 8) { unsigned k8[2][8];
#pragma unroll
                for (int i = 0; i < 8; ++i) { k8[0][i] = krow[0][64 * ((w0 + i) & 63)]; k8[1][i] = krow[1][64 * ((w0 + i) & 63)]; }
#pragma unroll
                for (int i = 0; i < 8; ++i)
#pragma unroll
                    for (int q = 0; q < 2; ++q) { const unsigned k = k8[q][i]; if (w0 + i < nwords && (k >> 8) == d1[q]) atomicAdd((unsigned*)(h2[q] + (k & 255u)), 1u); } }
            asm volatile("s_waitcnt lgkmcnt(0)" ::: "memory");
#pragma unroll
            for (int q = 0; q < 2; ++q) find_digit<false>(h2[q], lane, 256u - ab1[q], d2[q], ab2[q]);
            asm volatile("s_waitcnt lgkmcnt(0)" ::: "memory");
            unsigned vstar[2], need[2], mylo[2] = {0u, 0u}, myhi[2] = {0u, 0u};
#pragma unroll
            for (int q = 0; q < 2; ++q) { vstar[q] = (d1[q] << 8) | d2[q]; need[q] = 256u - ab1[q] - ab2[q]; }
            for (int w0 = 0; w0 < nwords; w0 += 8) { unsigned k8[2][8];
#pragma unroll
              for (int i = 0; i < 8; ++i) { k8[0][i] = krow[0][64 * ((w0 + i) & 63)]; k8[1][i] = krow[1][64 * ((w0 + i) & 63)]; }
#pragma unroll
              for (int i = 0; i < 8; ++i)
#pragma unroll
                for (int q = 0; q < 2; ++q) { const int w = w0 + i; const unsigned k = w < nwords ? k8[q][i] : 0u;
                  const unsigned long long gt = __ballot(k > vstar[q]); unsigned long long eq = __ballot(k == vstar[q]);
                  if (eq != 0ull) { const unsigned ne = (unsigned)__builtin_popcountll(eq);
                    if (ne > need[q]) { unsigned long long e = eq, rsel = 0ull; for (unsigned ii = 0; ii < need[q]; ++ii) { const unsigned long long bbit = e & (0ull - e); rsel |= bbit; e ^= bbit; } eq = rsel; need[q] = 0u; }
                    else need[q] -= ne; }
                  const unsigned long long sel = gt | eq;
                  if (lane == w) { mylo[q] = (unsigned)sel; myhi[q] = (unsigned)(sel >> 32); } } }
#pragma unroll
            for (int q = 0; q < 2; ++q) { const int t = t0r + q; const int rem = t - 64 * lane;
                const unsigned long long cm = rem >= 63 ? ~0ull : (rem < 0 ? 0ull : ((2ull << rem) - 1ull));
                mask[(tg0 + t) * 64 + lane] = lane < nwords ? ((((unsigned long long)myhi[q] << 32) | mylo[q]) & cm) : 0ull; }
        }
        __syncthreads();
    }
}

__device__ __forceinline__ void attn_dma(const int st, const int wave, const int lane, const bf16_t* kglob, const bf16_t* vglob, const unsigned long long* mglob, LAS unsigned char* kv, LAS unsigned char* mb) {
#pragma unroll
    for (int i = 0; i < 4; ++i) { const int L = (wave * 4 + i) * 64 + lane, row = L >> 4, c = (L & 15) ^ (row & 15);
        __builtin_amdgcn_global_load_lds((const unsigned*)(kglob + (size_t)(128 * st + row) * NP + 8 * c), (LAS unsigned*)(kv + (wave * 4 + i) * 1024), 16, 0, 0);
        __builtin_amdgcn_global_load_lds((const unsigned*)(vglob + (size_t)row * SEQ + 128 * st + 8 * c), (LAS unsigned*)(kv + 32768 + (wave * 4 + i) * 1024), 16, 0, 0); }
    if (wave < 2) __builtin_amdgcn_global_load_lds((const unsigned*)(mglob + (size_t)(wave * 64 + lane) * 64 + 2 * st), (LAS unsigned*)(mb + wave * 1024), 16, 0, 0);
}
template <bool FAR>
__device__ __forceinline__ void attn_tile(const int st, const int r, const int hf, const int g, const int wq, const int tq, const float scale2,
                                          const LAS unsigned char* Ks, const LAS unsigned char* Vs, const LAS unsigned char* mb, const LAS float* bt,
                                          const bf16x8 (&Qf)[8], f32x16 (&O)[4], float& mrun, float& lrun) {
    const unsigned long long mw = *(const LAS unsigned long long*)(mb + (32 * wq + r) * 16 + 8 * g) >> (4 * hf);
    const unsigned mlo = (unsigned)mw, mhi = (unsigned)(mw >> 32);
    f32x16 S[2];
#pragma unroll
    for (int kb = 0; kb < 2; ++kb) {
#pragma unroll
        for (int k = 0; k < 16; ++k) S[kb][k] = 0.f;
        const int row = 64 * g + 32 * kb + r;
#pragma unroll
        for (int ks = 0; ks < 8; ++ks) { const bf16x8 a = *(const LAS bf16x8*)(Ks + row * 256 + (((2 * ks + hf) ^ (row & 15)) << 4));
            S[kb] = __builtin_amdgcn_mfma_f32_32x32x16_bf16(a, Qf[ks], S[kb], 0, 0, 0); } }
    const int kg0 = 128 * st + 64 * g;
    float mx = -1e30f;
    const float bfar = bt[128];
#pragma unroll
    for (int kb = 0; kb < 2; ++kb)
#pragma unroll
        for (int k = 0; k < 16; ++k) { const int ko = 32 * kb + (k & 3) + 8 * (k >> 2); const int sel = __builtin_amdgcn_sbfe((int)(kb ? mhi : mlo), (k & 3) + 8 * (k >> 2), 1);
            float bias = bfar;
            if (!FAR) { int rel = tq - (kg0 + ko + 4 * hf); rel = rel < 0 ? 0 : (rel > 128 ? 128 : rel); bias = bt[rel]; }
            const float lg = __uint_as_float((__float_as_uint(S[kb][k] * scale2 + bias) & (unsigned)sel) | (~(unsigned)sel & 0xff800000u)); S[kb][k] = lg; mx = fmaxf(mx, lg); }
    mx = max_x32(mx);
    if (__ballot(mx > mrun + 8.f) != 0ull) {
        const float mnew = fmaxf(mrun, mx), alpha = __builtin_amdgcn_exp2f(mrun - mnew);
        lrun *= alpha; mrun = mnew;
#pragma unroll
        for (int eb = 0; eb < 4; ++eb)
#pragma unroll
            for (int k = 0; k < 16; ++k) O[eb][k] *= alpha;
    }
    float ps = 0.f;
#pragma unroll
    for (int kb = 0; kb < 2; ++kb)
#pragma unroll
        for (int k = 0; k < 16; ++k) { const float p = __builtin_amdgcn_exp2f(S[kb][k] - mrun); S[kb][k] = p; ps += p; }
    ps = sum_x32(ps);
    lrun += ps;
#pragma unroll
    for (int kb = 0; kb < 2; ++kb)
#pragma unroll
        for (int s = 0; s < 2; ++s) {
            union { bf16x8 v; unsigned w[4]; } P;
#pragma unroll
            for (int j = 0; j < 4; ++j) P.w[j] = cvt_pk_bf16(S[kb][8 * s + 2 * j], S[kb][8 * s + 2 * j + 1]);
#pragma unroll
            for (int eb = 0; eb < 4; ++eb) { const int row = 32 * eb + r;
                const bf16x8 a = *(const LAS bf16x8*)(Vs + row * 256 + (((8 * g + 4 * kb + 2 * s + hf) ^ (row & 15)) << 4));
                O[eb] = __builtin_amdgcn_mfma_f32_32x32x16_bf16(a, P.v, O[eb], 0, 0, 0); } }
}
__device__ __forceinline__ void sub_dsa_attn(const Ctx& X, int l) {
    const bf16_t* proj = WSP(bf16_t, WS_PROJ); const bf16_t* vtg = WSP(bf16_t, WS_VT); const unsigned long long* mask = WSP(unsigned long long, WS_MASK);
    bf16_t* y = WSP(bf16_t, WS_Y); const float* relb = X.in[16];
    LAS unsigned char* KV = X.lds;
    LAS unsigned char* MB = X.lds + AUX_OFF + 1024;
    LAS float* bt = (LAS float*)(X.lds + AUX_OFF + 1024 + 4096);
    LAS float* Ox = (LAS float*)X.lds; LAS float* MLx = (LAS float*)(X.lds + 65536);
    const int lane = X.lane, r = lane & 31, hf = lane >> 5, g = X.wave >> 2, wq = X.wave & 3;
    const float scale2 = 0.08838834764831845f * 1.4426950408889634f;
    for (int u = X.c; u < 512; u += X.G) {
        const int bh = u & 15, qt = u < 256 ? 31 - (u >> 4) : ((u - 256) >> 4), b = bh >> 2, hh = bh & 3;
        const size_t tg0 = (size_t)b * SEQ; const int q0 = 128 * qt, tq = q0 + 32 * wq + r;
        if (X.tid < 129) { const int n = X.tid; int bk;
            if (n < 16) bk = n; else { bk = 16 + (int)(__logf((float)n * (1.f / 16.f)) / 2.0794415416798357f * 16.f); bk = bk > 31 ? 31 : bk; }
            bt[n] = relb[bk * 4 + hh] * 1.4426950408889634f; }
        bf16x8 Qf[8];
        {
            union { bf16x8 v; unsigned w[4]; } qr[8]; float ss = 0.f;
#pragma unroll
            for (int ks = 0; ks < 8; ++ks) { qr[ks].v = *(const bf16x8*)(proj + (tg0 + tq) * NP + C_DQ + 128 * hh + 16 * ks + 8 * hf);
#pragma unroll
                for (int j = 0; j < 4; ++j) { const float a = lo_bf(qr[ks].w[j]), bq = hi_bf(qr[ks].w[j]); ss += a * a + bq * bq; } }
            ss = sum_x32(ss);
            const float rstd = __builtin_amdgcn_rsqf(ss * (1.f / 128.f) + EPS);
            const float* qg = X.in[14] + (size_t)l * 128 + 8 * hf;
#pragma unroll
            for (int ks = 0; ks < 8; ++ks) { const f32x4 g0 = *(const f32x4*)(qg + 16 * ks), g1 = *(const f32x4*)(qg + 16 * ks + 4);
                qr[ks].w[0] = cvt_pk_bf16(lo_bf(qr[ks].w[0]) * rstd * g0[0], hi_bf(qr[ks].w[0]) * rstd * g0[1]);
                qr[ks].w[1] = cvt_pk_bf16(lo_bf(qr[ks].w[1]) * rstd * g0[2], hi_bf(qr[ks].w[1]) * rstd * g0[3]);
                qr[ks].w[2] = cvt_pk_bf16(lo_bf(qr[ks].w[2]) * rstd * g1[0], hi_bf(qr[ks].w[2]) * rstd * g1[1]);
                qr[ks].w[3] = cvt_pk_bf16(lo_bf(qr[ks].w[3]) * rstd * g1[2], hi_bf(qr[ks].w[3]) * rstd * g1[3]);
                Qf[ks] = qr[ks].v; } }
        f32x16 O[4];
#pragma unroll
        for (int eb = 0; eb < 4; ++eb)
#pragma unroll
            for (int k = 0; k < 16; ++k) O[eb][k] = 0.f;
        float mrun = -1e30f, lrun = 0.f;
        const bf16_t* kglob = proj + tg0 * NP + C_DK + 128 * hh; const bf16_t* vglob = vtg + (size_t)bh * 128 * SEQ; const unsigned long long* mglob = mask + (tg0 + q0) * 64;
        const int nfar = qt - 1;
        attn_dma(0, X.wave, lane, kglob, vglob, mglob, KV, MB);
        for (int st = 0; st < nfar; ++st) {
            asm volatile("s_waitcnt vmcnt(0)" ::: "memory"); __syncthreads();
            attn_dma(st + 1, X.wave, lane, kglob, vglob, mglob, KV + ((st + 1) & 1) * 65536, MB + ((st + 1) & 1) * 2048);
            const LAS unsigned char* kvb = KV + (st & 1) * 65536;
            attn_tile<true>(st, r, hf, g, wq, tq, scale2, kvb, kvb + 32768, MB + (st & 1) * 2048, bt, Qf, O, mrun, lrun);
        }
        for (int st = nfar < 0 ? 0 : nfar; st <= qt; ++st) {
            asm volatile("s_waitcnt vmcnt(0)" ::: "memory"); __syncthreads();
            if (st < qt) attn_dma(st + 1, X.wave, lane, kglob, vglob, mglob, KV + ((st + 1) & 1) * 65536, MB + ((st + 1) & 1) * 2048);
            const LAS unsigned char* kvb = KV + (st & 1) * 65536;
            attn_tile<false>(st, r, hf, g, wq, tq, scale2, kvb, kvb + 32768, MB + (st & 1) * 2048, bt, Qf, O, mrun, lrun);
        }
        __syncthreads();
        if (g == 1) {
#pragma unroll
            for (int eb = 0; eb < 4; ++eb)
#pragma unroll
                for (int k = 0; k < 16; ++k) Ox[((wq * 4 + eb) * 16 + k) * 64 + lane] = O[eb][k];
            MLx[(wq * 64 + lane) * 2] = mrun; MLx[(wq * 64 + lane) * 2 + 1] = lrun; }
        __syncthreads();
        if (g == 0) {
            const float m1 = MLx[(wq * 64 + lane) * 2], l1 = MLx[(wq * 64 + lane) * 2 + 1];
            const float m = fmaxf(mrun, m1), a0 = __builtin_amdgcn_exp2f(mrun - m), a1 = __builtin_amdgcn_exp2f(m1 - m);
            const float inv = 1.f / (lrun * a0 + l1 * a1);
#pragma unroll
            for (int eb = 0; eb < 4; ++eb)
#pragma unroll
                for (int k4 = 0; k4 < 4; ++k4) { float o[4];
#pragma unroll
                    for (int j = 0; j < 4; ++j) { const int k = 4 * k4 + j; o[j] = (O[eb][k] * a0 + Ox[((wq * 4 + eb) * 16 + k) * 64 + lane] * a1) * inv; }
                    u32x2 w; w.x = cvt_pk_bf16(o[0], o[1]); w.y = cvt_pk_bf16(o[2], o[3]);
                    *(u32x2*)(y + (tg0 + tq) * YW + 1024 + 128 * hh + 32 * eb + 8 * k4 + 4 * hf) = w; } }
        __syncthreads();
    }
}

__device__ __forceinline__ void phase_norm2(const Ctx& X, int l) {
    const float* out = X.out; const float* mod = WSP(float, WS_MOD); bf16_t* h = WSP(bf16_t, WS_H);
    int* toke = WSP(int, WS_TOKE); float* tokw = WSP(float, WS_TOKW); unsigned* cntb = WSP(unsigned, WS_CNT);
    LAS float* WT = (LAS float*)X.lds;
    LAS unsigned* cnt = (LAS unsigned*)(X.lds + AUX_OFF + 1024);
    const float* wg = X.in[20] + (size_t)l * 4096; const float* wr = X.in[22] + (size_t)l * 16384;
    { f32x4 a[2], b[8];
#pragma unroll
      for (int i = 0; i < 2; ++i) a[i] = *(const f32x4*)(wg + 4 * (X.tid + 512 * i));
#pragma unroll
      for (int i = 0; i < 8; ++i) b[i] = *(const f32x4*)(wr + 4 * (X.tid + 512 * i));
#pragma unroll
      for (int i = 0; i < 2; ++i) { const int e0 = 4 * (X.tid + 512 * i);
#pragma unroll
          for (int k = 0; k < 4; ++k) WT[((e0 + k) & 3) * 1024 + ((e0 + k) >> 2)] = a[i][k]; }
#pragma unroll
      for (int i = 0; i < 8; ++i) { const int e0 = 4 * (X.tid + 512 * i);
#pragma unroll
          for (int k = 0; k < 4; ++k) WT[(4 + ((e0 + k) & 15)) * 1024 + ((e0 + k) >> 4)] = b[i][k]; } }
    if (X.tid < 16) cnt[X.tid] = 0u;
    __syncthreads();
    const float* g2 = X.in[5] + (size_t)l * 1024; const float* bgrp = X.in[21] + l * 4; const float* brt = X.in[23] + l * 16;
    const int rpb = (T + X.G - 1) / X.G;
  for (int i0 = X.wave; i0 < rpb; i0 += 8 * 8) {
#pragma unroll 1
    for (int jg = 0; jg < 8; jg += 2) {
        f32x4 xall[2][4];
#pragma unroll
        for (int q = 0; q < 2; ++q) { const int i = i0 + 8 * (jg + q); const int r = (i < rpb && X.c * rpb + i < T) ? X.c * rpb + i : X.c * rpb;
#pragma unroll
            for (int k = 0; k < 4; ++k) xall[q][k] = *(const f32x4*)(out + (size_t)r * 1024 + 4 * X.lane + 256 * k); }
        float rstd[2]; int rr[2]; bool ok[2];
#pragma unroll
        for (int q = 0; q < 2; ++q) { const int i = i0 + 8 * (jg + q); ok[q] = i < rpb && X.c * rpb + i < T; rr[q] = ok[q] ? X.c * rpb + i : X.c * rpb;
            float ss = 0.f;
#pragma unroll
            for (int k = 0; k < 4; ++k) { const f32x4 xv = xall[q][k]; ss += xv[0] * xv[0] + xv[1] * xv[1] + xv[2] * xv[2] + xv[3] * xv[3]; }
            rstd[q] = __builtin_amdgcn_rsqf(wave_sum(ss) * (1.f / 1024.f) + EPS); }
        float lg[2][20];
#pragma unroll
        for (int q = 0; q < 2; ++q)
#pragma unroll
            for (int o = 0; o < 20; ++o) lg[q][o] = 0.f;
#pragma unroll 1
        for (int k = 0; k < 4; ++k) { const int col = 4 * X.lane + 256 * k; const f32x4 g = *(const f32x4*)(g2 + col);
            f32x4 yv[2];
#pragma unroll
            for (int q = 0; q < 2; ++q) { const float* md = mod + ((size_t)l * NB + (rr[q] >> 12)) * 6144;
                const f32x4 sh = *(const f32x4*)(md + 3072 + col), sc = *(const f32x4*)(md + 4096 + col);
                yv[q] = xall[q][k] * rstd[q] * g * (sc + 1.f) + sh;
                if (ok[q]) { u32x2 w; w.x = cvt_pk_bf16(yv[q][0], yv[q][1]); w.y = cvt_pk_bf16(yv[q][2], yv[q][3]); *(u32x2*)(h + (size_t)rr[q] * 1024 + col) = w; } }
#pragma unroll
            for (int o = 0; o < 20; ++o) { const f32x4 wv = *(const LAS f32x4*)(WT + o * 1024 + col);
#pragma unroll
                for (int q = 0; q < 2; ++q) lg[q][o] += yv[q][0] * wv[0] + yv[q][1] * wv[1] + yv[q][2] * wv[2] + yv[q][3] * wv[3]; } }
#pragma unroll
        for (int q = 0; q < 2; ++q) {
#pragma unroll
            for (int o = 0; o < 20; ++o) lg[q][o] = wave_sum(lg[q][o]);
            if (X.lane == 0 && ok[q]) { const int r = rr[q];
                float gl[4];
#pragma unroll
                for (int k = 0; k < 4; ++k) gl[k] = lg[q][k] + bgrp[k];
                int gi = 0; float gm = gl[0];
#pragma unroll
                for (int k = 1; k < 4; ++k) if (gl[k] > gm) { gm = gl[k]; gi = k; }
                float se = 0.f;
#pragma unroll
                for (int k = 0; k < 4; ++k) se += __expf(gl[k] - gm);
                const float pg = 1.f / se;
                float sl[4];
#pragma unroll
                for (int k = 0; k < 4; ++k) { sl[k] = lg[q][4 + k] + brt[k];
#pragma unroll
                    for (int qq = 1; qq < 4; ++qq) if (gi == qq) sl[k] = lg[q][4 + 4 * qq + k] + brt[4 * qq + k]; }
                int i1 = 0; float v1 = sl[0];
#pragma unroll
                for (int k = 1; k < 4; ++k) if (sl[k] > v1) { v1 = sl[k]; i1 = k; }
                int i2 = -1; float v2 = -3.0e38f;
#pragma unroll
                for (int k = 0; k < 4; ++k) if (k != i1 && sl[k] > v2) { v2 = sl[k]; i2 = k; }
                const float w1 = 1.f / (1.f + __expf(v2 - v1));
                const int e1 = 4 * gi + i1, e2 = 4 * gi + i2;
                toke[2 * r] = e1; toke[2 * r + 1] = e2; tokw[2 * r] = pg * w1; tokw[2 * r + 1] = pg * (1.f - w1);
                atomicAdd((unsigned*)(cnt + e1), 1u); atomicAdd((unsigned*)(cnt + e2), 1u);
            }
        }
    }
  }
    __syncthreads();
    if (X.tid < 16) cntb[X.c * 16 + X.tid] = cnt[X.tid];
    __syncthreads();
}

__device__ __forceinline__ void build_tiles(const Ctx& X, LAS int* tb, LAS int* myoff  ) {
    const unsigned* cntb = WSP(unsigned, WS_CNT);
    LAS int* tot = tb + 32;
    LAS int* part = tb + 512;
    { const int e = X.tid & 15, p = X.tid >> 4, per = (X.G + 31) >> 5; int s = 0, mine = 0;
      for (int k = 0; k < per; ++k) { const int c = p * per + k; if (c < X.G) { const int v = (int)cntb[c * 16 + e]; s += v; if (c < X.c) mine += v; } }
      part[p * 16 + e] = s; if (X.c >= p * per && X.c < (p + 1) * per) part[512 + e] = mine; }
    __syncthreads();
    if (X.tid < 16) { const int per = (X.G + 31) >> 5, mp = X.c / per; int s = 0, mine = part[512 + X.tid];
        for (int p = 0; p < 32; ++p) { const int v = part[p * 16 + X.tid]; s += v; if (p < mp) mine += v; }
        tot[X.tid] = s; myoff[X.tid] = mine; }
    __syncthreads();
    if (X.tid == 0) { int row = 0, nT = 0;
        for (int e = 0; e < 16; ++e) { const int nt = (tot[e] + 255) >> 8; tb[16 + e] = row; for (int k = 0; k < nt; ++k) { tb[64 + nT] = e; tb[256 + nT] = (row >> 8) + k; ++nT; } row += nt * 256; }
        tb[0] = nT; }
    __syncthreads();
    if (X.tid < 16) myoff[X.tid] += tb[16 + X.tid];
    __syncthreads();
}

__device__ __forceinline__ void moe_lists(const Ctx& X, const LAS int* tb, LAS int* rows, LAS float* lw, LAS int* sc) {
    const unsigned* cntb = WSP(unsigned, WS_CNT); const int* toke = WSP(int, WS_TOKE); const float* tokw = WSP(float, WS_TOKW); int* toks = WSP(int, WS_TOKS);
    const int nT = tb[0], rpb = (T + X.G - 1) / X.G;
    for (int i = 0; i < 2; ++i) {
        const long L = (long)i * X.G + X.c; if (L >= ((long)nT << 1)) break;
        const int rt = (int)(L >> 1), e = tb[64 + rt], pm = tb[256 + rt], rbase = pm * 256 - tb[16 + e];
        const int v = X.tid < X.G ? (int)cntb[X.tid * 16 + e] : 0;
        sc[X.tid] = v; rows[i * 256 + (X.tid & 255)] = 0; lw[i * 256 + (X.tid & 255)] = 0.f;
        __syncthreads();
        for (int off = 1; off < 512; off <<= 1) { const int t = X.tid >= off ? sc[X.tid - off] : 0; __syncthreads(); sc[X.tid] += t; __syncthreads(); }
        sc[512 + X.tid] = v;
        __syncthreads();
        for (int cs = X.wave; cs < X.G; cs += 8) {
            const int cnt = sc[512 + cs], lo = sc[cs] - cnt;
            if (cnt == 0 || lo + cnt <= rbase || lo >= rbase + 256) continue;
            int run = lo;
            for (int n0 = 0; n0 < 2 * rpb; n0 += 64) { const int n = n0 + X.lane, tr = cs * rpb + (n >> 1), k = n & 1;
                const bool in = n < 2 * rpb && tr < T; const int ex = in ? toke[2 * tr + k] : -1; const bool match = ex == e;
                const unsigned long long bal = __ballot(match);
                const int rank = run + (int)__builtin_popcountll(bal & ((1ull << X.lane) - 1ull)) - rbase;
                if (match && rank >= 0 && rank < 256) { rows[i * 256 + rank] = tr; lw[i * 256 + rank] = tokw[2 * tr + k]; toks[2 * tr + k] = pm * 256 + rank; }
                run += (int)__builtin_popcountll(bal); }
        }
        __syncthreads();
    }
}

__global__ void __launch_bounds__(512, 2) fwd_kernel(Params P) {
    extern __shared__ __attribute__((aligned(16))) unsigned char lds_raw[];
    Ctx X0; X0.in = (const float* const CAS*)__builtin_amdgcn_kernarg_segment_ptr(); X0.out = P.out; X0.ws = P.ws; X0.lds = (LAS unsigned char*)lds_raw;
    X0.tid = threadIdx.x; X0.lane = X0.tid & 63; X0.wave = __builtin_amdgcn_readfirstlane(X0.tid >> 6); X0.G = gridDim.x; X0.c = blockIdx.x;
    LAS unsigned* auxw = (LAS unsigned*)(X0.lds + AUX_OFF);
    if (X0.tid < 4) auxw[X0.tid] = 0u;
    __syncthreads();
#define FRESH() Ctx X = X0; { int wv_ = X0.wave; asm volatile("" : "+s"(wv_)); unsigned m_ = ~0u; asm volatile("" : "+s"(m_)); const int ln_ = __builtin_amdgcn_mbcnt_hi(m_, __builtin_amdgcn_mbcnt_lo(m_, 0u)); \
        X.wave = wv_; X.lane = ln_; X.tid = wv_ * 64 + ln_; \
        unsigned char* w_ = X0.ws; asm volatile("" : "+s"(w_)); X.ws = w_; int c_ = X0.c; asm volatile("" : "+s"(c_)); X.c = c_; \
        const float* const CAS* i_ = X0.in; asm volatile("" : "+s"(i_)); X.in = i_; }
#if N_LAUNCH_MODE == 1
    XcdBarrier bar = xcd_barrier_post((unsigned*)(X0.ws + WS_CTL), (volatile LAS unsigned*)auxw);
#define SEAM() do { unsigned long long t1_ = 0; if (PROBE_STAMP) { t1_ = __builtin_amdgcn_s_memrealtime(); if (ph_ >= 0 && ((PROBE_STAMP >> ph_) & 1)) st_acc += t1_ - st_t0; } \
        if (gp >= lo && gp + 1 < hi) { xcd_barrier(bar); if (PROBE_DUP == 17) xcd_barrier(bar); } \
        if (PROBE_STAMP) { st_t0 = __builtin_amdgcn_s_memrealtime(); if ((PROBE_STAMP >> 11) & 1) st_acc += st_t0 - t1_; ph_ = ph_ < 0 ? ph_ : (ph_ + 1) % 10; } ++gp; } while (0)
#else
#define SEAM() do { ++gp; } while (0)
#endif
    const int lo = P.ph_lo, hi = P.ph_hi; int gp = 0;
    unsigned long long st_acc = 0, st_t0 = PROBE_STAMP ? __builtin_amdgcn_s_memrealtime() : 0ull; int ph_ = -1;
#define IN() (gp >= lo && gp < hi)
    if (IN()) { REP(13) { FRESH(); phase_mod(X); } { FRESH(); __syncthreads(); phase_conv_dyn(X, 0, (unsigned*)(X.ws + WS_CTL + 14336) + 64 * 3, 1 << 30); } }
    SEAM();
    ph_ = 0;
#define LAYER_BODY(l) do { \
        if (IN()) { REP(19) { FRESH(); if (l == 0) phase_norm1(X, l, 0); else phase_norm1(X, l, 1, rep_ == 0 ? 1.f : 0.f); } } \
        SEAM(); \
        if (IN()) REP(3) { \
            FRESH(); \
            SchedStatic S{64, 30, X.G, X.c, (const char*)WSP(bf16_t, WS_H), (const char*)WSW(bf16_t, WS_WIN, l), (size_t)256 * 1024 * 2, (size_t)256 * 1024 * 2}; \
            EpiProj E{WSP(bf16_t, WS_PROJ), X.in[18] + (size_t)(l) * 3072}; \
            pg8::gemm_phase(X.lds, X.tid, 1024, 1024, 16, S, E); \
              \
            if ((l) + 1 < NL && (64 * 30) % X.G != 0 && X.c >= (64 * 30) % X.G) { __syncthreads(); phase_conv_dyn(X, (l) + 1, (unsigned*)(X.ws + WS_CTL + 14336) + 64 * (l), 4); } \
        } \
        SEAM(); \
        if (IN()) { { FRESH(); sub_qknorm(X, l); } REP(4) { FRESH(); sub_vtrans(X); } REP(5) { FRESH(); sub_gmlp(X, l); } REP(6) { FRESH(); sub_gla_local(X, l); } REP(7) { FRESH(); sub_dsa_select(X); } } \
        SEAM(); \
        if (IN()) { { FRESH(); sub_gla_scan(X); } if (PROBE_DUP == 16) { xcd_barrier(bar); { FRESH(); sub_gla_local(X, l); } xcd_barrier(bar); { FRESH(); sub_gla_scan(X); } } REP(8) { FRESH(); sub_dsa_attn(X, l); } } \
        SEAM(); \
        if (IN()) REP(9) { FRESH(); sub_gla_out(X, l); } \
        SEAM(); \
        if (IN()) REP(10) { \
            FRESH(); \
            SchedStatic S{64, 4, X.G, X.c, (const char*)WSP(bf16_t, WS_Y), (const char*)WSW(bf16_t, WS_WBR, l), (size_t)256 * YW * 2, (size_t)256 * YW * 2}; \
            EpiMerge E{WSP(bf16_t, WS_PROJ), WSP(bf16_t, WS_H)}; \
            pg8::gemm_phase(X.lds, X.tid, YW, YW, 24, S, E); \
        } \
        SEAM(); \
        if (IN()) REP(18) { \
            FRESH(); \
            SchedStatic S{64, 4, X.G, X.c, (const char*)WSP(bf16_t, WS_H), (const char*)WSW(bf16_t, WS_WOUT, l), (size_t)256 * 1024 * 2, (size_t)256 * 1024 * 2}; \
            EpiOut E{X.out, ((l) == 0 && rep_ == 0) ? X.in[0] : (const float*)X.out, WSP(float, WS_MOD) + (size_t)l * NB * 6144 + 2048, rep_ == 0 ? 1.f : 0.f}; \
            pg8::gemm_phase(X.lds, X.tid, 1024, 1024, 16, S, E); \
        } \
        SEAM(); \
        if (IN()) REP(14) { FRESH(); phase_norm2(X, l); } \
        SEAM(); \
        if (IN()) REP(11) { \
            FRESH(); \
            LAS int* tb = (LAS int*)(X.lds + AUX_OFF + 2048); LAS int* myoff = (LAS int*)(X.lds + AUX_OFF + 1024); \
            LAS int* rows = (LAS int*)(X.lds + AUX_OFF + 12288); LAS float* lw = (LAS float*)(X.lds + AUX_OFF + 14336); \
            build_tiles(X, tb, myoff); \
            moe_lists(X, tb, rows, lw, (LAS int*)(X.lds + AUX_OFF + 16384)); \
            SchedMoeG S{X.G, X.c, tb[0], tb + 64, tb + 256, rows, (const char*)WSP(bf16_t, WS_H), (const char*)WSW(bf16_t, WS_WE1, l), (size_t)512 * 1024 * 2, (size_t)256 * 1024 * 2}; \
            EpiMoe1 E{WSP(bf16_t, WS_ACT), lw}; \
            pg8::gemm_phase(X.lds, X.tid, 1024, 1024, 16, S, E); \
            if ((l) + 1 < NL) { __syncthreads(); phase_conv_dyn(X, (l) + 1, (unsigned*)(X.ws + WS_CTL + 14336) + 64 * (l), 1 << 30); } \
        } \
        SEAM(); \
        if (IN()) REP(12) { \
            FRESH(); \
            LAS int* tb = (LAS int*)(X.lds + AUX_OFF + 2048); LAS int* myoff = (LAS int*)(X.lds + AUX_OFF + 1024); \
            build_tiles(X, tb, myoff); \
            SchedMoe S{X.G, X.c, 2, tb[0], tb + 64, tb + 256, (const char*)WSP(bf16_t, WS_ACT), (const char*)WSW(bf16_t, WS_WE2, l), (size_t)256 * 256 * 2, (size_t)1024 * 256 * 2, (size_t)256 * 256 * 2}; \
            EpiMoe2 E{WSP(bf16_t, WS_FFN)}; \
            pg8::gemm_phase(X.lds, X.tid, 256, 256, 4, S, E); \
        } \
        SEAM(); \
 \
    } while (0)
    LAYER_BODY(0); LAYER_BODY(1); LAYER_BODY(2); LAYER_BODY(3);
    if (IN()) { FRESH(); phase_norm1(X, NL, 2); }
    if (PROBE_STAMP) { if (blockIdx.x == 0) { const unsigned long long tb = __builtin_amdgcn_s_memrealtime(); while (__builtin_amdgcn_s_memrealtime() - tb < 4ull * st_acc) __builtin_amdgcn_s_sleep(8); } }
#undef IN
#undef SEAM
}

constexpr int N_PHASES = 1 + NL * 10 + 1;

extern "C" void kernel_launch(void* const* d_in, const int* in_sizes, int n_in, void* d_out, int out_size, void* d_ws, size_t ws_size, hipStream_t stream) {
    static int grid = 0;
    if (grid == 0) {
        if (n_in != 27 || out_size != T * D || ws_size < WS_END) { fprintf(stderr, "kernel_launch: unexpected problem (n_in %d, out %d, ws %zu, need %zu)\n", n_in, out_size, ws_size, (size_t)WS_END); grid = -1; return; }
        int dev = 0, cus = 0, per_cu = 0;
        if (hipGetDevice(&dev) != hipSuccess || hipDeviceGetAttribute(&cus, hipDeviceAttributeMultiprocessorCount, dev) != hipSuccess) { grid = -1; return; }
        if (hipFuncSetAttribute((const void*)fwd_kernel, hipFuncAttributeMaxDynamicSharedMemorySize, LDS_BYTES) != hipSuccess) { fprintf(stderr, "kernel_launch: hipFuncSetAttribute failed\n"); grid = -1; return; }
        if (hipOccupancyMaxActiveBlocksPerMultiprocessor(&per_cu, (const void*)fwd_kernel, 512, LDS_BYTES) != hipSuccess || per_cu < 1) fprintf(stderr, "kernel_launch: occupancy query says %d\n", per_cu);
        (void)hipGetLastError();
        grid = cus;
    }
    if (grid < 0) return;
    (void)hipMemsetAsync((char*)d_ws + WS_CTL, 0, 16384, stream);
    Params p{};
    for (int i = 0; i < 27; ++i) p.in[i] = (const float*)d_in[i];
    p.out = (float*)d_out; p.ws = (unsigned char*)d_ws;
#if N_LAUNCH_MODE == 1
    p.ph_lo = 0; p.ph_hi = N_PHASES;
    hipLaunchKernelGGL(fwd_kernel, dim3(grid), dim3(512), LDS_BYTES, stream, p);
#else
    for (int ph = 0; ph < N_PHASES; ++ph) { p.ph_lo = ph; p.ph_hi = ph + 1; hipLaunchKernelGGL(fwd_kernel, dim3(grid), dim3(512), LDS_BYTES, stream, p); }
#endif
}
```

```cpp
#include <hip/hip_runtime.h>
#include <stdint.h>
#include <stdio.h>

#ifndef N_LAUNCH_MODE
#define N_LAUNCH_MODE 1
#endif

#ifndef PROBE_DUP
#define PROBE_DUP 0
#endif
#ifndef PROBE_STAMP
#define PROBE_STAMP 0
#endif
#define REP(id) for (int rep_ = 0; rep_ < ((PROBE_DUP == (id)) ? 2 : 1); ++rep_)
#define LAS __attribute__((address_space(3)))
#define CAS __attribute__((address_space(4)))
#define GAS __attribute__((address_space(1)))
typedef unsigned short bf16_t;
typedef short bf16x8 __attribute__((ext_vector_type(8)));
typedef float f32x2 __attribute__((ext_vector_type(2)));
typedef float f32x4 __attribute__((ext_vector_type(4)));
typedef float f32x16 __attribute__((ext_vector_type(16)));
typedef unsigned u32x2 __attribute__((ext_vector_type(2)));
typedef unsigned u32x4 __attribute__((ext_vector_type(4)));

constexpr int NB = 4, SEQ = 4096, T = NB * SEQ, D = 1024, NL = 4;
constexpr int NIN = 7508, NP = 7680;
constexpr int C_AU = 0, C_AV = 512, C_GQ = 1024, C_GK = 1280, C_GV = 1536, C_GR = 2048, C_DQ = 2560, C_DK = 3072, C_DV = 3584,
              C_IQ = 4096, C_IK = 4352, C_GA = 4416, C_IW = 4432, C_GATE = 4608;
constexpr int YW = 1536;
constexpr int MOE_ROWS = 32768 + 16 * 256;
constexpr float EPS = 1e-6f;

constexpr size_t WS_CTL = 0;
constexpr size_t WS_CNT = 16384;
constexpr size_t WS_MOD = 65536;
constexpr size_t WS_WIN = WS_MOD + 524288;
constexpr size_t WS_WBR = WS_WIN + (size_t)NP * 1024 * 2;
constexpr size_t WS_WOUT = WS_WBR + (size_t)1024 * 1536 * 2;
constexpr size_t WS_WE1 = WS_WOUT + (size_t)1024 * 1024 * 2;
constexpr size_t WS_WE2 = WS_WE1 + (size_t)16 * 512 * 1024 * 2;
constexpr size_t WS_WS = WS_WE2 + (size_t)16 * 1024 * 256 * 2;
constexpr size_t WS_W2 = WS_WS + (size_t)4 * 128 * 128 * 2;
constexpr size_t WSET = WS_W2 - WS_WIN;
constexpr size_t WS_H = WS_W2 + WSET;
constexpr size_t WS_PROJ = WS_H + (size_t)T * 1024 * 2;
constexpr size_t WS_Y = WS_PROJ + (size_t)T * NP * 2;
constexpr size_t WS_SCR = WS_Y + (size_t)T * YW * 2;
constexpr size_t WS_MASK = WS_SCR + (size_t)T * 1024 * 4;
constexpr size_t WS_VT = WS_MASK + (size_t)T * 64 * 8;
constexpr size_t WS_TOKE = WS_VT + (size_t)16 * 128 * 4096 * 2;
constexpr size_t WS_TOKW = WS_TOKE + (size_t)T * 8;
constexpr size_t WS_TOKS = WS_TOKW + (size_t)T * 8;
constexpr size_t WS_DEC = WS_TOKS + (size_t)T * 8;
constexpr size_t WS_SW = WS_DEC + (size_t)1024 * 64 * 4;
constexpr size_t WS_END = WS_SW + (size_t)MOE_ROWS * 4;
constexpr size_t WS_H2S = WS_PROJ;
constexpr size_t WS_ACT = WS_H2S + (size_t)MOE_ROWS * 1024 * 2;
constexpr size_t WS_FFN = WS_ACT + (size_t)MOE_ROWS * 256 * 2;
static_assert(WS_FFN + (size_t)MOE_ROWS * 1024 * 2 <= WS_Y, "moe alias");

constexpr int LDS_BYTES = 158720;
constexpr int AUX_OFF = 132096;

__device__ __forceinline__ float bf2f(bf16_t v) { return __uint_as_float(((unsigned)v) << 16); }
__device__ __forceinline__ unsigned cvt_pk_bf16(float lo, float hi) { unsigned r; asm volatile("v_cvt_pk_bf16_f32 %0, %1, %2" : "=v"(r) : "v"(lo), "v"(hi)); return r; }
__device__ __forceinline__ bf16_t f2bf(float f) { return (bf16_t)(cvt_pk_bf16(f, 0.f) & 0xffffu); }
__device__ __forceinline__ float lo_bf(unsigned w) { return __uint_as_float(w << 16); }
__device__ __forceinline__ float hi_bf(unsigned w) { return __uint_as_float(w & 0xffff0000u); }
__device__ __forceinline__ float max_x32(float v) { const auto r = __builtin_amdgcn_permlane32_swap(__float_as_uint(v), __float_as_uint(v), false, false); return fmaxf(__uint_as_float(r[0]), __uint_as_float(r[1])); }
__device__ __forceinline__ float sum_x32(float v) { const auto r = __builtin_amdgcn_permlane32_swap(__float_as_uint(v), __float_as_uint(v), false, false); return __uint_as_float(r[0]) + __uint_as_float(r[1]); }
template <int CTRL> __device__ __forceinline__ float dpp_f(float v) { return __int_as_float(__builtin_amdgcn_update_dpp(0, __float_as_int(v), CTRL, 0xf, 0xf, true)); }
__device__ __forceinline__ float sum8(float v) { v += dpp_f<0xB1>(v); v += dpp_f<0x4E>(v); v += dpp_f<0x141>(v); return v; }
__device__ __forceinline__ float sum16(float v) { v = sum8(v); v += dpp_f<0x140>(v); return v; }
__device__ __forceinline__ float wave_sum(float v) {
    v = sum16(v);
    const float a = __int_as_float(__builtin_amdgcn_readlane(__float_as_int(v), 0)), b = __int_as_float(__builtin_amdgcn_readlane(__float_as_int(v), 16));
    const float c = __int_as_float(__builtin_amdgcn_readlane(__float_as_int(v), 32)), d = __int_as_float(__builtin_amdgcn_readlane(__float_as_int(v), 48));
    return (a + b) + (c + d);
}
__device__ __forceinline__ float fast_exp(float x) { return __builtin_amdgcn_exp2f(x * 1.4426950408889634f); }
__device__ __forceinline__ float sigmoidf_(float x) { return __builtin_amdgcn_rcpf(1.f + fast_exp(-x)); }
__device__ __forceinline__ float gelu_tanh(float x) { const float u = x + 0.044715f * x * x * x; return x * __builtin_amdgcn_rcpf(1.f + __builtin_amdgcn_exp2f(-2.3022082f * u)); }

#define XB_TMO      128
#define XB_XCNT(j)  (256  + 64 * (j))
#define XB_XSUB(j)  (1280 + 64 * (j))
#define XB_XGEN(j)  (2304 + 64 * (j))
#define XB_TOP      3328
#define XB_TOPGEN   3392
#define XCD_BAR_WORDS 3456
#define XB_SPIN_CAP (1u << 22)
__device__ __forceinline__ unsigned xb_ld(unsigned* p)              { return __hip_atomic_load(p, __ATOMIC_RELAXED, __HIP_MEMORY_SCOPE_AGENT); }
__device__ __forceinline__ unsigned xb_add(unsigned* p, unsigned v) { return __hip_atomic_fetch_add(p, v, __ATOMIC_RELAXED, __HIP_MEMORY_SCOPE_AGENT); }
__device__ __forceinline__ unsigned xb_xcc_id() { return (unsigned)__builtin_amdgcn_s_getreg((3 << 11) | 20) & 0xFu; }
#define XB_SPIN(cond, bar) do { unsigned _sp = 0; while (cond) { __builtin_amdgcn_s_sleep(1); \
    if ((++_sp & 255u) == 0u) { if (xb_ld(&(bar)[XB_TMO])) break; if (_sp > XB_SPIN_CAP) { atomicAdd(&(bar)[XB_TMO], 1u); break; } } } } while (0)
struct XcdBarrier { unsigned* bar; unsigned x; volatile LAS unsigned* st; };
__device__ __forceinline__ XcdBarrier xcd_barrier_post(unsigned* bar, volatile LAS unsigned* st) {
    XcdBarrier b; b.bar = bar; b.x = xb_xcc_id(); b.st = st;
    if (threadIdx.x == 0) (void)xb_add(&bar[XB_XCNT(b.x)], 1u);
    return b;
}
__device__ __forceinline__ void xcd_barrier_complete(unsigned* bar, unsigned x, unsigned& nloc, unsigned& nx) {
    const unsigned G = gridDim.x * gridDim.y * gridDim.z;
    unsigned sum, cnt, mine, sp = 0u;
    for (;;) {
        sum = 0u; cnt = 0u; mine = 0u;
#pragma unroll
        for (unsigned j = 0; j < 16; ++j) { const unsigned c = xb_ld(&bar[XB_XCNT(j)]); sum += c; cnt += (c > 0u) ? 1u : 0u; mine = (j == x) ? c : mine; }
        if (sum == G) break;
        __builtin_amdgcn_s_sleep(1);
        if ((++sp & 255u) == 0u) { if (xb_ld(&bar[XB_TMO])) break; if (sp > XB_SPIN_CAP) { atomicAdd(&bar[XB_TMO], 1u); break; } }
    }
    nloc = mine > 0u ? mine : 1u; nx = cnt > 0u ? cnt : 1u;
}
__device__ __forceinline__ void xcd_barrier(const XcdBarrier& b) {
    asm volatile("s_waitcnt vmcnt(0)" ::: "memory");
    __syncthreads();
    if (threadIdx.x == 0) {
        unsigned* bar = b.bar;
        __builtin_amdgcn_s_waitcnt(0);
        unsigned nloc = b.st[0], nx = b.st[1];
        if (nloc == 0u) { xcd_barrier_complete(bar, b.x, nloc, nx); b.st[0] = nloc; b.st[1] = nx; }
        const unsigned old = xb_add(&bar[XB_XSUB(b.x)], 1u);
        const unsigned gen = old / nloc;
        if (old + 1u == (gen + 1u) * nloc) {
            __builtin_amdgcn_fence(__ATOMIC_RELEASE, "agent");
            asm volatile("s_waitcnt vmcnt(0)" ::: "memory");
            const unsigned og = xb_add(&bar[XB_TOP], 1u);
            const unsigned tg = og / nx;
            if (og + 1u == (tg + 1u) * nx) xb_add(&bar[XB_TOPGEN], 1u);
            else XB_SPIN(xb_ld(&bar[XB_TOPGEN]) == tg, bar);
            __builtin_amdgcn_fence(__ATOMIC_ACQUIRE, "agent");
            xb_add(&bar[XB_XGEN(b.x)], 1u);
            asm volatile("s_waitcnt vmcnt(0)" ::: "memory");
        } else {
            XB_SPIN(xb_ld(&bar[XB_XGEN(b.x)]) == gen, bar);
            __builtin_amdgcn_fence(__ATOMIC_ACQUIRE, "agent");
            asm volatile("s_waitcnt vmcnt(0)" ::: "memory");
        }
    }
    __syncthreads();
}

namespace pg8 {
constexpr int BM = 256, BK = 64, HALF = 128, HTB = HALF * BK * 2, STAGE_BYTES = 8 * HTB, NXCD = 8, WGM = 8;
__device__ __forceinline__ int lds_byte(int r, int c) { const int st = (r >> 4) * 2 + (c >> 5), rr = r & 15, cc = c & 31, ob = rr * 64 + cc * 2; return st * 1024 + (ob ^ (((ob >> 9) & 1) << 5)); }
__device__ __forceinline__ void stage_rc(int b, int& R, int& C) { const int st = b / 1024, sb = b % 1024, swz = sb ^ (((sb >> 9) & 1) << 5); R = (st >> 1) * 16 + swz / 64; C = (st & 1) * 32 + (swz % 64) / 2; }
__device__ __forceinline__ int perm32(int rho) { const int n = rho >> 4, i = rho & 15; return 8 * (i >> 2) + 4 * n + (i & 3); }

struct Unit { int pm, pn, aux, ord; const char* A; const char* B; };
__device__ __forceinline__ void tile_of(int L, int nM, int nN, int& pm, int& pn) {
    const int nwg = nM * nN; int wgid = L;
    { const int q = nwg / NXCD, r = nwg % NXCD, xcd = wgid % NXCD, off = wgid / NXCD; wgid = (xcd < r ? xcd * (q + 1) : r * (q + 1) + (xcd - r) * q) + off; }
    const int nig = WGM * nN, gid = wgid / nig, fm = gid * WGM, gsz = (nM - fm) < WGM ? (nM - fm) : WGM;
    pm = fm + ((wgid % nig) % gsz); pn = (wgid % nig) / gsz;
}

template <class Epi, class Sched>
__device__ __forceinline__ void gemm_phase(LAS unsigned char* lds, const int tid, const int lda, const int ldb, const int nt, const Sched& S, const Epi& E) {
    const int wid = __builtin_amdgcn_readfirstlane(tid >> 6), lane = tid & 63, wr = wid >> 2, wc = wid & 3, fr = lane & 15, fq = lane >> 4;
    unsigned voffA[2], voffB[2]; int stR[2], stC[2];
#pragma unroll
    for (int i = 0; i < 2; ++i) { int R, C; stage_rc(tid * 16 + i * 8192, R, C); const int Rb = Epi::PERM ? ((R & ~31) + perm32(R & 31)) : R; stR[i] = R; stC[i] = C;
        voffA[i] = (unsigned)(R * lda + C) * 2u; voffB[i] = (unsigned)(Rb * ldb + C) * 2u; }
    unsigned gC[2][2], gN[2][2];
#define PG8_GROWS(dst, un) do { if constexpr (Sched::GATHER) { _Pragma("unroll") for (int _h = 0; _h < 2; ++_h) _Pragma("unroll") for (int _i = 0; _i < 2; ++_i) \
        dst[_h][_i] = (unsigned)(S.row(un, _h * HALF + stR[_i]) * lda + stC[_i]) * 2u; } } while (0)
#define PG8_STAGEA(bufoff, kidx, h, nx) do { if constexpr (Sched::GATHER) { const char* _b = cA + (size_t)(kidx) * kstep; if (nx) PG8_STAGE(bufoff, _b, gN[h]); else PG8_STAGE(bufoff, _b, gC[h]); } \
        else { const char* _b = ((nx) ? nA : cA) + (size_t)(kidx) * kstep + (size_t)(h) * hstepA; PG8_STAGE(bufoff, _b, voffA); } } while (0)
    const size_t kstep = (size_t)(BK * 2);
    const size_t hstepA = (size_t)HALF * lda * 2, hstepB = (size_t)HALF * ldb * 2;
    const unsigned ldsw = (unsigned)wid * 1024u;
    const int aoff = lds_byte(wr * 64 + fr, fq * 8), boff = lds_byte(wc * 32 + fr, fq * 8);
#define PG8_SA(b, h) (((b) * 2 + (h)) * HTB)
#define PG8_SB(b, h) ((4 + (b) * 2 + (h)) * HTB)
#define PG8_STAGE(bufoff, gbase, voff) do { _Pragma("unroll") for (int _i = 0; _i < 2; ++_i) \
        __builtin_amdgcn_global_load_lds((const unsigned*)((const char*)(gbase) + (voff)[_i]), (LAS unsigned*)(lds + (bufoff) + ldsw + _i * 8192), 16, 0, 0); } while (0)
#define PG8_LDA(dst, b, h) do { _Pragma("unroll") for (int m = 0; m < 4; ++m) _Pragma("unroll") for (int k = 0; k < 2; ++k) dst[m][k] = *(const LAS bf16x8*)(lds + PG8_SA(b, h) + aoff + m * 2048 + k * 1024); } while (0)
#define PG8_LDB(dst, b, h) do { _Pragma("unroll") for (int n = 0; n < 2; ++n) _Pragma("unroll") for (int k = 0; k < 2; ++k) dst[n][k] = *(const LAS bf16x8*)(lds + PG8_SB(b, h) + boff + n * 2048 + k * 1024); } while (0)
#define PG8_MMA(ai, bj, At, Bt) do { __builtin_amdgcn_s_setprio(1); _Pragma("unroll") for (int m = 0; m < 4; ++m) _Pragma("unroll") for (int n = 0; n < 2; ++n) _Pragma("unroll") for (int k = 0; k < 2; ++k) \
        acc[ai][bj][m][n] = __builtin_amdgcn_mfma_f32_16x16x32_bf16(Bt[n][k], At[m][k], acc[ai][bj][m][n], 0, 0, 0); __builtin_amdgcn_s_setprio(0); } while (0)
#define PG8_WAIT_V(n) asm volatile("s_waitcnt vmcnt(" #n ")" ::: "memory")
#define PG8_WAIT_L(n) asm volatile("s_waitcnt lgkmcnt(" #n ")" ::: "memory")
#define PG8_BAR __builtin_amdgcn_s_barrier()
#define PG8_SCHED __builtin_amdgcn_sched_barrier(0)
    Unit cur, nxt; int ui = 0;
    if (!S.next(0, cur)) return;
    f32x4 acc[2][2][4][2];
#pragma unroll
    for (int a = 0; a < 2; ++a)
#pragma unroll
        for (int b = 0; b < 2; ++b)
#pragma unroll
            for (int m = 0; m < 4; ++m)
#pragma unroll
                for (int n = 0; n < 2; ++n) acc[a][b][m][n] = (f32x4){0.f, 0.f, 0.f, 0.f};
    bf16x8 At[4][2], B0[2][2], B1[2][2];
    const char* cA = cur.A; const char* cB = cur.B; const char* nA = cA;
    PG8_GROWS(gC, cur);
    PG8_STAGE(PG8_SB(0, 0), cB, voffB); PG8_STAGEA(PG8_SA(0, 0), 0, 0, false); PG8_STAGE(PG8_SB(0, 1), cB + hstepB, voffB); PG8_STAGEA(PG8_SA(0, 1), 0, 1, false);
    if (wr == 1) PG8_BAR;
    PG8_WAIT_V(4); PG8_BAR;
    PG8_STAGE(PG8_SB(1, 0), cB + kstep, voffB); PG8_STAGEA(PG8_SA(1, 0), 1, 0, false); PG8_STAGE(PG8_SB(1, 1), cB + hstepB + kstep, voffB);
    PG8_WAIT_V(6); PG8_BAR;
    for (;;) {
        const bool has_next = S.next(ui + 1, nxt);
        nA = has_next ? nxt.A : cA; const char* nB = has_next ? nxt.B : cB;
        if constexpr (Sched::GATHER) { if (has_next) PG8_GROWS(gN, nxt); else { _Pragma("unroll") for (int _h = 0; _h < 2; ++_h) _Pragma("unroll") for (int _i = 0; _i < 2; ++_i) gN[_h][_i] = gC[_h][_i]; } }
        for (int t = 0; t < nt; t += 2) {
            const bool last = (t == nt - 2);
            const int k2 = last ? 0 : t + 2;
            const char* b2 = last ? nB : cB + (size_t)(t + 2) * kstep;
            const char* b3 = b2 + kstep;
            if constexpr (Epi::MID != 0) { if (t != 0 && (t % Epi::MID) == 0) E.mid(acc, cur, t / Epi::MID, wr, wc, fr, fq); }
            PG8_LDB(B0, 0, 0); PG8_SCHED; PG8_LDA(At, 0, 0); PG8_STAGEA(PG8_SA(1, 1), t + 1, 1, false);
            PG8_WAIT_L(8); PG8_BAR; PG8_WAIT_L(0); PG8_MMA(0, 0, At, B0); PG8_BAR; PG8_SCHED;
            PG8_LDB(B1, 0, 1); PG8_STAGE(PG8_SB(0, 0), b2, voffB);
            PG8_BAR; PG8_WAIT_L(0); PG8_MMA(0, 1, At, B1); PG8_BAR;
            PG8_LDA(At, 0, 1); PG8_STAGEA(PG8_SA(0, 0), k2, 0, last);
            PG8_BAR; PG8_WAIT_L(0); PG8_MMA(1, 0, At, B0); PG8_BAR; PG8_SCHED;
            PG8_STAGE(PG8_SB(0, 1), b2 + hstepB, voffB);
            PG8_WAIT_V(6); PG8_BAR; PG8_MMA(1, 1, At, B1); PG8_BAR;
            PG8_LDB(B0, 1, 0); PG8_SCHED; PG8_LDA(At, 1, 0); PG8_STAGEA(PG8_SA(0, 1), k2, 1, last);
            PG8_WAIT_L(8); PG8_BAR; PG8_WAIT_L(0); PG8_MMA(0, 0, At, B0); PG8_BAR; PG8_SCHED;
            PG8_LDB(B1, 1, 1); PG8_STAGE(PG8_SB(1, 0), b3, voffB);
            PG8_BAR; PG8_WAIT_L(0); PG8_MMA(0, 1, At, B1); PG8_BAR;
            PG8_LDA(At, 1, 1); PG8_STAGEA(PG8_SA(1, 0), k2 + 1, 0, last);
            PG8_BAR; PG8_WAIT_L(0); PG8_MMA(1, 0, At, B0); PG8_BAR; PG8_SCHED;
            PG8_STAGE(PG8_SB(1, 1), b3 + hstepB, voffB);
            PG8_WAIT_V(6); PG8_BAR; PG8_MMA(1, 1, At, B1); PG8_BAR;
        }
        E(acc, cur, wr, wc, fr, fq);
        if (!has_next) break;
#pragma unroll
        for (int a = 0; a < 2; ++a)
#pragma unroll
            for (int b = 0; b < 2; ++b)
#pragma unroll
                for (int m = 0; m < 4; ++m)
#pragma unroll
                    for (int n = 0; n < 2; ++n) acc[a][b][m][n] = (f32x4){0.f, 0.f, 0.f, 0.f};
        cur = nxt; cA = nA; cB = nB; ++ui;
        if constexpr (Sched::GATHER) { _Pragma("unroll") for (int _h = 0; _h < 2; ++_h) _Pragma("unroll") for (int _i = 0; _i < 2; ++_i) gC[_h][_i] = gN[_h][_i]; }
    }
    PG8_WAIT_V(0);
    if (wr == 0) PG8_BAR;
    PG8_BAR;
#undef PG8_SA
#undef PG8_SB
#undef PG8_STAGE
#undef PG8_STAGEA
#undef PG8_GROWS
#undef PG8_LDA
#undef PG8_LDB
#undef PG8_MMA
#undef PG8_WAIT_V
#undef PG8_WAIT_L
#undef PG8_BAR
#undef PG8_SCHED
}
}
using pg8::Unit;

struct Params { const float* in[27]; float* out; unsigned char* ws; int ph_lo, ph_hi; };
struct Ctx {
    const float* const CAS* in; float* out; unsigned char* ws; LAS unsigned char* lds;
    int tid, lane, wave, G, c;
};
#define INP(k_) ((const float*)(const GAS float*)X.in[k_])
#define WSP(T_, off) ((T_*)(X.ws + (off)))
#define WSW(T_, off, l_) ((T_*)(X.ws + (off) + (size_t)((l_) & 1) * WSET))

struct SchedStatic {
    static constexpr bool GATHER = false; __device__ __forceinline__ int row(const Unit&, int) const { return 0; }
    int nM, nN, G, c; const char* A; const char* B; size_t tA, tB;
    __device__ __forceinline__ bool next(int i, Unit& u) const {
        const long L = (long)i * G + c; if (L >= (long)nM * nN) return false;
        pg8::tile_of((int)L, nM, nN, u.pm, u.pn); u.aux = 0; u.ord = i; u.A = A + (size_t)u.pm * tA; u.B = B + (size_t)u.pn * tB; return true;
    }
};
struct SchedMoe {
    static constexpr bool GATHER = false; __device__ __forceinline__ int row(const Unit&, int) const { return 0; }
    int G, c, ncol_shift, nT; const LAS int* tile_e; const LAS int* tile_pm; const char* A; const char* B; size_t tA, eB, tB;
    __device__ __forceinline__ bool next(int i, Unit& u) const {
        const long L = (long)i * G + c; if (L >= ((long)nT << ncol_shift)) return false;
        const int rt = (int)(L >> ncol_shift); u.pn = (int)(L & ((1 << ncol_shift) - 1)); u.pm = tile_pm[rt]; u.aux = tile_e[rt]; u.ord = i;
        u.A = A + (size_t)u.pm * tA; u.B = B + (size_t)u.aux * eB + (size_t)u.pn * tB; return true;
    }
};

struct SchedMoeG {
    static constexpr bool GATHER = true;
    int G, c, nT; const LAS int* tile_e; const LAS int* tile_pm; const LAS int* rows; const char* A; const char* B; size_t eB, tB;
    __device__ __forceinline__ bool next(int i, Unit& u) const {
        const long L = (long)i * G + c; if (L >= ((long)nT << 1)) return false;
        const int rt = (int)(L >> 1); u.pn = (int)(L & 1); u.pm = tile_pm[rt]; u.aux = tile_e[rt]; u.ord = i;
        u.A = A; u.B = B + (size_t)u.aux * eB + (size_t)u.pn * tB; return true;
    }
    __device__ __forceinline__ int row(const Unit& u, int r) const { return rows[(u.ord & 1) * 256 + r]; }
};

struct EpiProj { static constexpr int MID = 0; static constexpr bool PERM = true; bf16_t* O; const float* bgate;
    __device__ __forceinline__ void operator()(const f32x4 (&acc)[2][2][4][2], const Unit& u, int wr, int wc, int fr, int fq) const {
        const int row0 = u.pm * 256 + wr * 64 + fr, col0 = u.pn * 256 + wc * 32 + 8 * fq; const bool act = u.pn < 4, gate = u.pn >= 18;
        for (int rep_ = 0; rep_ < (PROBE_DUP == 22 ? 2 : 1); ++rep_) {
        f32x4 bv[2][2];
#pragma unroll
        for (int bj = 0; bj < 2; ++bj)
#pragma unroll
            for (int n = 0; n < 2; ++n) bv[bj][n] = gate ? *(const f32x4*)(bgate + (col0 - C_GATE) + bj * 128 + 4 * n) : (f32x4){0.f, 0.f, 0.f, 0.f};
#pragma unroll
        for (int ai = 0; ai < 2; ++ai)
#pragma unroll
            for (int m = 0; m < 4; ++m) { bf16_t* rowp = O + (size_t)(row0 + ai * 128 + m * 16) * NP + col0;
#pragma unroll
                for (int bj = 0; bj < 2; ++bj) { f32x4 v0 = acc[ai][bj][m][0], v1 = acc[ai][bj][m][1];
                    if (act) {
#pragma unroll
                        for (int j = 0; j < 4; ++j) { v0[j] = gelu_tanh(v0[j]); v1[j] = gelu_tanh(v1[j]); } }
                    if (gate) {
                        v0 += bv[bj][0]; v1 += bv[bj][1];
#pragma unroll
                        for (int j = 0; j < 4; ++j) { v0[j] = sigmoidf_(fminf(fmaxf(v0[j], -30.f), 30.f)); v1[j] = sigmoidf_(fminf(fmaxf(v1[j], -30.f), 30.f)); } }
                    u32x4 w; w.x = cvt_pk_bf16(v0[0], v0[1]); w.y = cvt_pk_bf16(v0[2], v0[3]); w.z = cvt_pk_bf16(v1[0], v1[1]); w.w = cvt_pk_bf16(v1[2], v1[3]);
                    *(u32x4*)(rowp + bj * 128) = w; } }
        }
    }
};
struct EpiMerge { static constexpr int MID = 8; static constexpr bool PERM = true; const bf16_t* proj; bf16_t* mb;
    __device__ __forceinline__ void mid(f32x4 (&acc)[2][2][4][2], const Unit& u, int j, int wr, int wc, int fr, int fq) const {
        const int row0 = u.pm * 256 + wr * 64 + fr, col0 = u.pn * 256 + wc * 32 + 8 * fq;
        const bf16_t* gp = proj + (size_t)row0 * NP + C_GATE + (j - 1) * 1024 + col0;
#pragma unroll
        for (int ai = 0; ai < 2; ++ai) {
            u32x4 gprev[4][2], gcur[4][2];
#pragma unroll
            for (int m = 0; m < 4; ++m)
#pragma unroll
                for (int bj = 0; bj < 2; ++bj) { const bf16_t* p = gp + (size_t)(ai * 128 + m * 16) * NP + bj * 128; gprev[m][bj] = *(const u32x4*)p; gcur[m][bj] = *(const u32x4*)(p + 1024); }
#pragma unroll
            for (int m = 0; m < 4; ++m)
#pragma unroll
                for (int bj = 0; bj < 2; ++bj) { const unsigned pw[4] = {gprev[m][bj].x, gprev[m][bj].y, gprev[m][bj].z, gprev[m][bj].w}, cw[4] = {gcur[m][bj].x, gcur[m][bj].y, gcur[m][bj].z, gcur[m][bj].w};
#pragma unroll
                    for (int n = 0; n < 2; ++n)
#pragma unroll
                        for (int k = 0; k < 4; ++k) { const int e = 4 * n + k; const float gpv = (e & 1) ? hi_bf(pw[e >> 1]) : lo_bf(pw[e >> 1]), gcv = (e & 1) ? hi_bf(cw[e >> 1]) : lo_bf(cw[e >> 1]);
                            acc[ai][bj][m][n][k] *= gpv * __builtin_amdgcn_rcpf(gcv); } }
        }
    }
    __device__ __forceinline__ void operator()(const f32x4 (&acc)[2][2][4][2], const Unit& u, int wr, int wc, int fr, int fq) const {
        const int row0 = u.pm * 256 + wr * 64 + fr, col0 = u.pn * 256 + wc * 32 + 8 * fq;
        const bf16_t* gp = proj + (size_t)row0 * NP + C_GATE + 2 * 1024 + col0;
#pragma unroll
        for (int ai = 0; ai < 2; ++ai) {
            u32x4 g2[4][2];
#pragma unroll
            for (int m = 0; m < 4; ++m)
#pragma unroll
                for (int bj = 0; bj < 2; ++bj) g2[m][bj] = *(const u32x4*)(gp + (size_t)(ai * 128 + m * 16) * NP + bj * 128);
#pragma unroll
            for (int m = 0; m < 4; ++m)
#pragma unroll
                for (int bj = 0; bj < 2; ++bj) { const unsigned gw[4] = {g2[m][bj].x, g2[m][bj].y, g2[m][bj].z, g2[m][bj].w}; float o[8];
#pragma unroll
                    for (int n = 0; n < 2; ++n)
#pragma unroll
                        for (int k = 0; k < 4; ++k) { const int e = 4 * n + k; o[e] = acc[ai][bj][m][n][k] * ((e & 1) ? hi_bf(gw[e >> 1]) : lo_bf(gw[e >> 1])); }
                    u32x4 w; w.x = cvt_pk_bf16(o[0], o[1]); w.y = cvt_pk_bf16(o[2], o[3]); w.z = cvt_pk_bf16(o[4], o[5]); w.w = cvt_pk_bf16(o[6], o[7]);
                    *(u32x4*)(mb + (size_t)(row0 + ai * 128 + m * 16) * 1024 + col0 + bj * 128) = w; }
        }
    }
};
struct EpiOut { static constexpr int MID = 0; static constexpr bool PERM = false; float* out; const float* xsrc; const float* gt; float scl;
    __device__ __forceinline__ void operator()(const f32x4 (&acc)[2][2][4][2], const Unit& u, int wr, int wc, int fr, int fq) const {
        const int row0 = u.pm * 256 + wr * 64 + fr, col0 = u.pn * 256 + wc * 32 + 4 * fq; const float* g = gt + (size_t)(u.pm >> 4) * 6144;
        f32x4 gv[2][2];
#pragma unroll
        for (int bj = 0; bj < 2; ++bj)
#pragma unroll
            for (int n = 0; n < 2; ++n) gv[bj][n] = *(const f32x4*)(g + col0 + bj * 128 + n * 16) * scl;
#pragma unroll
        for (int ai = 0; ai < 2; ++ai) {
            f32x4 xv[4][2][2];
#pragma unroll
            for (int m = 0; m < 4; ++m)
#pragma unroll
                for (int bj = 0; bj < 2; ++bj)
#pragma unroll
                    for (int n = 0; n < 2; ++n) xv[m][bj][n] = *(const f32x4*)(xsrc + (size_t)(row0 + ai * 128 + m * 16) * 1024 + col0 + bj * 128 + n * 16);
#pragma unroll
            for (int m = 0; m < 4; ++m)
#pragma unroll
                for (int bj = 0; bj < 2; ++bj)
#pragma unroll
                    for (int n = 0; n < 2; ++n) *(f32x4*)(out + (size_t)(row0 + ai * 128 + m * 16) * 1024 + col0 + bj * 128 + n * 16) = xv[m][bj][n] + gv[bj][n] * acc[ai][bj][m][n];
        }
    }
};
struct EpiMoe1 { static constexpr int MID = 0; static constexpr bool PERM = true; bf16_t* act; const LAS float* lw;
    __device__ __forceinline__ void operator()(const f32x4 (&acc)[2][2][4][2], const Unit& u, int wr, int wc, int fr, int fq) const {
        const int row0 = u.pm * 256 + wr * 64 + fr, col0 = u.pn * 128 + wc * 32 + 8 * fq;
        float wv[2][4];
#pragma unroll
        for (int ai = 0; ai < 2; ++ai)
#pragma unroll
            for (int m = 0; m < 4; ++m) wv[ai][m] = lw[(u.ord & 1) * 256 + wr * 64 + fr + ai * 128 + m * 16];
#pragma unroll
        for (int ai = 0; ai < 2; ++ai)
#pragma unroll
            for (int m = 0; m < 4; ++m) { const int r = row0 + ai * 128 + m * 16; const float w = wv[ai][m]; float o[8];
#pragma unroll
                for (int n = 0; n < 2; ++n)
#pragma unroll
                    for (int j = 0; j < 4; ++j) { const float g = acc[ai][0][m][n][j], up = acc[ai][1][m][n][j]; o[4 * n + j] = g * sigmoidf_(g) * up * w; }
                u32x4 pk; pk.x = cvt_pk_bf16(o[0], o[1]); pk.y = cvt_pk_bf16(o[2], o[3]); pk.z = cvt_pk_bf16(o[4], o[5]); pk.w = cvt_pk_bf16(o[6], o[7]);
                *(u32x4*)(act + (size_t)r * 256 + col0) = pk; }
    }
};
struct EpiMoe2 { static constexpr int MID = 0; static constexpr bool PERM = true; bf16_t* O;
    __device__ __forceinline__ void operator()(const f32x4 (&acc)[2][2][4][2], const Unit& u, int wr, int wc, int fr, int fq) const {
        const int row0 = u.pm * 256 + wr * 64 + fr, col0 = u.pn * 256 + wc * 32 + 8 * fq;
#pragma unroll
        for (int ai = 0; ai < 2; ++ai)
#pragma unroll
            for (int m = 0; m < 4; ++m) { bf16_t* rowp = O + (size_t)(row0 + ai * 128 + m * 16) * 1024 + col0;
#pragma unroll
                for (int bj = 0; bj < 2; ++bj) { const f32x4 v0 = acc[ai][bj][m][0], v1 = acc[ai][bj][m][1];
                    u32x4 w; w.x = cvt_pk_bf16(v0[0], v0[1]); w.y = cvt_pk_bf16(v0[2], v0[3]); w.z = cvt_pk_bf16(v1[0], v1[1]); w.w = cvt_pk_bf16(v1[2], v1[3]);
                    *(u32x4*)(rowp + bj * 128) = w; } }
    }
};

__device__ __forceinline__ void phase_mod(const Ctx& X) {
    LAS float* sc = (LAS float*)X.lds;
    LAS float* red = (LAS float*)(X.lds + 16384);
    const float* c = INP(1); const float* wm = INP(2); const float* bm = INP(3); float* mod = WSP(float, WS_MOD);
    for (int i = X.tid; i < 4096; i += 512) { const float v = c[i]; sc[i] = v * sigmoidf_(v); }
    __syncthreads();
    const int jj = X.tid & 63, ks = X.tid >> 6;
    for (int u = X.c; u < NL * 96; u += X.G) {
        const int l = u / 96, j0 = (u % 96) * 64;
        float a0 = 0.f, a1 = 0.f, a2 = 0.f, a3 = 0.f;
        const float* wp = wm + ((size_t)l * 1024 + ks * 128) * 6144 + j0 + jj;
        for (int k0 = 0; k0 < 128; k0 += 32) { float w[32];
#pragma unroll
            for (int k = 0; k < 32; ++k) w[k] = __builtin_nontemporal_load(wp + (size_t)(k0 + k) * 6144);
#pragma unroll
            for (int k = 0; k < 32; ++k) { const int kk = ks * 128 + k0 + k;
                a0 += sc[kk] * w[k]; a1 += sc[1024 + kk] * w[k]; a2 += sc[2048 + kk] * w[k]; a3 += sc[3072 + kk] * w[k]; } }
        red[(ks * 64 + jj) * 4 + 0] = a0; red[(ks * 64 + jj) * 4 + 1] = a1; red[(ks * 64 + jj) * 4 + 2] = a2; red[(ks * 64 + jj) * 4 + 3] = a3;
        __syncthreads();
        if (X.tid < 256) { const int b = X.tid >> 6; float s = bm[l * 6144 + j0 + jj];
#pragma unroll
            for (int q = 0; q < 8; ++q) s += red[(q * 64 + jj) * 4 + b];
            mod[((size_t)l * NB + b) * 6144 + j0 + jj] = s; }
        __syncthreads();
    }
}

__device__ __forceinline__ int wincol(int m) {
    if (m < 2560) return m;
    if (m < 4416) return m + 16;
    if (m < 4432) return 2560 + (m - 4416);
    if (m < 4436) return m;
    if (m < 4608) return -1;
    return 4436 + (m - 4608);
}
constexpr int CJ0 = 480, CJ1 = CJ0 + 96, CJ2 = CJ1 + 64, CJ3 = CJ2 + 512, CJ4 = CJ3 + 256, CJ5 = CJ4 + 16;
__device__ __forceinline__ void conv_job(const Ctx& X, int l, int j) {
    LAS float* tile = (LAS float*)X.lds;
    const int c = X.tid & 63, r0 = X.tid >> 6;
    if (j >= CJ4) {
        const int q = j - CJ4; const float* src = INP(9) + (size_t)l * 65536; bf16_t* dst = WSW(bf16_t, WS_WS, l);
        for (int i = X.tid; i < 4096; i += 512) { const int e = q * 4096 + i, t = (e >> 7) & 127, s = e & 127; dst[e] = f2bf(s <= t ? src[e] : 0.f); }
        return;
    }
    const float* sp; int sld, scol; bf16_t* dp; int dld;
    if (j < CJ0) { const int nt = j >> 2, kt = j & 3; sp = INP(6) + ((size_t)l * 1024 + kt * 256) * NIN; sld = NIN; scol = wincol(nt * 64 + c);
        dp = WSW(bf16_t, WS_WIN, l) + (size_t)(nt * 64) * 1024 + kt * 256; dld = 1024; }
    else if (j < CJ1) { const int q = j - CJ0, n = q >> 5, dt = (q >> 1) & 15, et = q & 1;
        sp = INP(17) + (((size_t)l * 3 + n) * 512 + et * 256) * 1024; sld = 1024; scol = dt * 64 + c;
        dp = WSW(bf16_t, WS_WBR, l) + (size_t)(dt * 64) * YW + n * 512 + et * 256; dld = YW; }
    else if (j < CJ2) { const int q = j - CJ1, nt = q >> 2, kt = q & 3;
        sp = INP(19) + ((size_t)l * 1024 + kt * 256) * 1024; sld = 1024; scol = nt * 64 + c;
        dp = WSW(bf16_t, WS_WOUT, l) + (size_t)(nt * 64) * 1024 + kt * 256; dld = 1024; }
    else if (j < CJ3) { const int q = j - CJ2, e = q >> 5, rt = (q >> 2) & 7, kt = q & 3; const int n0 = rt * 64, pn = n0 >> 8, half = (n0 >> 7) & 1;
        sp = (half ? INP(25) : INP(24)) + (((size_t)l * 16 + e) * 1024 + kt * 256) * 256; sld = 256; scol = 128 * pn + (n0 & 127) + c;
        dp = WSW(bf16_t, WS_WE1, l) + ((size_t)e * 512 + n0) * 1024 + kt * 256; dld = 1024; }
    else { const int q = j - CJ3, e = q >> 4, dt = q & 15;
        sp = INP(26) + ((size_t)l * 16 + e) * 256 * 1024; sld = 1024; scol = dt * 64 + c;
        dp = WSW(bf16_t, WS_WE2, l) + ((size_t)e * 1024 + dt * 64) * 256; dld = 256; }
#pragma unroll
    for (int i = 0; i < 32; ++i) { const int k = r0 + 8 * i; tile[k * 65 + c] = scol >= 0 ? __builtin_nontemporal_load(sp + (size_t)k * sld + scol) : 0.f; }
    __syncthreads();
    { const int kc = X.tid & 127, nr = X.tid >> 7;
#pragma unroll
      for (int i = 0; i < 16; ++i) { const int n = nr + 4 * i; *(unsigned*)(dp + (size_t)n * dld + 2 * kc) = cvt_pk_bf16(tile[(2 * kc) * 65 + n], tile[(2 * kc + 1) * 65 + n]); } }
    __syncthreads();
}
__device__ __forceinline__ void phase_conv(const Ctx& X, int l) {
    for (int j = X.c; j < CJ5; j += X.G) conv_job(X, l, j);
}
__device__ __forceinline__ void phase_conv_dyn(const Ctx& X, int l, unsigned* q, int maxjobs) {
    LAS int* jslot = (LAS int*)(X.lds + AUX_OFF + 64);
    for (int nj = 0; nj < maxjobs; ++nj) {
        if (X.tid == 0) *jslot = (int)__hip_atomic_fetch_add(q, 1u, __ATOMIC_RELAXED, __HIP_MEMORY_SCOPE_AGENT);
        __syncthreads();
        const int j = *jslot;
        __syncthreads();
        if (j >= CJ5) break;
        conv_job(X, l, j);
    }
}

__device__ __forceinline__ void phase_norm1(const Ctx& X, int l, int mode, float fscale = 1.f) {
    const float* xin = INP(0); float* out = X.out; const float* mod = WSP(float, WS_MOD);
    const bf16_t* ffn = WSP(bf16_t, WS_FFN); const int* toks = WSP(int, WS_TOKS); bf16_t* h = WSP(bf16_t, WS_H);
    const float* g1 = INP(4) + (size_t)l * 1024;
    constexpr int NBATCH = 4;
    const int rstride = X.G * 8;
    for (int r0 = X.c * 8 + X.wave; r0 < T; r0 += rstride * NBATCH) {
        f32x4 xv[NBATCH][4]; u32x2 fa[NBATCH][4], fb[NBATCH][4]; int sl[NBATCH][2];
        if (mode != 0) {
#pragma unroll
            for (int j = 0; j < NBATCH; ++j) { const int r = r0 + j * rstride; sl[j][0] = r < T ? toks[2 * r] : 0; sl[j][1] = r < T ? toks[2 * r + 1] : 0; }
        }
#pragma unroll
        for (int j = 0; j < NBATCH; ++j) { const int r = r0 + j * rstride < T ? r0 + j * rstride : r0;
#pragma unroll
            for (int i = 0; i < 4; ++i) { const int col = 4 * X.lane + 256 * i;
                xv[j][i] = *(const f32x4*)((mode == 0 ? xin : out) + (size_t)r * 1024 + col);
                if (mode != 0) { fa[j][i] = *(const u32x2*)(ffn + (size_t)sl[j][0] * 1024 + col); fb[j][i] = *(const u32x2*)(ffn + (size_t)sl[j][1] * 1024 + col); } } }
#pragma unroll
        for (int j = 0; j < NBATCH; ++j) { const int r = r0 + j * rstride; if (r >= T) break;
            const int b = r >> 12;
            if (mode != 0) { const float* gt2 = mod + ((size_t)(l - 1) * NB + b) * 6144 + 5120;
#pragma unroll
                for (int i = 0; i < 4; ++i) { const int col = 4 * X.lane + 256 * i; const f32x4 g = *(const f32x4*)(gt2 + col); const u32x2 a = fa[j][i], bb = fb[j][i];
                    f32x4 f; f[0] = lo_bf(a.x) + lo_bf(bb.x); f[1] = hi_bf(a.x) + hi_bf(bb.x); f[2] = lo_bf(a.y) + lo_bf(bb.y); f[3] = hi_bf(a.y) + hi_bf(bb.y);
                    xv[j][i] = xv[j][i] + g * f * fscale; } }
            if (mode != 0) {
#pragma unroll
                for (int i = 0; i < 4; ++i) *(f32x4*)(out + (size_t)r * 1024 + 4 * X.lane + 256 * i) = xv[j][i]; }
            if (mode == 2) continue;
            float ss = 0.f;
#pragma unroll
            for (int i = 0; i < 4; ++i) ss += xv[j][i][0] * xv[j][i][0] + xv[j][i][1] * xv[j][i][1] + xv[j][i][2] * xv[j][i][2] + xv[j][i][3] * xv[j][i][3];
            ss = wave_sum(ss);
            const float rstd = __builtin_amdgcn_rsqf(ss * (1.f / 1024.f) + EPS);
            const float* md = mod + ((size_t)l * NB + b) * 6144;
#pragma unroll
            for (int i = 0; i < 4; ++i) { const int col = 4 * X.lane + 256 * i;
                const f32x4 g = *(const f32x4*)(g1 + col), sh = *(const f32x4*)(md + col), sc = *(const f32x4*)(md + 1024 + col);
                f32x4 yv = xv[j][i] * rstd * g * (sc + 1.f) + sh;
                u32x2 w; w.x = cvt_pk_bf16(yv[0], yv[1]); w.y = cvt_pk_bf16(yv[2], yv[3]); *(u32x2*)(h + (size_t)r * 1024 + col) = w; }
        }
    }
}

__device__ __forceinline__ void sub_qknorm(const Ctx& X, int l) {
    bf16_t* proj = WSP(bf16_t, WS_PROJ);
    const float* gp = INP(15) + (size_t)l * 128 + 8 * (X.lane & 15);
    float g[8];
#pragma unroll
    for (int i = 0; i < 8; ++i) g[i] = gp[i];
    const int rstride = X.G * 8;
    for (int r0 = X.c * 8 + X.wave; r0 < T; r0 += 4 * rstride) {
        u32x4 lk[4];
#pragma unroll
        for (int q = 0; q < 4; ++q) { const int r = r0 + q * rstride < T ? r0 + q * rstride : r0; lk[q] = *(const u32x4*)(proj + (size_t)r * NP + C_DK + 8 * X.lane); }
#pragma unroll
        for (int q = 0; q < 4; ++q) { const int r = r0 + q * rstride; if (r >= T) break;
            const u32x4 a = lk[q]; float v[8] = {lo_bf(a.x), hi_bf(a.x), lo_bf(a.y), hi_bf(a.y), lo_bf(a.z), hi_bf(a.z), lo_bf(a.w), hi_bf(a.w)};
            float ss = 0.f;
#pragma unroll
            for (int i = 0; i < 8; ++i) ss += v[i] * v[i];
            ss = sum16(ss);
            const float rstd = __builtin_amdgcn_rsqf(ss * (1.f / 128.f) + EPS);
#pragma unroll
            for (int i = 0; i < 8; ++i) v[i] = v[i] * rstd * g[i];
            u32x4 o; o.x = cvt_pk_bf16(v[0], v[1]); o.y = cvt_pk_bf16(v[2], v[3]); o.z = cvt_pk_bf16(v[4], v[5]); o.w = cvt_pk_bf16(v[6], v[7]);
            *(u32x4*)(proj + (size_t)r * NP + C_DK + 8 * X.lane) = o; }
    }
}
__device__ __forceinline__ void sub_vtrans(const Ctx& X) {
    const bf16_t* proj = WSP(bf16_t, WS_PROJ); bf16_t* vt = WSP(bf16_t, WS_VT);
    LAS bf16_t* tile = (LAS bf16_t*)X.lds;
    for (int j0 = X.c; j0 < 2048; j0 += 2 * X.G) {
        u32x4 v[2];
#pragma unroll
        for (int q = 0; q < 2; ++q) { const int j = j0 + q * X.G < 2048 ? j0 + q * X.G : j0; const int bh = j >> 7, et = (j >> 6) & 1, st = j & 63, b = bh >> 2, hh = bh & 3;
            v[q] = *(const u32x4*)(proj + ((size_t)b * SEQ + st * 64 + (X.tid >> 3)) * NP + C_DV + 128 * hh + et * 64 + (X.tid & 7) * 8); }
#pragma unroll
        for (int q = 0; q < 2; ++q) *(LAS u32x4*)(tile + q * 4608 + (X.tid >> 3) * 72 + (X.tid & 7) * 8) = v[q];
        __syncthreads();
#pragma unroll
        for (int q = 0; q < 2; ++q) { const int j = j0 + q * X.G; if (j >= 2048) break; const int bh = j >> 7, et = (j >> 6) & 1, st = j & 63;
          const int e = X.tid >> 3, s8 = (X.tid & 7) * 8; unsigned short w8[8];
#pragma unroll
          for (int i = 0; i < 8; ++i) w8[i] = tile[q * 4608 + ((s8 & ~15) + 4 * ((s8 >> 3) & 1) + (i & 3) + 8 * (i >> 2)) * 72 + e];
          u32x4 w; w.x = w8[0] | ((unsigned)w8[1] << 16); w.y = w8[2] | ((unsigned)w8[3] << 16); w.z = w8[4] | ((unsigned)w8[5] << 16); w.w = w8[6] | ((unsigned)w8[7] << 16);
          *(u32x4*)(vt + ((size_t)bh * 128 + et * 64 + e) * SEQ + st * 64 + s8) = w; }
        __syncthreads();
    }
}

__device__ __forceinline__ void sub_gmlp(const Ctx& X, int l) {
    const bf16_t* proj = WSP(bf16_t, WS_PROJ); bf16_t* y = WSP(bf16_t, WS_Y); const bf16_t* wsb = WSW(bf16_t, WS_WS, l);
    LAS unsigned char* Wg = X.lds; LAS unsigned char* Vn = X.lds + 34816; LAS float* st = (LAS float*)(X.lds + 69632);
    const float* lng = INP(7) + (size_t)l * 512; const float* lnb = INP(8) + (size_t)l * 512; const float* bs = INP(10) + (size_t)l * 512;
    const int r = X.lane & 31, hf = X.lane >> 5;
    for (int u = X.c; u < 512; u += X.G) {
        const int ch = u >> 2, g = u & 3; const size_t t0 = (size_t)ch * 128;
#pragma unroll
        for (int i = 0; i < 4; ++i) { const int q = X.tid + 512 * i, row = q >> 4, cc = q & 15;
            *(LAS u32x4*)(Wg + row * 272 + cc * 16) = *(const u32x4*)(wsb + ((size_t)g * 128 + row) * 128 + cc * 8); }
        { u32x4 av[16];
#pragma unroll
          for (int i = 0; i < 16; ++i) av[i] = *(const u32x4*)(proj + (t0 + X.wave * 16 + i) * NP + C_AV + 8 * X.lane);
#pragma unroll
          for (int i = 0; i < 16; ++i) { const int tt = X.wave * 16 + i; const u32x4 a = av[i];
            float v[8] = {lo_bf(a.x), hi_bf(a.x), lo_bf(a.y), hi_bf(a.y), lo_bf(a.z), hi_bf(a.z), lo_bf(a.w), hi_bf(a.w)};
            float s = 0.f;
#pragma unroll
            for (int k = 0; k < 8; ++k) s += v[k];
            const float mean = wave_sum(s) * (1.f / 512.f);
            float q2 = 0.f;
#pragma unroll
            for (int k = 0; k < 8; ++k) { const float d = v[k] - mean; q2 += d * d; }
            const float rstd = __builtin_amdgcn_rsqf(wave_sum(q2) * (1.f / 512.f) + EPS);
            if (X.lane == 0) { st[2 * tt] = mean; st[2 * tt + 1] = rstd; } } }
        __syncthreads();
#pragma unroll
        for (int i = 0; i < 4; ++i) { const int q = X.tid + 512 * i, tt = q & 127, jb = q >> 7;
            const u32x4 a = *(const u32x4*)(proj + (t0 + tt) * NP + C_AV + 128 * g + 8 * jb);
            const float mean = st[2 * tt], rstd = st[2 * tt + 1];
            float v[8] = {lo_bf(a.x), hi_bf(a.x), lo_bf(a.y), hi_bf(a.y), lo_bf(a.z), hi_bf(a.z), lo_bf(a.w), hi_bf(a.w)};
#pragma unroll
            for (int e = 0; e < 8; ++e) { const int d = 8 * jb + e; const float o = (v[e] - mean) * rstd * lng[128 * g + d] + lnb[128 * g + d];
                *(LAS bf16_t*)(Vn + d * 272 + tt * 2) = f2bf(o); } }
        __syncthreads();
        { const int tb = X.wave >> 1, dh = X.wave & 1;
          f32x16 acc[2]; bf16_t uu[2][16];
#pragma unroll
          for (int nb = 0; nb < 2; ++nb)
#pragma unroll
              for (int k = 0; k < 16; ++k) { acc[nb][k] = 0.f; uu[nb][k] = proj[(t0 + 32 * tb + (k & 3) + 8 * (k >> 2) + 4 * hf) * NP + C_AU + 128 * g + 64 * dh + 32 * nb + r]; }
          const int nks = 2 * (tb + 1);
          for (int ks = 0; ks < nks; ++ks) {
              const bf16x8 a = *(const LAS bf16x8*)(Wg + (32 * tb + r) * 272 + (16 * ks + 8 * hf) * 2);
#pragma unroll
              for (int nb = 0; nb < 2; ++nb) { const bf16x8 b = *(const LAS bf16x8*)(Vn + (64 * dh + 32 * nb + r) * 272 + (16 * ks + 8 * hf) * 2);
                  acc[nb] = __builtin_amdgcn_mfma_f32_32x32x16_bf16(a, b, acc[nb], 0, 0, 0); } }
#pragma unroll
          for (int nb = 0; nb < 2; ++nb)
#pragma unroll
              for (int k = 0; k < 16; ++k) { const int t = 32 * tb + (k & 3) + 8 * (k >> 2) + 4 * hf, d = 64 * dh + 32 * nb + r;
                  y[(t0 + t) * YW + 128 * g + d] = f2bf((acc[nb][k] + bs[g * 128 + t]) * bf2f(uu[nb][k])); } }
        __syncthreads();
    }
}

__device__ __forceinline__ float log_sigmoid_(float z) { return fminf(z, 0.f) - __logf(1.f + __expf(-fabsf(z))); }

__device__ __forceinline__ void sub_gla_local(const Ctx& X, int l) {
    const bf16_t* proj = WSP(bf16_t, WS_PROJ); float* U = WSP(float, WS_SCR); float* dec = WSP(float, WS_DEC);
    LAS float* ga = (LAS float*)X.lds; LAS float* seg = (LAS float*)(X.lds + 4096);
    LAS unsigned char* kkT = X.lds + 8192; LAS unsigned char* vT = X.lds + 17408; LAS unsigned char* kraw = X.lds + 36864;
    const int r = X.lane & 31, hf = X.lane >> 5;
    for (int u = X.c; u < 1024; u += X.G) {
        const int hh = u & 3, cch = (u >> 2) & 63, b = u >> 8; const size_t t0 = (size_t)b * SEQ + cch * 64;
        const int d = X.tid & 63, tq = X.tid >> 6;
        u32x4 lga = {0u, 0u, 0u, 0u}; if (X.tid < 128) lga = *(const u32x4*)(proj + (t0 + (X.tid >> 1)) * NP + C_GA + 8 * (X.tid & 1));
        u32x4 lv[2];
#pragma unroll
        for (int i = 0; i < 2; ++i) { const int q = X.tid + 512 * i, s = q & 63, eb = q >> 6; lv[i] = *(const u32x4*)(proj + (t0 + s) * NP + C_GV + 128 * hh + 8 * eb); }
        const u32x4 lk = *(const u32x4*)(proj + (t0 + (X.tid >> 3)) * NP + C_GK + 64 * hh + 8 * (X.tid & 7));
        float w2[16];
#pragma unroll
        for (int q = 0; q < 16; ++q) w2[q] = INP(11)[((size_t)l * 16 + q) * 256 + hh * 64 + d];
        const float bg = INP(12)[(size_t)l * 256 + hh * 64 + d];
        if (X.tid < 128) { LAS float* gp = ga + (X.tid >> 1) * 16 + 8 * (X.tid & 1);
            gp[0] = lo_bf(lga.x); gp[1] = hi_bf(lga.x); gp[2] = lo_bf(lga.y); gp[3] = hi_bf(lga.y); gp[4] = lo_bf(lga.z); gp[5] = hi_bf(lga.z); gp[6] = lo_bf(lga.w); gp[7] = hi_bf(lga.w); }
#pragma unroll
        for (int i = 0; i < 2; ++i) { const int q = X.tid + 512 * i, s = q & 63, eb = q >> 6; const unsigned w[4] = {lv[i].x, lv[i].y, lv[i].z, lv[i].w};
#pragma unroll
            for (int k = 0; k < 4; ++k) { *(LAS bf16_t*)(vT + (8 * eb + 2 * k) * 144 + s * 2) = (bf16_t)(w[k] & 0xffffu); *(LAS bf16_t*)(vT + (8 * eb + 2 * k + 1) * 144 + s * 2) = (bf16_t)(w[k] >> 16); } }
        *(LAS u32x4*)(kraw + (X.tid >> 3) * 144 + 16 * (X.tid & 7)) = lk;
        __syncthreads();
        float cum[8];
        { float run = 0.f;
#pragma unroll
          for (int i = 0; i < 8; ++i) { const int t = 8 * tq + i; float z = bg;
#pragma unroll
              for (int q = 0; q < 16; ++q) z += ga[t * 16 + q] * w2[q];
              run += log_sigmoid_(z) * (1.f / 16.f); cum[i] = run; }
          seg[tq * 64 + d] = run; }
        __syncthreads();
        { float pre = 0.f, tot = 0.f;
#pragma unroll
          for (int q = 0; q < 8; ++q) { const float s = seg[q * 64 + d]; tot += s; if (q < tq) pre += s; }
          float kk[8];
#pragma unroll
          for (int i = 0; i < 8; ++i) { const int t = 8 * tq + i; const float kv = bf2f(*(const LAS bf16_t*)(kraw + t * 144 + d * 2)); kk[i] = kv * __expf(tot - (pre + cum[i])); }
          u32x4 w; w.x = cvt_pk_bf16(kk[0], kk[1]); w.y = cvt_pk_bf16(kk[2], kk[3]); w.z = cvt_pk_bf16(kk[4], kk[5]); w.w = cvt_pk_bf16(kk[6], kk[7]);
          *(LAS u32x4*)(kkT + d * 144 + 16 * tq) = w;
          if (tq == 0) dec[(size_t)u * 64 + d] = __expf(tot); }
        __syncthreads();
        { const int db = X.wave >> 2, eb = X.wave & 3; f32x16 acc;
#pragma unroll
          for (int k = 0; k < 16; ++k) acc[k] = 0.f;
#pragma unroll
          for (int ks = 0; ks < 4; ++ks) { const bf16x8 a = *(const LAS bf16x8*)(kkT + (32 * db + r) * 144 + (16 * ks + 8 * hf) * 2);
              const bf16x8 bb = *(const LAS bf16x8*)(vT + (32 * eb + r) * 144 + (16 * ks + 8 * hf) * 2);
              acc = __builtin_amdgcn_mfma_f32_32x32x16_bf16(a, bb, acc, 0, 0, 0); }
#pragma unroll
          for (int k = 0; k < 16; ++k) { const int dd = 32 * db + (k & 3) + 8 * (k >> 2) + 4 * hf; U[((size_t)u * 64 + dd) * 128 + 32 * eb + r] = acc[k]; } }
        __syncthreads();
    }
}

__device__ __forceinline__ void sub_gla_scan(const Ctx& X) {
    float* U = WSP(float, WS_SCR); const float* dec = WSP(float, WS_DEC);
    for (int gid = X.c * 512 + X.tid; gid < 16 * 8192; gid += X.G * 512) {
        const int bh = gid >> 13, de = gid & 8191, d = de >> 7, b = bh >> 2, hh = bh & 3;
        float S = 0.f;
        for (int cb = 0; cb < 4; ++cb) {
            float uv[16], dc[16];
#pragma unroll
            for (int j = 0; j < 16; ++j) { const size_t u = (size_t)b * 256 + (cb * 16 + j) * 4 + hh; uv[j] = U[u * 8192 + de]; dc[j] = dec[u * 64 + d]; }
#pragma unroll
            for (int j = 0; j < 16; ++j) { const size_t u = (size_t)b * 256 + (cb * 16 + j) * 4 + hh; U[u * 8192 + de] = S; S = dc[j] * S + uv[j]; }
        }
    }
}

__device__ __forceinline__ void sub_gla_out(const Ctx& X, int l) {
    const bf16_t* proj = WSP(bf16_t, WS_PROJ); const float* Sg = WSP(float, WS_SCR); bf16_t* y = WSP(bf16_t, WS_Y);
    LAS float* ga = (LAS float*)X.lds; LAS float* seg = (LAS float*)(X.lds + 4096);
    LAS unsigned char* qq = X.lds + 8192; LAS unsigned char* qS = X.lds + 17408; LAS unsigned char* kk2 = X.lds + 26624;
    LAS unsigned char* vT = X.lds + 35840; LAS unsigned char* ST = X.lds + 54272; LAS unsigned char* at = X.lds + 72704; LAS float* ob = (LAS float*)(X.lds + 81920);
    LAS unsigned char* qraw = at; LAS unsigned char* kraw = X.lds + 81920;
    const int r = X.lane & 31, hf = X.lane >> 5;
    for (int u = X.c; u < 1024; u += X.G) {
        const int hh = u & 3, cch = (u >> 2) & 63, b = u >> 8; const size_t t0 = (size_t)b * SEQ + cch * 64;
        const int d = X.tid & 63, tq = X.tid >> 6;
        u32x4 lga = {0u, 0u, 0u, 0u}; if (X.tid < 128) lga = *(const u32x4*)(proj + (t0 + (X.tid >> 1)) * NP + C_GA + 8 * (X.tid & 1));
        u32x4 lv[2]; f32x4 ls[4];
#pragma unroll
        for (int i = 0; i < 2; ++i) { const int q = X.tid + 512 * i, s = q & 63, eb = q >> 6; lv[i] = *(const u32x4*)(proj + (t0 + s) * NP + C_GV + 128 * hh + 8 * eb); }
#pragma unroll
        for (int i = 0; i < 4; ++i) ls[i] = *(const f32x4*)(Sg + (size_t)u * 8192 + 4 * X.tid + 2048 * i);
        const u32x4 lq = *(const u32x4*)(proj + (t0 + (X.tid >> 3)) * NP + C_GQ + 64 * hh + 8 * (X.tid & 7));
        const u32x4 lk = *(const u32x4*)(proj + (t0 + (X.tid >> 3)) * NP + C_GK + 64 * hh + 8 * (X.tid & 7));
        const bf16_t* rp = proj + (t0 + (X.tid >> 3)) * NP + C_GR + 128 * hh + 16 * (X.tid & 7);
        const u32x4 ra = *(const u32x4*)rp, rb = *(const u32x4*)(rp + 8);
        float w2[16];
#pragma unroll
        for (int q = 0; q < 16; ++q) w2[q] = INP(11)[((size_t)l * 16 + q) * 256 + hh * 64 + d];
        const float bg = INP(12)[(size_t)l * 256 + hh * 64 + d];
        if (X.tid < 128) { LAS float* gp = ga + (X.tid >> 1) * 16 + 8 * (X.tid & 1);
            gp[0] = lo_bf(lga.x); gp[1] = hi_bf(lga.x); gp[2] = lo_bf(lga.y); gp[3] = hi_bf(lga.y); gp[4] = lo_bf(lga.z); gp[5] = hi_bf(lga.z); gp[6] = lo_bf(lga.w); gp[7] = hi_bf(lga.w); }
#pragma unroll
        for (int i = 0; i < 2; ++i) { const int q = X.tid + 512 * i, s = q & 63, eb = q >> 6; const unsigned w[4] = {lv[i].x, lv[i].y, lv[i].z, lv[i].w};
#pragma unroll
            for (int k = 0; k < 4; ++k) { *(LAS bf16_t*)(vT + (8 * eb + 2 * k) * 144 + s * 2) = (bf16_t)(w[k] & 0xffffu); *(LAS bf16_t*)(vT + (8 * eb + 2 * k + 1) * 144 + s * 2) = (bf16_t)(w[k] >> 16); } }
#pragma unroll
        for (int i = 0; i < 4; ++i) { const int q = 4 * X.tid + 2048 * i, dd = q >> 7, e = q & 127;
#pragma unroll
            for (int k = 0; k < 4; ++k) *(LAS bf16_t*)(ST + (e + k) * 144 + dd * 2) = f2bf(ls[i][k]); }
        *(LAS u32x4*)(qraw + (X.tid >> 3) * 144 + 16 * (X.tid & 7)) = lq; *(LAS u32x4*)(kraw + (X.tid >> 3) * 144 + 16 * (X.tid & 7)) = lk;
        __syncthreads();
        float cum[8];
        { float run = 0.f;
#pragma unroll
          for (int i = 0; i < 8; ++i) { const int t = 8 * tq + i; float z = bg;
#pragma unroll
              for (int q = 0; q < 16; ++q) z += ga[t * 16 + q] * w2[q];
              run += log_sigmoid_(z) * (1.f / 16.f); cum[i] = run; }
          seg[tq * 64 + d] = run; }
        __syncthreads();
        { float pre = 0.f, bref = 0.f;
#pragma unroll
          for (int q = 0; q < 8; ++q) { const float s = seg[q * 64 + d]; if (q < tq) pre += s; if (q < 4) bref += s; }
          float qv[8], kv[8];
#pragma unroll
          for (int i = 0; i < 8; ++i) { const int t = 8 * tq + i; qv[i] = bf2f(*(const LAS bf16_t*)(qraw + t * 144 + d * 2)) * 0.125f; kv[i] = bf2f(*(const LAS bf16_t*)(kraw + t * 144 + d * 2)); }
#pragma unroll
          for (int i = 0; i < 8; ++i) { const int t = 8 * tq + i; const float bt = pre + cum[i];
              *(LAS bf16_t*)(qq + t * 144 + d * 2) = f2bf(qv[i] * __expf(bt - bref));
              *(LAS bf16_t*)(qS + t * 144 + d * 2) = f2bf(qv[i] * __expf(bt));
              *(LAS bf16_t*)(kk2 + t * 144 + d * 2) = f2bf(kv[i] * __expf(bref - bt)); } }
        __syncthreads();
        if (X.wave < 4) { const int tb = X.wave >> 1, sb = X.wave & 1; f32x16 acc;
#pragma unroll
            for (int k = 0; k < 16; ++k) acc[k] = 0.f;
#pragma unroll
            for (int ks = 0; ks < 4; ++ks) { const bf16x8 a = *(const LAS bf16x8*)(qq + (32 * tb + r) * 144 + (16 * ks + 8 * hf) * 2);
                const bf16x8 bb = *(const LAS bf16x8*)(kk2 + (32 * sb + r) * 144 + (16 * ks + 8 * hf) * 2);
                acc = __builtin_amdgcn_mfma_f32_32x32x16_bf16(a, bb, acc, 0, 0, 0); }
#pragma unroll
            for (int k = 0; k < 16; ++k) { const int t = 32 * tb + (k & 3) + 8 * (k >> 2) + 4 * hf, s = 32 * sb + r;
                *(LAS bf16_t*)(at + t * 144 + s * 2) = f2bf(s <= t ? acc[k] : 0.f); } }
        __syncthreads();
        { const int tb = X.wave >> 2, eb = X.wave & 3; f32x16 acc;
#pragma unroll
          for (int k = 0; k < 16; ++k) acc[k] = 0.f;
#pragma unroll
          for (int ks = 0; ks < 4; ++ks) { const bf16x8 a = *(const LAS bf16x8*)(qS + (32 * tb + r) * 144 + (16 * ks + 8 * hf) * 2);
              const bf16x8 bb = *(const LAS bf16x8*)(ST + (32 * eb + r) * 144 + (16 * ks + 8 * hf) * 2);
              acc = __builtin_amdgcn_mfma_f32_32x32x16_bf16(a, bb, acc, 0, 0, 0); }
#pragma unroll
          for (int ks = 0; ks < 4; ++ks) { const bf16x8 a = *(const LAS bf16x8*)(at + (32 * tb + r) * 144 + (16 * ks + 8 * hf) * 2);
              const bf16x8 bb = *(const LAS bf16x8*)(vT + (32 * eb + r) * 144 + (16 * ks + 8 * hf) * 2);
              acc = __builtin_amdgcn_mfma_f32_32x32x16_bf16(a, bb, acc, 0, 0, 0); }
#pragma unroll
          for (int k = 0; k < 16; ++k) { const int t = 32 * tb + (k & 3) + 8 * (k >> 2) + 4 * hf; ob[t * 132 + 32 * eb + r] = acc[k]; } }
        __syncthreads();
        { const int t = X.tid >> 3, j = X.tid & 7; float o[16]; float ss = 0.f;
#pragma unroll
          for (int i = 0; i < 16; ++i) { o[i] = ob[t * 132 + 16 * j + i]; ss += o[i] * o[i]; }
          ss = sum8(ss);
          const float rstd = __builtin_amdgcn_rsqf(ss * (1.f / 128.f) + EPS);
          const float* gn = INP(13) + (size_t)l * 128 + 16 * j;
          const unsigned rw[8] = {ra.x, ra.y, ra.z, ra.w, rb.x, rb.y, rb.z, rb.w};
          unsigned pk[8];
#pragma unroll
          for (int i = 0; i < 8; ++i) { const float r0 = lo_bf(rw[i]), r1 = hi_bf(rw[i]);
              const float v0 = o[2 * i] * rstd * gn[2 * i] * (r0 * sigmoidf_(r0)), v1 = o[2 * i + 1] * rstd * gn[2 * i + 1] * (r1 * sigmoidf_(r1));
              pk[i] = cvt_pk_bf16(v0, v1); }
          bf16_t* yp = y + (t0 + t) * YW + 512 + 128 * hh + 16 * j;
          *(u32x4*)yp = (u32x4){pk[0], pk[1], pk[2], pk[3]}; *(u32x4*)(yp + 8) = (u32x4){pk[4], pk[5], pk[6], pk[7]}; }
        __syncthreads();
    }
}

__device__ __forceinline__ unsigned score_code(float sc) {
    const unsigned ub = __float_as_uint(sc); unsigned t = (ub & 0x7fffffffu) >> 13;
    t = t < (107u << 10) ? (107u << 10) : t; t -= (107u << 10); t = t > 32766u ? 32766u : t;
    return (ub >> 31) ? (0x7fffu - t) : (0x8000u | t);
}
template <bool PACKED16>
__device__ __forceinline__ void find_digit(const LAS unsigned* hist, int lane, unsigned K, unsigned& digit, unsigned& above) {
    unsigned hb[4];
    if (PACKED16) { const unsigned h0 = hist[(2 * lane) * 16], h1 = hist[(2 * lane + 1) * 16]; hb[0] = h0 & 0xffffu; hb[1] = h0 >> 16; hb[2] = h1 & 0xffffu; hb[3] = h1 >> 16; }
    else { const u32x4 h4 = *(const LAS u32x4*)(hist + 4 * lane); hb[0] = h4.x; hb[1] = h4.y; hb[2] = h4.z; hb[3] = h4.w; }
    const unsigned s = hb[0] + hb[1] + hb[2] + hb[3];
    int v = (int)s;
    v += __builtin_amdgcn_update_dpp(0, v, 0x111, 0xf, 0xf, true); v += __builtin_amdgcn_update_dpp(0, v, 0x112, 0xf, 0xf, true);
    v += __builtin_amdgcn_update_dpp(0, v, 0x114, 0xf, 0xf, true); v += __builtin_amdgcn_update_dpp(0, v, 0x118, 0xf, 0xf, true);
    v += __builtin_amdgcn_update_dpp(0, v, 0x142, 0xa, 0xf, false); v += __builtin_amdgcn_update_dpp(0, v, 0x143, 0xc, 0xf, false);
    const unsigned total = (unsigned)__builtin_amdgcn_readlane(v, 63);
    unsigned run = total - (unsigned)v, dg = 0, ab = 0; bool found = false;
#pragma unroll
    for (int bi = 3; bi >= 0; --bi) { if (!found && run < K && run + hb[bi] >= K) { found = true; dg = 4 * lane + bi; ab = run; } run += hb[bi]; }
    const unsigned long long m = __ballot(found);
    const int src = m ? (int)__builtin_ctzll(m) : 0;
    digit = (unsigned)__builtin_amdgcn_readlane((int)dg, src); above = (unsigned)__builtin_amdgcn_readlane((int)ab, src);
}
__device__ __forceinline__ void sub_dsa_select(const Ctx& X) {
    const bf16_t* proj = WSP(bf16_t, WS_PROJ); unsigned long long* mask = WSP(unsigned long long, WS_MASK);
    LAS bf16_t* keys = (LAS bf16_t*)X.lds;
    LAS unsigned* hist1 = (LAS unsigned*)(X.lds + AUX_OFF + 1024);
    LAS unsigned* hist2 = (LAS unsigned*)(X.lds + AUX_OFF + 1024 + 8192) + X.wave * 512;
    const int lane = X.lane;
    for (int u0 = X.c; u0 < 1024; u0 += X.G) {
        const int rnd = u0 / X.G, u = (rnd & 1) ? (rnd + 1) * X.G - 1 - (u0 - rnd * X.G) : u0;
        if (u >= 1024) continue;
        const int b = u & 3, qb = 255 - (u >> 2); const size_t tg0 = (size_t)b * SEQ;
        if (qb < 16) {
#pragma unroll
            for (int rr = 0; rr < 2; ++rr) { const int t = 16 * qb + 2 * X.wave + rr; const int rem = t - 64 * lane;
                const unsigned long long w = rem >= 63 ? ~0ull : (rem < 0 ? 0ull : ((2ull << rem) - 1ull));
                mask[(tg0 + t) * 64 + lane] = w; }
            continue;
        }
        const int nk = 16 * (qb + 1), nkp = (nk + 63) & ~63, ntile = nkp >> 4, nwords = nkp >> 6;
        REP(21) {
        *(LAS u32x4*)(hist1 + 4 * X.tid) = (u32x4){0u, 0u, 0u, 0u};
        __syncthreads();
        {
            const int q = lane & 15, kg = lane >> 4; const size_t qrow = (tg0 + 16 * qb + q) * NP;
            bf16x8 Bq[4][2]; float iw[4];
#pragma unroll
            for (int hh = 0; hh < 4; ++hh) { iw[hh] = bf2f(proj[qrow + C_IW + hh]);
#pragma unroll
                for (int ks = 0; ks < 2; ++ks) Bq[hh][ks] = *(const bf16x8*)(proj + qrow + C_IQ + 64 * hh + 32 * ks + 8 * kg); }
            const int tq = 16 * qb + q;
            const bf16_t* kbase = proj + (tg0 + q) * NP + C_IK + 8 * kg;
            for (int jb = X.wave; jb < ntile; jb += 64) {
                bf16x8 Ax[4][2], Ay[4][2];
#pragma unroll
                for (int i = 0; i < 4; ++i) { int j = jb + 8 * i; j = j > 255 ? 255 : j; Ax[i][0] = *(const bf16x8*)(kbase + (size_t)(16 * j) * NP); Ax[i][1] = *(const bf16x8*)(kbase + (size_t)(16 * j) * NP + 32); }
#pragma unroll
                for (int i = 0; i < 4; ++i) { int j = jb + 32 + 8 * i; j = j > 255 ? 255 : j; Ay[i][0] = *(const bf16x8*)(kbase + (size_t)(16 * j) * NP); Ay[i][1] = *(const bf16x8*)(kbase + (size_t)(16 * j) * NP + 32); }
#pragma unroll
                for (int i2 = 0; i2 < 8; ++i2) { const int i = i2 & 3; const int j = jb + 8 * i2;
                    {
                        const bf16x8 A0 = i2 < 4 ? Ax[i][0] : Ay[i][0], A1 = i2 < 4 ? Ax[i][1] : Ay[i][1];
                        f32x4 sc = {0.f, 0.f, 0.f, 0.f};
#pragma unroll
                        for (int hh = 0; hh < 4; ++hh) { f32x4 a = {0.f, 0.f, 0.f, 0.f};
                            a = __builtin_amdgcn_mfma_f32_16x16x32_bf16(A0, Bq[hh][0], a, 0, 0, 0);
                            a = __builtin_amdgcn_mfma_f32_16x16x32_bf16(A1, Bq[hh][1], a, 0, 0, 0);
#pragma unroll
                            for (int k = 0; k < 4; ++k) sc[k] += iw[hh] * fmaxf(a[k], 0.f); }
                        unsigned kk[4];
#pragma unroll
                        for (int k = 0; k < 4; ++k) { const int key = 16 * j + 4 * kg + k; const unsigned code = score_code(sc[k]);
                            const bool adm = key <= tq; kk[k] = adm ? code : 0u;
                            if (adm) atomicAdd((unsigned*)(hist1 + (code >> 9) * 16 + q), (code & 0x100u) ? 0x10000u : 1u); }
                        u32x2 w; w.x = kk[0] | (kk[1] << 16); w.y = kk[2] | (kk[3] << 16);
                        if (j < ntile) *(LAS u32x2*)(keys + q * 4104 + 16 * j + 4 * kg) = w; } }
            }
        }
        __syncthreads();
        }
        {
            const int t0r = 16 * qb + 2 * X.wave;
            const LAS bf16_t* krow[2] = {keys + (2 * X.wave) * 4104 + lane, keys + (2 * X.wave + 1) * 4104 + lane};
            LAS unsigned* h2[2] = {hist2, hist2 + 256};
            unsigned d1[2], ab1[2], d2[2], ab2[2];
#pragma unroll
            for (int q = 0; q < 2; ++q) { find_digit<true>(hist1 + 2 * X.wave + q, lane, 256u, d1[q], ab1[q]); *(LAS u32x4*)(h2[q] + 4 * lane) = (u32x4){0u, 0u, 0u, 0u}; }
            asm volatile("s_waitcnt lgkmcnt(0)" ::: "memory");
            for (int w0 = 0; w0 < nwords; w0 += 8) { unsigned k8[2][8];
#pragma unroll
                for (int i = 0; i < 8; ++i) { k8[0][i] = krow[0][64 * ((w0 + i) & 63)]; k8[1][i] = krow[1][64 * ((w0 + i) & 63)]; }
#pragma unroll
                for (int i = 0; i < 8; ++i)
#pragma unroll
                    for (int q = 0; q < 2; ++q) { const unsigned k = k8[q][i]; if (w0 + i < nwords && (k >> 8) == d1[q]) atomicAdd((unsigned*)(h2[q] + (k & 255u)), 1u); } }
            asm volatile("s_waitcnt lgkmcnt(0)" ::: "memory");
#pragma unroll
            for (int q = 0; q < 2; ++q) find_digit<false>(h2[q], lane, 256u - ab1[q], d2[q], ab2[q]);
            asm volatile("s_waitcnt lgkmcnt(0)" ::: "memory");
            unsigned vstar[2], need[2], mylo[2] = {0u, 0u}, myhi[2] = {0u, 0u};
#pragma unroll
            for (int q = 0; q < 2; ++q) { vstar[q] = (d1[q] << 8) | d2[q]; need[q] = 256u - ab1[q] - ab2[q]; }
            for (int w0 = 0; w0 < nwords; w0 += 8) { unsigned k8[2][8];
#pragma unroll
              for (int i = 0; i < 8; ++i) { k8[0][i] = krow[0][64 * ((w0 + i) & 63)]; k8[1][i] = krow[1][64 * ((w0 + i) & 63)]; }
#pragma unroll
              for (int i = 0; i < 8; ++i)
#pragma unroll
                for (int q = 0; q < 2; ++q) { const int w = w0 + i; const unsigned k = w < nwords ? k8[q][i] : 0u;
                  const unsigned long long gt = __ballot(k > vstar[q]); unsigned long long eq = __ballot(k == vstar[q]);
                  const unsigned ne = (unsigned)__builtin_popcountll(eq);
                  if (ne > need[q]) { unsigned long long e = eq, rsel = 0ull; for (unsigned ii = 0; ii < need[q]; ++ii) { const unsigned long long bbit = e & (0ull - e); rsel |= bbit; e ^= bbit; } eq = rsel; need[q] = 0u; }
                  else need[q] -= ne;
                  const unsigned long long sel = gt | eq;
                  if (lane == w) { mylo[q] = (unsigned)sel; myhi[q] = (unsigned)(sel >> 32); } } }
#pragma unroll
            for (int q = 0; q < 2; ++q) { const int t = t0r + q; const int rem = t - 64 * lane;
                const unsigned long long cm = rem >= 63 ? ~0ull : (rem < 0 ? 0ull : ((2ull << rem) - 1ull));
                mask[(tg0 + t) * 64 + lane] = lane < nwords ? ((((unsigned long long)myhi[q] << 32) | mylo[q]) & cm) : 0ull; }
        }
        __syncthreads();
    }
}

__device__ __forceinline__ void attn_dma(const int st, const int wave, const int lane, const bf16_t* kglob, const bf16_t* vglob, const unsigned long long* mglob, LAS unsigned char* kv, LAS unsigned char* mb) {
#pragma unroll
    for (int i = 0; i < 4; ++i) { const int L = (wave * 4 + i) * 64 + lane, row = L >> 4, c = (L & 15) ^ (row & 15);
        __builtin_amdgcn_global_load_lds((const unsigned*)(kglob + (size_t)(128 * st + row) * NP + 8 * c), (LAS unsigned*)(kv + (wave * 4 + i) * 1024), 16, 0, 0);
        __builtin_amdgcn_global_load_lds((const unsigned*)(vglob + (size_t)row * SEQ + 128 * st + 8 * c), (LAS unsigned*)(kv + 32768 + (wave * 4 + i) * 1024), 16, 0, 0); }
    if (wave < 2) __builtin_amdgcn_global_load_lds((const unsigned*)(mglob + (size_t)(wave * 64 + lane) * 64 + 2 * st), (LAS unsigned*)(mb + wave * 1024), 16, 0, 0);
}
template <bool FAR>
__device__ __forceinline__ void attn_tile(const int st, const int r, const int hf, const int g, const int wq, const int tq, const float scale2,
                                          const LAS unsigned char* Ks, const LAS unsigned char* Vs, const LAS unsigned char* mb, const LAS float* bt,
                                          const bf16x8 (&Qf)[8], f32x16 (&O)[4], float& mrun, float& lrun) {
    const unsigned long long mw = *(const LAS unsigned long long*)(mb + (32 * wq + r) * 16 + 8 * g) >> (4 * hf);
    const unsigned mlo = (unsigned)mw, mhi = (unsigned)(mw >> 32);
    f32x16 S[2];
#pragma unroll
    for (int kb = 0; kb < 2; ++kb) {
#pragma unroll
        for (int k = 0; k < 16; ++k) S[kb][k] = 0.f;
        const int row = 64 * g + 32 * kb + r;
#pragma unroll
        for (int ks = 0; ks < 8; ++ks) { const bf16x8 a = *(const LAS bf16x8*)(Ks + row * 256 + (((2 * ks + hf) ^ (row & 15)) << 4));
            S[kb] = __builtin_amdgcn_mfma_f32_32x32x16_bf16(a, Qf[ks], S[kb], 0, 0, 0); } }
    const int kg0 = 128 * st + 64 * g;
    float mx = -1e30f;
    const float bfar = bt[128];
#pragma unroll
    for (int kb = 0; kb < 2; ++kb)
#pragma unroll
        for (int k = 0; k < 16; ++k) { const int ko = 32 * kb + (k & 3) + 8 * (k >> 2); const int sel = __builtin_amdgcn_sbfe((int)(kb ? mhi : mlo), (k & 3) + 8 * (k >> 2), 1);
            float bias = bfar;
            if (!FAR) { int rel = tq - (kg0 + ko + 4 * hf); rel = rel < 0 ? 0 : (rel > 128 ? 128 : rel); bias = bt[rel]; }
            const float lg = __uint_as_float((__float_as_uint(S[kb][k] * scale2 + bias) & (unsigned)sel) | (~(unsigned)sel & 0xff800000u)); S[kb][k] = lg; mx = fmaxf(mx, lg); }
    mx = max_x32(mx);
    if (__ballot(mx > mrun + 8.f) != 0ull) {
        const float mnew = fmaxf(mrun, mx), alpha = __builtin_amdgcn_exp2f(mrun - mnew);
        lrun *= alpha; mrun = mnew;
#pragma unroll
        for (int eb = 0; eb < 4; ++eb)
#pragma unroll
            for (int k = 0; k < 16; ++k) O[eb][k] *= alpha;
    }
    float ps = 0.f;
#pragma unroll
    for (int kb = 0; kb < 2; ++kb)
#pragma unroll
        for (int k = 0; k < 16; ++k) { const float p = __builtin_amdgcn_exp2f(S[kb][k] - mrun); S[kb][k] = p; ps += p; }
    ps = sum_x32(ps);
    lrun += ps;
#pragma unroll
    for (int kb = 0; kb < 2; ++kb)
#pragma unroll
        for (int s = 0; s < 2; ++s) {
            union { bf16x8 v; unsigned w[4]; } P;
#pragma unroll
            for (int j = 0; j < 4; ++j) P.w[j] = cvt_pk_bf16(S[kb][8 * s + 2 * j], S[kb][8 * s + 2 * j + 1]);
#pragma unroll
            for (int eb = 0; eb < 4; ++eb) { const int row = 32 * eb + r;
                const bf16x8 a = *(const LAS bf16x8*)(Vs + row * 256 + (((8 * g + 4 * kb + 2 * s + hf) ^ (row & 15)) << 4));
                O[eb] = __builtin_amdgcn_mfma_f32_32x32x16_bf16(a, P.v, O[eb], 0, 0, 0); } }
}
__device__ __forceinline__ void sub_dsa_attn(const Ctx& X, int l) {
    const bf16_t* proj = WSP(bf16_t, WS_PROJ); const bf16_t* vtg = WSP(bf16_t, WS_VT); const unsigned long long* mask = WSP(unsigned long long, WS_MASK);
    bf16_t* y = WSP(bf16_t, WS_Y); const float* relb = INP(16);
    LAS unsigned char* KV = X.lds;
    LAS unsigned char* MB = X.lds + AUX_OFF + 1024;
    LAS float* bt = (LAS float*)(X.lds + AUX_OFF + 1024 + 4096);
    LAS float* Ox = (LAS float*)X.lds; LAS float* MLx = (LAS float*)(X.lds + 65536);
    const int lane = X.lane, r = lane & 31, hf = lane >> 5, g = X.wave >> 2, wq = X.wave & 3;
    const float scale2 = 0.08838834764831845f * 1.4426950408889634f;
    for (int u = X.c; u < 512; u += X.G) {
        const int bh = u & 15, qt = u < 256 ? 31 - (u >> 4) : ((u - 256) >> 4), b = bh >> 2, hh = bh & 3;
        const size_t tg0 = (size_t)b * SEQ; const int q0 = 128 * qt, tq = q0 + 32 * wq + r;
        if (X.tid < 129) { const int n = X.tid; int bk;
            if (n < 16) bk = n; else { bk = 16 + (int)(__logf((float)n * (1.f / 16.f)) / 2.0794415416798357f * 16.f); bk = bk > 31 ? 31 : bk; }
            bt[n] = relb[bk * 4 + hh] * 1.4426950408889634f; }
        bf16x8 Qf[8];
        {
            union { bf16x8 v; unsigned w[4]; } qr[8]; float ss = 0.f;
#pragma unroll
            for (int ks = 0; ks < 8; ++ks) { qr[ks].v = *(const bf16x8*)(proj + (tg0 + tq) * NP + C_DQ + 128 * hh + 16 * ks + 8 * hf);
#pragma unroll
                for (int j = 0; j < 4; ++j) { const float a = lo_bf(qr[ks].w[j]), bq = hi_bf(qr[ks].w[j]); ss += a * a + bq * bq; } }
            ss = sum_x32(ss);
            const float rstd = __builtin_amdgcn_rsqf(ss * (1.f / 128.f) + EPS);
            const float* qg = INP(14) + (size_t)l * 128 + 8 * hf;
#pragma unroll
            for (int ks = 0; ks < 8; ++ks) { const f32x4 g0 = *(const f32x4*)(qg + 16 * ks), g1 = *(const f32x4*)(qg + 16 * ks + 4);
                qr[ks].w[0] = cvt_pk_bf16(lo_bf(qr[ks].w[0]) * rstd * g0[0], hi_bf(qr[ks].w[0]) * rstd * g0[1]);
                qr[ks].w[1] = cvt_pk_bf16(lo_bf(qr[ks].w[1]) * rstd * g0[2], hi_bf(qr[ks].w[1]) * rstd * g0[3]);
                qr[ks].w[2] = cvt_pk_bf16(lo_bf(qr[ks].w[2]) * rstd * g1[0], hi_bf(qr[ks].w[2]) * rstd * g1[1]);
                qr[ks].w[3] = cvt_pk_bf16(lo_bf(qr[ks].w[3]) * rstd * g1[2], hi_bf(qr[ks].w[3]) * rstd * g1[3]);
                Qf[ks] = qr[ks].v; } }
        f32x16 O[4];
#pragma unroll
        for (int eb = 0; eb < 4; ++eb)
#pragma unroll
            for (int k = 0; k < 16; ++k) O[eb][k] = 0.f;
        float mrun = -1e30f, lrun = 0.f;
        const bf16_t* kglob = proj + tg0 * NP + C_DK + 128 * hh; const bf16_t* vglob = vtg + (size_t)bh * 128 * SEQ; const unsigned long long* mglob = mask + (tg0 + q0) * 64;
        const int nfar = qt - 1;
        attn_dma(0, X.wave, lane, kglob, vglob, mglob, KV, MB);
        for (int st = 0; st < nfar; ++st) {
            asm volatile("s_waitcnt vmcnt(0)" ::: "memory"); __syncthreads();
            attn_dma(st + 1, X.wave, lane, kglob, vglob, mglob, KV + ((st + 1) & 1) * 65536, MB + ((st + 1) & 1) * 2048);
            const LAS unsigned char* kvb = KV + (st & 1) * 65536;
            attn_tile<true>(st, r, hf, g, wq, tq, scale2, kvb, kvb + 32768, MB + (st & 1) * 2048, bt, Qf, O, mrun, lrun);
        }
        for (int st = nfar < 0 ? 0 : nfar; st <= qt; ++st) {
            asm volatile("s_waitcnt vmcnt(0)" ::: "memory"); __syncthreads();
            if (st < qt) attn_dma(st + 1, X.wave, lane, kglob, vglob, mglob, KV + ((st + 1) & 1) * 65536, MB + ((st + 1) & 1) * 2048);
            const LAS unsigned char* kvb = KV + (st & 1) * 65536;
            attn_tile<false>(st, r, hf, g, wq, tq, scale2, kvb, kvb + 32768, MB + (st & 1) * 2048, bt, Qf, O, mrun, lrun);
        }
        __syncthreads();
        if (g == 1) {
#pragma unroll
            for (int eb = 0; eb < 4; ++eb)
#pragma unroll
                for (int k = 0; k < 16; ++k) Ox[((wq * 4 + eb) * 16 + k) * 64 + lane] = O[eb][k];
            MLx[(wq * 64 + lane) * 2] = mrun; MLx[(wq * 64 + lane) * 2 + 1] = lrun; }
        __syncthreads();
        if (g == 0) {
            const float m1 = MLx[(wq * 64 + lane) * 2], l1 = MLx[(wq * 64 + lane) * 2 + 1];
            const float m = fmaxf(mrun, m1), a0 = __builtin_amdgcn_exp2f(mrun - m), a1 = __builtin_amdgcn_exp2f(m1 - m);
            const float inv = 1.f / (lrun * a0 + l1 * a1);
#pragma unroll
            for (int eb = 0; eb < 4; ++eb)
#pragma unroll
                for (int k4 = 0; k4 < 4; ++k4) { float o[4];
#pragma unroll
                    for (int j = 0; j < 4; ++j) { const int k = 4 * k4 + j; o[j] = (O[eb][k] * a0 + Ox[((wq * 4 + eb) * 16 + k) * 64 + lane] * a1) * inv; }
                    u32x2 w; w.x = cvt_pk_bf16(o[0], o[1]); w.y = cvt_pk_bf16(o[2], o[3]);
                    *(u32x2*)(y + (tg0 + tq) * YW + 1024 + 128 * hh + 32 * eb + 8 * k4 + 4 * hf) = w; } }
        __syncthreads();
    }
}

__device__ __forceinline__ void phase_norm2(const Ctx& X, int l) {
    const float* out = X.out; const float* mod = WSP(float, WS_MOD); bf16_t* h = WSP(bf16_t, WS_H);
    int* toke = WSP(int, WS_TOKE); float* tokw = WSP(float, WS_TOKW); unsigned* cntb = WSP(unsigned, WS_CNT);
    LAS float* WT = (LAS float*)X.lds;
    LAS unsigned* cnt = (LAS unsigned*)(X.lds + AUX_OFF + 1024);
    const float* wg = INP(20) + (size_t)l * 4096; const float* wr = INP(22) + (size_t)l * 16384;
    { f32x4 a[2], b[8];
#pragma unroll
      for (int i = 0; i < 2; ++i) a[i] = *(const f32x4*)(wg + 4 * (X.tid + 512 * i));
#pragma unroll
      for (int i = 0; i < 8; ++i) b[i] = *(const f32x4*)(wr + 4 * (X.tid + 512 * i));
#pragma unroll
      for (int i = 0; i < 2; ++i) { const int e0 = 4 * (X.tid + 512 * i);
#pragma unroll
          for (int k = 0; k < 4; ++k) WT[((e0 + k) & 3) * 1024 + ((e0 + k) >> 2)] = a[i][k]; }
#pragma unroll
      for (int i = 0; i < 8; ++i) { const int e0 = 4 * (X.tid + 512 * i);
#pragma unroll
          for (int k = 0; k < 4; ++k) WT[(4 + ((e0 + k) & 15)) * 1024 + ((e0 + k) >> 4)] = b[i][k]; } }
    if (X.tid < 16) cnt[X.tid] = 0u;
    __syncthreads();
    const float* g2 = INP(5) + (size_t)l * 1024; const float* bgrp = INP(21) + l * 4; const float* brt = INP(23) + l * 16;
    const int rpb = (T + X.G - 1) / X.G;
  for (int i0 = X.wave; i0 < rpb; i0 += 8 * 8) {
#pragma unroll 1
    for (int jg = 0; jg < 8; jg += 2) {
        f32x4 xall[2][4];
#pragma unroll
        for (int q = 0; q < 2; ++q) { const int i = i0 + 8 * (jg + q); const int r = (i < rpb && X.c * rpb + i < T) ? X.c * rpb + i : X.c * rpb;
#pragma unroll
            for (int k = 0; k < 4; ++k) xall[q][k] = *(const f32x4*)(out + (size_t)r * 1024 + 4 * X.lane + 256 * k); }
        float rstd[2]; int rr[2]; bool ok[2];
#pragma unroll
        for (int q = 0; q < 2; ++q) { const int i = i0 + 8 * (jg + q); ok[q] = i < rpb && X.c * rpb + i < T; rr[q] = ok[q] ? X.c * rpb + i : X.c * rpb;
            float ss = 0.f;
#pragma unroll
            for (int k = 0; k < 4; ++k) { const f32x4 xv = xall[q][k]; ss += xv[0] * xv[0] + xv[1] * xv[1] + xv[2] * xv[2] + xv[3] * xv[3]; }
            rstd[q] = __builtin_amdgcn_rsqf(wave_sum(ss) * (1.f / 1024.f) + EPS); }
        float lg[2][20];
#pragma unroll
        for (int q = 0; q < 2; ++q)
#pragma unroll
            for (int o = 0; o < 20; ++o) lg[q][o] = 0.f;
#pragma unroll 1
        for (int k = 0; k < 4; ++k) { const int col = 4 * X.lane + 256 * k; const f32x4 g = *(const f32x4*)(g2 + col);
            f32x4 yv[2];
#pragma unroll
            for (int q = 0; q < 2; ++q) { const float* md = mod + ((size_t)l * NB + (rr[q] >> 12)) * 6144;
                const f32x4 sh = *(const f32x4*)(md + 3072 + col), sc = *(const f32x4*)(md + 4096 + col);
                yv[q] = xall[q][k] * rstd[q] * g * (sc + 1.f) + sh;
                if (ok[q]) { u32x2 w; w.x = cvt_pk_bf16(yv[q][0], yv[q][1]); w.y = cvt_pk_bf16(yv[q][2], yv[q][3]); *(u32x2*)(h + (size_t)rr[q] * 1024 + col) = w; } }
#pragma unroll
            for (int o = 0; o < 20; ++o) { const f32x4 wv = *(const LAS f32x4*)(WT + o * 1024 + col);
#pragma unroll
                for (int q = 0; q < 2; ++q) lg[q][o] += yv[q][0] * wv[0] + yv[q][1] * wv[1] + yv[q][2] * wv[2] + yv[q][3] * wv[3]; } }
#pragma unroll
        for (int q = 0; q < 2; ++q) {
#pragma unroll
            for (int o = 0; o < 20; ++o) lg[q][o] = wave_sum(lg[q][o]);
            if (X.lane == 0 && ok[q]) { const int r = rr[q];
                float gl[4];
#pragma unroll
                for (int k = 0; k < 4; ++k) gl[k] = lg[q][k] + bgrp[k];
                int gi = 0; float gm = gl[0];
#pragma unroll
                for (int k = 1; k < 4; ++k) if (gl[k] > gm) { gm = gl[k]; gi = k; }
                float se = 0.f;
#pragma unroll
                for (int k = 0; k < 4; ++k) se += __expf(gl[k] - gm);
                const float pg = 1.f / se;
                float sl[4];
#pragma unroll
                for (int k = 0; k < 4; ++k) { sl[k] = lg[q][4 + k] + brt[k];
#pragma unroll
                    for (int qq = 1; qq < 4; ++qq) if (gi == qq) sl[k] = lg[q][4 + 4 * qq + k] + brt[4 * qq + k]; }
                int i1 = 0; float v1 = sl[0];
#pragma unroll
                for (int k = 1; k < 4; ++k) if (sl[k] > v1) { v1 = sl[k]; i1 = k; }
                int i2 = -1; float v2 = -3.0e38f;
#pragma unroll
                for (int k = 0; k < 4; ++k) if (k != i1 && sl[k] > v2) { v2 = sl[k]; i2 = k; }
                const float w1 = 1.f / (1.f + __expf(v2 - v1));
                const int e1 = 4 * gi + i1, e2 = 4 * gi + i2;
                toke[2 * r] = e1; toke[2 * r + 1] = e2; tokw[2 * r] = pg * w1; tokw[2 * r + 1] = pg * (1.f - w1);
                atomicAdd((unsigned*)(cnt + e1), 1u); atomicAdd((unsigned*)(cnt + e2), 1u);
            }
        }
    }
  }
    __syncthreads();
    if (X.tid < 16) cntb[X.c * 16 + X.tid] = cnt[X.tid];
    __syncthreads();
}

__device__ __forceinline__ void build_tiles(const Ctx& X, LAS int* tb, LAS int* myoff  ) {
    const unsigned* cntb = WSP(unsigned, WS_CNT);
    LAS int* tot = tb + 32;
    LAS int* part = tb + 512;
    { const int e = X.tid & 15, p = X.tid >> 4, per = (X.G + 31) >> 5; int s = 0, mine = 0;
      for (int k = 0; k < per; ++k) { const int c = p * per + k; if (c < X.G) { const int v = (int)cntb[c * 16 + e]; s += v; if (c < X.c) mine += v; } }
      part[p * 16 + e] = s; if (X.c >= p * per && X.c < (p + 1) * per) part[512 + e] = mine; }
    __syncthreads();
    if (X.tid < 16) { const int per = (X.G + 31) >> 5, mp = X.c / per; int s = 0, mine = part[512 + X.tid];
        for (int p = 0; p < 32; ++p) { const int v = part[p * 16 + X.tid]; s += v; if (p < mp) mine += v; }
        tot[X.tid] = s; myoff[X.tid] = mine; }
    __syncthreads();
    if (X.tid == 0) { int row = 0, nT = 0;
        for (int e = 0; e < 16; ++e) { const int nt = (tot[e] + 255) >> 8; tb[16 + e] = row; for (int k = 0; k < nt; ++k) { tb[64 + nT] = e; tb[256 + nT] = (row >> 8) + k; ++nT; } row += nt * 256; }
        tb[0] = nT; }
    __syncthreads();
    if (X.tid < 16) myoff[X.tid] += tb[16 + X.tid];
    __syncthreads();
}

__device__ __forceinline__ void moe_lists(const Ctx& X, const LAS int* tb, LAS int* rows, LAS float* lw, LAS int* sc) {
    const unsigned* cntb = WSP(unsigned, WS_CNT); const int* toke = WSP(int, WS_TOKE); const float* tokw = WSP(float, WS_TOKW); int* toks = WSP(int, WS_TOKS);
    const int nT = tb[0], rpb = (T + X.G - 1) / X.G;
    for (int i = 0; i < 2; ++i) {
        const long L = (long)i * X.G + X.c; if (L >= ((long)nT << 1)) break;
        const int rt = (int)(L >> 1), e = tb[64 + rt], pm = tb[256 + rt], rbase = pm * 256 - tb[16 + e];
        const int v = X.tid < X.G ? (int)cntb[X.tid * 16 + e] : 0;
        sc[X.tid] = v; rows[i * 256 + (X.tid & 255)] = 0; lw[i * 256 + (X.tid & 255)] = 0.f;
        __syncthreads();
        for (int off = 1; off < 512; off <<= 1) { const int t = X.tid >= off ? sc[X.tid - off] : 0; __syncthreads(); sc[X.tid] += t; __syncthreads(); }
        sc[512 + X.tid] = v;
        __syncthreads();
        for (int cs = X.wave; cs < X.G; cs += 8) {
            const int cnt = sc[512 + cs], lo = sc[cs] - cnt;
            if (cnt == 0 || lo + cnt <= rbase || lo >= rbase + 256) continue;
            int run = lo;
            for (int n0 = 0; n0 < 2 * rpb; n0 += 64) { const int n = n0 + X.lane, tr = cs * rpb + (n >> 1), k = n & 1;
                const bool in = n < 2 * rpb && tr < T; const int ex = in ? toke[2 * tr + k] : -1; const bool match = ex == e;
                const unsigned long long bal = __ballot(match);
                const int rank = run + (int)__builtin_popcountll(bal & ((1ull << X.lane) - 1ull)) - rbase;
                if (match && rank >= 0 && rank < 256) { rows[i * 256 + rank] = tr; lw[i * 256 + rank] = tokw[2 * tr + k]; toks[2 * tr + k] = pm * 256 + rank; }
                run += (int)__builtin_popcountll(bal); }
        }
        __syncthreads();
    }
}

__global__ void __launch_bounds__(512, 2) fwd_kernel(Params P) {
    extern __shared__ __attribute__((aligned(16))) unsigned char lds_raw[];
    Ctx X0; X0.in = (const float* const CAS*)__builtin_amdgcn_kernarg_segment_ptr(); X0.out = P.out; X0.ws = P.ws; X0.lds = (LAS unsigned char*)lds_raw;
    X0.tid = threadIdx.x; X0.lane = X0.tid & 63; X0.wave = __builtin_amdgcn_readfirstlane(X0.tid >> 6); X0.G = gridDim.x; X0.c = blockIdx.x;
    LAS unsigned* auxw = (LAS unsigned*)(X0.lds + AUX_OFF);
    if (X0.tid < 4) auxw[X0.tid] = 0u;
    __syncthreads();
#define FRESH() Ctx X = X0; { int wv_ = X0.wave; asm volatile("" : "+s"(wv_)); unsigned m_ = ~0u; asm volatile("" : "+s"(m_)); const int ln_ = __builtin_amdgcn_mbcnt_hi(m_, __builtin_amdgcn_mbcnt_lo(m_, 0u)); \
        X.wave = wv_; X.lane = ln_; X.tid = wv_ * 64 + ln_; \
        size_t z_ = 0; asm volatile("" : "+s"(z_)); X.ws = X0.ws + z_; X.out = (float*)((unsigned char*)X0.out + z_); int c_ = X0.c; asm volatile("" : "+s"(c_)); X.c = c_; \
        const float* const CAS* i_ = X0.in; asm volatile("" : "+s"(i_)); X.in = i_; }
#if N_LAUNCH_MODE == 1
    XcdBarrier bar = xcd_barrier_post((unsigned*)(X0.ws + WS_CTL), (volatile LAS unsigned*)auxw);
#define SEAM() do { unsigned long long t1_ = 0; if (PROBE_STAMP) { t1_ = __builtin_amdgcn_s_memrealtime(); if (ph_ >= 0 && ((PROBE_STAMP >> ph_) & 1)) st_acc += t1_ - st_t0; } \
        if (gp >= lo && gp + 1 < hi) { xcd_barrier(bar); if (PROBE_DUP == 17) xcd_barrier(bar); } \
        if (PROBE_STAMP) { st_t0 = __builtin_amdgcn_s_memrealtime(); if ((PROBE_STAMP >> 11) & 1) st_acc += st_t0 - t1_; ph_ = ph_ < 0 ? ph_ : (ph_ + 1) % 10; } ++gp; } while (0)
#else
#define SEAM() do { ++gp; } while (0)
#endif
    const int lo = P.ph_lo, hi = P.ph_hi; int gp = 0;
    unsigned long long st_acc = 0, st_t0 = PROBE_STAMP ? __builtin_amdgcn_s_memrealtime() : 0ull; int ph_ = -1;
#define IN() (gp >= lo && gp < hi)
    if (IN()) { REP(13) { FRESH(); phase_mod(X); } { FRESH(); __syncthreads(); phase_conv_dyn(X, 0, (unsigned*)(X.ws + WS_CTL + 14336) + 64 * 3, 1 << 30); } }
    SEAM();
    ph_ = 0;
#define LAYER_BODY(l) do { \
        if (IN()) { REP(19) { FRESH(); if (l == 0) phase_norm1(X, l, 0); else phase_norm1(X, l, 1, rep_ == 0 ? 1.f : 0.f); } } \
        SEAM(); \
        if (IN()) REP(3) { \
            FRESH(); \
            SchedStatic S{64, 30, X.G, X.c, (const char*)WSP(bf16_t, WS_H), (const char*)WSW(bf16_t, WS_WIN, l), (size_t)256 * 1024 * 2, (size_t)256 * 1024 * 2}; \
            EpiProj E{WSP(bf16_t, WS_PROJ), INP(18) + (size_t)(l) * 3072}; \
            pg8::gemm_phase(X.lds, X.tid, 1024, 1024, 16, S, E); \
              \
            if ((l) + 1 < NL && (64 * 30) % X.G != 0 && X.c >= (64 * 30) % X.G) { __syncthreads(); phase_conv_dyn(X, (l) + 1, (unsigned*)(X.ws + WS_CTL + 14336) + 64 * (l), 4); } \
        } \
        SEAM(); \
        if (IN()) { { FRESH(); sub_qknorm(X, l); } REP(4) { FRESH(); sub_vtrans(X); } REP(5) { FRESH(); sub_gmlp(X, l); } REP(6) { FRESH(); sub_gla_local(X, l); } REP(7) { FRESH(); sub_dsa_select(X); } } \
        SEAM(); \
        if (IN()) { { FRESH(); sub_gla_scan(X); } if (PROBE_DUP == 16) { xcd_barrier(bar); { FRESH(); sub_gla_local(X, l); } xcd_barrier(bar); { FRESH(); sub_gla_scan(X); } } REP(8) { FRESH(); sub_dsa_attn(X, l); } } \
        SEAM(); \
        if (IN()) REP(9) { FRESH(); sub_gla_out(X, l); } \
        SEAM(); \
        if (IN()) REP(10) { \
            FRESH(); \
            SchedStatic S{64, 4, X.G, X.c, (const char*)WSP(bf16_t, WS_Y), (const char*)WSW(bf16_t, WS_WBR, l), (size_t)256 * YW * 2, (size_t)256 * YW * 2}; \
            EpiMerge E{WSP(bf16_t, WS_PROJ), WSP(bf16_t, WS_H)}; \
            pg8::gemm_phase(X.lds, X.tid, YW, YW, 24, S, E); \
        } \
        SEAM(); \
        if (IN()) REP(18) { \
            FRESH(); \
            SchedStatic S{64, 4, X.G, X.c, (const char*)WSP(bf16_t, WS_H), (const char*)WSW(bf16_t, WS_WOUT, l), (size_t)256 * 1024 * 2, (size_t)256 * 1024 * 2}; \
            EpiOut E{X.out, ((l) == 0 && rep_ == 0) ? INP(0) : (const float*)X.out, WSP(float, WS_MOD) + (size_t)l * NB * 6144 + 2048, rep_ == 0 ? 1.f : 0.f}; \
            pg8::gemm_phase(X.lds, X.tid, 1024, 1024, 16, S, E); \
        } \
        SEAM(); \
        if (IN()) REP(14) { FRESH(); phase_norm2(X, l); } \
        SEAM(); \
        if (IN()) REP(11) { \
            FRESH(); \
            LAS int* tb = (LAS int*)(X.lds + AUX_OFF + 2048); LAS int* myoff = (LAS int*)(X.lds + AUX_OFF + 1024); \
            LAS int* rows = (LAS int*)(X.lds + AUX_OFF + 12288); LAS float* lw = (LAS float*)(X.lds + AUX_OFF + 14336); \
            build_tiles(X, tb, myoff); \
            moe_lists(X, tb, rows, lw, (LAS int*)(X.lds + AUX_OFF + 16384)); \
            SchedMoeG S{X.G, X.c, tb[0], tb + 64, tb + 256, rows, (const char*)WSP(bf16_t, WS_H), (const char*)WSW(bf16_t, WS_WE1, l), (size_t)512 * 1024 * 2, (size_t)256 * 1024 * 2}; \
            EpiMoe1 E{WSP(bf16_t, WS_ACT), lw}; \
            pg8::gemm_phase(X.lds, X.tid, 1024, 1024, 16, S, E); \
            if ((l) + 1 < NL) { __syncthreads(); phase_conv_dyn(X, (l) + 1, (unsigned*)(X.ws + WS_CTL + 14336) + 64 * (l), 1 << 30); } \
        } \
        SEAM(); \
        if (IN()) REP(12) { \
            FRESH(); \
            LAS int* tb = (LAS int*)(X.lds + AUX_OFF + 2048); LAS int* myoff = (LAS int*)(X.lds + AUX_OFF + 1024); \
            build_tiles(X, tb, myoff); \
            SchedMoe S{X.G, X.c, 2, tb[0], tb + 64, tb + 256, (const char*)WSP(bf16_t, WS_ACT), (const char*)WSW(bf16_t, WS_WE2, l), (size_t)256 * 256 * 2, (size_t)1024 * 256 * 2, (size_t)256 * 256 * 2}; \
            EpiMoe2 E{WSP(bf16_t, WS_FFN)}; \
            pg8::gemm_phase(X.lds, X.tid, 256, 256, 4, S, E); \
        } \
        SEAM(); \
 \
    } while (0)
    LAYER_BODY(0); LAYER_BODY(1); LAYER_BODY(2); LAYER_BODY(3);
    if (IN()) { FRESH(); phase_norm1(X, NL, 2); }
    if (PROBE_STAMP) { if (blockIdx.x == 0) { const unsigned long long tb = __builtin_amdgcn_s_memrealtime(); while (__builtin_amdgcn_s_memrealtime() - tb < 4ull * st_acc) __builtin_amdgcn_s_sleep(8); } }
#undef IN
#undef SEAM
}

constexpr int N_PHASES = 1 + NL * 10 + 1;

extern "C" void kernel_launch(void* const* d_in, const int* in_sizes, int n_in, void* d_out, int out_size, void* d_ws, size_t ws_size, hipStream_t stream) {
    static int grid = 0;
    if (grid == 0) {
        if (n_in != 27 || out_size != T * D || ws_size < WS_END) { fprintf(stderr, "kernel_launch: unexpected problem (n_in %d, out %d, ws %zu, need %zu)\n", n_in, out_size, ws_size, (size_t)WS_END); grid = -1; return; }
        int dev = 0, cus = 0, per_cu = 0;
        if (hipGetDevice(&dev) != hipSuccess || hipDeviceGetAttribute(&cus, hipDeviceAttributeMultiprocessorCount, dev) != hipSuccess) { grid = -1; return; }
        if (hipFuncSetAttribute((const void*)fwd_kernel, hipFuncAttributeMaxDynamicSharedMemorySize, LDS_BYTES) != hipSuccess) { fprintf(stderr, "kernel_launch: hipFuncSetAttribute failed\n"); grid = -1; return; }
        if (hipOccupancyMaxActiveBlocksPerMultiprocessor(&per_cu, (const void*)fwd_kernel, 512, LDS_BYTES) != hipSuccess || per_cu < 1) fprintf(stderr, "kernel_launch: occupancy query says %d\n", per_cu);
        (void)hipGetLastError();
        grid = cus;
    }
    if (grid < 0) return;
    (void)hipMemsetAsync((char*)d_ws + WS_CTL, 0, 16384, stream);
    Params p{};
    for (int i = 0; i < 27; ++i) p.in[i] = (const float*)d_in[i];
    p.out = (float*)d_out; p.ws = (unsigned char*)d_ws;
#if N_LAUNCH_MODE == 1
    p.ph_lo = 0; p.ph_hi = N_PHASES;
    hipLaunchKernelGGL(fwd_kernel, dim3(grid), dim3(512), LDS_BYTES, stream, p);
#else
    for (int ph = 0; ph < N_PHASES; ++ph) { p.ph_lo = ph; p.ph_hi = ph + 1; hipLaunchKernelGGL(fwd_kernel, dim3(grid), dim3(512), LDS_BYTES, stream, p); }
#endif
}
```

```cpp
#include <hip/hip_runtime.h>
#include <stdint.h>
#include <stdio.h>

#ifndef N_LAUNCH_MODE
#define N_LAUNCH_MODE 1
#endif

#ifndef PROBE_DUP
#define PROBE_DUP 0
#endif
#ifndef PROBE_STAMP
#define PROBE_STAMP 0
#endif
#define REP(id) for (int rep_ = 0; rep_ < ((PROBE_DUP == (id)) ? 2 : 1); ++rep_)
#define LAS __attribute__((address_space(3)))
#define CAS __attribute__((address_space(4)))
#define GAS __attribute__((address_space(1)))
typedef unsigned short bf16_t;
typedef short bf16x8 __attribute__((ext_vector_type(8)));
typedef float f32x2 __attribute__((ext_vector_type(2)));
typedef float f32x4 __attribute__((ext_vector_type(4)));
typedef float f32x16 __attribute__((ext_vector_type(16)));
typedef unsigned u32x2 __attribute__((ext_vector_type(2)));
typedef unsigned u32x4 __attribute__((ext_vector_type(4)));

constexpr int NB = 4, SEQ = 4096, T = NB * SEQ, D = 1024, NL = 4;
constexpr int NIN = 7508, NP = 7680;
constexpr int C_AU = 0, C_AV = 512, C_GQ = 1024, C_GK = 1280, C_GV = 1536, C_GR = 2048, C_DQ = 2560, C_DK = 3072, C_DV = 3584,
              C_IQ = 4096, C_IK = 4352, C_GA = 4416, C_IW = 4432, C_GATE = 4608;
constexpr int YW = 1536;
constexpr int MOE_ROWS = 32768 + 16 * 256;
constexpr float EPS = 1e-6f;

constexpr size_t WS_CTL = 0;
constexpr size_t WS_CNT = 16384;
constexpr size_t WS_MOD = 65536;
constexpr size_t WS_WIN = WS_MOD + 524288;
constexpr size_t WS_WBR = WS_WIN + (size_t)NP * 1024 * 2;
constexpr size_t WS_WOUT = WS_WBR + (size_t)1024 * 1536 * 2;
constexpr size_t WS_WE1 = WS_WOUT + (size_t)1024 * 1024 * 2;
constexpr size_t WS_WE2 = WS_WE1 + (size_t)16 * 512 * 1024 * 2;
constexpr size_t WS_WS = WS_WE2 + (size_t)16 * 1024 * 256 * 2;
constexpr size_t WS_W2 = WS_WS + (size_t)4 * 128 * 128 * 2;
constexpr size_t WSET = WS_W2 - WS_WIN;
constexpr size_t WS_H = WS_W2 + WSET;
constexpr size_t WS_PROJ = WS_H + (size_t)T * 1024 * 2;
constexpr size_t WS_Y = WS_PROJ + (size_t)T * NP * 2;
constexpr size_t WS_SCR = WS_Y + (size_t)T * YW * 2;
constexpr size_t WS_MASK = WS_SCR + (size_t)T * 1024 * 4;
constexpr size_t WS_VT = WS_MASK + (size_t)T * 64 * 8;
constexpr size_t WS_TOKE = WS_VT + (size_t)16 * 128 * 4096 * 2;
constexpr size_t WS_TOKW = WS_TOKE + (size_t)T * 8;
constexpr size_t WS_TOKS = WS_TOKW + (size_t)T * 8;
constexpr size_t WS_DEC = WS_TOKS + (size_t)T * 8;
constexpr size_t WS_SW = WS_DEC + (size_t)1024 * 64 * 4;
constexpr size_t WS_END = WS_SW + (size_t)MOE_ROWS * 4;
constexpr size_t WS_H2S = WS_PROJ;
constexpr size_t WS_ACT = WS_H2S + (size_t)MOE_ROWS * 1024 * 2;
constexpr size_t WS_FFN = WS_ACT + (size_t)MOE_ROWS * 256 * 2;
static_assert(WS_FFN + (size_t)MOE_ROWS * 1024 * 2 <= WS_Y, "moe alias");

constexpr int LDS_BYTES = 158720;
constexpr int AUX_OFF = 132096;

__device__ __forceinline__ float bf2f(bf16_t v) { return __uint_as_float(((unsigned)v) << 16); }
__device__ __forceinline__ unsigned cvt_pk_bf16(float lo, float hi) { unsigned r; asm volatile("v_cvt_pk_bf16_f32 %0, %1, %2" : "=v"(r) : "v"(lo), "v"(hi)); return r; }
__device__ __forceinline__ bf16_t f2bf(float f) { return (bf16_t)(cvt_pk_bf16(f, 0.f) & 0xffffu); }
__device__ __forceinline__ float lo_bf(unsigned w) { return __uint_as_float(w << 16); }
__device__ __forceinline__ float hi_bf(unsigned w) { return __uint_as_float(w & 0xffff0000u); }
__device__ __forceinline__ float max_x32(float v) { const auto r = __builtin_amdgcn_permlane32_swap(__float_as_uint(v), __float_as_uint(v), false, false); return fmaxf(__uint_as_float(r[0]), __uint_as_float(r[1])); }
__device__ __forceinline__ float sum_x32(float v) { const auto r = __builtin_amdgcn_permlane32_swap(__float_as_uint(v), __float_as_uint(v), false, false); return __uint_as_float(r[0]) + __uint_as_float(r[1]); }
template <int CTRL> __device__ __forceinline__ float dpp_f(float v) { return __int_as_float(__builtin_amdgcn_update_dpp(0, __float_as_int(v), CTRL, 0xf, 0xf, true)); }
__device__ __forceinline__ float sum8(float v) { v += dpp_f<0xB1>(v); v += dpp_f<0x4E>(v); v += dpp_f<0x141>(v); return v; }
__device__ __forceinline__ float sum16(float v) { v = sum8(v); v += dpp_f<0x140>(v); return v; }
__device__ __forceinline__ float wave_sum(float v) {
    v = sum16(v);
    const float a = __int_as_float(__builtin_amdgcn_readlane(__float_as_int(v), 0)), b = __int_as_float(__builtin_amdgcn_readlane(__float_as_int(v), 16));
    const float c = __int_as_float(__builtin_amdgcn_readlane(__float_as_int(v), 32)), d = __int_as_float(__builtin_amdgcn_readlane(__float_as_int(v), 48));
    return (a + b) + (c + d);
}
__device__ __forceinline__ float fast_exp(float x) { return __builtin_amdgcn_exp2f(x * 1.4426950408889634f); }
__device__ __forceinline__ float sigmoidf_(float x) { return __builtin_amdgcn_rcpf(1.f + fast_exp(-x)); }
__device__ __forceinline__ float gelu_tanh(float x) { const float u = x + 0.044715f * x * x * x; return x * __builtin_amdgcn_rcpf(1.f + __builtin_amdgcn_exp2f(-2.3022082f * u)); }

#define XB_TMO      128
#define XB_XCNT(j)  (256  + 64 * (j))
#define XB_XSUB(j)  (1280 + 64 * (j))
#define XB_XGEN(j)  (2304 + 64 * (j))
#define XB_TOP      3328
#define XB_TOPGEN   3392
#define XCD_BAR_WORDS 3456
#define XB_SPIN_CAP (1u << 22)
__device__ __forceinline__ unsigned xb_ld(unsigned* p)              { return __hip_atomic_load(p, __ATOMIC_RELAXED, __HIP_MEMORY_SCOPE_AGENT); }
__device__ __forceinline__ unsigned xb_add(unsigned* p, unsigned v) { return __hip_atomic_fetch_add(p, v, __ATOMIC_RELAXED, __HIP_MEMORY_SCOPE_AGENT); }
__device__ __forceinline__ unsigned xb_xcc_id() { return (unsigned)__builtin_amdgcn_s_getreg((3 << 11) | 20) & 0xFu; }
#define XB_SPIN(cond, bar) do { unsigned _sp = 0; while (cond) { __builtin_amdgcn_s_sleep(1); \
    if ((++_sp & 255u) == 0u) { if (xb_ld(&(bar)[XB_TMO])) break; if (_sp > XB_SPIN_CAP) { atomicAdd(&(bar)[XB_TMO], 1u); break; } } } } while (0)
struct XcdBarrier { unsigned* bar; unsigned x; volatile LAS unsigned* st; };
__device__ __forceinline__ XcdBarrier xcd_barrier_post(unsigned* bar, volatile LAS unsigned* st) {
    XcdBarrier b; b.bar = bar; b.x = xb_xcc_id(); b.st = st;
    if (threadIdx.x == 0) (void)xb_add(&bar[XB_XCNT(b.x)], 1u);
    return b;
}
__device__ __forceinline__ void xcd_barrier_complete(unsigned* bar, unsigned x, unsigned& nloc, unsigned& nx) {
    const unsigned G = gridDim.x * gridDim.y * gridDim.z;
    unsigned sum, cnt, mine, sp = 0u;
    for (;;) {
        sum = 0u; cnt = 0u; mine = 0u;
#pragma unroll
        for (unsigned j = 0; j < 16; ++j) { const unsigned c = xb_ld(&bar[XB_XCNT(j)]); sum += c; cnt += (c > 0u) ? 1u : 0u; mine = (j == x) ? c : mine; }
        if (sum == G) break;
        __builtin_amdgcn_s_sleep(1);
        if ((++sp & 255u) == 0u) { if (xb_ld(&bar[XB_TMO])) break; if (sp > XB_SPIN_CAP) { atomicAdd(&bar[XB_TMO], 1u); break; } }
    }
    nloc = mine > 0u ? mine : 1u; nx = cnt > 0u ? cnt : 1u;
}
__device__ __forceinline__ void xcd_barrier(const XcdBarrier& b) {
    asm volatile("s_waitcnt vmcnt(0)" ::: "memory");
    __syncthreads();
    if (threadIdx.x == 0) {
        unsigned* bar = b.bar;
        __builtin_amdgcn_s_waitcnt(0);
        unsigned nloc = b.st[0], nx = b.st[1];
        if (nloc == 0u) { xcd_barrier_complete(bar, b.x, nloc, nx); b.st[0] = nloc; b.st[1] = nx; }
        const unsigned old = xb_add(&bar[XB_XSUB(b.x)], 1u);
        const unsigned gen = old / nloc;
        if (old + 1u == (gen + 1u) * nloc) {
            __builtin_amdgcn_fence(__ATOMIC_RELEASE, "agent");
            asm volatile("s_waitcnt vmcnt(0)" ::: "memory");
            const unsigned og = xb_add(&bar[XB_TOP], 1u);
            const unsigned tg = og / nx;
            if (og + 1u == (tg + 1u) * nx) xb_add(&bar[XB_TOPGEN], 1u);
            else XB_SPIN(xb_ld(&bar[XB_TOPGEN]) == tg, bar);
            __builtin_amdgcn_fence(__ATOMIC_ACQUIRE, "agent");
            xb_add(&bar[XB_XGEN(b.x)], 1u);
            asm volatile("s_waitcnt vmcnt(0)" ::: "memory");
        } else {
            XB_SPIN(xb_ld(&bar[XB_XGEN(b.x)]) == gen, bar);
            __builtin_amdgcn_fence(__ATOMIC_ACQUIRE, "agent");
            asm volatile("s_waitcnt vmcnt(0)" ::: "memory");
        }
    }
    __syncthreads();
}

namespace pg8 {
constexpr int BM = 256, BK = 64, HALF = 128, HTB = HALF * BK * 2, STAGE_BYTES = 8 * HTB, NXCD = 8, WGM = 8;
__device__ __forceinline__ int lds_byte(int r, int c) { const int st = (r >> 4) * 2 + (c >> 5), rr = r & 15, cc = c & 31, ob = rr * 64 + cc * 2; return st * 1024 + (ob ^ (((ob >> 9) & 1) << 5)); }
__device__ __forceinline__ void stage_rc(int b, int& R, int& C) { const int st = b / 1024, sb = b % 1024, swz = sb ^ (((sb >> 9) & 1) << 5); R = (st >> 1) * 16 + swz / 64; C = (st & 1) * 32 + (swz % 64) / 2; }
__device__ __forceinline__ int perm32(int rho) { const int n = rho >> 4, i = rho & 15; return 8 * (i >> 2) + 4 * n + (i & 3); }

struct Unit { int pm, pn, aux, ord; const char* A; const char* B; };
__device__ __forceinline__ void tile_of(int L, int nM, int nN, int& pm, int& pn) {
    const int nwg = nM * nN; int wgid = L;
    { const int q = nwg / NXCD, r = nwg % NXCD, xcd = wgid % NXCD, off = wgid / NXCD; wgid = (xcd < r ? xcd * (q + 1) : r * (q + 1) + (xcd - r) * q) + off; }
    const int nig = WGM * nN, gid = wgid / nig, fm = gid * WGM, gsz = (nM - fm) < WGM ? (nM - fm) : WGM;
    pm = fm + ((wgid % nig) % gsz); pn = (wgid % nig) / gsz;
}

template <class Epi, class Sched>
__device__ __forceinline__ void gemm_phase(LAS unsigned char* lds, const int tid, const int lda, const int ldb, const int nt, const Sched& S, const Epi& E) {
    const int wid = __builtin_amdgcn_readfirstlane(tid >> 6), lane = tid & 63, wr = wid >> 2, wc = wid & 3, fr = lane & 15, fq = lane >> 4;
    unsigned voffA[2], voffB[2]; int stR[2], stC[2];
#pragma unroll
    for (int i = 0; i < 2; ++i) { int R, C; stage_rc(tid * 16 + i * 8192, R, C); const int Rb = Epi::PERM ? ((R & ~31) + perm32(R & 31)) : R; stR[i] = R; stC[i] = C;
        voffA[i] = (unsigned)(R * lda + C) * 2u; voffB[i] = (unsigned)(Rb * ldb + C) * 2u; }
    unsigned gC[2][2], gN[2][2];
#define PG8_GROWS(dst, un) do { if constexpr (Sched::GATHER) { _Pragma("unroll") for (int _h = 0; _h < 2; ++_h) _Pragma("unroll") for (int _i = 0; _i < 2; ++_i) \
        dst[_h][_i] = (unsigned)(S.row(un, _h * HALF + stR[_i]) * lda + stC[_i]) * 2u; } } while (0)
#define PG8_STAGEA(bufoff, kidx, h, nx) do { if constexpr (Sched::GATHER) { const char* _b = cA + (size_t)(kidx) * kstep; if (nx) PG8_STAGE(bufoff, _b, gN[h]); else PG8_STAGE(bufoff, _b, gC[h]); } \
        else { const char* _b = ((nx) ? nA : cA) + (size_t)(kidx) * kstep + (size_t)(h) * hstepA; PG8_STAGE(bufoff, _b, voffA); } } while (0)
    const size_t kstep = (size_t)(BK * 2);
    const size_t hstepA = (size_t)HALF * lda * 2, hstepB = (size_t)HALF * ldb * 2;
    const unsigned ldsw = (unsigned)wid * 1024u;
    const int aoff = lds_byte(wr * 64 + fr, fq * 8), boff = lds_byte(wc * 32 + fr, fq * 8);
#define PG8_SA(b, h) (((b) * 2 + (h)) * HTB)
#define PG8_SB(b, h) ((4 + (b) * 2 + (h)) * HTB)
#define PG8_STAGE(bufoff, gbase, voff) do { _Pragma("unroll") for (int _i = 0; _i < 2; ++_i) \
        __builtin_amdgcn_global_load_lds((const unsigned*)((const char*)(gbase) + (voff)[_i]), (LAS unsigned*)(lds + (bufoff) + ldsw + _i * 8192), 16, 0, 0); } while (0)
#define PG8_LDA(dst, b, h) do { _Pragma("unroll") for (int m = 0; m < 4; ++m) _Pragma("unroll") for (int k = 0; k < 2; ++k) dst[m][k] = *(const LAS bf16x8*)(lds + PG8_SA(b, h) + aoff + m * 2048 + k * 1024); } while (0)
#define PG8_LDB(dst, b, h) do { _Pragma("unroll") for (int n = 0; n < 2; ++n) _Pragma("unroll") for (int k = 0; k < 2; ++k) dst[n][k] = *(const LAS bf16x8*)(lds + PG8_SB(b, h) + boff + n * 2048 + k * 1024); } while (0)
#define PG8_MMA(ai, bj, At, Bt) do { __builtin_amdgcn_s_setprio(1); _Pragma("unroll") for (int m = 0; m < 4; ++m) _Pragma("unroll") for (int n = 0; n < 2; ++n) _Pragma("unroll") for (int k = 0; k < 2; ++k) \
        acc[ai][bj][m][n] = __builtin_amdgcn_mfma_f32_16x16x32_bf16(Bt[n][k], At[m][k], acc[ai][bj][m][n], 0, 0, 0); __builtin_amdgcn_s_setprio(0); } while (0)
#define PG8_WAIT_V(n) asm volatile("s_waitcnt vmcnt(" #n ")" ::: "memory")
#define PG8_WAIT_L(n) asm volatile("s_waitcnt lgkmcnt(" #n ")" ::: "memory")
#define PG8_BAR __builtin_amdgcn_s_barrier()
#define PG8_SCHED __builtin_amdgcn_sched_barrier(0)
    Unit cur, nxt; int ui = 0;
    if (!S.next(0, cur)) return;
    f32x4 acc[2][2][4][2];
#pragma unroll
    for (int a = 0; a < 2; ++a)
#pragma unroll
        for (int b = 0; b < 2; ++b)
#pragma unroll
            for (int m = 0; m < 4; ++m)
#pragma unroll
                for (int n = 0; n < 2; ++n) acc[a][b][m][n] = (f32x4){0.f, 0.f, 0.f, 0.f};
    bf16x8 At[4][2], B0[2][2], B1[2][2];
    const char* cA = cur.A; const char* cB = cur.B; const char* nA = cA;
    PG8_GROWS(gC, cur);
    PG8_STAGE(PG8_SB(0, 0), cB, voffB); PG8_STAGEA(PG8_SA(0, 0), 0, 0, false); PG8_STAGE(PG8_SB(0, 1), cB + hstepB, voffB); PG8_STAGEA(PG8_SA(0, 1), 0, 1, false);
    if (wr == 1) PG8_BAR;
    PG8_WAIT_V(4); PG8_BAR;
    PG8_STAGE(PG8_SB(1, 0), cB + kstep, voffB); PG8_STAGEA(PG8_SA(1, 0), 1, 0, false); PG8_STAGE(PG8_SB(1, 1), cB + hstepB + kstep, voffB);
    PG8_WAIT_V(6); PG8_BAR;
    for (;;) {
        const bool has_next = S.next(ui + 1, nxt);
        nA = has_next ? nxt.A : cA; const char* nB = has_next ? nxt.B : cB;
        if constexpr (Sched::GATHER) { if (has_next) PG8_GROWS(gN, nxt); else { _Pragma("unroll") for (int _h = 0; _h < 2; ++_h) _Pragma("unroll") for (int _i = 0; _i < 2; ++_i) gN[_h][_i] = gC[_h][_i]; } }
        for (int t = 0; t < nt; t += 2) {
            const bool last = (t == nt - 2);
            const int k2 = last ? 0 : t + 2;
            const char* b2 = last ? nB : cB + (size_t)(t + 2) * kstep;
            const char* b3 = b2 + kstep;
            if constexpr (Epi::MID != 0) { if (t != 0 && (t % Epi::MID) == 0) E.mid(acc, cur, t / Epi::MID, wr, wc, fr, fq); }
            PG8_LDB(B0, 0, 0); PG8_SCHED; PG8_LDA(At, 0, 0); PG8_STAGEA(PG8_SA(1, 1), t + 1, 1, false);
            PG8_WAIT_L(8); PG8_BAR; PG8_WAIT_L(0); PG8_MMA(0, 0, At, B0); PG8_BAR; PG8_SCHED;
            PG8_LDB(B1, 0, 1); PG8_STAGE(PG8_SB(0, 0), b2, voffB);
            PG8_BAR; PG8_WAIT_L(0); PG8_MMA(0, 1, At, B1); PG8_BAR;
            PG8_LDA(At, 0, 1); PG8_STAGEA(PG8_SA(0, 0), k2, 0, last);
            PG8_BAR; PG8_WAIT_L(0); PG8_MMA(1, 0, At, B0); PG8_BAR; PG8_SCHED;
            PG8_STAGE(PG8_SB(0, 1), b2 + hstepB, voffB);
            PG8_WAIT_V(6); PG8_BAR; PG8_MMA(1, 1, At, B1); PG8_BAR;
            PG8_LDB(B0, 1, 0); PG8_SCHED; PG8_LDA(At, 1, 0); PG8_STAGEA(PG8_SA(0, 1), k2, 1, last);
            PG8_WAIT_L(8); PG8_BAR; PG8_WAIT_L(0); PG8_MMA(0, 0, At, B0); PG8_BAR; PG8_SCHED;
            PG8_LDB(B1, 1, 1); PG8_STAGE(PG8_SB(1, 0), b3, voffB);
            PG8_BAR; PG8_WAIT_L(0); PG8_MMA(0, 1, At, B1); PG8_BAR;
            PG8_LDA(At, 1, 1); PG8_STAGEA(PG8_SA(1, 0), k2 + 1, 0, last);
            PG8_BAR; PG8_WAIT_L(0); PG8_MMA(1, 0, At, B0); PG8_BAR; PG8_SCHED;
            PG8_STAGE(PG8_SB(1, 1), b3 + hstepB, voffB);
            PG8_WAIT_V(6); PG8_BAR; PG8_MMA(1, 1, At, B1); PG8_BAR;
        }
        E(acc, cur, wr, wc, fr, fq);
        if (!has_next) break;
#pragma unroll
        for (int a = 0; a < 2; ++a)
#pragma unroll
            for (int b = 0; b < 2; ++b)
#pragma unroll
                for (int m = 0; m < 4; ++m)
#pragma unroll
                    for (int n = 0; n < 2; ++n) acc[a][b][m][n] = (f32x4){0.f, 0.f, 0.f, 0.f};
        cur = nxt; cA = nA; cB = nB; ++ui;
        if constexpr (Sched::GATHER) { _Pragma("unroll") for (int _h = 0; _h < 2; ++_h) _Pragma("unroll") for (int _i = 0; _i < 2; ++_i) gC[_h][_i] = gN[_h][_i]; }
    }
    PG8_WAIT_V(0);
    if (wr == 0) PG8_BAR;
    PG8_BAR;
#undef PG8_SA
#undef PG8_SB
#undef PG8_STAGE
#undef PG8_STAGEA
#undef PG8_GROWS
#undef PG8_LDA
#undef PG8_LDB
#undef PG8_MMA
#undef PG8_WAIT_V
#undef PG8_WAIT_L
#undef PG8_BAR
#undef PG8_SCHED
}
}
using pg8::Unit;

struct Params { const float* in[27]; float* out; unsigned char* ws; int ph_lo, ph_hi; };
struct Ctx {
    const float* const CAS* in; float* out; unsigned char* ws; LAS unsigned char* lds;
    int tid, lane, wave, G, c;
};
#define INP(k_) ((const float*)(const GAS float*)X.in[k_])
#define WSP(T_, off) ((T_*)(X.ws + (off)))
#define WSW(T_, off, l_) ((T_*)(X.ws + (off) + (size_t)((l_) & 1) * WSET))

struct SchedStatic {
    static constexpr bool GATHER = false; __device__ __forceinline__ int row(const Unit&, int) const { return 0; }
    int nM, nN, G, c; const char* A; const char* B; size_t tA, tB;
    __device__ __forceinline__ bool next(int i, Unit& u) const {
        const long L = (long)i * G + c; if (L >= (long)nM * nN) return false;
        pg8::tile_of((int)L, nM, nN, u.pm, u.pn); u.aux = 0; u.ord = i; u.A = A + (size_t)u.pm * tA; u.B = B + (size_t)u.pn * tB; return true;
    }
};
struct SchedMoe {
    static constexpr bool GATHER = false; __device__ __forceinline__ int row(const Unit&, int) const { return 0; }
    int G, c, ncol_shift, nT; const LAS int* tile_e; const LAS int* tile_pm; const char* A; const char* B; size_t tA, eB, tB;
    __device__ __forceinline__ bool next(int i, Unit& u) const {
        const long L = (long)i * G + c; if (L >= ((long)nT << ncol_shift)) return false;
        const int rt = (int)(L >> ncol_shift); u.pn = (int)(L & ((1 << ncol_shift) - 1)); u.pm = tile_pm[rt]; u.aux = tile_e[rt]; u.ord = i;
        u.A = A + (size_t)u.pm * tA; u.B = B + (size_t)u.aux * eB + (size_t)u.pn * tB; return true;
    }
};

struct SchedMoeG {
    static constexpr bool GATHER = true;
    int G, c, nT; const LAS int* tile_e; const LAS int* tile_pm; const LAS int* rows; const char* A; const char* B; size_t eB, tB;
    __device__ __forceinline__ bool next(int i, Unit& u) const {
        const long L = (long)i * G + c; if (L >= ((long)nT << 1)) return false;
        const int rt = (int)(L >> 1); u.pn = (int)(L & 1); u.pm = tile_pm[rt]; u.aux = tile_e[rt]; u.ord = i;
        u.A = A; u.B = B + (size_t)u.aux * eB + (size_t)u.pn * tB; return true;
    }
    __device__ __forceinline__ int row(const Unit& u, int r) const { return rows[(u.ord & 1) * 256 + r]; }
};

struct EpiProj { static constexpr int MID = 0; static constexpr bool PERM = true; bf16_t* O; const float* bgate;
    __device__ __forceinline__ void operator()(const f32x4 (&acc)[2][2][4][2], const Unit& u, int wr, int wc, int fr, int fq) const {
        const int row0 = u.pm * 256 + wr * 64 + fr, col0 = u.pn * 256 + wc * 32 + 8 * fq; const bool act = u.pn < 4, gate = u.pn >= 18;
        for (int rep_ = 0; rep_ < (PROBE_DUP == 22 ? 2 : 1); ++rep_) {
        f32x4 bv[2][2];
#pragma unroll
        for (int bj = 0; bj < 2; ++bj)
#pragma unroll
            for (int n = 0; n < 2; ++n) bv[bj][n] = gate ? *(const f32x4*)(bgate + (col0 - C_GATE) + bj * 128 + 4 * n) : (f32x4){0.f, 0.f, 0.f, 0.f};
#pragma unroll
        for (int ai = 0; ai < 2; ++ai)
#pragma unroll
            for (int m = 0; m < 4; ++m) { bf16_t* rowp = O + (size_t)(row0 + ai * 128 + m * 16) * NP + col0;
#pragma unroll
                for (int bj = 0; bj < 2; ++bj) { f32x4 v0 = acc[ai][bj][m][0], v1 = acc[ai][bj][m][1];
                    if (act) {
#pragma unroll
                        for (int j = 0; j < 4; ++j) { v0[j] = gelu_tanh(v0[j]); v1[j] = gelu_tanh(v1[j]); } }
                    if (gate) {
                        v0 += bv[bj][0]; v1 += bv[bj][1];
#pragma unroll
                        for (int j = 0; j < 4; ++j) { v0[j] = sigmoidf_(fminf(fmaxf(v0[j], -30.f), 30.f)); v1[j] = sigmoidf_(fminf(fmaxf(v1[j], -30.f), 30.f)); } }
                    u32x4 w; w.x = cvt_pk_bf16(v0[0], v0[1]); w.y = cvt_pk_bf16(v0[2], v0[3]); w.z = cvt_pk_bf16(v1[0], v1[1]); w.w = cvt_pk_bf16(v1[2], v1[3]);
                    *(u32x4*)(rowp + bj * 128) = w; } }
        }
    }
};
struct EpiMerge { static constexpr int MID = 8; static constexpr bool PERM = true; const bf16_t* proj; bf16_t* mb;
    __device__ __forceinline__ void mid(f32x4 (&acc)[2][2][4][2], const Unit& u, int j, int wr, int wc, int fr, int fq) const {
        const int row0 = u.pm * 256 + wr * 64 + fr, col0 = u.pn * 256 + wc * 32 + 8 * fq;
        const bf16_t* gp = proj + (size_t)row0 * NP + C_GATE + (j - 1) * 1024 + col0;
#pragma unroll
        for (int ai = 0; ai < 2; ++ai) {
            u32x4 gprev[4][2], gcur[4][2];
#pragma unroll
            for (int m = 0; m < 4; ++m)
#pragma unroll
                for (int bj = 0; bj < 2; ++bj) { const bf16_t* p = gp + (size_t)(ai * 128 + m * 16) * NP + bj * 128; gprev[m][bj] = *(const u32x4*)p; gcur[m][bj] = *(const u32x4*)(p + 1024); }
#pragma unroll
            for (int m = 0; m < 4; ++m)
#pragma unroll
                for (int bj = 0; bj < 2; ++bj) { const unsigned pw[4] = {gprev[m][bj].x, gprev[m][bj].y, gprev[m][bj].z, gprev[m][bj].w}, cw[4] = {gcur[m][bj].x, gcur[m][bj].y, gcur[m][bj].z, gcur[m][bj].w};
#pragma unroll
                    for (int n = 0; n < 2; ++n)
#pragma unroll
                        for (int k = 0; k < 4; ++k) { const int e = 4 * n + k; const float gpv = (e & 1) ? hi_bf(pw[e >> 1]) : lo_bf(pw[e >> 1]), gcv = (e & 1) ? hi_bf(cw[e >> 1]) : lo_bf(cw[e >> 1]);
                            acc[ai][bj][m][n][k] *= gpv * __builtin_amdgcn_rcpf(gcv); } }
        }
    }
    __device__ __forceinline__ void operator()(const f32x4 (&acc)[2][2][4][2], const Unit& u, int wr, int wc, int fr, int fq) const {
        const int row0 = u.pm * 256 + wr * 64 + fr, col0 = u.pn * 256 + wc * 32 + 8 * fq;
        const bf16_t* gp = proj + (size_t)row0 * NP + C_GATE + 2 * 1024 + col0;
#pragma unroll
        for (int ai = 0; ai < 2; ++ai) {
            u32x4 g2[4][2];
#pragma unroll
            for (int m = 0; m < 4; ++m)
#pragma unroll
                for (int bj = 0; bj < 2; ++bj) g2[m][bj] = *(const u32x4*)(gp + (size_t)(ai * 128 + m * 16) * NP + bj * 128);
#pragma unroll
            for (int m = 0; m < 4; ++m)
#pragma unroll
                for (int bj = 0; bj < 2; ++bj) { const unsigned gw[4] = {g2[m][bj].x, g2[m][bj].y, g2[m][bj].z, g2[m][bj].w}; float o[8];
#pragma unroll
                    for (int n = 0; n < 2; ++n)
#pragma unroll
                        for (int k = 0; k < 4; ++k) { const int e = 4 * n + k; o[e] = acc[ai][bj][m][n][k] * ((e & 1) ? hi_bf(gw[e >> 1]) : lo_bf(gw[e >> 1])); }
                    u32x4 w; w.x = cvt_pk_bf16(o[0], o[1]); w.y = cvt_pk_bf16(o[2], o[3]); w.z = cvt_pk_bf16(o[4], o[5]); w.w = cvt_pk_bf16(o[6], o[7]);
                    *(u32x4*)(mb + (size_t)(row0 + ai * 128 + m * 16) * 1024 + col0 + bj * 128) = w; }
        }
    }
};
struct EpiOut { static constexpr int MID = 0; static constexpr bool PERM = false; float* out; const float* xsrc; const float* gt; float scl;
    __device__ __forceinline__ void operator()(const f32x4 (&acc)[2][2][4][2], const Unit& u, int wr, int wc, int fr, int fq) const {
        const int row0 = u.pm * 256 + wr * 64 + fr, col0 = u.pn * 256 + wc * 32 + 4 * fq; const float* g = gt + (size_t)(u.pm >> 4) * 6144;
        f32x4 gv[2][2];
#pragma unroll
        for (int bj = 0; bj < 2; ++bj)
#pragma unroll
            for (int n = 0; n < 2; ++n) gv[bj][n] = *(const f32x4*)(g + col0 + bj * 128 + n * 16) * scl;
#pragma unroll
        for (int ai = 0; ai < 2; ++ai) {
            f32x4 xv[4][2][2];
#pragma unroll
            for (int m = 0; m < 4; ++m)
#pragma unroll
                for (int bj = 0; bj < 2; ++bj)
#pragma unroll
                    for (int n = 0; n < 2; ++n) xv[m][bj][n] = *(const f32x4*)(xsrc + (size_t)(row0 + ai * 128 + m * 16) * 1024 + col0 + bj * 128 + n * 16);
#pragma unroll
            for (int m = 0; m < 4; ++m)
#pragma unroll
                for (int bj = 0; bj < 2; ++bj)
#pragma unroll
                    for (int n = 0; n < 2; ++n) *(f32x4*)(out + (size_t)(row0 + ai * 128 + m * 16) * 1024 + col0 + bj * 128 + n * 16) = xv[m][bj][n] + gv[bj][n] * acc[ai][bj][m][n];
        }
    }
};
struct EpiMoe1 { static constexpr int MID = 0; static constexpr bool PERM = true; bf16_t* act; const LAS float* lw;
    __device__ __forceinline__ void operator()(const f32x4 (&acc)[2][2][4][2], const Unit& u, int wr, int wc, int fr, int fq) const {
        const int row0 = u.pm * 256 + wr * 64 + fr, col0 = u.pn * 128 + wc * 32 + 8 * fq;
        float wv[2][4];
#pragma unroll
        for (int ai = 0; ai < 2; ++ai)
#pragma unroll
            for (int m = 0; m < 4; ++m) wv[ai][m] = lw[(u.ord & 1) * 256 + wr * 64 + fr + ai * 128 + m * 16];
#pragma unroll
        for (int ai = 0; ai < 2; ++ai)
#pragma unroll
            for (int m = 0; m < 4; ++m) { const int r = row0 + ai * 128 + m * 16; const float w = wv[ai][m]; float o[8];
#pragma unroll
                for (int n = 0; n < 2; ++n)
#pragma unroll
                    for (int j = 0; j < 4; ++j) { const float g = acc[ai][0][m][n][j], up = acc[ai][1][m][n][j]; o[4 * n + j] = g * sigmoidf_(g) * up * w; }
                u32x4 pk; pk.x = cvt_pk_bf16(o[0], o[1]); pk.y = cvt_pk_bf16(o[2], o[3]); pk.z = cvt_pk_bf16(o[4], o[5]); pk.w = cvt_pk_bf16(o[6], o[7]);
                *(u32x4*)(act + (size_t)r * 256 + col0) = pk; }
    }
};
struct EpiMoe2 { static constexpr int MID = 0; static constexpr bool PERM = true; bf16_t* O;
    __device__ __forceinline__ void operator()(const f32x4 (&acc)[2][2][4][2], const Unit& u, int wr, int wc, int fr, int fq) const {
        const int row0 = u.pm * 256 + wr * 64 + fr, col0 = u.pn * 256 + wc * 32 + 8 * fq;
#pragma unroll
        for (int ai = 0; ai < 2; ++ai)
#pragma unroll
            for (int m = 0; m < 4; ++m) { bf16_t* rowp = O + (size_t)(row0 + ai * 128 + m * 16) * 1024 + col0;
#pragma unroll
                for (int bj = 0; bj < 2; ++bj) { const f32x4 v0 = acc[ai][bj][m][0], v1 = acc[ai][bj][m][1];
                    u32x4 w; w.x = cvt_pk_bf16(v0[0], v0[1]); w.y = cvt_pk_bf16(v0[2], v0[3]); w.z = cvt_pk_bf16(v1[0], v1[1]); w.w = cvt_pk_bf16(v1[2], v1[3]);
                    *(u32x4*)(rowp + bj * 128) = w; } }
    }
};

__device__ __forceinline__ void phase_mod(const Ctx& X) {
    LAS float* sc = (LAS float*)X.lds;
    LAS float* red = (LAS float*)(X.lds + 16384);
    const float* c = INP(1); const float* wm = INP(2); const float* bm = INP(3); float* mod = WSP(float, WS_MOD);
    for (int i = X.tid; i < 4096; i += 512) { const float v = c[i]; sc[i] = v * sigmoidf_(v); }
    __syncthreads();
    const int jj = X.tid & 63, ks = X.tid >> 6;
    for (int u = X.c; u < NL * 96; u += X.G) {
        const int l = u / 96, j0 = (u % 96) * 64;
        float a0 = 0.f, a1 = 0.f, a2 = 0.f, a3 = 0.f;
        const float* wp = wm + ((size_t)l * 1024 + ks * 128) * 6144 + j0 + jj;
        for (int k0 = 0; k0 < 128; k0 += 32) { float w[32];
#pragma unroll
            for (int k = 0; k < 32; ++k) w[k] = __builtin_nontemporal_load(wp + (size_t)(k0 + k) * 6144);
#pragma unroll
            for (int k = 0; k < 32; ++k) { const int kk = ks * 128 + k0 + k;
                a0 += sc[kk] * w[k]; a1 += sc[1024 + kk] * w[k]; a2 += sc[2048 + kk] * w[k]; a3 += sc[3072 + kk] * w[k]; } }
        red[(ks * 64 + jj) * 4 + 0] = a0; red[(ks * 64 + jj) * 4 + 1] = a1; red[(ks * 64 + jj) * 4 + 2] = a2; red[(ks * 64 + jj) * 4 + 3] = a3;
        __syncthreads();
        if (X.tid < 256) { const int b = X.tid >> 6; float s = bm[l * 6144 + j0 + jj];
#pragma unroll
            for (int q = 0; q < 8; ++q) s += red[(q * 64 + jj) * 4 + b];
            mod[((size_t)l * NB + b) * 6144 + j0 + jj] = s; }
        __syncthreads();
    }
}

__device__ __forceinline__ int wincol(int m) {
    if (m < 2560) return m;
    if (m < 4416) return m + 16;
    if (m < 4432) return 2560 + (m - 4416);
    if (m < 4436) return m;
    if (m < 4608) return -1;
    return 4436 + (m - 4608);
}
constexpr int CJ0 = 480, CJ1 = CJ0 + 96, CJ2 = CJ1 + 64, CJ3 = CJ2 + 512, CJ4 = CJ3 + 256, CJ5 = CJ4 + 16;
__device__ __forceinline__ void conv_job(const Ctx& X, int l, int j) {
    LAS float* tile = (LAS float*)X.lds;
    const int c = X.tid & 63, r0 = X.tid >> 6;
    if (j >= CJ4) {
        const int q = j - CJ4; const float* src = INP(9) + (size_t)l * 65536; bf16_t* dst = WSW(bf16_t, WS_WS, l);
        for (int i = X.tid; i < 4096; i += 512) { const int e = q * 4096 + i, t = (e >> 7) & 127, s = e & 127; dst[e] = f2bf(s <= t ? src[e] : 0.f); }
        return;
    }
    const float* sp; int sld, scol; bf16_t* dp; int dld;
    if (j < CJ0) { const int nt = j >> 2, kt = j & 3; sp = INP(6) + ((size_t)l * 1024 + kt * 256) * NIN; sld = NIN; scol = wincol(nt * 64 + c);
        dp = WSW(bf16_t, WS_WIN, l) + (size_t)(nt * 64) * 1024 + kt * 256; dld = 1024; }
    else if (j < CJ1) { const int q = j - CJ0, n = q >> 5, dt = (q >> 1) & 15, et = q & 1;
        sp = INP(17) + (((size_t)l * 3 + n) * 512 + et * 256) * 1024; sld = 1024; scol = dt * 64 + c;
        dp = WSW(bf16_t, WS_WBR, l) + (size_t)(dt * 64) * YW + n * 512 + et * 256; dld = YW; }
    else if (j < CJ2) { const int q = j - CJ1, nt = q >> 2, kt = q & 3;
        sp = INP(19) + ((size_t)l * 1024 + kt * 256) * 1024; sld = 1024; scol = nt * 64 + c;
        dp = WSW(bf16_t, WS_WOUT, l) + (size_t)(nt * 64) * 1024 + kt * 256; dld = 1024; }
    else if (j < CJ3) { const int q = j - CJ2, e = q >> 5, rt = (q >> 2) & 7, kt = q & 3; const int n0 = rt * 64, pn = n0 >> 8, half = (n0 >> 7) & 1;
        sp = (half ? INP(25) : INP(24)) + (((size_t)l * 16 + e) * 1024 + kt * 256) * 256; sld = 256; scol = 128 * pn + (n0 & 127) + c;
        dp = WSW(bf16_t, WS_WE1, l) + ((size_t)e * 512 + n0) * 1024 + kt * 256; dld = 1024; }
    else { const int q = j - CJ3, e = q >> 4, dt = q & 15;
        sp = INP(26) + ((size_t)l * 16 + e) * 256 * 1024; sld = 1024; scol = dt * 64 + c;
        dp = WSW(bf16_t, WS_WE2, l) + ((size_t)e * 1024 + dt * 64) * 256; dld = 256; }
#pragma unroll
    for (int i = 0; i < 32; ++i) { const int k = r0 + 8 * i; tile[k * 65 + c] = scol >= 0 ? __builtin_nontemporal_load(sp + (size_t)k * sld + scol) : 0.f; }
    __syncthreads();
    { const int kc = X.tid & 127, nr = X.tid >> 7;
#pragma unroll
      for (int i = 0; i < 16; ++i) { const int n = nr + 4 * i; *(unsigned*)(dp + (size_t)n * dld + 2 * kc) = cvt_pk_bf16(tile[(2 * kc) * 65 + n], tile[(2 * kc + 1) * 65 + n]); } }
    __syncthreads();
}
__device__ __forceinline__ void phase_conv(const Ctx& X, int l) {
    for (int j = X.c; j < CJ5; j += X.G) conv_job(X, l, j);
}
__device__ __forceinline__ void phase_conv_dyn(const Ctx& X, int l, unsigned* q, int maxjobs) {
    LAS int* jslot = (LAS int*)(X.lds + AUX_OFF + 64);
    for (int nj = 0; nj < maxjobs; ++nj) {
        if (X.tid == 0) *jslot = (int)__hip_atomic_fetch_add(q, 1u, __ATOMIC_RELAXED, __HIP_MEMORY_SCOPE_AGENT);
        __syncthreads();
        const int j = *jslot;
        __syncthreads();
        if (j >= CJ5) break;
        conv_job(X, l, j);
    }
}

__device__ __forceinline__ void phase_norm1(const Ctx& X, int l, int mode, float fscale = 1.f) {
    const float* xin = INP(0); float* out = X.out; const float* mod = WSP(float, WS_MOD);
    const bf16_t* ffn = WSP(bf16_t, WS_FFN); const int* toks = WSP(int, WS_TOKS); bf16_t* h = WSP(bf16_t, WS_H);
    const float* g1 = INP(4) + (size_t)l * 1024;
    constexpr int NBATCH = 4;
    const int rstride = X.G * 8;
    for (int r0 = X.c * 8 + X.wave; r0 < T; r0 += rstride * NBATCH) {
        f32x4 xv[NBATCH][4]; u32x2 fa[NBATCH][4], fb[NBATCH][4]; int sl[NBATCH][2];
        if (mode != 0) {
#pragma unroll
            for (int j = 0; j < NBATCH; ++j) { const int r = r0 + j * rstride; sl[j][0] = r < T ? toks[2 * r] : 0; sl[j][1] = r < T ? toks[2 * r + 1] : 0; }
        }
#pragma unroll
        for (int j = 0; j < NBATCH; ++j) { const int r = r0 + j * rstride < T ? r0 + j * rstride : r0;
#pragma unroll
            for (int i = 0; i < 4; ++i) { const int col = 4 * X.lane + 256 * i;
                xv[j][i] = *(const f32x4*)((mode == 0 ? xin : out) + (size_t)r * 1024 + col);
                if (mode != 0) { fa[j][i] = *(const u32x2*)(ffn + (size_t)sl[j][0] * 1024 + col); fb[j][i] = *(const u32x2*)(ffn + (size_t)sl[j][1] * 1024 + col); } } }
#pragma unroll
        for (int j = 0; j < NBATCH; ++j) { const int r = r0 + j * rstride; if (r >= T) break;
            const int b = r >> 12;
            if (mode != 0) { const float* gt2 = mod + ((size_t)(l - 1) * NB + b) * 6144 + 5120;
#pragma unroll
                for (int i = 0; i < 4; ++i) { const int col = 4 * X.lane + 256 * i; const f32x4 g = *(const f32x4*)(gt2 + col); const u32x2 a = fa[j][i], bb = fb[j][i];
                    f32x4 f; f[0] = lo_bf(a.x) + lo_bf(bb.x); f[1] = hi_bf(a.x) + hi_bf(bb.x); f[2] = lo_bf(a.y) + lo_bf(bb.y); f[3] = hi_bf(a.y) + hi_bf(bb.y);
                    xv[j][i] = xv[j][i] + g * f * fscale; } }
            if (mode != 0) {
#pragma unroll
                for (int i = 0; i < 4; ++i) *(f32x4*)(out + (size_t)r * 1024 + 4 * X.lane + 256 * i) = xv[j][i]; }
            if (mode == 2) continue;
            float ss = 0.f;
#pragma unroll
            for (int i = 0; i < 4; ++i) ss += xv[j][i][0] * xv[j][i][0] + xv[j][i][1] * xv[j][i][1] + xv[j][i][2] * xv[j][i][2] + xv[j][i][3] * xv[j][i][3];
            ss = wave_sum(ss);
            const float rstd = __builtin_amdgcn_rsqf(ss * (1.f / 1024.f) + EPS);
            const float* md = mod + ((size_t)l * NB + b) * 6144;
#pragma unroll
            for (int i = 0; i < 4; ++i) { const int col = 4 * X.lane + 256 * i;
                const f32x4 g = *(const f32x4*)(g1 + col), sh = *(const f32x4*)(md + col), sc = *(const f32x4*)(md + 1024 + col);
                f32x4 yv = xv[j][i] * rstd * g * (sc + 1.f) + sh;
                u32x2 w; w.x = cvt_pk_bf16(yv[0], yv[1]); w.y = cvt_pk_bf16(yv[2], yv[3]); *(u32x2*)(h + (size_t)r * 1024 + col) = w; }
        }
    }
}

__device__ __forceinline__ void sub_qknorm(const Ctx& X, int l) {
    bf16_t* proj = WSP(bf16_t, WS_PROJ);
    const float* gp = INP(15) + (size_t)l * 128 + 8 * (X.lane & 15);
    float g[8];
#pragma unroll
    for (int i = 0; i < 8; ++i) g[i] = gp[i];
    const int rstride = X.G * 8;
    for (int r0 = X.c * 8 + X.wave; r0 < T; r0 += 4 * rstride) {
        u32x4 lk[4];
#pragma unroll
        for (int q = 0; q < 4; ++q) { const int r = r0 + q * rstride < T ? r0 + q * rstride : r0; lk[q] = *(const u32x4*)(proj + (size_t)r * NP + C_DK + 8 * X.lane); }
#pragma unroll
        for (int q = 0; q < 4; ++q) { const int r = r0 + q * rstride; if (r >= T) break;
            const u32x4 a = lk[q]; float v[8] = {lo_bf(a.x), hi_bf(a.x), lo_bf(a.y), hi_bf(a.y), lo_bf(a.z), hi_bf(a.z), lo_bf(a.w), hi_bf(a.w)};
            float ss = 0.f;
#pragma unroll
            for (int i = 0; i < 8; ++i) ss += v[i] * v[i];
            ss = sum16(ss);
            const float rstd = __builtin_amdgcn_rsqf(ss * (1.f / 128.f) + EPS);
#pragma unroll
            for (int i = 0; i < 8; ++i) v[i] = v[i] * rstd * g[i];
            u32x4 o; o.x = cvt_pk_bf16(v[0], v[1]); o.y = cvt_pk_bf16(v[2], v[3]); o.z = cvt_pk_bf16(v[4], v[5]); o.w = cvt_pk_bf16(v[6], v[7]);
            *(u32x4*)(proj + (size_t)r * NP + C_DK + 8 * X.lane) = o; }
    }
}
__device__ __forceinline__ void sub_vtrans(const Ctx& X) {
    const bf16_t* proj = WSP(bf16_t, WS_PROJ); bf16_t* vt = WSP(bf16_t, WS_VT);
    LAS bf16_t* tile = (LAS bf16_t*)X.lds;
    for (int j0 = X.c; j0 < 2048; j0 += 2 * X.G) {
        u32x4 v[2];
#pragma unroll
        for (int q = 0; q < 2; ++q) { const int j = j0 + q * X.G < 2048 ? j0 + q * X.G : j0; const int bh = j >> 7, et = (j >> 6) & 1, st = j & 63, b = bh >> 2, hh = bh & 3;
            v[q] = *(const u32x4*)(proj + ((size_t)b * SEQ + st * 64 + (X.tid >> 3)) * NP + C_DV + 128 * hh + et * 64 + (X.tid & 7) * 8); }
#pragma unroll
        for (int q = 0; q < 2; ++q) *(LAS u32x4*)(tile + q * 4608 + (X.tid >> 3) * 72 + (X.tid & 7) * 8) = v[q];
        __syncthreads();
#pragma unroll
        for (int q = 0; q < 2; ++q) { const int j = j0 + q * X.G; if (j >= 2048) break; const int bh = j >> 7, et = (j >> 6) & 1, st = j & 63;
          const int e = X.tid >> 3, s8 = (X.tid & 7) * 8; unsigned short w8[8];
#pragma unroll
          for (int i = 0; i < 8; ++i) w8[i] = tile[q * 4608 + ((s8 & ~15) + 4 * ((s8 >> 3) & 1) + (i & 3) + 8 * (i >> 2)) * 72 + e];
          u32x4 w; w.x = w8[0] | ((unsigned)w8[1] << 16); w.y = w8[2] | ((unsigned)w8[3] << 16); w.z = w8[4] | ((unsigned)w8[5] << 16); w.w = w8[6] | ((unsigned)w8[7] << 16);
          *(u32x4*)(vt + ((size_t)bh * 128 + et * 64 + e) * SEQ + st * 64 + s8) = w; }
        __syncthreads();
    }
}

__device__ __forceinline__ void sub_gmlp(const Ctx& X, int l) {
    const bf16_t* proj = WSP(bf16_t, WS_PROJ); bf16_t* y = WSP(bf16_t, WS_Y); const bf16_t* wsb = WSW(bf16_t, WS_WS, l);
    LAS unsigned char* Wg = X.lds; LAS unsigned char* Vn = X.lds + 34816; LAS float* st = (LAS float*)(X.lds + 69632);
    const float* lng = INP(7) + (size_t)l * 512; const float* lnb = INP(8) + (size_t)l * 512; const float* bs = INP(10) + (size_t)l * 512;
    const int r = X.lane & 31, hf = X.lane >> 5;
    for (int u = X.c; u < 512; u += X.G) {
        const int ch = u >> 2, g = u & 3; const size_t t0 = (size_t)ch * 128;
#pragma unroll
        for (int i = 0; i < 4; ++i) { const int q = X.tid + 512 * i, row = q >> 4, cc = q & 15;
            *(LAS u32x4*)(Wg + row * 272 + cc * 16) = *(const u32x4*)(wsb + ((size_t)g * 128 + row) * 128 + cc * 8); }
        { u32x4 av[16];
#pragma unroll
          for (int i = 0; i < 16; ++i) av[i] = *(const u32x4*)(proj + (t0 + X.wave * 16 + i) * NP + C_AV + 8 * X.lane);
#pragma unroll
          for (int i = 0; i < 16; ++i) { const int tt = X.wave * 16 + i; const u32x4 a = av[i];
            float v[8] = {lo_bf(a.x), hi_bf(a.x), lo_bf(a.y), hi_bf(a.y), lo_bf(a.z), hi_bf(a.z), lo_bf(a.w), hi_bf(a.w)};
            float s = 0.f;
#pragma unroll
            for (int k = 0; k < 8; ++k) s += v[k];
            const float mean = wave_sum(s) * (1.f / 512.f);
            float q2 = 0.f;
#pragma unroll
            for (int k = 0; k < 8; ++k) { const float d = v[k] - mean; q2 += d * d; }
            const float rstd = __builtin_amdgcn_rsqf(wave_sum(q2) * (1.f / 512.f) + EPS);
            if (X.lane == 0) { st[2 * tt] = mean; st[2 * tt + 1] = rstd; } } }
        __syncthreads();
#pragma unroll
        for (int i = 0; i < 4; ++i) { const int q = X.tid + 512 * i, tt = q & 127, jb = q >> 7;
            const u32x4 a = *(const u32x4*)(proj + (t0 + tt) * NP + C_AV + 128 * g + 8 * jb);
            const float mean = st[2 * tt], rstd = st[2 * tt + 1];
            float v[8] = {lo_bf(a.x), hi_bf(a.x), lo_bf(a.y), hi_bf(a.y), lo_bf(a.z), hi_bf(a.z), lo_bf(a.w), hi_bf(a.w)};
#pragma unroll
            for (int e = 0; e < 8; ++e) { const int d = 8 * jb + e; const float o = (v[e] - mean) * rstd * lng[128 * g + d] + lnb[128 * g + d];
                *(LAS bf16_t*)(Vn + d * 272 + tt * 2) = f2bf(o); } }
        __syncthreads();
        { const int tb = X.wave >> 1, dh = X.wave & 1;
          f32x16 acc[2]; bf16_t uu[2][16];
#pragma unroll
          for (int nb = 0; nb < 2; ++nb)
#pragma unroll
              for (int k = 0; k < 16; ++k) { acc[nb][k] = 0.f; uu[nb][k] = proj[(t0 + 32 * tb + (k & 3) + 8 * (k >> 2) + 4 * hf) * NP + C_AU + 128 * g + 64 * dh + 32 * nb + r]; }
          const int nks = 2 * (tb + 1);
          for (int ks = 0; ks < nks; ++ks) {
              const bf16x8 a = *(const LAS bf16x8*)(Wg + (32 * tb + r) * 272 + (16 * ks + 8 * hf) * 2);
#pragma unroll
              for (int nb = 0; nb < 2; ++nb) { const bf16x8 b = *(const LAS bf16x8*)(Vn + (64 * dh + 32 * nb + r) * 272 + (16 * ks + 8 * hf) * 2);
                  acc[nb] = __builtin_amdgcn_mfma_f32_32x32x16_bf16(a, b, acc[nb], 0, 0, 0); } }
#pragma unroll
          for (int nb = 0; nb < 2; ++nb)
#pragma unroll
              for (int k = 0; k < 16; ++k) { const int t = 32 * tb + (k & 3) + 8 * (k >> 2) + 4 * hf, d = 64 * dh + 32 * nb + r;
                  y[(t0 + t) * YW + 128 * g + d] = f2bf((acc[nb][k] + bs[g * 128 + t]) * bf2f(uu[nb][k])); } }
        __syncthreads();
    }
}

__device__ __forceinline__ float log_sigmoid_(float z) { return fminf(z, 0.f) - __logf(1.f + __expf(-fabsf(z))); }

__device__ __forceinline__ void sub_gla_local(const Ctx& X, int l) {
    const bf16_t* proj = WSP(bf16_t, WS_PROJ); float* U = WSP(float, WS_SCR); float* dec = WSP(float, WS_DEC);
    LAS float* ga = (LAS float*)X.lds; LAS float* seg = (LAS float*)(X.lds + 4096);
    LAS unsigned char* kkT = X.lds + 8192; LAS unsigned char* vT = X.lds + 17408; LAS unsigned char* kraw = X.lds + 36864;
    const int r = X.lane & 31, hf = X.lane >> 5;
    for (int u = X.c; u < 1024; u += X.G) {
        const int hh = u & 3, cch = (u >> 2) & 63, b = u >> 8; const size_t t0 = (size_t)b * SEQ + cch * 64;
        const int d = X.tid & 63, tq = X.tid >> 6;
        u32x4 lga = {0u, 0u, 0u, 0u}; if (X.tid < 128) lga = *(const u32x4*)(proj + (t0 + (X.tid >> 1)) * NP + C_GA + 8 * (X.tid & 1));
        u32x4 lv[2];
#pragma unroll
        for (int i = 0; i < 2; ++i) { const int q = X.tid + 512 * i, s = q & 63, eb = q >> 6; lv[i] = *(const u32x4*)(proj + (t0 + s) * NP + C_GV + 128 * hh + 8 * eb); }
        const u32x4 lk = *(const u32x4*)(proj + (t0 + (X.tid >> 3)) * NP + C_GK + 64 * hh + 8 * (X.tid & 7));
        float w2[16];
#pragma unroll
        for (int q = 0; q < 16; ++q) w2[q] = INP(11)[((size_t)l * 16 + q) * 256 + hh * 64 + d];
        const float bg = INP(12)[(size_t)l * 256 + hh * 64 + d];
        if (X.tid < 128) { LAS float* gp = ga + (X.tid >> 1) * 16 + 8 * (X.tid & 1);
            gp[0] = lo_bf(lga.x); gp[1] = hi_bf(lga.x); gp[2] = lo_bf(lga.y); gp[3] = hi_bf(lga.y); gp[4] = lo_bf(lga.z); gp[5] = hi_bf(lga.z); gp[6] = lo_bf(lga.w); gp[7] = hi_bf(lga.w); }
#pragma unroll
        for (int i = 0; i < 2; ++i) { const int q = X.tid + 512 * i, s = q & 63, eb = q >> 6; const unsigned w[4] = {lv[i].x, lv[i].y, lv[i].z, lv[i].w};
#pragma unroll
            for (int k = 0; k < 4; ++k) { *(LAS bf16_t*)(vT + (8 * eb + 2 * k) * 144 + s * 2) = (bf16_t)(w[k] & 0xffffu); *(LAS bf16_t*)(vT + (8 * eb + 2 * k + 1) * 144 + s * 2) = (bf16_t)(w[k] >> 16); } }
        *(LAS u32x4*)(kraw + (X.tid >> 3) * 144 + 16 * (X.tid & 7)) = lk;
        __syncthreads();
        float cum[8];
        { float run = 0.f;
#pragma unroll
          for (int i = 0; i < 8; ++i) { const int t = 8 * tq + i; float z = bg;
#pragma unroll
              for (int q = 0; q < 16; ++q) z += ga[t * 16 + q] * w2[q];
              run += log_sigmoid_(z) * (1.f / 16.f); cum[i] = run; }
          seg[tq * 64 + d] = run; }
        __syncthreads();
        { float pre = 0.f, tot = 0.f;
#pragma unroll
          for (int q = 0; q < 8; ++q) { const float s = seg[q * 64 + d]; tot += s; if (q < tq) pre += s; }
          float kk[8];
#pragma unroll
          for (int i = 0; i < 8; ++i) { const int t = 8 * tq + i; const float kv = bf2f(*(const LAS bf16_t*)(kraw + t * 144 + d * 2)); kk[i] = kv * __expf(tot - (pre + cum[i])); }
          u32x4 w; w.x = cvt_pk_bf16(kk[0], kk[1]); w.y = cvt_pk_bf16(kk[2], kk[3]); w.z = cvt_pk_bf16(kk[4], kk[5]); w.w = cvt_pk_bf16(kk[6], kk[7]);
          *(LAS u32x4*)(kkT + d * 144 + 16 * tq) = w;
          if (tq == 0) dec[(size_t)u * 64 + d] = __expf(tot); }
        __syncthreads();
        { const int db = X.wave >> 2, eb = X.wave & 3; f32x16 acc;
#pragma unroll
          for (int k = 0; k < 16; ++k) acc[k] = 0.f;
#pragma unroll
          for (int ks = 0; ks < 4; ++ks) { const bf16x8 a = *(const LAS bf16x8*)(kkT + (32 * db + r) * 144 + (16 * ks + 8 * hf) * 2);
              const bf16x8 bb = *(const LAS bf16x8*)(vT + (32 * eb + r) * 144 + (16 * ks + 8 * hf) * 2);
              acc = __builtin_amdgcn_mfma_f32_32x32x16_bf16(a, bb, acc, 0, 0, 0); }
#pragma unroll
          for (int k = 0; k < 16; ++k) { const int dd = 32 * db + (k & 3) + 8 * (k >> 2) + 4 * hf; U[((size_t)u * 64 + dd) * 128 + 32 * eb + r] = acc[k]; } }
        __syncthreads();
    }
}

__device__ __forceinline__ void sub_gla_scan(const Ctx& X) {
    const float* U = WSP(float, WS_SCR); bf16_t* Sb = WSP(bf16_t, WS_SCR + (size_t)T * 1024 * 2); const float* dec = WSP(float, WS_DEC);
    for (int gid = X.c * 512 + X.tid; gid < 16 * 8192; gid += X.G * 512) {
        const int bh = gid >> 13, de = gid & 8191, d = de >> 7, b = bh >> 2, hh = bh & 3;
        float S = 0.f;
        for (int cb = 0; cb < 4; ++cb) {
            float uv[16], dc[16];
#pragma unroll
            for (int j = 0; j < 16; ++j) { const size_t u = (size_t)b * 256 + (cb * 16 + j) * 4 + hh; uv[j] = U[u * 8192 + de]; dc[j] = dec[u * 64 + d]; }
#pragma unroll
            for (int j = 0; j < 16; ++j) { const size_t u = (size_t)b * 256 + (cb * 16 + j) * 4 + hh; Sb[u * 8192 + de] = f2bf(S); S = dc[j] * S + uv[j]; }
        }
    }
}

__device__ __forceinline__ void sub_gla_out(const Ctx& X, int l) {
    const bf16_t* proj = WSP(bf16_t, WS_PROJ); const bf16_t* Sg = WSP(bf16_t, WS_SCR + (size_t)T * 1024 * 2); bf16_t* y = WSP(bf16_t, WS_Y);
    LAS float* ga = (LAS float*)X.lds; LAS float* seg = (LAS float*)(X.lds + 4096);
    LAS unsigned char* qq = X.lds + 8192; LAS unsigned char* qS = X.lds + 17408; LAS unsigned char* kk2 = X.lds + 26624;
    LAS unsigned char* vT = X.lds + 35840; LAS unsigned char* ST = X.lds + 54272; LAS unsigned char* at = X.lds + 72704; LAS float* ob = (LAS float*)(X.lds + 81920);
    LAS unsigned char* qraw = at; LAS unsigned char* kraw = X.lds + 81920;
    const int r = X.lane & 31, hf = X.lane >> 5;
    for (int u = X.c; u < 1024; u += X.G) {
        const int hh = u & 3, cch = (u >> 2) & 63, b = u >> 8; const size_t t0 = (size_t)b * SEQ + cch * 64;
        const int d = X.tid & 63, tq = X.tid >> 6;
        u32x4 lga = {0u, 0u, 0u, 0u}; if (X.tid < 128) lga = *(const u32x4*)(proj + (t0 + (X.tid >> 1)) * NP + C_GA + 8 * (X.tid & 1));
        u32x4 lv[2]; u32x4 ls[2];
#pragma unroll
        for (int i = 0; i < 2; ++i) { const int q = X.tid + 512 * i, s = q & 63, eb = q >> 6; lv[i] = *(const u32x4*)(proj + (t0 + s) * NP + C_GV + 128 * hh + 8 * eb); }
#pragma unroll
        for (int i = 0; i < 2; ++i) ls[i] = *(const u32x4*)(Sg + (size_t)u * 8192 + 8 * X.tid + 4096 * i);
        const u32x4 lq = *(const u32x4*)(proj + (t0 + (X.tid >> 3)) * NP + C_GQ + 64 * hh + 8 * (X.tid & 7));
        const u32x4 lk = *(const u32x4*)(proj + (t0 + (X.tid >> 3)) * NP + C_GK + 64 * hh + 8 * (X.tid & 7));
        const bf16_t* rp = proj + (t0 + (X.tid >> 3)) * NP + C_GR + 128 * hh + 16 * (X.tid & 7);
        const u32x4 ra = *(const u32x4*)rp, rb = *(const u32x4*)(rp + 8);
        float w2[16];
#pragma unroll
        for (int q = 0; q < 16; ++q) w2[q] = INP(11)[((size_t)l * 16 + q) * 256 + hh * 64 + d];
        const float bg = INP(12)[(size_t)l * 256 + hh * 64 + d];
        if (X.tid < 128) { LAS float* gp = ga + (X.tid >> 1) * 16 + 8 * (X.tid & 1);
            gp[0] = lo_bf(lga.x); gp[1] = hi_bf(lga.x); gp[2] = lo_bf(lga.y); gp[3] = hi_bf(lga.y); gp[4] = lo_bf(lga.z); gp[5] = hi_bf(lga.z); gp[6] = lo_bf(lga.w); gp[7] = hi_bf(lga.w); }
#pragma unroll
        for (int i = 0; i < 2; ++i) { const int q = X.tid + 512 * i, s = q & 63, eb = q >> 6; const unsigned w[4] = {lv[i].x, lv[i].y, lv[i].z, lv[i].w};
#pragma unroll
            for (int k = 0; k < 4; ++k) { *(LAS bf16_t*)(vT + (8 * eb + 2 * k) * 144 + s * 2) = (bf16_t)(w[k] & 0xffffu); *(LAS bf16_t*)(vT + (8 * eb + 2 * k + 1) * 144 + s * 2) = (bf16_t)(w[k] >> 16); } }
#pragma unroll
        for (int i = 0; i < 2; ++i) { const int q = 8 * X.tid + 4096 * i, dd = q >> 7, e = q & 127; const unsigned w[4] = {ls[i].x, ls[i].y, ls[i].z, ls[i].w};
#pragma unroll
            for (int k = 0; k < 4; ++k) { *(LAS bf16_t*)(ST + (e + 2 * k) * 144 + dd * 2) = (bf16_t)(w[k] & 0xffffu); *(LAS bf16_t*)(ST + (e + 2 * k + 1) * 144 + dd * 2) = (bf16_t)(w[k] >> 16); } }
        *(LAS u32x4*)(qraw + (X.tid >> 3) * 144 + 16 * (X.tid & 7)) = lq; *(LAS u32x4*)(kraw + (X.tid >> 3) * 144 + 16 * (X.tid & 7)) = lk;
        __syncthreads();
        float cum[8];
        { float run = 0.f;
#pragma unroll
          for (int i = 0; i < 8; ++i) { const int t = 8 * tq + i; float z = bg;
#pragma unroll
              for (int q = 0; q < 16; ++q) z += ga[t * 16 + q] * w2[q];
              run += log_sigmoid_(z) * (1.f / 16.f); cum[i] = run; }
          seg[tq * 64 + d] = run; }
        __syncthreads();
        { float pre = 0.f, bref = 0.f;
#pragma unroll
          for (int q = 0; q < 8; ++q) { const float s = seg[q * 64 + d]; if (q < tq) pre += s; if (q < 4) bref += s; }
          float qv[8], kv[8];
#pragma unroll
          for (int i = 0; i < 8; ++i) { const int t = 8 * tq + i; qv[i] = bf2f(*(const LAS bf16_t*)(qraw + t * 144 + d * 2)) * 0.125f; kv[i] = bf2f(*(const LAS bf16_t*)(kraw + t * 144 + d * 2)); }
#pragma unroll
          for (int i = 0; i < 8; ++i) { const int t = 8 * tq + i; const float bt = pre + cum[i];
              *(LAS bf16_t*)(qq + t * 144 + d * 2) = f2bf(qv[i] * __expf(bt - bref));
              *(LAS bf16_t*)(qS + t * 144 + d * 2) = f2bf(qv[i] * __expf(bt));
              *(LAS bf16_t*)(kk2 + t * 144 + d * 2) = f2bf(kv[i] * __expf(bref - bt)); } }
        __syncthreads();
        if (X.wave < 4) { const int tb = X.wave >> 1, sb = X.wave & 1; f32x16 acc;
#pragma unroll
            for (int k = 0; k < 16; ++k) acc[k] = 0.f;
#pragma unroll
            for (int ks = 0; ks < 4; ++ks) { const bf16x8 a = *(const LAS bf16x8*)(qq + (32 * tb + r) * 144 + (16 * ks + 8 * hf) * 2);
                const bf16x8 bb = *(const LAS bf16x8*)(kk2 + (32 * sb + r) * 144 + (16 * ks + 8 * hf) * 2);
                acc = __builtin_amdgcn_mfma_f32_32x32x16_bf16(a, bb, acc, 0, 0, 0); }
#pragma unroll
            for (int k = 0; k < 16; ++k) { const int t = 32 * tb + (k & 3) + 8 * (k >> 2) + 4 * hf, s = 32 * sb + r;
                *(LAS bf16_t*)(at + t * 144 + s * 2) = f2bf(s <= t ? acc[k] : 0.f); } }
        __syncthreads();
        { const int tb = X.wave >> 2, eb = X.wave & 3; f32x16 acc;
#pragma unroll
          for (int k = 0; k < 16; ++k) acc[k] = 0.f;
#pragma unroll
          for (int ks = 0; ks < 4; ++ks) { const bf16x8 a = *(const LAS bf16x8*)(qS + (32 * tb + r) * 144 + (16 * ks + 8 * hf) * 2);
              const bf16x8 bb = *(const LAS bf16x8*)(ST + (32 * eb + r) * 144 + (16 * ks + 8 * hf) * 2);
              acc = __builtin_amdgcn_mfma_f32_32x32x16_bf16(a, bb, acc, 0, 0, 0); }
#pragma unroll
          for (int ks = 0; ks < 4; ++ks) { const bf16x8 a = *(const LAS bf16x8*)(at + (32 * tb + r) * 144 + (16 * ks + 8 * hf) * 2);
              const bf16x8 bb = *(const LAS bf16x8*)(vT + (32 * eb + r) * 144 + (16 * ks + 8 * hf) * 2);
              acc = __builtin_amdgcn_mfma_f32_32x32x16_bf16(a, bb, acc, 0, 0, 0); }
#pragma unroll
          for (int k = 0; k < 16; ++k) { const int t = 32 * tb + (k & 3) + 8 * (k >> 2) + 4 * hf; ob[t * 132 + 32 * eb + r] = acc[k]; } }
        __syncthreads();
        { const int t = X.tid >> 3, j = X.tid & 7; float o[16]; float ss = 0.f;
#pragma unroll
          for (int i = 0; i < 16; ++i) { o[i] = ob[t * 132 + 16 * j + i]; ss += o[i] * o[i]; }
          ss = sum8(ss);
          const float rstd = __builtin_amdgcn_rsqf(ss * (1.f / 128.f) + EPS);
          const float* gn = INP(13) + (size_t)l * 128 + 16 * j;
          const unsigned rw[8] = {ra.x, ra.y, ra.z, ra.w, rb.x, rb.y, rb.z, rb.w};
          unsigned pk[8];
#pragma unroll
          for (int i = 0; i < 8; ++i) { const float r0 = lo_bf(rw[i]), r1 = hi_bf(rw[i]);
              const float v0 = o[2 * i] * rstd * gn[2 * i] * (r0 * sigmoidf_(r0)), v1 = o[2 * i + 1] * rstd * gn[2 * i + 1] * (r1 * sigmoidf_(r1));
              pk[i] = cvt_pk_bf16(v0, v1); }
          bf16_t* yp = y + (t0 + t) * YW + 512 + 128 * hh + 16 * j;
          *(u32x4*)yp = (u32x4){pk[0], pk[1], pk[2], pk[3]}; *(u32x4*)(yp + 8) = (u32x4){pk[4], pk[5], pk[6], pk[7]}; }
        __syncthreads();
    }
}

__device__ __forceinline__ unsigned score_code(float sc) {
    const unsigned ub = __float_as_uint(sc); unsigned t = (ub & 0x7fffffffu) >> 13;
    t = t < (107u << 10) ? (107u << 10) : t; t -= (107u << 10); t = t > 32766u ? 32766u : t;
    return (ub >> 31) ? (0x7fffu - t) : (0x8000u | t);
}
template <bool PACKED16>
__device__ __forceinline__ void find_digit(const LAS unsigned* hist, int lane, unsigned K, unsigned& digit, unsigned& above) {
    unsigned hb[4];
    if (PACKED16) { const unsigned h0 = hist[(2 * lane) * 16], h1 = hist[(2 * lane + 1) * 16]; hb[0] = h0 & 0xffffu; hb[1] = h0 >> 16; hb[2] = h1 & 0xffffu; hb[3] = h1 >> 16; }
    else { const u32x4 h4 = *(const LAS u32x4*)(hist + 4 * lane); hb[0] = h4.x; hb[1] = h4.y; hb[2] = h4.z; hb[3] = h4.w; }
    const unsigned s = hb[0] + hb[1] + hb[2] + hb[3];
    int v = (int)s;
    v += __builtin_amdgcn_update_dpp(0, v, 0x111, 0xf, 0xf, true); v += __builtin_amdgcn_update_dpp(0, v, 0x112, 0xf, 0xf, true);
    v += __builtin_amdgcn_update_dpp(0, v, 0x114, 0xf, 0xf, true); v += __builtin_amdgcn_update_dpp(0, v, 0x118, 0xf, 0xf, true);
    v += __builtin_amdgcn_update_dpp(0, v, 0x142, 0xa, 0xf, false); v += __builtin_amdgcn_update_dpp(0, v, 0x143, 0xc, 0xf, false);
    const unsigned total = (unsigned)__builtin_amdgcn_readlane(v, 63);
    unsigned run = total - (unsigned)v, dg = 0, ab = 0; bool found = false;
#pragma unroll
    for (int bi = 3; bi >= 0; --bi) { if (!found && run < K && run + hb[bi] >= K) { found = true; dg = 4 * lane + bi; ab = run; } run += hb[bi]; }
    const unsigned long long m = __ballot(found);
    const int src = m ? (int)__builtin_ctzll(m) : 0;
    digit = (unsigned)__builtin_amdgcn_readlane((int)dg, src); above = (unsigned)__builtin_amdgcn_readlane((int)ab, src);
}
__device__ __forceinline__ void sub_dsa_select(const Ctx& X) {
    const bf16_t* proj = WSP(bf16_t, WS_PROJ); unsigned long long* mask = WSP(unsigned long long, WS_MASK);
    LAS bf16_t* keys = (LAS bf16_t*)X.lds;
    LAS unsigned* hist1 = (LAS unsigned*)(X.lds + AUX_OFF + 1024);
    LAS unsigned* hist2 = (LAS unsigned*)(X.lds + AUX_OFF + 1024 + 8192) + X.wave * 512;
    const int lane = X.lane;
    for (int u0 = X.c; u0 < 1024; u0 += X.G) {
        const int rnd = u0 / X.G, u = (rnd & 1) ? (rnd + 1) * X.G - 1 - (u0 - rnd * X.G) : u0;
        if (u >= 1024) continue;
        const int b = u & 3, qb = 255 - (u >> 2); const size_t tg0 = (size_t)b * SEQ;
        if (qb < 16) {
#pragma unroll
            for (int rr = 0; rr < 2; ++rr) { const int t = 16 * qb + 2 * X.wave + rr; const int rem = t - 64 * lane;
                const unsigned long long w = rem >= 63 ? ~0ull : (rem < 0 ? 0ull : ((2ull << rem) - 1ull));
                mask[(tg0 + t) * 64 + lane] = w; }
            continue;
        }
        const int nk = 16 * (qb + 1), nkp = (nk + 63) & ~63, ntile = nkp >> 4, nwords = nkp >> 6;
        REP(21) {
        *(LAS u32x4*)(hist1 + 4 * X.tid) = (u32x4){0u, 0u, 0u, 0u};
        __syncthreads();
        {
            const int q = lane & 15, kg = lane >> 4; const size_t qrow = (tg0 + 16 * qb + q) * NP;
            bf16x8 Bq[4][2]; float iw[4];
#pragma unroll
            for (int hh = 0; hh < 4; ++hh) { iw[hh] = bf2f(proj[qrow + C_IW + hh]);
#pragma unroll
                for (int ks = 0; ks < 2; ++ks) Bq[hh][ks] = *(const bf16x8*)(proj + qrow + C_IQ + 64 * hh + 32 * ks + 8 * kg); }
            const int tq = 16 * qb + q;
            const bf16_t* kbase = proj + (tg0 + q) * NP + C_IK + 8 * kg;
            for (int jb = X.wave; jb < ntile; jb += 64) {
                bf16x8 Ax[4][2], Ay[4][2];
#pragma unroll
                for (int i = 0; i < 4; ++i) { int j = jb + 8 * i; j = j > 255 ? 255 : j; Ax[i][0] = *(const bf16x8*)(kbase + (size_t)(16 * j) * NP); Ax[i][1] = *(const bf16x8*)(kbase + (size_t)(16 * j) * NP + 32); }
#pragma unroll
                for (int i = 0; i < 4; ++i) { int j = jb + 32 + 8 * i; j = j > 255 ? 255 : j; Ay[i][0] = *(const bf16x8*)(kbase + (size_t)(16 * j) * NP); Ay[i][1] = *(const bf16x8*)(kbase + (size_t)(16 * j) * NP + 32); }
#pragma unroll
                for (int i2 = 0; i2 < 8; ++i2) { const int i = i2 & 3; const int j = jb + 8 * i2;
                    {
                        const bf16x8 A0 = i2 < 4 ? Ax[i][0] : Ay[i][0], A1 = i2 < 4 ? Ax[i][1] : Ay[i][1];
                        f32x4 sc = {0.f, 0.f, 0.f, 0.f};
#pragma unroll
                        for (int hh = 0; hh < 4; ++hh) { f32x4 a = {0.f, 0.f, 0.f, 0.f};
                            a = __builtin_amdgcn_mfma_f32_16x16x32_bf16(A0, Bq[hh][0], a, 0, 0, 0);
                            a = __builtin_amdgcn_mfma_f32_16x16x32_bf16(A1, Bq[hh][1], a, 0, 0, 0);
#pragma unroll
                            for (int k = 0; k < 4; ++k) sc[k] += iw[hh] * fmaxf(a[k], 0.f); }
                        unsigned kk[4];
#pragma unroll
                        for (int k = 0; k < 4; ++k) { const int key = 16 * j + 4 * kg + k; const unsigned code = score_code(sc[k]);
                            const bool adm = key <= tq; kk[k] = adm ? code : 0u;
                            if (adm) atomicAdd((unsigned*)(hist1 + (code >> 9) * 16 + q), (code & 0x100u) ? 0x10000u : 1u); }
                        u32x2 w; w.x = kk[0] | (kk[1] << 16); w.y = kk[2] | (kk[3] << 16);
                        if (j < ntile) *(LAS u32x2*)(keys + q * 4104 + 16 * j + 4 * kg) = w; } }
            }
        }
        __syncthreads();
        }
        {
            const int t0r = 16 * qb + 2 * X.wave;
            const LAS bf16_t* krow[2] = {keys + (2 * X.wave) * 4104 + lane, keys + (2 * X.wave + 1) * 4104 + lane};
            LAS unsigned* h2[2] = {hist2, hist2 + 256};
            unsigned d1[2], ab1[2], d2[2], ab2[2];
#pragma unroll
            for (int q = 0; q < 2; ++q) { find_digit<true>(hist1 + 2 * X.wave + q, lane, 256u, d1[q], ab1[q]); *(LAS u32x4*)(h2[q] + 4 * lane) = (u32x4){0u, 0u, 0u, 0u}; }
            asm volatile("s_waitcnt lgkmcnt(0)" ::: "memory");
            for (int w0 = 0; w0 < nwords; w0 += 8) { unsigned k8[2][8];
#pragma unroll
                for (int i = 0; i < 8; ++i) { k8[0][i] = krow[0][64 * ((w0 + i) & 63)]; k8[1][i] = krow[1][64 * ((w0 + i) & 63)]; }
#pragma unroll
                for (int i = 0; i < 8; ++i)
#pragma unroll
                    for (int q = 0; q < 2; ++q) { const unsigned k = k8[q][i]; if (w0 + i < nwords && (k >> 8) == d1[q]) atomicAdd((unsigned*)(h2[q] + (k & 255u)), 1u); } }
            asm volatile("s_waitcnt lgkmcnt(0)" ::: "memory");
#pragma unroll
            for (int q = 0; q < 2; ++q) find_digit<false>(h2[q], lane, 256u - ab1[q], d2[q], ab2[q]);
            asm volatile("s_waitcnt lgkmcnt(0)" ::: "memory");
            unsigned vstar[2], need[2], mylo[2] = {0u, 0u}, myhi[2] = {0u, 0u};
#pragma unroll
            for (int q = 0; q < 2; ++q) { vstar[q] = (d1[q] << 8) | d2[q]; need[q] = 256u - ab1[q] - ab2[q]; }
            for (int w0 = 0; w0 < nwords; w0 += 8) { unsigned k8[2][8];
#pragma unroll
              for (int i = 0; i < 8; ++i) { k8[0][i] = krow[0][64 * ((w0 + i) & 63)]; k8[1][i] = krow[1][64 * ((w0 + i) & 63)]; }
#pragma unroll
              for (int i = 0; i < 8; ++i)
#pragma unroll
                for (int q = 0; q < 2; ++q) { const int w = w0 + i; const unsigned k = w < nwords ? k8[q][i] : 0u;
                  const unsigned long long gt = __ballot(k > vstar[q]); unsigned long long eq = __ballot(k == vstar[q]);
                  const unsigned ne = (unsigned)__builtin_popcountll(eq);
                  if (ne > need[q]) { unsigned long long e = eq, rsel = 0ull; for (unsigned ii = 0; ii < need[q]; ++ii) { const unsigned long long bbit = e & (0ull - e); rsel |= bbit; e ^= bbit; } eq = rsel; need[q] = 0u; }
                  else need[q] -= ne;
                  const unsigned long long sel = gt | eq;
                  if (lane == w) { mylo[q] = (unsigned)sel; myhi[q] = (unsigned)(sel >> 32); } } }
#pragma unroll
            for (int q = 0; q < 2; ++q) { const int t = t0r + q; const int rem = t - 64 * lane;
                const unsigned long long cm = rem >= 63 ? ~0ull : (rem < 0 ? 0ull : ((2ull << rem) - 1ull));
                mask[(tg0 + t) * 64 + lane] = lane < nwords ? ((((unsigned long long)myhi[q] << 32) | mylo[q]) & cm) : 0ull; }
        }
        __syncthreads();
    }
}

__device__ __forceinline__ void attn_dma(const int st, const int wave, const int lane, const bf16_t* kglob, const bf16_t* vglob, const unsigned long long* mglob, LAS unsigned char* kv, LAS unsigned char* mb) {
#pragma unroll
    for (int i = 0; i < 4; ++i) { const int L = (wave * 4 + i) * 64 + lane, row = L >> 4, c = (L & 15) ^ (row & 15);
        __builtin_amdgcn_global_load_lds((const unsigned*)(kglob + (size_t)(128 * st + row) * NP + 8 * c), (LAS unsigned*)(kv + (wave * 4 + i) * 1024), 16, 0, 0);
        __builtin_amdgcn_global_load_lds((const unsigned*)(vglob + (size_t)row * SEQ + 128 * st + 8 * c), (LAS unsigned*)(kv + 32768 + (wave * 4 + i) * 1024), 16, 0, 0); }
    if (wave < 2) __builtin_amdgcn_global_load_lds((const unsigned*)(mglob + (size_t)(wave * 64 + lane) * 64 + 2 * st), (LAS unsigned*)(mb + wave * 1024), 16, 0, 0);
}
template <bool FAR>
__device__ __forceinline__ void attn_tile(const int st, const int r, const int hf, const int g, const int wq, const int tq, const float scale2,
                                          const LAS unsigned char* Ks, const LAS unsigned char* Vs, const LAS unsigned char* mb, const LAS float* bt,
                                          const bf16x8 (&Qf)[8], f32x16 (&O)[4], float& mrun, float& lrun) {
    const unsigned long long mw = *(const LAS unsigned long long*)(mb + (32 * wq + r) * 16 + 8 * g) >> (4 * hf);
    const unsigned mlo = (unsigned)mw, mhi = (unsigned)(mw >> 32);
    f32x16 S[2];
#pragma unroll
    for (int kb = 0; kb < 2; ++kb) {
#pragma unroll
        for (int k = 0; k < 16; ++k) S[kb][k] = 0.f;
        const int row = 64 * g + 32 * kb + r;
#pragma unroll
        for (int ks = 0; ks < 8; ++ks) { const bf16x8 a = *(const LAS bf16x8*)(Ks + row * 256 + (((2 * ks + hf) ^ (row & 15)) << 4));
            S[kb] = __builtin_amdgcn_mfma_f32_32x32x16_bf16(a, Qf[ks], S[kb], 0, 0, 0); } }
    const int kg0 = 128 * st + 64 * g;
    float mx = -1e30f;
    const float bfar = bt[128];
#pragma unroll
    for (int kb = 0; kb < 2; ++kb)
#pragma unroll
        for (int k = 0; k < 16; ++k) { const int ko = 32 * kb + (k & 3) + 8 * (k >> 2); const int sel = __builtin_amdgcn_sbfe((int)(kb ? mhi : mlo), (k & 3) + 8 * (k >> 2), 1);
            float bias = bfar;
            if (!FAR) { int rel = tq - (kg0 + ko + 4 * hf); rel = rel < 0 ? 0 : (rel > 128 ? 128 : rel); bias = bt[rel]; }
            const float lg = __uint_as_float((__float_as_uint(S[kb][k] * scale2 + bias) & (unsigned)sel) | (~(unsigned)sel & 0xff800000u)); S[kb][k] = lg; mx = fmaxf(mx, lg); }
    mx = max_x32(mx);
    if (__ballot(mx > mrun + 8.f) != 0ull) {
        const float mnew = fmaxf(mrun, mx), alpha = __builtin_amdgcn_exp2f(mrun - mnew);
        lrun *= alpha; mrun = mnew;
#pragma unroll
        for (int eb = 0; eb < 4; ++eb)
#pragma unroll
            for (int k = 0; k < 16; ++k) O[eb][k] *= alpha;
    }
    float ps = 0.f;
#pragma unroll
    for (int kb = 0; kb < 2; ++kb)
#pragma unroll
        for (int k = 0; k < 16; ++k) { const float p = __builtin_amdgcn_exp2f(S[kb][k] - mrun); S[kb][k] = p; ps += p; }
    ps = sum_x32(ps);
    lrun += ps;
#pragma unroll
    for (int kb = 0; kb < 2; ++kb)
#pragma unroll
        for (int s = 0; s < 2; ++s) {
            union { bf16x8 v; unsigned w[4]; } P;
#pragma unroll
            for (int j = 0; j < 4; ++j) P.w[j] = cvt_pk_bf16(S[kb][8 * s + 2 * j], S[kb][8 * s + 2 * j + 1]);
#pragma unroll
            for (int eb = 0; eb < 4; ++eb) { const int row = 32 * eb + r;
                const bf16x8 a = *(const LAS bf16x8*)(Vs + row * 256 + (((8 * g + 4 * kb + 2 * s + hf) ^ (row & 15)) << 4));
                O[eb] = __builtin_amdgcn_mfma_f32_32x32x16_bf16(a, P.v, O[eb], 0, 0, 0); } }
}
__device__ __forceinline__ void sub_dsa_attn(const Ctx& X, int l) {
    const bf16_t* proj = WSP(bf16_t, WS_PROJ); const bf16_t* vtg = WSP(bf16_t, WS_VT); const unsigned long long* mask = WSP(unsigned long long, WS_MASK);
    bf16_t* y = WSP(bf16_t, WS_Y); const float* relb = INP(16);
    LAS unsigned char* KV = X.lds;
    LAS unsigned char* MB = X.lds + AUX_OFF + 1024;
    LAS float* bt = (LAS float*)(X.lds + AUX_OFF + 1024 + 4096);
    LAS float* Ox = (LAS float*)X.lds; LAS float* MLx = (LAS float*)(X.lds + 65536);
    const int lane = X.lane, r = lane & 31, hf = lane >> 5, g = X.wave >> 2, wq = X.wave & 3;
    const float scale2 = 0.08838834764831845f * 1.4426950408889634f;
    for (int u = X.c; u < 512; u += X.G) {
        const int bh = u & 15, qt = u < 256 ? 31 - (u >> 4) : ((u - 256) >> 4), b = bh >> 2, hh = bh & 3;
        const size_t tg0 = (size_t)b * SEQ; const int q0 = 128 * qt, tq = q0 + 32 * wq + r;
        if (X.tid < 129) { const int n = X.tid; int bk;
            if (n < 16) bk = n; else { bk = 16 + (int)(__logf((float)n * (1.f / 16.f)) / 2.0794415416798357f * 16.f); bk = bk > 31 ? 31 : bk; }
            bt[n] = relb[bk * 4 + hh] * 1.4426950408889634f; }
        bf16x8 Qf[8];
        {
            union { bf16x8 v; unsigned w[4]; } qr[8]; float ss = 0.f;
#pragma unroll
            for (int ks = 0; ks < 8; ++ks) { qr[ks].v = *(const bf16x8*)(proj + (tg0 + tq) * NP + C_DQ + 128 * hh + 16 * ks + 8 * hf);
#pragma unroll
                for (int j = 0; j < 4; ++j) { const float a = lo_bf(qr[ks].w[j]), bq = hi_bf(qr[ks].w[j]); ss += a * a + bq * bq; } }
            ss = sum_x32(ss);
            const float rstd = __builtin_amdgcn_rsqf(ss * (1.f / 128.f) + EPS);
            const float* qg = INP(14) + (size_t)l * 128 + 8 * hf;
#pragma unroll
            for (int ks = 0; ks < 8; ++ks) { const f32x4 g0 = *(const f32x4*)(qg + 16 * ks), g1 = *(const f32x4*)(qg + 16 * ks + 4);
                qr[ks].w[0] = cvt_pk_bf16(lo_bf(qr[ks].w[0]) * rstd * g0[0], hi_bf(qr[ks].w[0]) * rstd * g0[1]);
                qr[ks].w[1] = cvt_pk_bf16(lo_bf(qr[ks].w[1]) * rstd * g0[2], hi_bf(qr[ks].w[1]) * rstd * g0[3]);
                qr[ks].w[2] = cvt_pk_bf16(lo_bf(qr[ks].w[2]) * rstd * g1[0], hi_bf(qr[ks].w[2]) * rstd * g1[1]);
                qr[ks].w[3] = cvt_pk_bf16(lo_bf(qr[ks].w[3]) * rstd * g1[2], hi_bf(qr[ks].w[3]) * rstd * g1[3]);
                Qf[ks] = qr[ks].v; } }
        f32x16 O[4];
#pragma unroll
        for (int eb = 0; eb < 4; ++eb)
#pragma unroll
            for (int k = 0; k < 16; ++k) O[eb][k] = 0.f;
        float mrun = -1e30f, lrun = 0.f;
        const bf16_t* kglob = proj + tg0 * NP + C_DK + 128 * hh; const bf16_t* vglob = vtg + (size_t)bh * 128 * SEQ; const unsigned long long* mglob = mask + (tg0 + q0) * 64;
        const int nfar = qt - 1;
        attn_dma(0, X.wave, lane, kglob, vglob, mglob, KV, MB);
        for (int st = 0; st < nfar; ++st) {
            asm volatile("s_waitcnt vmcnt(0)" ::: "memory"); __syncthreads();
            attn_dma(st + 1, X.wave, lane, kglob, vglob, mglob, KV + ((st + 1) & 1) * 65536, MB + ((st + 1) & 1) * 2048);
            const LAS unsigned char* kvb = KV + (st & 1) * 65536;
            attn_tile<true>(st, r, hf, g, wq, tq, scale2, kvb, kvb + 32768, MB + (st & 1) * 2048, bt, Qf, O, mrun, lrun);
        }
        for (int st = nfar < 0 ? 0 : nfar; st <= qt; ++st) {
            asm volatile("s_waitcnt vmcnt(0)" ::: "memory"); __syncthreads();
            if (st < qt) attn_dma(st + 1, X.wave, lane, kglob, vglob, mglob, KV + ((st + 1) & 1) * 65536, MB + ((st + 1) & 1) * 2048);
            const LAS unsigned char* kvb = KV + (st & 1) * 65536;
            attn_tile<false>(st, r, hf, g, wq, tq, scale2, kvb, kvb + 32768, MB + (st & 1) * 2048, bt, Qf, O, mrun, lrun);
        }
        __syncthreads();
        if (g == 1) {
#pragma unroll
            for (int eb = 0; eb < 4; ++eb)
#pragma unroll
                for (int k = 0; k < 16; ++k) Ox[((wq * 4 + eb) * 16 + k) * 64 + lane] = O[eb][k];
            MLx[(wq * 64 + lane) * 2] = mrun; MLx[(wq * 64 + lane) * 2 + 1] = lrun; }
        __syncthreads();
        if (g == 0) {
            const float m1 = MLx[(wq * 64 + lane) * 2], l1 = MLx[(wq * 64 + lane) * 2 + 1];
            const float m = fmaxf(mrun, m1), a0 = __builtin_amdgcn_exp2f(mrun - m), a1 = __builtin_amdgcn_exp2f(m1 - m);
            const float inv = 1.f / (lrun * a0 + l1 * a1);
#pragma unroll
            for (int eb = 0; eb < 4; ++eb)
#pragma unroll
                for (int k4 = 0; k4 < 4; ++k4) { float o[4];
#pragma unroll
                    for (int j = 0; j < 4; ++j) { const int k = 4 * k4 + j; o[j] = (O[eb][k] * a0 + Ox[((wq * 4 + eb) * 16 + k) * 64 + lane] * a1) * inv; }
                    u32x2 w; w.x = cvt_pk_bf16(o[0], o[1]); w.y = cvt_pk_bf16(o[2], o[3]);
                    *(u32x2*)(y + (tg0 + tq) * YW + 1024 + 128 * hh + 32 * eb + 8 * k4 + 4 * hf) = w; } }
        __syncthreads();
    }
}

__device__ __forceinline__ void phase_norm2(const Ctx& X, int l) {
    const float* out = X.out; const float* mod = WSP(float, WS_MOD); bf16_t* h = WSP(bf16_t, WS_H);
    int* toke = WSP(int, WS_TOKE); float* tokw = WSP(float, WS_TOKW); unsigned* cntb = WSP(unsigned, WS_CNT);
    LAS float* WT = (LAS float*)X.lds;
    LAS unsigned* cnt = (LAS unsigned*)(X.lds + AUX_OFF + 1024);
    const float* wg = INP(20) + (size_t)l * 4096; const float* wr = INP(22) + (size_t)l * 16384;
    { f32x4 a[2], b[8];
#pragma unroll
      for (int i = 0; i < 2; ++i) a[i] = *(const f32x4*)(wg + 4 * (X.tid + 512 * i));
#pragma unroll
      for (int i = 0; i < 8; ++i) b[i] = *(const f32x4*)(wr + 4 * (X.tid + 512 * i));
#pragma unroll
      for (int i = 0; i < 2; ++i) { const int e0 = 4 * (X.tid + 512 * i);
#pragma unroll
          for (int k = 0; k < 4; ++k) WT[((e0 + k) & 3) * 1024 + ((e0 + k) >> 2)] = a[i][k]; }
#pragma unroll
      for (int i = 0; i < 8; ++i) { const int e0 = 4 * (X.tid + 512 * i);
#pragma unroll
          for (int k = 0; k < 4; ++k) WT[(4 + ((e0 + k) & 15)) * 1024 + ((e0 + k) >> 4)] = b[i][k]; } }
    if (X.tid < 16) cnt[X.tid] = 0u;
    __syncthreads();
    const float* g2 = INP(5) + (size_t)l * 1024; const float* bgrp = INP(21) + l * 4; const float* brt = INP(23) + l * 16;
    const int rpb = (T + X.G - 1) / X.G;
  for (int i0 = X.wave; i0 < rpb; i0 += 8 * 8) {
#pragma unroll 1
    for (int jg = 0; jg < 8; jg += 2) {
        f32x4 xall[2][4];
#pragma unroll
        for (int q = 0; q < 2; ++q) { const int i = i0 + 8 * (jg + q); const int r = (i < rpb && X.c * rpb + i < T) ? X.c * rpb + i : X.c * rpb;
#pragma unroll
            for (int k = 0; k < 4; ++k) xall[q][k] = *(const f32x4*)(out + (size_t)r * 1024 + 4 * X.lane + 256 * k); }
        float rstd[2]; int rr[2]; bool ok[2];
#pragma unroll
        for (int q = 0; q < 2; ++q) { const int i = i0 + 8 * (jg + q); ok[q] = i < rpb && X.c * rpb + i < T; rr[q] = ok[q] ? X.c * rpb + i : X.c * rpb;
            float ss = 0.f;
#pragma unroll
            for (int k = 0; k < 4; ++k) { const f32x4 xv = xall[q][k]; ss += xv[0] * xv[0] + xv[1] * xv[1] + xv[2] * xv[2] + xv[3] * xv[3]; }
            rstd[q] = __builtin_amdgcn_rsqf(wave_sum(ss) * (1.f / 1024.f) + EPS); }
        float lg[2][20];
#pragma unroll
        for (int q = 0; q < 2; ++q)
#pragma unroll
            for (int o = 0; o < 20; ++o) lg[q][o] = 0.f;
#pragma unroll 1
        for (int k = 0; k < 4; ++k) { const int col = 4 * X.lane + 256 * k; const f32x4 g = *(const f32x4*)(g2 + col);
            f32x4 yv[2];
#pragma unroll
            for (int q = 0; q < 2; ++q) { const float* md = mod + ((size_t)l * NB + (rr[q] >> 12)) * 6144;
                const f32x4 sh = *(const f32x4*)(md + 3072 + col), sc = *(const f32x4*)(md + 4096 + col);
                yv[q] = xall[q][k] * rstd[q] * g * (sc + 1.f) + sh;
                if (ok[q]) { u32x2 w; w.x = cvt_pk_bf16(yv[q][0], yv[q][1]); w.y = cvt_pk_bf16(yv[q][2], yv[q][3]); *(u32x2*)(h + (size_t)rr[q] * 1024 + col) = w; } }
#pragma unroll
            for (int o = 0; o < 20; ++o) { const f32x4 wv = *(const LAS f32x4*)(WT + o * 1024 + col);
#pragma unroll
                for (int q = 0; q < 2; ++q) lg[q][o] += yv[q][0] * wv[0] + yv[q][1] * wv[1] + yv[q][2] * wv[2] + yv[q][3] * wv[3]; } }
#pragma unroll
        for (int q = 0; q < 2; ++q) {
#pragma unroll
            for (int o = 0; o < 20; ++o) lg[q][o] = wave_sum(lg[q][o]);
            if (X.lane == 0 && ok[q]) { const int r = rr[q];
                float gl[4];
#pragma unroll
                for (int k = 0; k < 4; ++k) gl[k] = lg[q][k] + bgrp[k];
                int gi = 0; float gm = gl[0];
#pragma unroll
                for (int k = 1; k < 4; ++k) if (gl[k] > gm) { gm = gl[k]; gi = k; }
                float se = 0.f;
#pragma unroll
                for (int k = 0; k < 4; ++k) se += __expf(gl[k] - gm);
                const float pg = 1.f / se;
                float sl[4];
#pragma unroll
                for (int k = 0; k < 4; ++k) { sl[k] = lg[q][4 + k] + brt[k];
#pragma unroll
                    for (int qq = 1; qq < 4; ++qq) if (gi == qq) sl[k] = lg[q][4 + 4 * qq + k] + brt[4 * qq + k]; }
                int i1 = 0; float v1 = sl[0];
#pragma unroll
                for (int k = 1; k < 4; ++k) if (sl[k] > v1) { v1 = sl[k]; i1 = k; }
                int i2 = -1; float v2 = -3.0e38f;
#pragma unroll
                for (int k = 0; k < 4; ++k) if (k != i1 && sl[k] > v2) { v2 = sl[k]; i2 = k; }
                const float w1 = 1.f / (1.f + __expf(v2 - v1));
                const int e1 = 4 * gi + i1, e2 = 4 * gi + i2;
                toke[2 * r] = e1; toke[2 * r + 1] = e2; tokw[2 * r] = pg * w1; tokw[2 * r + 1] = pg * (1.f - w1);
                atomicAdd((unsigned*)(cnt + e1), 1u); atomicAdd((unsigned*)(cnt + e2), 1u);
            }
        }
    }
  }
    __syncthreads();
    if (X.tid < 16) cntb[X.c * 16 + X.tid] = cnt[X.tid];
    __syncthreads();
}

__device__ __forceinline__ void build_tiles(const Ctx& X, LAS int* tb, LAS int* myoff  ) {
    const unsigned* cntb = WSP(unsigned, WS_CNT);
    LAS int* tot = tb + 32;
    LAS int* part = tb + 512;
    { const int e = X.tid & 15, p = X.tid >> 4, per = (X.G + 31) >> 5; int s = 0, mine = 0;
      for (int k = 0; k < per; ++k) { const int c = p * per + k; if (c < X.G) { const int v = (int)cntb[c * 16 + e]; s += v; if (c < X.c) mine += v; } }
      part[p * 16 + e] = s; if (X.c >= p * per && X.c < (p + 1) * per) part[512 + e] = mine; }
    __syncthreads();
    if (X.tid < 16) { const int per = (X.G + 31) >> 5, mp = X.c / per; int s = 0, mine = part[512 + X.tid];
        for (int p = 0; p < 32; ++p) { const int v = part[p * 16 + X.tid]; s += v; if (p < mp) mine += v; }
        tot[X.tid] = s; myoff[X.tid] = mine; }
    __syncthreads();
    if (X.tid == 0) { int row = 0, nT = 0;
        for (int e = 0; e < 16; ++e) { const int nt = (tot[e] + 255) >> 8; tb[16 + e] = row; for (int k = 0; k < nt; ++k) { tb[64 + nT] = e; tb[256 + nT] = (row >> 8) + k; ++nT; } row += nt * 256; }
        tb[0] = nT; }
    __syncthreads();
    if (X.tid < 16) myoff[X.tid] += tb[16 + X.tid];
    __syncthreads();
}

__device__ __forceinline__ void moe_lists(const Ctx& X, const LAS int* tb, LAS int* rows, LAS float* lw, LAS int* sc) {
    const unsigned* cntb = WSP(unsigned, WS_CNT); const int* toke = WSP(int, WS_TOKE); const float* tokw = WSP(float, WS_TOKW); int* toks = WSP(int, WS_TOKS);
    const int nT = tb[0], rpb = (T + X.G - 1) / X.G;
    for (int i = 0; i < 2; ++i) {
        const long L = (long)i * X.G + X.c; if (L >= ((long)nT << 1)) break;
        const int rt = (int)(L >> 1), e = tb[64 + rt], pm = tb[256 + rt], rbase = pm * 256 - tb[16 + e];
        const int v = X.tid < X.G ? (int)cntb[X.tid * 16 + e] : 0;
        sc[X.tid] = v; rows[i * 256 + (X.tid & 255)] = 0; lw[i * 256 + (X.tid & 255)] = 0.f;
        __syncthreads();
        for (int off = 1; off < 512; off <<= 1) { const int t = X.tid >= off ? sc[X.tid - off] : 0; __syncthreads(); sc[X.tid] += t; __syncthreads(); }
        sc[512 + X.tid] = v;
        __syncthreads();
        for (int cs = X.wave; cs < X.G; cs += 8) {
            const int cnt = sc[512 + cs], lo = sc[cs] - cnt;
            if (cnt == 0 || lo + cnt <= rbase || lo >= rbase + 256) continue;
            int run = lo;
            for (int n0 = 0; n0 < 2 * rpb; n0 += 64) { const int n = n0 + X.lane, tr = cs * rpb + (n >> 1), k = n & 1;
                const bool in = n < 2 * rpb && tr < T; const int ex = in ? toke[2 * tr + k] : -1; const bool match = ex == e;
                const unsigned long long bal = __ballot(match);
                const int rank = run + (int)__builtin_popcountll(bal & ((1ull << X.lane) - 1ull)) - rbase;
                if (match && rank >= 0 && rank < 256) { rows[i * 256 + rank] = tr; lw[i * 256 + rank] = tokw[2 * tr + k]; toks[2 * tr + k] = pm * 256 + rank; }
                run += (int)__builtin_popcountll(bal); }
        }
        __syncthreads();
    }
}

__global__ void __launch_bounds__(512, 2) fwd_kernel(Params P) {
    extern __shared__ __attribute__((aligned(16))) unsigned char lds_raw[];
    Ctx X0; X0.in = (const float* const CAS*)__builtin_amdgcn_kernarg_segment_ptr(); X0.out = P.out; X0.ws = P.ws; X0.lds = (LAS unsigned char*)lds_raw;
    X0.tid = threadIdx.x; X0.lane = X0.tid & 63; X0.wave = __builtin_amdgcn_readfirstlane(X0.tid >> 6); X0.G = gridDim.x; X0.c = blockIdx.x;
    LAS unsigned* auxw = (LAS unsigned*)(X0.lds + AUX_OFF);
    if (X0.tid < 4) auxw[X0.tid] = 0u;
    __syncthreads();
#define FRESH() Ctx X = X0; { int wv_ = X0.wave; asm volatile("" : "+s"(wv_)); unsigned m_ = ~0u; asm volatile("" : "+s"(m_)); const int ln_ = __builtin_amdgcn_mbcnt_hi(m_, __builtin_amdgcn_mbcnt_lo(m_, 0u)); \
        X.wave = wv_; X.lane = ln_; X.tid = wv_ * 64 + ln_; \
        size_t z_ = 0; asm volatile("" : "+s"(z_)); X.ws = X0.ws + z_; X.out = (float*)((unsigned char*)X0.out + z_); int c_ = X0.c; asm volatile("" : "+s"(c_)); X.c = c_; \
        const float* const CAS* i_ = X0.in; asm volatile("" : "+s"(i_)); X.in = i_; }
#if N_LAUNCH_MODE == 1
    XcdBarrier bar = xcd_barrier_post((unsigned*)(X0.ws + WS_CTL), (volatile LAS unsigned*)auxw);
#define SEAM() do { unsigned long long t1_ = 0; if (PROBE_STAMP) { t1_ = __builtin_amdgcn_s_memrealtime(); if (ph_ >= 0 && ((PROBE_STAMP >> ph_) & 1)) st_acc += t1_ - st_t0; } \
        if (gp >= lo && gp + 1 < hi) { xcd_barrier(bar); if (PROBE_DUP == 17) xcd_barrier(bar); } \
        if (PROBE_STAMP) { st_t0 = __builtin_amdgcn_s_memrealtime(); if ((PROBE_STAMP >> 11) & 1) st_acc += st_t0 - t1_; ph_ = ph_ < 0 ? ph_ : (ph_ + 1) % 10; } ++gp; } while (0)
#else
#define SEAM() do { ++gp; } while (0)
#endif
    const int lo = P.ph_lo, hi = P.ph_hi; int gp = 0;
    unsigned long long st_acc = 0, st_t0 = PROBE_STAMP ? __builtin_amdgcn_s_memrealtime() : 0ull; int ph_ = -1;
#define IN() (gp >= lo && gp < hi)
    if (IN()) { REP(13) { FRESH(); phase_mod(X); } { FRESH(); __syncthreads(); phase_conv_dyn(X, 0, (unsigned*)(X.ws + WS_CTL + 14336) + 64 * 3, 1 << 30); } }
    SEAM();
    ph_ = 0;
#define LAYER_BODY(l) do { \
        if (IN()) { REP(19) { FRESH(); if (l == 0) phase_norm1(X, l, 0); else phase_norm1(X, l, 1, rep_ == 0 ? 1.f : 0.f); } } \
        SEAM(); \
        if (IN()) REP(3) { \
            FRESH(); \
            SchedStatic S{64, 30, X.G, X.c, (const char*)WSP(bf16_t, WS_H), (const char*)WSW(bf16_t, WS_WIN, l), (size_t)256 * 1024 * 2, (size_t)256 * 1024 * 2}; \
            EpiProj E{WSP(bf16_t, WS_PROJ), INP(18) + (size_t)(l) * 3072}; \
            pg8::gemm_phase(X.lds, X.tid, 1024, 1024, 16, S, E); \
              \
            if ((l) + 1 < NL && (64 * 30) % X.G != 0 && X.c >= (64 * 30) % X.G) { __syncthreads(); phase_conv_dyn(X, (l) + 1, (unsigned*)(X.ws + WS_CTL + 14336) + 64 * (l), 4); } \
        } \
        SEAM(); \
        if (IN()) { { FRESH(); sub_qknorm(X, l); } REP(4) { FRESH(); sub_vtrans(X); } REP(5) { FRESH(); sub_gmlp(X, l); } REP(6) { FRESH(); sub_gla_local(X, l); } REP(7) { FRESH(); sub_dsa_select(X); } } \
        SEAM(); \
        if (IN()) { { FRESH(); sub_gla_scan(X); } if (PROBE_DUP == 16) { xcd_barrier(bar); { FRESH(); sub_gla_local(X, l); } xcd_barrier(bar); { FRESH(); sub_gla_scan(X); } } REP(8) { FRESH(); sub_dsa_attn(X, l); } } \
        SEAM(); \
        if (IN()) REP(9) { FRESH(); sub_gla_out(X, l); } \
        SEAM(); \
        if (IN()) REP(10) { \
            FRESH(); \
            SchedStatic S{64, 4, X.G, X.c, (const char*)WSP(bf16_t, WS_Y), (const char*)WSW(bf16_t, WS_WBR, l), (size_t)256 * YW * 2, (size_t)256 * YW * 2}; \
            EpiMerge E{WSP(bf16_t, WS_PROJ), WSP(bf16_t, WS_H)}; \
            pg8::gemm_phase(X.lds, X.tid, YW, YW, 24, S, E); \
        } \
        SEAM(); \
        if (IN()) REP(18) { \
            FRESH(); \
            SchedStatic S{64, 4, X.G, X.c, (const char*)WSP(bf16_t, WS_H), (const char*)WSW(bf16_t, WS_WOUT, l), (size_t)256 * 1024 * 2, (size_t)256 * 1024 * 2}; \
            EpiOut E{X.out, ((l) == 0 && rep_ == 0) ? INP(0) : (const float*)X.out, WSP(float, WS_MOD) + (size_t)l * NB * 6144 + 2048, rep_ == 0 ? 1.f : 0.f}; \
            pg8::gemm_phase(X.lds, X.tid, 1024, 1024, 16, S, E); \
        } \
        SEAM(); \
        if (IN()) REP(14) { FRESH(); phase_norm2(X, l); } \
        SEAM(); \
        if (IN()) REP(11) { \
            FRESH(); \
            LAS int* tb = (LAS int*)(X.lds + AUX_OFF + 2048); LAS int* myoff = (LAS int*)(X.lds + AUX_OFF + 1024); \
            LAS int* rows = (LAS int*)(X.lds + AUX_OFF + 12288); LAS float* lw = (LAS float*)(X.lds + AUX_OFF + 14336); \
            build_tiles(X, tb, myoff); \
            moe_lists(X, tb, rows, lw, (LAS int*)(X.lds + AUX_OFF + 16384)); \
            SchedMoeG S{X.G, X.c, tb[0], tb + 64, tb + 256, rows, (const char*)WSP(bf16_t, WS_H), (const char*)WSW(bf16_t, WS_WE1, l), (size_t)512 * 1024 * 2, (size_t)256 * 1024 * 2}; \
            EpiMoe1 E{WSP(bf16_t, WS_ACT), lw}; \
            pg8::gemm_phase(X.lds, X.tid, 1024, 1024, 16, S, E); \
            if ((l) + 1 < NL) { __syncthreads(); phase_conv_dyn(X, (l) + 1, (unsigned*)(X.ws + WS_CTL + 14336) + 64 * (l), 1 << 30); } \
        } \
        SEAM(); \
        if (IN()) REP(12) { \
            FRESH(); \
            LAS int* tb = (LAS int*)(X.lds + AUX_OFF + 2048); LAS int* myoff = (LAS int*)(X.lds + AUX_OFF + 1024); \
            build_tiles(X, tb, myoff); \
            SchedMoe S{X.G, X.c, 2, tb[0], tb + 64, tb + 256, (const char*)WSP(bf16_t, WS_ACT), (const char*)WSW(bf16_t, WS_WE2, l), (size_t)256 * 256 * 2, (size_t)1024 * 256 * 2, (size_t)256 * 256 * 2}; \
            EpiMoe2 E{WSP(bf16_t, WS_FFN)}; \
            pg8::gemm_phase(X.lds, X.tid, 256, 256, 4, S, E); \
        } \
        SEAM(); \
 \
    } while (0)
    LAYER_BODY(0); LAYER_BODY(1); LAYER_BODY(2); LAYER_BODY(3);
    if (IN()) { FRESH(); phase_norm1(X, NL, 2); }
    if (PROBE_STAMP) { if (blockIdx.x == 0) { const unsigned long long tb = __builtin_amdgcn_s_memrealtime(); while (__builtin_amdgcn_s_memrealtime() - tb < 4ull * st_acc) __builtin_amdgcn_s_sleep(8); } }
#undef IN
#undef SEAM
}

constexpr int N_PHASES = 1 + NL * 10 + 1;

extern "C" void kernel_launch(void* const* d_in, const int* in_sizes, int n_in, void* d_out, int out_size, void* d_ws, size_t ws_size, hipStream_t stream) {
    static int grid = 0;
    if (grid == 0) {
        if (n_in != 27 || out_size != T * D || ws_size < WS_END) { fprintf(stderr, "kernel_launch: unexpected problem (n_in %d, out %d, ws %zu, need %zu)\n", n_in, out_size, ws_size, (size_t)WS_END); grid = -1; return; }
        int dev = 0, cus = 0, per_cu = 0;
        if (hipGetDevice(&dev) != hipSuccess || hipDeviceGetAttribute(&cus, hipDeviceAttributeMultiprocessorCount, dev) != hipSuccess) { grid = -1; return; }
        if (hipFuncSetAttribute((const void*)fwd_kernel, hipFuncAttributeMaxDynamicSharedMemorySize, LDS_BYTES) != hipSuccess) { fprintf(stderr, "kernel_launch: hipFuncSetAttribute failed\n"); grid = -1; return; }
        if (hipOccupancyMaxActiveBlocksPerMultiprocessor(&per_cu, (const void*)fwd_kernel, 512, LDS_BYTES) != hipSuccess || per_cu < 1) fprintf(stderr, "kernel_launch: occupancy query says %d\n", per_cu);
        (void)hipGetLastError();
        grid = cus;
    }
    if (grid < 0) return;
    (void)hipMemsetAsync((char*)d_ws + WS_CTL, 0, 16384, stream);
    Params p{};
    for (int i = 0; i < 27; ++i) p.in[i] = (const float*)d_in[i];
    p.out = (float*)d_out; p.ws = (unsigned char*)d_ws;
#if N_LAUNCH_MODE == 1
    p.ph_lo = 0; p.ph_hi = N_PHASES;
    hipLaunchKernelGGL(fwd_kernel, dim3(grid), dim3(512), LDS_BYTES, stream, p);
#else
    for (int ph = 0; ph < N_PHASES; ++ph) { p.ph_lo = ph; p.ph_hi = ph + 1; hipLaunchKernelGGL(fwd_kernel, dim3(grid), dim3(512), LDS_BYTES, stream, p); }
#endif
}
```

```cpp
#include <hip/hip_runtime.h>
#include <stdint.h>
#include <stdio.h>

#ifndef N_LAUNCH_MODE
#define N_LAUNCH_MODE 1
#endif

#ifndef PROBE_DUP
#define PROBE_DUP 0
#endif
#ifndef PROBE_STAMP
#define PROBE_STAMP 0
#endif
#define REP(id) for (int rep_ = 0; rep_ < ((PROBE_DUP == (id)) ? 2 : 1); ++rep_)
#define LAS __attribute__((address_space(3)))
#define CAS __attribute__((address_space(4)))
#define GAS __attribute__((address_space(1)))
typedef unsigned short bf16_t;
typedef short bf16x8 __attribute__((ext_vector_type(8)));
typedef float f32x2 __attribute__((ext_vector_type(2)));
typedef float f32x4 __attribute__((ext_vector_type(4)));
typedef float f32x16 __attribute__((ext_vector_type(16)));
typedef unsigned u32x2 __attribute__((ext_vector_type(2)));
typedef unsigned u32x4 __attribute__((ext_vector_type(4)));

constexpr int NB = 4, SEQ = 4096, T = NB * SEQ, D = 1024, NL = 4;
constexpr int NIN = 7508, NP = 7680, PP = 4608;
constexpr int C_AU = 0, C_AV = 512, C_GQ = 1024, C_GK = 1280, C_GV = 1536, C_GR = 2048, C_DQ = 2560, C_DK = 3072, C_DV = 3584,
              C_IQ = 4096, C_IK = 4352, C_GA = 4416, C_IW = 4432, C_GATE = 4608;
constexpr int YW = 1536;
constexpr int MOE_ROWS = 32768 + 16 * 256;
constexpr float EPS = 1e-6f;

constexpr size_t WS_CTL = 0;
constexpr size_t WS_CNT = 16384;
constexpr size_t WS_MOD = 65536;
constexpr size_t WS_WIN = WS_MOD + 524288;
constexpr size_t WS_WBR = WS_WIN + (size_t)NP * 1024 * 2;
constexpr size_t WS_WOUT = WS_WBR + (size_t)1024 * 1536 * 2;
constexpr size_t WS_WE1 = WS_WOUT + (size_t)1024 * 1024 * 2;
constexpr size_t WS_WE2 = WS_WE1 + (size_t)16 * 512 * 1024 * 2;
constexpr size_t WS_WS = WS_WE2 + (size_t)16 * 1024 * 256 * 2;
constexpr size_t WS_W2 = WS_WS + (size_t)4 * 128 * 128 * 2;
constexpr size_t WSET = WS_W2 - WS_WIN;
constexpr size_t WS_H = WS_W2 + WSET;
constexpr size_t WS_PROJ = WS_H + (size_t)T * 1024 * 2;
constexpr size_t WS_Y = WS_PROJ + (size_t)T * PP * 2;
constexpr size_t WS_SCR = WS_Y + (size_t)T * YW * 2;
constexpr size_t WS_MASK = WS_SCR + (size_t)T * 1024 * 4;
constexpr size_t WS_VT = WS_MASK + (size_t)T * 64 * 8;
constexpr size_t WS_TOKE = WS_VT + (size_t)16 * 128 * 4096 * 2;
constexpr size_t WS_TOKW = WS_TOKE + (size_t)T * 8;
constexpr size_t WS_TOKS = WS_TOKW + (size_t)T * 8;
constexpr size_t WS_DEC = WS_TOKS + (size_t)T * 8;
constexpr size_t WS_SW = WS_DEC + (size_t)1024 * 64 * 4;
constexpr size_t WS_G8 = WS_SW + (size_t)MOE_ROWS * 4;
constexpr size_t WS_END = WS_G8 + (size_t)T * 3072;
constexpr size_t WS_H2S = WS_PROJ;
constexpr size_t WS_ACT = WS_PROJ;
constexpr size_t WS_FFN = WS_ACT + (size_t)MOE_ROWS * 256 * 2;
static_assert(WS_FFN + (size_t)MOE_ROWS * 1024 * 2 <= WS_Y, "moe alias");

constexpr int LDS_BYTES = 158720;
constexpr int AUX_OFF = 132096;

__device__ __forceinline__ float bf2f(bf16_t v) { return __uint_as_float(((unsigned)v) << 16); }
__device__ __forceinline__ unsigned cvt_pk_bf16(float lo, float hi) { unsigned r; asm volatile("v_cvt_pk_bf16_f32 %0, %1, %2" : "=v"(r) : "v"(lo), "v"(hi)); return r; }
__device__ __forceinline__ bf16_t f2bf(float f) { return (bf16_t)(cvt_pk_bf16(f, 0.f) & 0xffffu); }
__device__ __forceinline__ float lo_bf(unsigned w) { return __uint_as_float(w << 16); }
__device__ __forceinline__ float hi_bf(unsigned w) { return __uint_as_float(w & 0xffff0000u); }
__device__ __forceinline__ float max_x32(float v) { const auto r = __builtin_amdgcn_permlane32_swap(__float_as_uint(v), __float_as_uint(v), false, false); return fmaxf(__uint_as_float(r[0]), __uint_as_float(r[1])); }
__device__ __forceinline__ float sum_x32(float v) { const auto r = __builtin_amdgcn_permlane32_swap(__float_as_uint(v), __float_as_uint(v), false, false); return __uint_as_float(r[0]) + __uint_as_float(r[1]); }
template <int CTRL> __device__ __forceinline__ float dpp_f(float v) { return __int_as_float(__builtin_amdgcn_update_dpp(0, __float_as_int(v), CTRL, 0xf, 0xf, true)); }
__device__ __forceinline__ float sum8(float v) { v += dpp_f<0xB1>(v); v += dpp_f<0x4E>(v); v += dpp_f<0x141>(v); return v; }
__device__ __forceinline__ float sum16(float v) { v = sum8(v); v += dpp_f<0x140>(v); return v; }
__device__ __forceinline__ float wave_sum(float v) {
    v = sum16(v);
    const float a = __int_as_float(__builtin_amdgcn_readlane(__float_as_int(v), 0)), b = __int_as_float(__builtin_amdgcn_readlane(__float_as_int(v), 16));
    const float c = __int_as_float(__builtin_amdgcn_readlane(__float_as_int(v), 32)), d = __int_as_float(__builtin_amdgcn_readlane(__float_as_int(v), 48));
    return (a + b) + (c + d);
}
__device__ __forceinline__ float fast_exp(float x) { return __builtin_amdgcn_exp2f(x * 1.4426950408889634f); }
__device__ __forceinline__ float sigmoidf_(float x) { return __builtin_amdgcn_rcpf(1.f + fast_exp(-x)); }
__device__ __forceinline__ float gelu_tanh(float x) { const float u = x + 0.044715f * x * x * x; return x * __builtin_amdgcn_rcpf(1.f + __builtin_amdgcn_exp2f(-2.3022082f * u)); }

#define XB_TMO      128
#define XB_XCNT(j)  (256  + 64 * (j))
#define XB_XSUB(j)  (1280 + 64 * (j))
#define XB_XGEN(j)  (2304 + 64 * (j))
#define XB_TOP      3328
#define XB_TOPGEN   3392
#define XCD_BAR_WORDS 3456
#define XB_SPIN_CAP (1u << 22)
__device__ __forceinline__ unsigned xb_ld(unsigned* p)              { return __hip_atomic_load(p, __ATOMIC_RELAXED, __HIP_MEMORY_SCOPE_AGENT); }
__device__ __forceinline__ unsigned xb_add(unsigned* p, unsigned v) { return __hip_atomic_fetch_add(p, v, __ATOMIC_RELAXED, __HIP_MEMORY_SCOPE_AGENT); }
__device__ __forceinline__ unsigned xb_xcc_id() { return (unsigned)__builtin_amdgcn_s_getreg((3 << 11) | 20) & 0xFu; }
#define XB_SPIN(cond, bar) do { unsigned _sp = 0; while (cond) { __builtin_amdgcn_s_sleep(1); \
    if ((++_sp & 255u) == 0u) { if (xb_ld(&(bar)[XB_TMO])) break; if (_sp > XB_SPIN_CAP) { atomicAdd(&(bar)[XB_TMO], 1u); break; } } } } while (0)
struct XcdBarrier { unsigned* bar; unsigned x; volatile LAS unsigned* st; };
__device__ __forceinline__ XcdBarrier xcd_barrier_post(unsigned* bar, volatile LAS unsigned* st) {
    XcdBarrier b; b.bar = bar; b.x = xb_xcc_id(); b.st = st;
    if (threadIdx.x == 0) (void)xb_add(&bar[XB_XCNT(b.x)], 1u);
    return b;
}
__device__ __forceinline__ void xcd_barrier_complete(unsigned* bar, unsigned x, unsigned& nloc, unsigned& nx) {
    const unsigned G = gridDim.x * gridDim.y * gridDim.z;
    unsigned sum, cnt, mine, sp = 0u;
    for (;;) {
        sum = 0u; cnt = 0u; mine = 0u;
#pragma unroll
        for (unsigned j = 0; j < 16; ++j) { const unsigned c = xb_ld(&bar[XB_XCNT(j)]); sum += c; cnt += (c > 0u) ? 1u : 0u; mine = (j == x) ? c : mine; }
        if (sum == G) break;
        __builtin_amdgcn_s_sleep(1);
        if ((++sp & 255u) == 0u) { if (xb_ld(&bar[XB_TMO])) break; if (sp > XB_SPIN_CAP) { atomicAdd(&bar[XB_TMO], 1u); break; } }
    }
    nloc = mine > 0u ? mine : 1u; nx = cnt > 0u ? cnt : 1u;
}
__device__ __forceinline__ void xcd_barrier(const XcdBarrier& b) {
    asm volatile("s_waitcnt vmcnt(0)" ::: "memory");
    __syncthreads();
    if (threadIdx.x == 0) {
        unsigned* bar = b.bar;
        __builtin_amdgcn_s_waitcnt(0);
        unsigned nloc = b.st[0], nx = b.st[1];
        if (nloc == 0u) { xcd_barrier_complete(bar, b.x, nloc, nx); b.st[0] = nloc; b.st[1] = nx; }
        const unsigned old = xb_add(&bar[XB_XSUB(b.x)], 1u);
        const unsigned gen = old / nloc;
        if (old + 1u == (gen + 1u) * nloc) {
            __builtin_amdgcn_fence(__ATOMIC_RELEASE, "agent");
            asm volatile("s_waitcnt vmcnt(0)" ::: "memory");
            const unsigned og = xb_add(&bar[XB_TOP], 1u);
            const unsigned tg = og / nx;
            if (og + 1u == (tg + 1u) * nx) xb_add(&bar[XB_TOPGEN], 1u);
            else XB_SPIN(xb_ld(&bar[XB_TOPGEN]) == tg, bar);
            __builtin_amdgcn_fence(__ATOMIC_ACQUIRE, "agent");
            xb_add(&bar[XB_XGEN(b.x)], 1u);
            asm volatile("s_waitcnt vmcnt(0)" ::: "memory");
        } else {
            XB_SPIN(xb_ld(&bar[XB_XGEN(b.x)]) == gen, bar);
            __builtin_amdgcn_fence(__ATOMIC_ACQUIRE, "agent");
            asm volatile("s_waitcnt vmcnt(0)" ::: "memory");
        }
    }
    __syncthreads();
}

namespace pg8 {
constexpr int BM = 256, BK = 64, HALF = 128, HTB = HALF * BK * 2, STAGE_BYTES = 8 * HTB, NXCD = 8, WGM = 8;
__device__ __forceinline__ int lds_byte(int r, int c) { const int st = (r >> 4) * 2 + (c >> 5), rr = r & 15, cc = c & 31, ob = rr * 64 + cc * 2; return st * 1024 + (ob ^ (((ob >> 9) & 1) << 5)); }
__device__ __forceinline__ void stage_rc(int b, int& R, int& C) { const int st = b / 1024, sb = b % 1024, swz = sb ^ (((sb >> 9) & 1) << 5); R = (st >> 1) * 16 + swz / 64; C = (st & 1) * 32 + (swz % 64) / 2; }
__device__ __forceinline__ int perm32(int rho) { const int n = rho >> 4, i = rho & 15; return 8 * (i >> 2) + 4 * n + (i & 3); }

struct Unit { int pm, pn, aux, ord; const char* A; const char* B; };
__device__ __forceinline__ void tile_of(int L, int nM, int nN, int& pm, int& pn) {
    const int nwg = nM * nN; int wgid = L;
    { const int q = nwg / NXCD, r = nwg % NXCD, xcd = wgid % NXCD, off = wgid / NXCD; wgid = (xcd < r ? xcd * (q + 1) : r * (q + 1) + (xcd - r) * q) + off; }
    const int nig = WGM * nN, gid = wgid / nig, fm = gid * WGM, gsz = (nM - fm) < WGM ? (nM - fm) : WGM;
    pm = fm + ((wgid % nig) % gsz); pn = (wgid % nig) / gsz;
}

template <class Epi, class Sched>
__device__ __forceinline__ void gemm_phase(LAS unsigned char* lds, const int tid, const int lda, const int ldb, const int nt, const Sched& S, const Epi& E) {
    const int wid = __builtin_amdgcn_readfirstlane(tid >> 6), lane = tid & 63, wr = wid >> 2, wc = wid & 3, fr = lane & 15, fq = lane >> 4;
    unsigned voffA[2], voffB[2]; int stR[2], stC[2];
#pragma unroll
    for (int i = 0; i < 2; ++i) { int R, C; stage_rc(tid * 16 + i * 8192, R, C); const int Rb = Epi::PERM ? ((R & ~31) + perm32(R & 31)) : R; stR[i] = R; stC[i] = C;
        voffA[i] = (unsigned)(R * lda + C) * 2u; voffB[i] = (unsigned)(Rb * ldb + C) * 2u; }
    unsigned gC[2][2], gN[2][2];
#define PG8_GROWS(dst, un) do { if constexpr (Sched::GATHER) { _Pragma("unroll") for (int _h = 0; _h < 2; ++_h) _Pragma("unroll") for (int _i = 0; _i < 2; ++_i) \
        dst[_h][_i] = (unsigned)(S.row(un, _h * HALF + stR[_i]) * lda + stC[_i]) * 2u; } } while (0)
#define PG8_STAGEA(bufoff, kidx, h, nx) do { if constexpr (Sched::GATHER) { const char* _b = cA + (size_t)(kidx) * kstep; if (nx) PG8_STAGE(bufoff, _b, gN[h]); else PG8_STAGE(bufoff, _b, gC[h]); } \
        else { const char* _b = ((nx) ? nA : cA) + (size_t)(kidx) * kstep + (size_t)(h) * hstepA; PG8_STAGE(bufoff, _b, voffA); } } while (0)
    const size_t kstep = (size_t)(BK * 2);
    const size_t hstepA = (size_t)HALF * lda * 2, hstepB = (size_t)HALF * ldb * 2;
    const unsigned ldsw = (unsigned)wid * 1024u;
    const int aoff = lds_byte(wr * 64 + fr, fq * 8), boff = lds_byte(wc * 32 + fr, fq * 8);
#define PG8_SA(b, h) (((b) * 2 + (h)) * HTB)
#define PG8_SB(b, h) ((4 + (b) * 2 + (h)) * HTB)
#define PG8_STAGE(bufoff, gbase, voff) do { _Pragma("unroll") for (int _i = 0; _i < 2; ++_i) \
        __builtin_amdgcn_global_load_lds((const unsigned*)((const char*)(gbase) + (voff)[_i]), (LAS unsigned*)(lds + (bufoff) + ldsw + _i * 8192), 16, 0, 0); } while (0)
#define PG8_LDA(dst, b, h) do { _Pragma("unroll") for (int m = 0; m < 4; ++m) _Pragma("unroll") for (int k = 0; k < 2; ++k) dst[m][k] = *(const LAS bf16x8*)(lds + PG8_SA(b, h) + aoff + m * 2048 + k * 1024); } while (0)
#define PG8_LDB(dst, b, h) do { _Pragma("unroll") for (int n = 0; n < 2; ++n) _Pragma("unroll") for (int k = 0; k < 2; ++k) dst[n][k] = *(const LAS bf16x8*)(lds + PG8_SB(b, h) + boff + n * 2048 + k * 1024); } while (0)
#define PG8_MMA(ai, bj, At, Bt) do { __builtin_amdgcn_s_setprio(1); _Pragma("unroll") for (int m = 0; m < 4; ++m) _Pragma("unroll") for (int n = 0; n < 2; ++n) _Pragma("unroll") for (int k = 0; k < 2; ++k) \
        acc[ai][bj][m][n] = __builtin_amdgcn_mfma_f32_16x16x32_bf16(Bt[n][k], At[m][k], acc[ai][bj][m][n], 0, 0, 0); __builtin_amdgcn_s_setprio(0); } while (0)
#define PG8_WAIT_V(n) asm volatile("s_waitcnt vmcnt(" #n ")" ::: "memory")
#define PG8_WAIT_L(n) asm volatile("s_waitcnt lgkmcnt(" #n ")" ::: "memory")
#define PG8_BAR __builtin_amdgcn_s_barrier()
#define PG8_SCHED __builtin_amdgcn_sched_barrier(0)
    Unit cur, nxt; int ui = 0;
    if (!S.next(0, cur)) return;
    f32x4 acc[2][2][4][2];
#pragma unroll
    for (int a = 0; a < 2; ++a)
#pragma unroll
        for (int b = 0; b < 2; ++b)
#pragma unroll
            for (int m = 0; m < 4; ++m)
#pragma unroll
                for (int n = 0; n < 2; ++n) acc[a][b][m][n] = (f32x4){0.f, 0.f, 0.f, 0.f};
    bf16x8 At[4][2], B0[2][2], B1[2][2];
    const char* cA = cur.A; const char* cB = cur.B; const char* nA = cA;
    PG8_GROWS(gC, cur);
    PG8_STAGE(PG8_SB(0, 0), cB, voffB); PG8_STAGEA(PG8_SA(0, 0), 0, 0, false); PG8_STAGE(PG8_SB(0, 1), cB + hstepB, voffB); PG8_STAGEA(PG8_SA(0, 1), 0, 1, false);
    if (wr == 1) PG8_BAR;
    PG8_WAIT_V(4); PG8_BAR;
    PG8_STAGE(PG8_SB(1, 0), cB + kstep, voffB); PG8_STAGEA(PG8_SA(1, 0), 1, 0, false); PG8_STAGE(PG8_SB(1, 1), cB + hstepB + kstep, voffB);
    PG8_WAIT_V(6); PG8_BAR;
    for (;;) {
        const bool has_next = S.next(ui + 1, nxt);
        nA = has_next ? nxt.A : cA; const char* nB = has_next ? nxt.B : cB;
        if constexpr (Sched::GATHER) { if (has_next) PG8_GROWS(gN, nxt); else { _Pragma("unroll") for (int _h = 0; _h < 2; ++_h) _Pragma("unroll") for (int _i = 0; _i < 2; ++_i) gN[_h][_i] = gC[_h][_i]; } }
        for (int t = 0; t < nt; t += 2) {
            const bool last = (t == nt - 2);
            const int k2 = last ? 0 : t + 2;
            const char* b2 = last ? nB : cB + (size_t)(t + 2) * kstep;
            const char* b3 = b2 + kstep;
            if constexpr (Epi::MID != 0) { if (t != 0 && (t % Epi::MID) == 0) E.mid(acc, cur, t / Epi::MID, wr, wc, fr, fq); }
            PG8_LDB(B0, 0, 0); PG8_SCHED; PG8_LDA(At, 0, 0); PG8_STAGEA(PG8_SA(1, 1), t + 1, 1, false);
            PG8_WAIT_L(8); PG8_BAR; PG8_WAIT_L(0); PG8_MMA(0, 0, At, B0); PG8_BAR; PG8_SCHED;
            PG8_LDB(B1, 0, 1); PG8_STAGE(PG8_SB(0, 0), b2, voffB);
            PG8_BAR; PG8_WAIT_L(0); PG8_MMA(0, 1, At, B1); PG8_BAR;
            PG8_LDA(At, 0, 1); PG8_STAGEA(PG8_SA(0, 0), k2, 0, last);
            PG8_BAR; PG8_WAIT_L(0); PG8_MMA(1, 0, At, B0); PG8_BAR; PG8_SCHED;
            PG8_STAGE(PG8_SB(0, 1), b2 + hstepB, voffB);
            PG8_WAIT_V(6); PG8_BAR; PG8_MMA(1, 1, At, B1); PG8_BAR;
            PG8_LDB(B0, 1, 0); PG8_SCHED; PG8_LDA(At, 1, 0); PG8_STAGEA(PG8_SA(0, 1), k2, 1, last);
            PG8_WAIT_L(8); PG8_BAR; PG8_WAIT_L(0); PG8_MMA(0, 0, At, B0); PG8_BAR; PG8_SCHED;
            PG8_LDB(B1, 1, 1); PG8_STAGE(PG8_SB(1, 0), b3, voffB);
            PG8_BAR; PG8_WAIT_L(0); PG8_MMA(0, 1, At, B1); PG8_BAR;
            PG8_LDA(At, 1, 1); PG8_STAGEA(PG8_SA(1, 0), k2 + 1, 0, last);
            PG8_BAR; PG8_WAIT_L(0); PG8_MMA(1, 0, At, B0); PG8_BAR; PG8_SCHED;
            PG8_STAGE(PG8_SB(1, 1), b3 + hstepB, voffB);
            PG8_WAIT_V(6); PG8_BAR; PG8_MMA(1, 1, At, B1); PG8_BAR;
        }
        E(acc, cur, wr, wc, fr, fq);
        if (!has_next) break;
#pragma unroll
        for (int a = 0; a < 2; ++a)
#pragma unroll
            for (int b = 0; b < 2; ++b)
#pragma unroll
                for (int m = 0; m < 4; ++m)
#pragma unroll
                    for (int n = 0; n < 2; ++n) acc[a][b][m][n] = (f32x4){0.f, 0.f, 0.f, 0.f};
        cur = nxt; cA = nA; cB = nB; ++ui;
        if constexpr (Sched::GATHER) { _Pragma("unroll") for (int _h = 0; _h < 2; ++_h) _Pragma("unroll") for (int _i = 0; _i < 2; ++_i) gC[_h][_i] = gN[_h][_i]; }
    }
    PG8_WAIT_V(0);
    if (wr == 0) PG8_BAR;
    PG8_BAR;
#undef PG8_SA
#undef PG8_SB
#undef PG8_STAGE
#undef PG8_STAGEA
#undef PG8_GROWS
#undef PG8_LDA
#undef PG8_LDB
#undef PG8_MMA
#undef PG8_WAIT_V
#undef PG8_WAIT_L
#undef PG8_BAR
#undef PG8_SCHED
}
}
using pg8::Unit;

struct Params { const float* in[27]; float* out; unsigned char* ws; int ph_lo, ph_hi; };
struct Ctx {
    const float* const CAS* in; float* out; unsigned char* ws; LAS unsigned char* lds;
    int tid, lane, wave, G, c;
};
#define INP(k_) ((const float*)(const GAS float*)X.in[k_])
#define WSP(T_, off) ((T_*)(X.ws + (off)))
#define WSW(T_, off, l_) ((T_*)(X.ws + (off) + (size_t)((l_) & 1) * WSET))

struct SchedStatic {
    static constexpr bool GATHER = false; __device__ __forceinline__ int row(const Unit&, int) const { return 0; }
    int nM, nN, G, c; const char* A; const char* B; size_t tA, tB;
    __device__ __forceinline__ bool next(int i, Unit& u) const {
        const long L = (long)i * G + c; if (L >= (long)nM * nN) return false;
        pg8::tile_of((int)L, nM, nN, u.pm, u.pn); u.aux = 0; u.ord = i; u.A = A + (size_t)u.pm * tA; u.B = B + (size_t)u.pn * tB; return true;
    }
};
struct SchedMoe {
    static constexpr bool GATHER = false; __device__ __forceinline__ int row(const Unit&, int) const { return 0; }
    int G, c, ncol_shift, nT; const LAS int* tile_e; const LAS int* tile_pm; const char* A; const char* B; size_t tA, eB, tB;
    __device__ __forceinline__ bool next(int i, Unit& u) const {
        const long L = (long)i * G + c; if (L >= ((long)nT << ncol_shift)) return false;
        const int rt = (int)(L >> ncol_shift); u.pn = (int)(L & ((1 << ncol_shift) - 1)); u.pm = tile_pm[rt]; u.aux = tile_e[rt]; u.ord = i;
        u.A = A + (size_t)u.pm * tA; u.B = B + (size_t)u.aux * eB + (size_t)u.pn * tB; return true;
    }
};

struct SchedMoeG {
    static constexpr bool GATHER = true;
    int G, c, nT; const LAS int* tile_e; const LAS int* tile_pm; const LAS int* rows; const char* A; const char* B; size_t eB, tB;
    __device__ __forceinline__ bool next(int i, Unit& u) const {
        const long L = (long)i * G + c; if (L >= ((long)nT << 1)) return false;
        const int rt = (int)(L >> 1); u.pn = (int)(L & 1); u.pm = tile_pm[rt]; u.aux = tile_e[rt]; u.ord = i;
        u.A = A; u.B = B + (size_t)u.aux * eB + (size_t)u.pn * tB; return true;
    }
    __device__ __forceinline__ int row(const Unit& u, int r) const { return rows[(u.ord & 1) * 256 + r]; }
};

struct EpiProj { static constexpr int MID = 0; static constexpr bool PERM = true; bf16_t* O; const float* bgate; unsigned char* g8;
    __device__ __forceinline__ void operator()(const f32x4 (&acc)[2][2][4][2], const Unit& u, int wr, int wc, int fr, int fq) const {
        const int row0 = u.pm * 256 + wr * 64 + fr, col0 = u.pn * 256 + wc * 32 + 8 * fq; const bool act = u.pn < 4, gate = u.pn >= 18;
        for (int rep_ = 0; rep_ < (PROBE_DUP == 22 ? 2 : 1); ++rep_) {
        f32x4 bv[2][2];
#pragma unroll
        for (int bj = 0; bj < 2; ++bj)
#pragma unroll
            for (int n = 0; n < 2; ++n) bv[bj][n] = gate ? *(const f32x4*)(bgate + (col0 - C_GATE) + bj * 128 + 4 * n) : (f32x4){0.f, 0.f, 0.f, 0.f};
#pragma unroll
        for (int ai = 0; ai < 2; ++ai)
#pragma unroll
            for (int m = 0; m < 4; ++m) { bf16_t* rowp = O + (size_t)(row0 + ai * 128 + m * 16) * PP + col0;
#pragma unroll
                for (int bj = 0; bj < 2; ++bj) { f32x4 v0 = acc[ai][bj][m][0], v1 = acc[ai][bj][m][1];
                    if (act) {
#pragma unroll
                        for (int j = 0; j < 4; ++j) { v0[j] = gelu_tanh(v0[j]); v1[j] = gelu_tanh(v1[j]); } }
                    if (gate) {
                        v0 += bv[bj][0]; v1 += bv[bj][1];
                        unsigned p0 = 0u, p1 = 0u;
#pragma unroll
                        for (int j = 0; j < 4; ++j) { const unsigned q0 = (unsigned)fminf(fmaxf(sigmoidf_(v0[j]) * 255.f + 0.5f, 1.f), 255.f), q1 = (unsigned)fminf(fmaxf(sigmoidf_(v1[j]) * 255.f + 0.5f, 1.f), 255.f);
                            p0 |= q0 << (8 * j); p1 |= q1 << (8 * j); }
                        *(u32x2*)(g8 + (size_t)(row0 + ai * 128 + m * 16) * 3072 + (col0 - C_GATE) + bj * 128) = (u32x2){p0, p1};
                        continue; }
                    u32x4 w; w.x = cvt_pk_bf16(v0[0], v0[1]); w.y = cvt_pk_bf16(v0[2], v0[3]); w.z = cvt_pk_bf16(v1[0], v1[1]); w.w = cvt_pk_bf16(v1[2], v1[3]);
                    *(u32x4*)(rowp + bj * 128) = w; } }
        }
    }
};
__device__ __forceinline__ float gq(unsigned w, int k) { return (float)((w >> (8 * k)) & 255u); }
struct EpiMerge { static constexpr int MID = 8; static constexpr bool PERM = true; const unsigned char* g8; bf16_t* mb;
    __device__ __forceinline__ void pre(const Unit&, int, LAS unsigned char*, int, int) const {}
    __device__ __forceinline__ void mid(f32x4 (&acc)[2][2][4][2], const Unit& u, int j, int wr, int wc, int fr, int fq) const {
        const int row0 = u.pm * 256 + wr * 64 + fr, col0 = u.pn * 256 + wc * 32 + 8 * fq;
        const unsigned char* gp = g8 + (size_t)row0 * 3072 + (j - 1) * 1024 + col0;
#pragma unroll
        for (int ai = 0; ai < 2; ++ai) {
            u32x2 gprev[4][2], gcur[4][2];
#pragma unroll
            for (int m = 0; m < 4; ++m)
#pragma unroll
                for (int bj = 0; bj < 2; ++bj) { const unsigned char* p = gp + (size_t)(ai * 128 + m * 16) * 3072 + bj * 128; gprev[m][bj] = *(const u32x2*)p; gcur[m][bj] = *(const u32x2*)(p + 1024); }
#pragma unroll
            for (int m = 0; m < 4; ++m)
#pragma unroll
                for (int bj = 0; bj < 2; ++bj)
#pragma unroll
                    for (int n = 0; n < 2; ++n) { const int pw = n ? (int)gprev[m][bj].y : (int)gprev[m][bj].x, cw = n ? (int)gcur[m][bj].y : (int)gcur[m][bj].x;
                        acc[ai][bj][m][n][0] *= gq((unsigned)pw, 0) * __builtin_amdgcn_rcpf(gq((unsigned)cw, 0));
                        acc[ai][bj][m][n][1] *= gq((unsigned)pw, 1) * __builtin_amdgcn_rcpf(gq((unsigned)cw, 1));
                        acc[ai][bj][m][n][2] *= gq((unsigned)pw, 2) * __builtin_amdgcn_rcpf(gq((unsigned)cw, 2));
                        acc[ai][bj][m][n][3] *= gq((unsigned)pw, 3) * __builtin_amdgcn_rcpf(gq((unsigned)cw, 3)); }
        }
    }
    __device__ __forceinline__ void operator()(const f32x4 (&acc)[2][2][4][2], const Unit& u, int wr, int wc, int fr, int fq) const {
        const int row0 = u.pm * 256 + wr * 64 + fr, col0 = u.pn * 256 + wc * 32 + 8 * fq;
        const unsigned char* gp = g8 + (size_t)row0 * 3072 + 2 * 1024 + col0;
#pragma unroll
        for (int ai = 0; ai < 2; ++ai) {
            u32x2 g2[4][2];
#pragma unroll
            for (int m = 0; m < 4; ++m)
#pragma unroll
                for (int bj = 0; bj < 2; ++bj) g2[m][bj] = *(const u32x2*)(gp + (size_t)(ai * 128 + m * 16) * 3072 + bj * 128);
#pragma unroll
            for (int m = 0; m < 4; ++m)
#pragma unroll
                for (int bj = 0; bj < 2; ++bj) { float o[8];
#pragma unroll
                    for (int n = 0; n < 2; ++n) { const int gw = n ? (int)g2[m][bj].y : (int)g2[m][bj].x;
                        o[4 * n + 0] = acc[ai][bj][m][n][0] * (gq((unsigned)gw, 0) * (1.f / 255.f)); o[4 * n + 1] = acc[ai][bj][m][n][1] * (gq((unsigned)gw, 1) * (1.f / 255.f));
                        o[4 * n + 2] = acc[ai][bj][m][n][2] * (gq((unsigned)gw, 2) * (1.f / 255.f)); o[4 * n + 3] = acc[ai][bj][m][n][3] * (gq((unsigned)gw, 3) * (1.f / 255.f)); }
                    u32x4 w; w.x = cvt_pk_bf16(o[0], o[1]); w.y = cvt_pk_bf16(o[2], o[3]); w.z = cvt_pk_bf16(o[4], o[5]); w.w = cvt_pk_bf16(o[6], o[7]);
                    *(u32x4*)(mb + (size_t)(row0 + ai * 128 + m * 16) * 1024 + col0 + bj * 128) = w; }
        }
    }
};
struct EpiOut { static constexpr int MID = 0; static constexpr bool PERM = false; float* out; const float* xsrc; const float* gt; float scl;
    __device__ __forceinline__ void operator()(const f32x4 (&acc)[2][2][4][2], const Unit& u, int wr, int wc, int fr, int fq) const {
        const int row0 = u.pm * 256 + wr * 64 + fr, col0 = u.pn * 256 + wc * 32 + 4 * fq; const float* g = gt + (size_t)(u.pm >> 4) * 6144;
        f32x4 gv[2][2];
#pragma unroll
        for (int bj = 0; bj < 2; ++bj)
#pragma unroll
            for (int n = 0; n < 2; ++n) gv[bj][n] = *(const f32x4*)(g + col0 + bj * 128 + n * 16) * scl;
#pragma unroll
        for (int ai = 0; ai < 2; ++ai) {
            f32x4 xv[4][2][2];
#pragma unroll
            for (int m = 0; m < 4; ++m)
#pragma unroll
                for (int bj = 0; bj < 2; ++bj)
#pragma unroll
                    for (int n = 0; n < 2; ++n) xv[m][bj][n] = *(const f32x4*)(xsrc + (size_t)(row0 + ai * 128 + m * 16) * 1024 + col0 + bj * 128 + n * 16);
#pragma unroll
            for (int m = 0; m < 4; ++m)
#pragma unroll
                for (int bj = 0; bj < 2; ++bj)
#pragma unroll
                    for (int n = 0; n < 2; ++n) *(f32x4*)(out + (size_t)(row0 + ai * 128 + m * 16) * 1024 + col0 + bj * 128 + n * 16) = xv[m][bj][n] + gv[bj][n] * acc[ai][bj][m][n];
        }
    }
};
struct EpiMoe1 { static constexpr int MID = 0; static constexpr bool PERM = true; bf16_t* act; const LAS float* lw;
    __device__ __forceinline__ void operator()(const f32x4 (&acc)[2][2][4][2], const Unit& u, int wr, int wc, int fr, int fq) const {
        const int row0 = u.pm * 256 + wr * 64 + fr, col0 = u.pn * 128 + wc * 32 + 8 * fq;
        float wv[2][4];
#pragma unroll
        for (int ai = 0; ai < 2; ++ai)
#pragma unroll
            for (int m = 0; m < 4; ++m) wv[ai][m] = lw[(u.ord & 1) * 256 + wr * 64 + fr + ai * 128 + m * 16];
#pragma unroll
        for (int ai = 0; ai < 2; ++ai)
#pragma unroll
            for (int m = 0; m < 4; ++m) { const int r = row0 + ai * 128 + m * 16; const float w = wv[ai][m]; float o[8];
#pragma unroll
                for (int n = 0; n < 2; ++n)
#pragma unroll
                    for (int j = 0; j < 4; ++j) { const float g = acc[ai][0][m][n][j], up = acc[ai][1][m][n][j]; o[4 * n + j] = g * sigmoidf_(g) * up * w; }
                u32x4 pk; pk.x = cvt_pk_bf16(o[0], o[1]); pk.y = cvt_pk_bf16(o[2], o[3]); pk.z = cvt_pk_bf16(o[4], o[5]); pk.w = cvt_pk_bf16(o[6], o[7]);
                *(u32x4*)(act + (size_t)r * 256 + col0) = pk; }
    }
};
struct EpiMoe2 { static constexpr int MID = 0; static constexpr bool PERM = true; bf16_t* O;
    __device__ __forceinline__ void operator()(const f32x4 (&acc)[2][2][4][2], const Unit& u, int wr, int wc, int fr, int fq) const {
        const int row0 = u.pm * 256 + wr * 64 + fr, col0 = u.pn * 256 + wc * 32 + 8 * fq;
#pragma unroll
        for (int ai = 0; ai < 2; ++ai)
#pragma unroll
            for (int m = 0; m < 4; ++m) { bf16_t* rowp = O + (size_t)(row0 + ai * 128 + m * 16) * 1024 + col0;
#pragma unroll
                for (int bj = 0; bj < 2; ++bj) { const f32x4 v0 = acc[ai][bj][m][0], v1 = acc[ai][bj][m][1];
                    u32x4 w; w.x = cvt_pk_bf16(v0[0], v0[1]); w.y = cvt_pk_bf16(v0[2], v0[3]); w.z = cvt_pk_bf16(v1[0], v1[1]); w.w = cvt_pk_bf16(v1[2], v1[3]);
                    *(u32x4*)(rowp + bj * 128) = w; } }
    }
};

__device__ __forceinline__ void phase_mod(const Ctx& X) {
    LAS float* sc = (LAS float*)X.lds;
    LAS float* red = (LAS float*)(X.lds + 16384);
    const float* c = INP(1); const float* wm = INP(2); const float* bm = INP(3); float* mod = WSP(float, WS_MOD);
    for (int i = X.tid; i < 4096; i += 512) { const float v = c[i]; sc[i] = v * sigmoidf_(v); }
    __syncthreads();
    const int jj = X.tid & 63, ks = X.tid >> 6;
    for (int u = X.c; u < NL * 96; u += X.G) {
        const int l = u / 96, j0 = (u % 96) * 64;
        float a0 = 0.f, a1 = 0.f, a2 = 0.f, a3 = 0.f;
        const float* wp = wm + ((size_t)l * 1024 + ks * 128) * 6144 + j0 + jj;
        for (int k0 = 0; k0 < 128; k0 += 32) { float w[32];
#pragma unroll
            for (int k = 0; k < 32; ++k) w[k] = __builtin_nontemporal_load(wp + (size_t)(k0 + k) * 6144);
#pragma unroll
            for (int k = 0; k < 32; ++k) { const int kk = ks * 128 + k0 + k;
                a0 += sc[kk] * w[k]; a1 += sc[1024 + kk] * w[k]; a2 += sc[2048 + kk] * w[k]; a3 += sc[3072 + kk] * w[k]; } }
        red[(ks * 64 + jj) * 4 + 0] = a0; red[(ks * 64 + jj) * 4 + 1] = a1; red[(ks * 64 + jj) * 4 + 2] = a2; red[(ks * 64 + jj) * 4 + 3] = a3;
        __syncthreads();
        if (X.tid < 256) { const int b = X.tid >> 6; float s = bm[l * 6144 + j0 + jj];
#pragma unroll
            for (int q = 0; q < 8; ++q) s += red[(q * 64 + jj) * 4 + b];
            mod[((size_t)l * NB + b) * 6144 + j0 + jj] = s; }
        __syncthreads();
    }
}

__device__ __forceinline__ int wincol(int m) {
    if (m < 2560) return m;
    if (m < 4416) return m + 16;
    if (m < 4432) return 2560 + (m - 4416);
    if (m < 4436) return m;
    if (m < 4608) return -1;
    return 4436 + (m - 4608);
}
constexpr int CJ0 = 480, CJ1 = CJ0 + 96, CJ2 = CJ1 + 64, CJ3 = CJ2 + 512, CJ4 = CJ3 + 256, CJ5 = CJ4 + 16;
__device__ __forceinline__ void conv_job(const Ctx& X, int l, int j) {
    LAS float* tile = (LAS float*)X.lds;
    const int c = X.tid & 63, r0 = X.tid >> 6;
    if (j >= CJ4) {
        const int q = j - CJ4; const float* src = INP(9) + (size_t)l * 65536; bf16_t* dst = WSW(bf16_t, WS_WS, l);
        for (int i = X.tid; i < 4096; i += 512) { const int e = q * 4096 + i, t = (e >> 7) & 127, s = e & 127; dst[e] = f2bf(s <= t ? src[e] : 0.f); }
        return;
    }
    const float* sp; int sld, scol; bf16_t* dp; int dld;
    if (j < CJ0) { const int nt = j >> 2, kt = j & 3; sp = INP(6) + ((size_t)l * 1024 + kt * 256) * NIN; sld = NIN; scol = wincol(nt * 64 + c);
        dp = WSW(bf16_t, WS_WIN, l) + (size_t)(nt * 64) * 1024 + kt * 256; dld = 1024; }
    else if (j < CJ1) { const int q = j - CJ0, n = q >> 5, dt = (q >> 1) & 15, et = q & 1;
        sp = INP(17) + (((size_t)l * 3 + n) * 512 + et * 256) * 1024; sld = 1024; scol = dt * 64 + c;
        dp = WSW(bf16_t, WS_WBR, l) + (size_t)(dt * 64) * YW + n * 512 + et * 256; dld = YW; }
    else if (j < CJ2) { const int q = j - CJ1, nt = q >> 2, kt = q & 3;
        sp = INP(19) + ((size_t)l * 1024 + kt * 256) * 1024; sld = 1024; scol = nt * 64 + c;
        dp = WSW(bf16_t, WS_WOUT, l) + (size_t)(nt * 64) * 1024 + kt * 256; dld = 1024; }
    else if (j < CJ3) { const int q = j - CJ2, e = q >> 5, rt = (q >> 2) & 7, kt = q & 3; const int n0 = rt * 64, pn = n0 >> 8, half = (n0 >> 7) & 1;
        sp = (half ? INP(25) : INP(24)) + (((size_t)l * 16 + e) * 1024 + kt * 256) * 256; sld = 256; scol = 128 * pn + (n0 & 127) + c;
        dp = WSW(bf16_t, WS_WE1, l) + ((size_t)e * 512 + n0) * 1024 + kt * 256; dld = 1024; }
    else { const int q = j - CJ3, e = q >> 4, dt = q & 15;
        sp = INP(26) + ((size_t)l * 16 + e) * 256 * 1024; sld = 1024; scol = dt * 64 + c;
        dp = WSW(bf16_t, WS_WE2, l) + ((size_t)e * 1024 + dt * 64) * 256; dld = 256; }
#pragma unroll
    for (int i = 0; i < 32; ++i) { const int k = r0 + 8 * i; tile[k * 65 + c] = scol >= 0 ? __builtin_nontemporal_load(sp + (size_t)k * sld + scol) : 0.f; }
    __syncthreads();
    { const int kc = X.tid & 127, nr = X.tid >> 7;
#pragma unroll
      for (int i = 0; i < 16; ++i) { const int n = nr + 4 * i; *(unsigned*)(dp + (size_t)n * dld + 2 * kc) = cvt_pk_bf16(tile[(2 * kc) * 65 + n], tile[(2 * kc + 1) * 65 + n]); } }
    __syncthreads();
}
__device__ __forceinline__ void phase_conv(const Ctx& X, int l) {
    for (int j = X.c; j < CJ5; j += X.G) conv_job(X, l, j);
}
__device__ __forceinline__ void phase_conv_dyn(const Ctx& X, int l, unsigned* q, int maxjobs) {
    LAS int* jslot = (LAS int*)(X.lds + AUX_OFF + 64);
    for (int nj = 0; nj < maxjobs; ++nj) {
        if (X.tid == 0) *jslot = (int)__hip_atomic_fetch_add(q, 1u, __ATOMIC_RELAXED, __HIP_MEMORY_SCOPE_AGENT);
        __syncthreads();
        const int j = *jslot;
        __syncthreads();
        if (j >= CJ5) break;
        conv_job(X, l, j);
    }
}

__device__ __forceinline__ void phase_norm1(const Ctx& X, int l, int mode, float fscale = 1.f) {
    const float* xin = INP(0); float* out = X.out; const float* mod = WSP(float, WS_MOD);
    const bf16_t* ffn = WSP(bf16_t, WS_FFN); const int* toks = WSP(int, WS_TOKS); bf16_t* h = WSP(bf16_t, WS_H);
    const float* g1 = INP(4) + (size_t)l * 1024;
    constexpr int NBATCH = 4;
    const int rstride = X.G * 8;
    for (int r0 = X.c * 8 + X.wave; r0 < T; r0 += rstride * NBATCH) {
        f32x4 xv[NBATCH][4]; u32x2 fa[NBATCH][4], fb[NBATCH][4]; int sl[NBATCH][2];
        if (mode != 0) {
#pragma unroll
            for (int j = 0; j < NBATCH; ++j) { const int r = r0 + j * rstride; sl[j][0] = r < T ? toks[2 * r] : 0; sl[j][1] = r < T ? toks[2 * r + 1] : 0; }
        }
#pragma unroll
        for (int j = 0; j < NBATCH; ++j) { const int r = r0 + j * rstride < T ? r0 + j * rstride : r0;
#pragma unroll
            for (int i = 0; i < 4; ++i) { const int col = 4 * X.lane + 256 * i;
                xv[j][i] = *(const f32x4*)((mode == 0 ? xin : out) + (size_t)r * 1024 + col);
                if (mode != 0) { fa[j][i] = *(const u32x2*)(ffn + (size_t)sl[j][0] * 1024 + col); fb[j][i] = *(const u32x2*)(ffn + (size_t)sl[j][1] * 1024 + col); } } }
#pragma unroll
        for (int j = 0; j < NBATCH; ++j) { const int r = r0 + j * rstride; if (r >= T) break;
            const int b = r >> 12;
            if (mode != 0) { const float* gt2 = mod + ((size_t)(l - 1) * NB + b) * 6144 + 5120;
#pragma unroll
                for (int i = 0; i < 4; ++i) { const int col = 4 * X.lane + 256 * i; const f32x4 g = *(const f32x4*)(gt2 + col); const u32x2 a = fa[j][i], bb = fb[j][i];
                    f32x4 f; f[0] = lo_bf(a.x) + lo_bf(bb.x); f[1] = hi_bf(a.x) + hi_bf(bb.x); f[2] = lo_bf(a.y) + lo_bf(bb.y); f[3] = hi_bf(a.y) + hi_bf(bb.y);
                    xv[j][i] = xv[j][i] + g * f * fscale; } }
            if (mode != 0) {
#pragma unroll
                for (int i = 0; i < 4; ++i) *(f32x4*)(out + (size_t)r * 1024 + 4 * X.lane + 256 * i) = xv[j][i]; }
            if (mode == 2) continue;
            float ss = 0.f;
#pragma unroll
            for (int i = 0; i < 4; ++i) ss += xv[j][i][0] * xv[j][i][0] + xv[j][i][1] * xv[j][i][1] + xv[j][i][2] * xv[j][i][2] + xv[j][i][3] * xv[j][i][3];
            ss = wave_sum(ss);
            const float rstd = __builtin_amdgcn_rsqf(ss * (1.f / 1024.f) + EPS);
            const float* md = mod + ((size_t)l * NB + b) * 6144;
#pragma unroll
            for (int i = 0; i < 4; ++i) { const int col = 4 * X.lane + 256 * i;
                const f32x4 g = *(const f32x4*)(g1 + col), sh = *(const f32x4*)(md + col), sc = *(const f32x4*)(md + 1024 + col);
                f32x4 yv = xv[j][i] * rstd * g * (sc + 1.f) + sh;
                u32x2 w; w.x = cvt_pk_bf16(yv[0], yv[1]); w.y = cvt_pk_bf16(yv[2], yv[3]); *(u32x2*)(h + (size_t)r * 1024 + col) = w; }
        }
    }
}

__device__ __forceinline__ void sub_qknorm(const Ctx& X, int l) {
    bf16_t* proj = WSP(bf16_t, WS_PROJ);
    const float* gp = INP(15) + (size_t)l * 128 + 8 * (X.lane & 15);
    float g[8];
#pragma unroll
    for (int i = 0; i < 8; ++i) g[i] = gp[i];
    const int rstride = X.G * 8;
    for (int r0 = X.c * 8 + X.wave; r0 < T; r0 += 4 * rstride) {
        u32x4 lk[4];
#pragma unroll
        for (int q = 0; q < 4; ++q) { const int r = r0 + q * rstride < T ? r0 + q * rstride : r0; lk[q] = *(const u32x4*)(proj + (size_t)r * PP + C_DK + 8 * X.lane); }
#pragma unroll
        for (int q = 0; q < 4; ++q) { const int r = r0 + q * rstride; if (r >= T) break;
            const u32x4 a = lk[q]; float v[8] = {lo_bf(a.x), hi_bf(a.x), lo_bf(a.y), hi_bf(a.y), lo_bf(a.z), hi_bf(a.z), lo_bf(a.w), hi_bf(a.w)};
            float ss = 0.f;
#pragma unroll
            for (int i = 0; i < 8; ++i) ss += v[i] * v[i];
            ss = sum16(ss);
            const float rstd = __builtin_amdgcn_rsqf(ss * (1.f / 128.f) + EPS);
#pragma unroll
            for (int i = 0; i < 8; ++i) v[i] = v[i] * rstd * g[i];
            u32x4 o; o.x = cvt_pk_bf16(v[0], v[1]); o.y = cvt_pk_bf16(v[2], v[3]); o.z = cvt_pk_bf16(v[4], v[5]); o.w = cvt_pk_bf16(v[6], v[7]);
            *(u32x4*)(proj + (size_t)r * PP + C_DK + 8 * X.lane) = o; }
    }
}
__device__ __forceinline__ void sub_vtrans(const Ctx& X) {
    const bf16_t* proj = WSP(bf16_t, WS_PROJ); bf16_t* vt = WSP(bf16_t, WS_VT);
    LAS bf16_t* tile = (LAS bf16_t*)X.lds;
    for (int j0 = X.c; j0 < 2048; j0 += 2 * X.G) {
        u32x4 v[2];
#pragma unroll
        for (int q = 0; q < 2; ++q) { const int j = j0 + q * X.G < 2048 ? j0 + q * X.G : j0; const int bh = j >> 7, et = (j >> 6) & 1, st = j & 63, b = bh >> 2, hh = bh & 3;
            v[q] = *(const u32x4*)(proj + ((size_t)b * SEQ + st * 64 + (X.tid >> 3)) * PP + C_DV + 128 * hh + et * 64 + (X.tid & 7) * 8); }
#pragma unroll
        for (int q = 0; q < 2; ++q) *(LAS u32x4*)(tile + q * 4608 + (X.tid >> 3) * 72 + (X.tid & 7) * 8) = v[q];
        __syncthreads();
#pragma unroll
        for (int q = 0; q < 2; ++q) { const int j = j0 + q * X.G; if (j >= 2048) break; const int bh = j >> 7, et = (j >> 6) & 1, st = j & 63;
          const int e = X.tid >> 3, s8 = (X.tid & 7) * 8; unsigned short w8[8];
#pragma unroll
          for (int i = 0; i < 8; ++i) w8[i] = tile[q * 4608 + ((s8 & ~15) + 4 * ((s8 >> 3) & 1) + (i & 3) + 8 * (i >> 2)) * 72 + e];
          u32x4 w; w.x = w8[0] | ((unsigned)w8[1] << 16); w.y = w8[2] | ((unsigned)w8[3] << 16); w.z = w8[4] | ((unsigned)w8[5] << 16); w.w = w8[6] | ((unsigned)w8[7] << 16);
          *(u32x4*)(vt + ((size_t)bh * 128 + et * 64 + e) * SEQ + st * 64 + s8) = w; }
        __syncthreads();
    }
}

__device__ __forceinline__ void sub_gmlp(const Ctx& X, int l) {
    const bf16_t* proj = WSP(bf16_t, WS_PROJ); bf16_t* y = WSP(bf16_t, WS_Y); const bf16_t* wsb = WSW(bf16_t, WS_WS, l);
    LAS unsigned char* Wg = X.lds; LAS unsigned char* Vn = X.lds + 34816; LAS float* st = (LAS float*)(X.lds + 69632);
    const float* lng = INP(7) + (size_t)l * 512; const float* lnb = INP(8) + (size_t)l * 512; const float* bs = INP(10) + (size_t)l * 512;
    const int r = X.lane & 31, hf = X.lane >> 5;
    for (int u = X.c; u < 512; u += X.G) {
        const int ch = u >> 2, g = u & 3; const size_t t0 = (size_t)ch * 128;
#pragma unroll
        for (int i = 0; i < 4; ++i) { const int q = X.tid + 512 * i, row = q >> 4, cc = q & 15;
            *(LAS u32x4*)(Wg + row * 272 + cc * 16) = *(const u32x4*)(wsb + ((size_t)g * 128 + row) * 128 + cc * 8); }
        { u32x4 av[16];
#pragma unroll
          for (int i = 0; i < 16; ++i) av[i] = *(const u32x4*)(proj + (t0 + X.wave * 16 + i) * PP + C_AV + 8 * X.lane);
#pragma unroll
          for (int i = 0; i < 16; ++i) { const int tt = X.wave * 16 + i; const u32x4 a = av[i];
            float v[8] = {lo_bf(a.x), hi_bf(a.x), lo_bf(a.y), hi_bf(a.y), lo_bf(a.z), hi_bf(a.z), lo_bf(a.w), hi_bf(a.w)};
            float s = 0.f;
#pragma unroll
            for (int k = 0; k < 8; ++k) s += v[k];
            const float mean = wave_sum(s) * (1.f / 512.f);
            float q2 = 0.f;
#pragma unroll
            for (int k = 0; k < 8; ++k) { const float d = v[k] - mean; q2 += d * d; }
            const float rstd = __builtin_amdgcn_rsqf(wave_sum(q2) * (1.f / 512.f) + EPS);
            if (X.lane == 0) { st[2 * tt] = mean; st[2 * tt + 1] = rstd; } } }
        __syncthreads();
#pragma unroll
        for (int i = 0; i < 4; ++i) { const int q = X.tid + 512 * i, tt = q & 127, jb = q >> 7;
            const u32x4 a = *(const u32x4*)(proj + (t0 + tt) * PP + C_AV + 128 * g + 8 * jb);
            const float mean = st[2 * tt], rstd = st[2 * tt + 1];
            float v[8] = {lo_bf(a.x), hi_bf(a.x), lo_bf(a.y), hi_bf(a.y), lo_bf(a.z), hi_bf(a.z), lo_bf(a.w), hi_bf(a.w)};
#pragma unroll
            for (int e = 0; e < 8; ++e) { const int d = 8 * jb + e; const float o = (v[e] - mean) * rstd * lng[128 * g + d] + lnb[128 * g + d];
                *(LAS bf16_t*)(Vn + d * 272 + tt * 2) = f2bf(o); } }
        __syncthreads();
        { const int tb = X.wave >> 1, dh = X.wave & 1;
          f32x16 acc[2]; bf16_t uu[2][16];
#pragma unroll
          for (int nb = 0; nb < 2; ++nb)
#pragma unroll
              for (int k = 0; k < 16; ++k) { acc[nb][k] = 0.f; uu[nb][k] = proj[(t0 + 32 * tb + (k & 3) + 8 * (k >> 2) + 4 * hf) * PP + C_AU + 128 * g + 64 * dh + 32 * nb + r]; }
          const int nks = 2 * (tb + 1);
          for (int ks = 0; ks < nks; ++ks) {
              const bf16x8 a = *(const LAS bf16x8*)(Wg + (32 * tb + r) * 272 + (16 * ks + 8 * hf) * 2);
#pragma unroll
              for (int nb = 0; nb < 2; ++nb) { const bf16x8 b = *(const LAS bf16x8*)(Vn + (64 * dh + 32 * nb + r) * 272 + (16 * ks + 8 * hf) * 2);
                  acc[nb] = __builtin_amdgcn_mfma_f32_32x32x16_bf16(a, b, acc[nb], 0, 0, 0); } }
#pragma unroll
          for (int nb = 0; nb < 2; ++nb)
#pragma unroll
              for (int k = 0; k < 16; ++k) { const int t = 32 * tb + (k & 3) + 8 * (k >> 2) + 4 * hf, d = 64 * dh + 32 * nb + r;
                  y[(t0 + t) * YW + 128 * g + d] = f2bf((acc[nb][k] + bs[g * 128 + t]) * bf2f(uu[nb][k])); } }
        __syncthreads();
    }
}

__device__ __forceinline__ float log_sigmoid_(float z) { return fminf(z, 0.f) - __logf(1.f + __expf(-fabsf(z))); }

__device__ __forceinline__ void sub_gla_local(const Ctx& X, int l) {
    const bf16_t* proj = WSP(bf16_t, WS_PROJ); float* U = WSP(float, WS_SCR); float* dec = WSP(float, WS_DEC);
    LAS float* ga = (LAS float*)X.lds; LAS float* seg = (LAS float*)(X.lds + 4096);
    LAS unsigned char* kkT = X.lds + 8192; LAS unsigned char* vT = X.lds + 17408; LAS unsigned char* kraw = X.lds + 36864;
    const int r = X.lane & 31, hf = X.lane >> 5;
    for (int u = X.c; u < 1024; u += X.G) {
        const int hh = u & 3, cch = (u >> 2) & 63, b = u >> 8; const size_t t0 = (size_t)b * SEQ + cch * 64;
        const int d = X.tid & 63, tq = X.tid >> 6;
        u32x4 lga = {0u, 0u, 0u, 0u}; if (X.tid < 128) lga = *(const u32x4*)(proj + (t0 + (X.tid >> 1)) * PP + C_GA + 8 * (X.tid & 1));
        u32x4 lv[2];
#pragma unroll
        for (int i = 0; i < 2; ++i) { const int q = X.tid + 512 * i, s = q & 63, eb = q >> 6; lv[i] = *(const u32x4*)(proj + (t0 + s) * PP + C_GV + 128 * hh + 8 * eb); }
        const u32x4 lk = *(const u32x4*)(proj + (t0 + (X.tid >> 3)) * PP + C_GK + 64 * hh + 8 * (X.tid & 7));
        float w2[16];
#pragma unroll
        for (int q = 0; q < 16; ++q) w2[q] = INP(11)[((size_t)l * 16 + q) * 256 + hh * 64 + d];
        const float bg = INP(12)[(size_t)l * 256 + hh * 64 + d];
        if (X.tid < 128) { LAS float* gp = ga + (X.tid >> 1) * 16 + 8 * (X.tid & 1);
            gp[0] = lo_bf(lga.x); gp[1] = hi_bf(lga.x); gp[2] = lo_bf(lga.y); gp[3] = hi_bf(lga.y); gp[4] = lo_bf(lga.z); gp[5] = hi_bf(lga.z); gp[6] = lo_bf(lga.w); gp[7] = hi_bf(lga.w); }
#pragma unroll
        for (int i = 0; i < 2; ++i) { const int q = X.tid + 512 * i, s = q & 63, eb = q >> 6; const unsigned w[4] = {lv[i].x, lv[i].y, lv[i].z, lv[i].w};
#pragma unroll
            for (int k = 0; k < 4; ++k) { *(LAS bf16_t*)(vT + (8 * eb + 2 * k) * 144 + s * 2) = (bf16_t)(w[k] & 0xffffu); *(LAS bf16_t*)(vT + (8 * eb + 2 * k + 1) * 144 + s * 2) = (bf16_t)(w[k] >> 16); } }
        *(LAS u32x4*)(kraw + (X.tid >> 3) * 144 + 16 * (X.tid & 7)) = lk;
        __syncthreads();
        float cum[8];
        { float run = 0.f;
#pragma unroll
          for (int i = 0; i < 8; ++i) { const int t = 8 * tq + i; float z = bg;
#pragma unroll
              for (int q = 0; q < 16; ++q) z += ga[t * 16 + q] * w2[q];
              run += log_sigmoid_(z) * (1.f / 16.f); cum[i] = run; }
          seg[tq * 64 + d] = run; }
        __syncthreads();
        { float pre = 0.f, tot = 0.f;
#pragma unroll
          for (int q = 0; q < 8; ++q) { const float s = seg[q * 64 + d]; tot += s; if (q < tq) pre += s; }
          float kk[8];
#pragma unroll
          for (int i = 0; i < 8; ++i) { const int t = 8 * tq + i; const float kv = bf2f(*(const LAS bf16_t*)(kraw + t * 144 + d * 2)); kk[i] = kv * __expf(tot - (pre + cum[i])); }
          u32x4 w; w.x = cvt_pk_bf16(kk[0], kk[1]); w.y = cvt_pk_bf16(kk[2], kk[3]); w.z = cvt_pk_bf16(kk[4], kk[5]); w.w = cvt_pk_bf16(kk[6], kk[7]);
          *(LAS u32x4*)(kkT + d * 144 + 16 * tq) = w;
          if (tq == 0) dec[(size_t)u * 64 + d] = __expf(tot); }
        __syncthreads();
        { const int db = X.wave >> 2, eb = X.wave & 3; f32x16 acc;
#pragma unroll
          for (int k = 0; k < 16; ++k) acc[k] = 0.f;
#pragma unroll
          for (int ks = 0; ks < 4; ++ks) { const bf16x8 a = *(const LAS bf16x8*)(kkT + (32 * db + r) * 144 + (16 * ks + 8 * hf) * 2);
              const bf16x8 bb = *(const LAS bf16x8*)(vT + (32 * eb + r) * 144 + (16 * ks + 8 * hf) * 2);
              acc = __builtin_amdgcn_mfma_f32_32x32x16_bf16(a, bb, acc, 0, 0, 0); }
#pragma unroll
          for (int k = 0; k < 16; ++k) { const int dd = 32 * db + (k & 3) + 8 * (k >> 2) + 4 * hf; U[((size_t)u * 64 + dd) * 128 + 32 * eb + r] = acc[k]; } }
        __syncthreads();
    }
}

__device__ __forceinline__ void sub_gla_scan(const Ctx& X) {
    const float* U = WSP(float, WS_SCR); bf16_t* Sb = WSP(bf16_t, WS_SCR + (size_t)T * 1024 * 2); const float* dec = WSP(float, WS_DEC);
    for (int gid = X.c * 512 + X.tid; gid < 16 * 8192; gid += X.G * 512) {
        const int bh = gid >> 13, de = gid & 8191, d = de >> 7, b = bh >> 2, hh = bh & 3;
        float S = 0.f;
        for (int cb = 0; cb < 4; ++cb) {
            float uv[16], dc[16];
#pragma unroll
            for (int j = 0; j < 16; ++j) { const size_t u = (size_t)b * 256 + (cb * 16 + j) * 4 + hh; uv[j] = U[u * 8192 + de]; dc[j] = dec[u * 64 + d]; }
#pragma unroll
            for (int j = 0; j < 16; ++j) { const size_t u = (size_t)b * 256 + (cb * 16 + j) * 4 + hh; Sb[u * 8192 + de] = f2bf(S); S = dc[j] * S + uv[j]; }
        }
    }
}

__device__ __forceinline__ void sub_gla_out(const Ctx& X, int l) {
    const bf16_t* proj = WSP(bf16_t, WS_PROJ); const bf16_t* Sg = WSP(bf16_t, WS_SCR + (size_t)T * 1024 * 2); bf16_t* y = WSP(bf16_t, WS_Y);
    LAS float* ga = (LAS float*)X.lds; LAS float* seg = (LAS float*)(X.lds + 4096);
    LAS unsigned char* qq = X.lds + 8192; LAS unsigned char* qS = X.lds + 17408; LAS unsigned char* kk2 = X.lds + 26624;
    LAS unsigned char* vT = X.lds + 35840; LAS unsigned char* ST = X.lds + 54272; LAS unsigned char* at = X.lds + 72704; LAS float* ob = (LAS float*)(X.lds + 81920);
    LAS unsigned char* qraw = at; LAS unsigned char* kraw = X.lds + 81920;
    const int r = X.lane & 31, hf = X.lane >> 5;
    for (int u = X.c; u < 1024; u += X.G) {
        const int hh = u & 3, cch = (u >> 2) & 63, b = u >> 8; const size_t t0 = (size_t)b * SEQ + cch * 64;
        const int d = X.tid & 63, tq = X.tid >> 6;
        u32x4 lga = {0u, 0u, 0u, 0u}; if (X.tid < 128) lga = *(const u32x4*)(proj + (t0 + (X.tid >> 1)) * PP + C_GA + 8 * (X.tid & 1));
        u32x4 lv[2]; u32x4 ls[2];
#pragma unroll
        for (int i = 0; i < 2; ++i) { const int q = X.tid + 512 * i, s = q & 63, eb = q >> 6; lv[i] = *(const u32x4*)(proj + (t0 + s) * PP + C_GV + 128 * hh + 8 * eb); }
#pragma unroll
        for (int i = 0; i < 2; ++i) ls[i] = *(const u32x4*)(Sg + (size_t)u * 8192 + 8 * X.tid + 4096 * i);
        const u32x4 lq = *(const u32x4*)(proj + (t0 + (X.tid >> 3)) * PP + C_GQ + 64 * hh + 8 * (X.tid & 7));
        const u32x4 lk = *(const u32x4*)(proj + (t0 + (X.tid >> 3)) * PP + C_GK + 64 * hh + 8 * (X.tid & 7));
        const bf16_t* rp = proj + (t0 + (X.tid >> 3)) * PP + C_GR + 128 * hh + 16 * (X.tid & 7);
        const u32x4 ra = *(const u32x4*)rp, rb = *(const u32x4*)(rp + 8);
        float w2[16];
#pragma unroll
        for (int q = 0; q < 16; ++q) w2[q] = INP(11)[((size_t)l * 16 + q) * 256 + hh * 64 + d];
        const float bg = INP(12)[(size_t)l * 256 + hh * 64 + d];
        if (X.tid < 128) { LAS float* gp = ga + (X.tid >> 1) * 16 + 8 * (X.tid & 1);
            gp[0] = lo_bf(lga.x); gp[1] = hi_bf(lga.x); gp[2] = lo_bf(lga.y); gp[3] = hi_bf(lga.y); gp[4] = lo_bf(lga.z); gp[5] = hi_bf(lga.z); gp[6] = lo_bf(lga.w); gp[7] = hi_bf(lga.w); }
#pragma unroll
        for (int i = 0; i < 2; ++i) { const int q = X.tid + 512 * i, s = q & 63, eb = q >> 6; const unsigned w[4] = {lv[i].x, lv[i].y, lv[i].z, lv[i].w};
#pragma unroll
            for (int k = 0; k < 4; ++k) { *(LAS bf16_t*)(vT + (8 * eb + 2 * k) * 144 + s * 2) = (bf16_t)(w[k] & 0xffffu); *(LAS bf16_t*)(vT + (8 * eb + 2 * k + 1) * 144 + s * 2) = (bf16_t)(w[k] >> 16); } }
#pragma unroll
        for (int i = 0; i < 2; ++i) { const int q = 8 * X.tid + 4096 * i, dd = q >> 7, e = q & 127; const unsigned w[4] = {ls[i].x, ls[i].y, ls[i].z, ls[i].w};
#pragma unroll
            for (int k = 0; k < 4; ++k) { *(LAS bf16_t*)(ST + (e + 2 * k) * 144 + dd * 2) = (bf16_t)(w[k] & 0xffffu); *(LAS bf16_t*)(ST + (e + 2 * k + 1) * 144 + dd * 2) = (bf16_t)(w[k] >> 16); } }
        *(LAS u32x4*)(qraw + (X.tid >> 3) * 144 + 16 * (X.tid & 7)) = lq; *(LAS u32x4*)(kraw + (X.tid >> 3) * 144 + 16 * (X.tid & 7)) = lk;
        __syncthreads();
        float cum[8];
        { float run = 0.f;
#pragma unroll
          for (int i = 0; i < 8; ++i) { const int t = 8 * tq + i; float z = bg;
#pragma unroll
              for (int q = 0; q < 16; ++q) z += ga[t * 16 + q] * w2[q];
              run += log_sigmoid_(z) * (1.f / 16.f); cum[i] = run; }
          seg[tq * 64 + d] = run; }
        __syncthreads();
        { float pre = 0.f, bref = 0.f;
#pragma unroll
          for (int q = 0; q < 8; ++q) { const float s = seg[q * 64 + d]; if (q < tq) pre += s; if (q < 4) bref += s; }
          float qv[8], kv[8];
#pragma unroll
          for (int i = 0; i < 8; ++i) { const int t = 8 * tq + i; qv[i] = bf2f(*(const LAS bf16_t*)(qraw + t * 144 + d * 2)) * 0.125f; kv[i] = bf2f(*(const LAS bf16_t*)(kraw + t * 144 + d * 2)); }
#pragma unroll
          for (int i = 0; i < 8; ++i) { const int t = 8 * tq + i; const float bt = pre + cum[i];
              *(LAS bf16_t*)(qq + t * 144 + d * 2) = f2bf(qv[i] * __expf(bt - bref));
              *(LAS bf16_t*)(qS + t * 144 + d * 2) = f2bf(qv[i] * __expf(bt));
              *(LAS bf16_t*)(kk2 + t * 144 + d * 2) = f2bf(kv[i] * __expf(bref - bt)); } }
        __syncthreads();
        if (X.wave < 4) { const int tb = X.wave >> 1, sb = X.wave & 1; f32x16 acc;
#pragma unroll
            for (int k = 0; k < 16; ++k) acc[k] = 0.f;
#pragma unroll
            for (int ks = 0; ks < 4; ++ks) { const bf16x8 a = *(const LAS bf16x8*)(qq + (32 * tb + r) * 144 + (16 * ks + 8 * hf) * 2);
                const bf16x8 bb = *(const LAS bf16x8*)(kk2 + (32 * sb + r) * 144 + (16 * ks + 8 * hf) * 2);
                acc = __builtin_amdgcn_mfma_f32_32x32x16_bf16(a, bb, acc, 0, 0, 0); }
#pragma unroll
            for (int k = 0; k < 16; ++k) { const int t = 32 * tb + (k & 3) + 8 * (k >> 2) + 4 * hf, s = 32 * sb + r;
                *(LAS bf16_t*)(at + t * 144 + s * 2) = f2bf(s <= t ? acc[k] : 0.f); } }
        __syncthreads();
        { const int tb = X.wave >> 2, eb = X.wave & 3; f32x16 acc;
#pragma unroll
          for (int k = 0; k < 16; ++k) acc[k] = 0.f;
#pragma unroll
          for (int ks = 0; ks < 4; ++ks) { const bf16x8 a = *(const LAS bf16x8*)(qS + (32 * tb + r) * 144 + (16 * ks + 8 * hf) * 2);
              const bf16x8 bb = *(const LAS bf16x8*)(ST + (32 * eb + r) * 144 + (16 * ks + 8 * hf) * 2);
              acc = __builtin_amdgcn_mfma_f32_32x32x16_bf16(a, bb, acc, 0, 0, 0); }
#pragma unroll
          for (int ks = 0; ks < 4; ++ks) { const bf16x8 a = *(const LAS bf16x8*)(at + (32 * tb + r) * 144 + (16 * ks + 8 * hf) * 2);
              const bf16x8 bb = *(const LAS bf16x8*)(vT + (32 * eb + r) * 144 + (16 * ks + 8 * hf) * 2);
              acc = __builtin_amdgcn_mfma_f32_32x32x16_bf16(a, bb, acc, 0, 0, 0); }
#pragma unroll
          for (int k = 0; k < 16; ++k) { const int t = 32 * tb + (k & 3) + 8 * (k >> 2) + 4 * hf; ob[t * 132 + 32 * eb + r] = acc[k]; } }
        __syncthreads();
        { const int t = X.tid >> 3, j = X.tid & 7; float o[16]; float ss = 0.f;
#pragma unroll
          for (int i = 0; i < 16; ++i) { o[i] = ob[t * 132 + 16 * j + i]; ss += o[i] * o[i]; }
          ss = sum8(ss);
          const float rstd = __builtin_amdgcn_rsqf(ss * (1.f / 128.f) + EPS);
          const float* gn = INP(13) + (size_t)l * 128 + 16 * j;
          const unsigned rw[8] = {ra.x, ra.y, ra.z, ra.w, rb.x, rb.y, rb.z, rb.w};
          unsigned pk[8];
#pragma unroll
          for (int i = 0; i < 8; ++i) { const float r0 = lo_bf(rw[i]), r1 = hi_bf(rw[i]);
              const float v0 = o[2 * i] * rstd * gn[2 * i] * (r0 * sigmoidf_(r0)), v1 = o[2 * i + 1] * rstd * gn[2 * i + 1] * (r1 * sigmoidf_(r1));
              pk[i] = cvt_pk_bf16(v0, v1); }
          bf16_t* yp = y + (t0 + t) * YW + 512 + 128 * hh + 16 * j;
          *(u32x4*)yp = (u32x4){pk[0], pk[1], pk[2], pk[3]}; *(u32x4*)(yp + 8) = (u32x4){pk[4], pk[5], pk[6], pk[7]}; }
        __syncthreads();
    }
}

__device__ __forceinline__ unsigned score_code(float sc) {
    const unsigned ub = __float_as_uint(sc); unsigned t = (ub & 0x7fffffffu) >> 13;
    t = t < (107u << 10) ? (107u << 10) : t; t -= (107u << 10); t = t > 32766u ? 32766u : t;
    return (ub >> 31) ? (0x7fffu - t) : (0x8000u | t);
}
template <bool PACKED16>
__device__ __forceinline__ void find_digit(const LAS unsigned* hist, int lane, unsigned K, unsigned& digit, unsigned& above) {
    unsigned hb[4];
    if (PACKED16) { const unsigned h0 = hist[(2 * lane) * 16], h1 = hist[(2 * lane + 1) * 16]; hb[0] = h0 & 0xffffu; hb[1] = h0 >> 16; hb[2] = h1 & 0xffffu; hb[3] = h1 >> 16; }
    else { const u32x4 h4 = *(const LAS u32x4*)(hist + 4 * lane); hb[0] = h4.x; hb[1] = h4.y; hb[2] = h4.z; hb[3] = h4.w; }
    const unsigned s = hb[0] + hb[1] + hb[2] + hb[3];
    int v = (int)s;
    v += __builtin_amdgcn_update_dpp(0, v, 0x111, 0xf, 0xf, true); v += __builtin_amdgcn_update_dpp(0, v, 0x112, 0xf, 0xf, true);
    v += __builtin_amdgcn_update_dpp(0, v, 0x114, 0xf, 0xf, true); v += __builtin_amdgcn_update_dpp(0, v, 0x118, 0xf, 0xf, true);
    v += __builtin_amdgcn_update_dpp(0, v, 0x142, 0xa, 0xf, false); v += __builtin_amdgcn_update_dpp(0, v, 0x143, 0xc, 0xf, false);
    const unsigned total = (unsigned)__builtin_amdgcn_readlane(v, 63);
    unsigned run = total - (unsigned)v, dg = 0, ab = 0; bool found = false;
#pragma unroll
    for (int bi = 3; bi >= 0; --bi) { if (!found && run < K && run + hb[bi] >= K) { found = true; dg = 4 * lane + bi; ab = run; } run += hb[bi]; }
    const unsigned long long m = __ballot(found);
    const int src = m ? (int)__builtin_ctzll(m) : 0;
    digit = (unsigned)__builtin_amdgcn_readlane((int)dg, src); above = (unsigned)__builtin_amdgcn_readlane((int)ab, src);
}
__device__ __forceinline__ void sub_dsa_select(const Ctx& X) {
    const bf16_t* proj = WSP(bf16_t, WS_PROJ); unsigned long long* mask = WSP(unsigned long long, WS_MASK);
    LAS bf16_t* keys = (LAS bf16_t*)X.lds;
    LAS unsigned* hist1 = (LAS unsigned*)(X.lds + AUX_OFF + 1024);
    LAS unsigned* hist2 = (LAS unsigned*)(X.lds + AUX_OFF + 1024 + 8192) + X.wave * 512;
    const int lane = X.lane;
    for (int u0 = X.c; u0 < 1024; u0 += X.G) {
        const int rnd = u0 / X.G, u = (rnd & 1) ? (rnd + 1) * X.G - 1 - (u0 - rnd * X.G) : u0;
        if (u >= 1024) continue;
        const int b = u & 3, qb = 255 - (u >> 2); const size_t tg0 = (size_t)b * SEQ;
        if (qb < 16) {
#pragma unroll
            for (int rr = 0; rr < 2; ++rr) { const int t = 16 * qb + 2 * X.wave + rr; const int rem = t - 64 * lane;
                const unsigned long long w = rem >= 63 ? ~0ull : (rem < 0 ? 0ull : ((2ull << rem) - 1ull));
                mask[(tg0 + t) * 64 + lane] = w; }
            continue;
        }
        const int nk = 16 * (qb + 1), nkp = (nk + 63) & ~63, ntile = nkp >> 4, nwords = nkp >> 6;
        REP(21) {
        *(LAS u32x4*)(hist1 + 4 * X.tid) = (u32x4){0u, 0u, 0u, 0u};
        __syncthreads();
        {
            const int q = lane & 15, kg = lane >> 4; const size_t qrow = (tg0 + 16 * qb + q) * PP;
            bf16x8 Bq[4][2]; float iw[4];
#pragma unroll
            for (int hh = 0; hh < 4; ++hh) { iw[hh] = bf2f(proj[qrow + C_IW + hh]);
#pragma unroll
                for (int ks = 0; ks < 2; ++ks) Bq[hh][ks] = *(const bf16x8*)(proj + qrow + C_IQ + 64 * hh + 32 * ks + 8 * kg); }
            const int tq = 16 * qb + q;
            const bf16_t* kbase = proj + (tg0 + q) * PP + C_IK + 8 * kg;
            for (int jb = X.wave; jb < ntile; jb += 64) {
                bf16x8 Ax[4][2], Ay[4][2];
#pragma unroll
                for (int i = 0; i < 4; ++i) { int j = jb + 8 * i; j = j > 255 ? 255 : j; Ax[i][0] = *(const bf16x8*)(kbase + (size_t)(16 * j) * PP); Ax[i][1] = *(const bf16x8*)(kbase + (size_t)(16 * j) * PP + 32); }
#pragma unroll
                for (int i = 0; i < 4; ++i) { int j = jb + 32 + 8 * i; j = j > 255 ? 255 : j; Ay[i][0] = *(const bf16x8*)(kbase + (size_t)(16 * j) * PP); Ay[i][1] = *(const bf16x8*)(kbase + (size_t)(16 * j) * PP + 32); }
#pragma unroll
                for (int i2 = 0; i2 < 8; ++i2) { const int i = i2 & 3; const int j = jb + 8 * i2;
                    {
                        const bf16x8 A0 = i2 < 4 ? Ax[i][0] : Ay[i][0], A1 = i2 < 4 ? Ax[i][1] : Ay[i][1];
                        f32x4 sc = {0.f, 0.f, 0.f, 0.f};
#pragma unroll
                        for (int hh = 0; hh < 4; ++hh) { f32x4 a = {0.f, 0.f, 0.f, 0.f};
                            a = __builtin_amdgcn_mfma_f32_16x16x32_bf16(A0, Bq[hh][0], a, 0, 0, 0);
                            a = __builtin_amdgcn_mfma_f32_16x16x32_bf16(A1, Bq[hh][1], a, 0, 0, 0);
#pragma unroll
                            for (int k = 0; k < 4; ++k) sc[k] += iw[hh] * fmaxf(a[k], 0.f); }
                        unsigned kk[4];
#pragma unroll
                        for (int k = 0; k < 4; ++k) { const int key = 16 * j + 4 * kg + k; const unsigned code = score_code(sc[k]);
                            const bool adm = key <= tq; kk[k] = adm ? code : 0u;
                            if (adm) atomicAdd((unsigned*)(hist1 + (code >> 9) * 16 + q), (code & 0x100u) ? 0x10000u : 1u); }
                        u32x2 w; w.x = kk[0] | (kk[1] << 16); w.y = kk[2] | (kk[3] << 16);
                        if (j < ntile) *(LAS u32x2*)(keys + q * 4104 + 16 * j + 4 * kg) = w; } }
            }
        }
        __syncthreads();
        }
        {
            const int t0r = 16 * qb + 2 * X.wave;
            const LAS bf16_t* krow[2] = {keys + (2 * X.wave) * 4104 + lane, keys + (2 * X.wave + 1) * 4104 + lane};
            LAS unsigned* h2[2] = {hist2, hist2 + 256};
            unsigned d1[2], ab1[2], d2[2], ab2[2];
#pragma unroll
            for (int q = 0; q < 2; ++q) { find_digit<true>(hist1 + 2 * X.wave + q, lane, 256u, d1[q], ab1[q]); *(LAS u32x4*)(h2[q] + 4 * lane) = (u32x4){0u, 0u, 0u, 0u}; }
            asm volatile("s_waitcnt lgkmcnt(0)" ::: "memory");
            for (int w0 = 0; w0 < nwords; w0 += 8) { unsigned k8[2][8];
#pragma unroll
                for (int i = 0; i < 8; ++i) { k8[0][i] = krow[0][64 * ((w0 + i) & 63)]; k8[1][i] = krow[1][64 * ((w0 + i) & 63)]; }
#pragma unroll
                for (int i = 0; i < 8; ++i)
#pragma unroll
                    for (int q = 0; q < 2; ++q) { const unsigned k = k8[q][i]; if (w0 + i < nwords && (k >> 8) == d1[q]) atomicAdd((unsigned*)(h2[q] + (k & 255u)), 1u); } }
            asm volatile("s_waitcnt lgkmcnt(0)" ::: "memory");
#pragma unroll
            for (int q = 0; q < 2; ++q) find_digit<false>(h2[q], lane, 256u - ab1[q], d2[q], ab2[q]);
            asm volatile("s_waitcnt lgkmcnt(0)" ::: "memory");
            unsigned vstar[2], need[2], mylo[2] = {0u, 0u}, myhi[2] = {0u, 0u};
#pragma unroll
            for (int q = 0; q < 2; ++q) { vstar[q] = (d1[q] << 8) | d2[q]; need[q] = 256u - ab1[q] - ab2[q]; }
            for (int w0 = 0; w0 < nwords; w0 += 8) { unsigned k8[2][8];
#pragma unroll
              for (int i = 0; i < 8; ++i) { k8[0][i] = krow[0][64 * ((w0 + i) & 63)]; k8[1][i] = krow[1][64 * ((w0 + i) & 63)]; }
#pragma unroll
              for (int i = 0; i < 8; ++i)
#pragma unroll
                for (int q = 0; q < 2; ++q) { const int w = w0 + i; const unsigned k = w < nwords ? k8[q][i] : 0u;
                  const unsigned long long gt = __ballot(k > vstar[q]); unsigned long long eq = __ballot(k == vstar[q]);
                  const unsigned ne = (unsigned)__builtin_popcountll(eq);
                  if (ne > need[q]) { unsigned long long e = eq, rsel = 0ull; for (unsigned ii = 0; ii < need[q]; ++ii) { const unsigned long long bbit = e & (0ull - e); rsel |= bbit; e ^= bbit; } eq = rsel; need[q] = 0u; }
                  else need[q] -= ne;
                  const unsigned long long sel = gt | eq;
                  if (lane == w) { mylo[q] = (unsigned)sel; myhi[q] = (unsigned)(sel >> 32); } } }
#pragma unroll
            for (int q = 0; q < 2; ++q) { const int t = t0r + q; const int rem = t - 64 * lane;
                const unsigned long long cm = rem >= 63 ? ~0ull : (rem < 0 ? 0ull : ((2ull << rem) - 1ull));
                mask[(tg0 + t) * 64 + lane] = lane < nwords ? ((((unsigned long long)myhi[q] << 32) | mylo[q]) & cm) : 0ull; }
        }
        __syncthreads();
    }
}

__device__ __forceinline__ void attn_dma(const int st, const int wave, const int lane, const bf16_t* kglob, const bf16_t* vglob, const unsigned long long* mglob, LAS unsigned char* kv, LAS unsigned char* mb) {
#pragma unroll
    for (int i = 0; i < 4; ++i) { const int L = (wave * 4 + i) * 64 + lane, row = L >> 4, c = (L & 15) ^ (row & 15);
        __builtin_amdgcn_global_load_lds((const unsigned*)(kglob + (size_t)(128 * st + row) * PP + 8 * c), (LAS unsigned*)(kv + (wave * 4 + i) * 1024), 16, 0, 0);
        __builtin_amdgcn_global_load_lds((const unsigned*)(vglob + (size_t)row * SEQ + 128 * st + 8 * c), (LAS unsigned*)(kv + 32768 + (wave * 4 + i) * 1024), 16, 0, 0); }
    if (wave < 2) __builtin_amdgcn_global_load_lds((const unsigned*)(mglob + (size_t)(wave * 64 + lane) * 64 + 2 * st), (LAS unsigned*)(mb + wave * 1024), 16, 0, 0);
}
template <bool FAR>
__device__ __forceinline__ void attn_tile(const int st, const int r, const int hf, const int g, const int wq, const int tq, const float scale2,
                                          const LAS unsigned char* Ks, const LAS unsigned char* Vs, const LAS unsigned char* mb, const LAS float* bt,
                                          const bf16x8 (&Qf)[8], f32x16 (&O)[4], float& mrun, float& lrun) {
    const unsigned long long mw = *(const LAS unsigned long long*)(mb + (32 * wq + r) * 16 + 8 * g) >> (4 * hf);
    const unsigned mlo = (unsigned)mw, mhi = (unsigned)(mw >> 32);
    f32x16 S[2];
#pragma unroll
    for (int kb = 0; kb < 2; ++kb) {
#pragma unroll
        for (int k = 0; k < 16; ++k) S[kb][k] = 0.f;
        const int row = 64 * g + 32 * kb + r;
#pragma unroll
        for (int ks = 0; ks < 8; ++ks) { const bf16x8 a = *(const LAS bf16x8*)(Ks + row * 256 + (((2 * ks + hf) ^ (row & 15)) << 4));
            S[kb] = __builtin_amdgcn_mfma_f32_32x32x16_bf16(a, Qf[ks], S[kb], 0, 0, 0); } }
    const int kg0 = 128 * st + 64 * g;
    float mx = -1e30f;
    const float bfar = bt[128];
#pragma unroll
    for (int kb = 0; kb < 2; ++kb)
#pragma unroll
        for (int k = 0; k < 16; ++k) { const int ko = 32 * kb + (k & 3) + 8 * (k >> 2); const int sel = __builtin_amdgcn_sbfe((int)(kb ? mhi : mlo), (k & 3) + 8 * (k >> 2), 1);
            float bias = bfar;
            if (!FAR) { int rel = tq - (kg0 + ko + 4 * hf); rel = rel < 0 ? 0 : (rel > 128 ? 128 : rel); bias = bt[rel]; }
            const float lg = __uint_as_float((__float_as_uint(S[kb][k] * scale2 + bias) & (unsigned)sel) | (~(unsigned)sel & 0xff800000u)); S[kb][k] = lg; mx = fmaxf(mx, lg); }
    mx = max_x32(mx);
    if (__ballot(mx > mrun + 8.f) != 0ull) {
        const float mnew = fmaxf(mrun, mx), alpha = __builtin_amdgcn_exp2f(mrun - mnew);
        lrun *= alpha; mrun = mnew;
#pragma unroll
        for (int eb = 0; eb < 4; ++eb)
#pragma unroll
            for (int k = 0; k < 16; ++k) O[eb][k] *= alpha;
    }
    float ps = 0.f;
#pragma unroll
    for (int kb = 0; kb < 2; ++kb)
#pragma unroll
        for (int k = 0; k < 16; ++k) { const float p = __builtin_amdgcn_exp2f(S[kb][k] - mrun); S[kb][k] = p; ps += p; }
    ps = sum_x32(ps);
    lrun += ps;
#pragma unroll
    for (int kb = 0; kb < 2; ++kb)
#pragma unroll
        for (int s = 0; s < 2; ++s) {
            union { bf16x8 v; unsigned w[4]; } P;
#pragma unroll
            for (int j = 0; j < 4; ++j) P.w[j] = cvt_pk_bf16(S[kb][8 * s + 2 * j], S[kb][8 * s + 2 * j + 1]);
#pragma unroll
            for (int eb = 0; eb < 4; ++eb) { const int row = 32 * eb + r;
                const bf16x8 a = *(const LAS bf16x8*)(Vs + row * 256 + (((8 * g + 4 * kb + 2 * s + hf) ^ (row & 15)) << 4));
                O[eb] = __builtin_amdgcn_mfma_f32_32x32x16_bf16(a, P.v, O[eb], 0, 0, 0); } }
}
__device__ __forceinline__ void sub_dsa_attn(const Ctx& X, int l) {
    const bf16_t* proj = WSP(bf16_t, WS_PROJ); const bf16_t* vtg = WSP(bf16_t, WS_VT); const unsigned long long* mask = WSP(unsigned long long, WS_MASK);
    bf16_t* y = WSP(bf16_t, WS_Y); const float* relb = INP(16);
    LAS unsigned char* KV = X.lds;
    LAS unsigned char* MB = X.lds + AUX_OFF + 1024;
    LAS float* bt = (LAS float*)(X.lds + AUX_OFF + 1024 + 4096);
    LAS float* Ox = (LAS float*)X.lds; LAS float* MLx = (LAS float*)(X.lds + 65536);
    const int lane = X.lane, r = lane & 31, hf = lane >> 5, g = X.wave >> 2, wq = X.wave & 3;
    const float scale2 = 0.08838834764831845f * 1.4426950408889634f;
    for (int u = X.c; u < 512; u += X.G) {
        const int bh = u & 15, qt = u < 256 ? 31 - (u >> 4) : ((u - 256) >> 4), b = bh >> 2, hh = bh & 3;
        const size_t tg0 = (size_t)b * SEQ; const int q0 = 128 * qt, tq = q0 + 32 * wq + r;
        if (X.tid < 129) { const int n = X.tid; int bk;
            if (n < 16) bk = n; else { bk = 16 + (int)(__logf((float)n * (1.f / 16.f)) / 2.0794415416798357f * 16.f); bk = bk > 31 ? 31 : bk; }
            bt[n] = relb[bk * 4 + hh] * 1.4426950408889634f; }
        bf16x8 Qf[8];
        {
            union { bf16x8 v; unsigned w[4]; } qr[8]; float ss = 0.f;
#pragma unroll
            for (int ks = 0; ks < 8; ++ks) { qr[ks].v = *(const bf16x8*)(proj + (tg0 + tq) * PP + C_DQ + 128 * hh + 16 * ks + 8 * hf);
#pragma unroll
                for (int j = 0; j < 4; ++j) { const float a = lo_bf(qr[ks].w[j]), bq = hi_bf(qr[ks].w[j]); ss += a * a + bq * bq; } }
            ss = sum_x32(ss);
            const float rstd = __builtin_amdgcn_rsqf(ss * (1.f / 128.f) + EPS);
            const float* qg = INP(14) + (size_t)l * 128 + 8 * hf;
#pragma unroll
            for (int ks = 0; ks < 8; ++ks) { const f32x4 g0 = *(const f32x4*)(qg + 16 * ks), g1 = *(const f32x4*)(qg + 16 * ks + 4);
                qr[ks].w[0] = cvt_pk_bf16(lo_bf(qr[ks].w[0]) * rstd * g0[0], hi_bf(qr[ks].w[0]) * rstd * g0[1]);
                qr[ks].w[1] = cvt_pk_bf16(lo_bf(qr[ks].w[1]) * rstd * g0[2], hi_bf(qr[ks].w[1]) * rstd * g0[3]);
                qr[ks].w[2] = cvt_pk_bf16(lo_bf(qr[ks].w[2]) * rstd * g1[0], hi_bf(qr[ks].w[2]) * rstd * g1[1]);
                qr[ks].w[3] = cvt_pk_bf16(lo_bf(qr[ks].w[3]) * rstd * g1[2], hi_bf(qr[ks].w[3]) * rstd * g1[3]);
                Qf[ks] = qr[ks].v; } }
        f32x16 O[4];
#pragma unroll
        for (int eb = 0; eb < 4; ++eb)
#pragma unroll
            for (int k = 0; k < 16; ++k) O[eb][k] = 0.f;
        float mrun = -1e30f, lrun = 0.f;
        const bf16_t* kglob = proj + tg0 * PP + C_DK + 128 * hh; const bf16_t* vglob = vtg + (size_t)bh * 128 * SEQ; const unsigned long long* mglob = mask + (tg0 + q0) * 64;
        const int nfar = qt - 1;
        attn_dma(0, X.wave, lane, kglob, vglob, mglob, KV, MB);
        for (int st = 0; st < nfar; ++st) {
            asm volatile("s_waitcnt vmcnt(0)" ::: "memory"); __syncthreads();
            attn_dma(st + 1, X.wave, lane, kglob, vglob, mglob, KV + ((st + 1) & 1) * 65536, MB + ((st + 1) & 1) * 2048);
            const LAS unsigned char* kvb = KV + (st & 1) * 65536;
            attn_tile<true>(st, r, hf, g, wq, tq, scale2, kvb, kvb + 32768, MB + (st & 1) * 2048, bt, Qf, O, mrun, lrun);
        }
        for (int st = nfar < 0 ? 0 : nfar; st <= qt; ++st) {
            asm volatile("s_waitcnt vmcnt(0)" ::: "memory"); __syncthreads();
            if (st < qt) attn_dma(st + 1, X.wave, lane, kglob, vglob, mglob, KV + ((st + 1) & 1) * 65536, MB + ((st + 1) & 1) * 2048);
            const LAS unsigned char* kvb = KV + (st & 1) * 65536;
            attn_tile<false>(st, r, hf, g, wq, tq, scale2, kvb, kvb + 32768, MB + (st & 1) * 2048, bt, Qf, O, mrun, lrun);
        }
        __syncthreads();
        if (g == 1) {
#pragma unroll
            for (int eb = 0; eb < 4; ++eb)
#pragma unroll
                for (int k = 0; k < 16; ++k) Ox[((wq * 4 + eb) * 16 + k) * 64 + lane] = O[eb][k];
            MLx[(wq * 64 + lane) * 2] = mrun; MLx[(wq * 64 + lane) * 2 + 1] = lrun; }
        __syncthreads();
        if (g == 0) {
            const float m1 = MLx[(wq * 64 + lane) * 2], l1 = MLx[(wq * 64 + lane) * 2 + 1];
            const float m = fmaxf(mrun, m1), a0 = __builtin_amdgcn_exp2f(mrun - m), a1 = __builtin_amdgcn_exp2f(m1 - m);
            const float inv = 1.f / (lrun * a0 + l1 * a1);
#pragma unroll
            for (int eb = 0; eb < 4; ++eb)
#pragma unroll
                for (int k4 = 0; k4 < 4; ++k4) { float o[4];
#pragma unroll
                    for (int j = 0; j < 4; ++j) { const int k = 4 * k4 + j; o[j] = (O[eb][k] * a0 + Ox[((wq * 4 + eb) * 16 + k) * 64 + lane] * a1) * inv; }
                    u32x2 w; w.x = cvt_pk_bf16(o[0], o[1]); w.y = cvt_pk_bf16(o[2], o[3]);
                    *(u32x2*)(y + (tg0 + tq) * YW + 1024 + 128 * hh + 32 * eb + 8 * k4 + 4 * hf) = w; } }
        __syncthreads();
    }
}

__device__ __forceinline__ void phase_norm2(const Ctx& X, int l) {
    const float* out = X.out; const float* mod = WSP(float, WS_MOD); bf16_t* h = WSP(bf16_t, WS_H);
    int* toke = WSP(int, WS_TOKE); float* tokw = WSP(float, WS_TOKW); unsigned* cntb = WSP(unsigned, WS_CNT);
    LAS float* WT = (LAS float*)X.lds;
    LAS unsigned* cnt = (LAS unsigned*)(X.lds + AUX_OFF + 1024);
    const float* wg = INP(20) + (size_t)l * 4096; const float* wr = INP(22) + (size_t)l * 16384;
    { f32x4 a[2], b[8];
#pragma unroll
      for (int i = 0; i < 2; ++i) a[i] = *(const f32x4*)(wg + 4 * (X.tid + 512 * i));
#pragma unroll
      for (int i = 0; i < 8; ++i) b[i] = *(const f32x4*)(wr + 4 * (X.tid + 512 * i));
#pragma unroll
      for (int i = 0; i < 2; ++i) { const int e0 = 4 * (X.tid + 512 * i);
#pragma unroll
          for (int k = 0; k < 4; ++k) WT[((e0 + k) & 3) * 1024 + ((e0 + k) >> 2)] = a[i][k]; }
#pragma unroll
      for (int i = 0; i < 8; ++i) { const int e0 = 4 * (X.tid + 512 * i);
#pragma unroll
          for (int k = 0; k < 4; ++k) WT[(4 + ((e0 + k) & 15)) * 1024 + ((e0 + k) >> 4)] = b[i][k]; } }
    if (X.tid < 16) cnt[X.tid] = 0u;
    __syncthreads();
    const float* g2 = INP(5) + (size_t)l * 1024; const float* bgrp = INP(21) + l * 4; const float* brt = INP(23) + l * 16;
    const int rpb = (T + X.G - 1) / X.G;
  for (int i0 = X.wave; i0 < rpb; i0 += 8 * 8) {
#pragma unroll 1
    for (int jg = 0; jg < 8; jg += 2) {
        f32x4 xall[2][4];
#pragma unroll
        for (int q = 0; q < 2; ++q) { const int i = i0 + 8 * (jg + q); const int r = (i < rpb && X.c * rpb + i < T) ? X.c * rpb + i : X.c * rpb;
#pragma unroll
            for (int k = 0; k < 4; ++k) xall[q][k] = *(const f32x4*)(out + (size_t)r * 1024 + 4 * X.lane + 256 * k); }
        float rstd[2]; int rr[2]; bool ok[2];
#pragma unroll
        for (int q = 0; q < 2; ++q) { const int i = i0 + 8 * (jg + q); ok[q] = i < rpb && X.c * rpb + i < T; rr[q] = ok[q] ? X.c * rpb + i : X.c * rpb;
            float ss = 0.f;
#pragma unroll
            for (int k = 0; k < 4; ++k) { const f32x4 xv = xall[q][k]; ss += xv[0] * xv[0] + xv[1] * xv[1] + xv[2] * xv[2] + xv[3] * xv[3]; }
            rstd[q] = __builtin_amdgcn_rsqf(wave_sum(ss) * (1.f / 1024.f) + EPS); }
        float lg[2][20];
#pragma unroll
        for (int q = 0; q < 2; ++q)
#pragma unroll
            for (int o = 0; o < 20; ++o) lg[q][o] = 0.f;
#pragma unroll 1
        for (int k = 0; k < 4; ++k) { const int col = 4 * X.lane + 256 * k; const f32x4 g = *(const f32x4*)(g2 + col);
            f32x4 yv[2];
#pragma unroll
            for (int q = 0; q < 2; ++q) { const float* md = mod + ((size_t)l * NB + (rr[q] >> 12)) * 6144;
                const f32x4 sh = *(const f32x4*)(md + 3072 + col), sc = *(const f32x4*)(md + 4096 + col);
                yv[q] = xall[q][k] * rstd[q] * g * (sc + 1.f) + sh;
                if (ok[q]) { u32x2 w; w.x = cvt_pk_bf16(yv[q][0], yv[q][1]); w.y = cvt_pk_bf16(yv[q][2], yv[q][3]); *(u32x2*)(h + (size_t)rr[q] * 1024 + col) = w; } }
#pragma unroll
            for (int o = 0; o < 20; ++o) { const f32x4 wv = *(const LAS f32x4*)(WT + o * 1024 + col);
#pragma unroll
                for (int q = 0; q < 2; ++q) lg[q][o] += yv[q][0] * wv[0] + yv[q][1] * wv[1] + yv[q][2] * wv[2] + yv[q][3] * wv[3]; } }
#pragma unroll
        for (int q = 0; q < 2; ++q) {
#pragma unroll
            for (int o = 0; o < 20; ++o) lg[q][o] = wave_sum(lg[q][o]);
            if (X.lane == 0 && ok[q]) { const int r = rr[q];
                float gl[4];
#pragma unroll
                for (int k = 0; k < 4; ++k) gl[k] = lg[q][k] + bgrp[k];
                int gi = 0; float gm = gl[0];
#pragma unroll
                for (int k = 1; k < 4; ++k) if (gl[k] > gm) { gm = gl[k]; gi = k; }
                float se = 0.f;
#pragma unroll
                for (int k = 0; k < 4; ++k) se += __expf(gl[k] - gm);
                const float pg = 1.f / se;
                float sl[4];
#pragma unroll
                for (int k = 0; k < 4; ++k) { sl[k] = lg[q][4 + k] + brt[k];
#pragma unroll
                    for (int qq = 1; qq < 4; ++qq) if (gi == qq) sl[k] = lg[q][4 + 4 * qq + k] + brt[4 * qq + k]; }
                int i1 = 0; float v1 = sl[0];
#pragma unroll
                for (int k = 1; k < 4; ++k) if (sl[k] > v1) { v1 = sl[k]; i1 = k; }
                int i2 = -1; float v2 = -3.0e38f;
#pragma unroll
                for (int k = 0; k < 4; ++k) if (k != i1 && sl[k] > v2) { v2 = sl[k]; i2 = k; }
                const float w1 = 1.f / (1.f + __expf(v2 - v1));
                const int e1 = 4 * gi + i1, e2 = 4 * gi + i2;
                toke[2 * r] = e1; toke[2 * r + 1] = e2; tokw[2 * r] = pg * w1; tokw[2 * r + 1] = pg * (1.f - w1);
                atomicAdd((unsigned*)(cnt + e1), 1u); atomicAdd((unsigned*)(cnt + e2), 1u);
            }
        }
    }
  }
    __syncthreads();
    if (X.tid < 16) cntb[X.c * 16 + X.tid] = cnt[X.tid];
    __syncthreads();
}

__device__ __forceinline__ void build_tiles(const Ctx& X, LAS int* tb, LAS int* myoff  ) {
    const unsigned* cntb = WSP(unsigned, WS_CNT);
    LAS int* tot = tb + 32;
    LAS int* part = tb + 512;
    { const int e = X.tid & 15, p = X.tid >> 4, per = (X.G + 31) >> 5; int s = 0, mine = 0;
      for (int k = 0; k < per; ++k) { const int c = p * per + k; if (c < X.G) { const int v = (int)cntb[c * 16 + e]; s += v; if (c < X.c) mine += v; } }
      part[p * 16 + e] = s; if (X.c >= p * per && X.c < (p + 1) * per) part[512 + e] = mine; }
    __syncthreads();
    if (X.tid < 16) { const int per = (X.G + 31) >> 5, mp = X.c / per; int s = 0, mine = part[512 + X.tid];
        for (int p = 0; p < 32; ++p) { const int v = part[p * 16 + X.tid]; s += v; if (p < mp) mine += v; }
        tot[X.tid] = s; myoff[X.tid] = mine; }
    __syncthreads();
    if (X.tid == 0) { int row = 0, nT = 0;
        for (int e = 0; e < 16; ++e) { const int nt = (tot[e] + 255) >> 8; tb[16 + e] = row; for (int k = 0; k < nt; ++k) { tb[64 + nT] = e; tb[256 + nT] = (row >> 8) + k; ++nT; } row += nt * 256; }
        tb[0] = nT; }
    __syncthreads();
    if (X.tid < 16) myoff[X.tid] += tb[16 + X.tid];
    __syncthreads();
}

__device__ __forceinline__ void moe_lists(const Ctx& X, const LAS int* tb, LAS int* rows, LAS float* lw, LAS int* sc) {
    const unsigned* cntb = WSP(unsigned, WS_CNT); const int* toke = WSP(int, WS_TOKE); const float* tokw = WSP(float, WS_TOKW); int* toks = WSP(int, WS_TOKS);
    const int nT = tb[0], rpb = (T + X.G - 1) / X.G;
    for (int i = 0; i < 2; ++i) {
        const long L = (long)i * X.G + X.c; if (L >= ((long)nT << 1)) break;
        const int rt = (int)(L >> 1), e = tb[64 + rt], pm = tb[256 + rt], rbase = pm * 256 - tb[16 + e];
        const int v = X.tid < X.G ? (int)cntb[X.tid * 16 + e] : 0;
        sc[X.tid] = v; rows[i * 256 + (X.tid & 255)] = 0; lw[i * 256 + (X.tid & 255)] = 0.f;
        __syncthreads();
        for (int off = 1; off < 512; off <<= 1) { const int t = X.tid >= off ? sc[X.tid - off] : 0; __syncthreads(); sc[X.tid] += t; __syncthreads(); }
        sc[512 + X.tid] = v;
        __syncthreads();
        for (int cs = X.wave; cs < X.G; cs += 8) {
            const int cnt = sc[512 + cs], lo = sc[cs] - cnt;
            if (cnt == 0 || lo + cnt <= rbase || lo >= rbase + 256) continue;
            int run = lo;
            for (int n0 = 0; n0 < 2 * rpb; n0 += 64) { const int n = n0 + X.lane, tr = cs * rpb + (n >> 1), k = n & 1;
                const bool in = n < 2 * rpb && tr < T; const int ex = in ? toke[2 * tr + k] : -1; const bool match = ex == e;
                const unsigned long long bal = __ballot(match);
                const int rank = run + (int)__builtin_popcountll(bal & ((1ull << X.lane) - 1ull)) - rbase;
                if (match && rank >= 0 && rank < 256) { rows[i * 256 + rank] = tr; lw[i * 256 + rank] = tokw[2 * tr + k]; toks[2 * tr + k] = pm * 256 + rank; }
                run += (int)__builtin_popcountll(bal); }
        }
        __syncthreads();
    }
}

__global__ void __launch_bounds__(512, 2) fwd_kernel(Params P) {
    extern __shared__ __attribute__((aligned(16))) unsigned char lds_raw[];
    Ctx X0; X0.in = (const float* const CAS*)__builtin_amdgcn_kernarg_segment_ptr(); X0.out = P.out; X0.ws = P.ws; X0.lds = (LAS unsigned char*)lds_raw;
    X0.tid = threadIdx.x; X0.lane = X0.tid & 63; X0.wave = __builtin_amdgcn_readfirstlane(X0.tid >> 6); X0.G = gridDim.x; X0.c = blockIdx.x;
    LAS unsigned* auxw = (LAS unsigned*)(X0.lds + AUX_OFF);
    if (X0.tid < 4) auxw[X0.tid] = 0u;
    __syncthreads();
#define FRESH() Ctx X = X0; { int wv_ = X0.wave; asm volatile("" : "+s"(wv_)); unsigned m_ = ~0u; asm volatile("" : "+s"(m_)); const int ln_ = __builtin_amdgcn_mbcnt_hi(m_, __builtin_amdgcn_mbcnt_lo(m_, 0u)); \
        X.wave = wv_; X.lane = ln_; X.tid = wv_ * 64 + ln_; \
        size_t z_ = 0; asm volatile("" : "+s"(z_)); X.ws = X0.ws + z_; X.out = (float*)((unsigned char*)X0.out + z_); int c_ = X0.c; asm volatile("" : "+s"(c_)); X.c = c_; \
        const float* const CAS* i_ = X0.in; asm volatile("" : "+s"(i_)); X.in = i_; }
#if N_LAUNCH_MODE == 1
    XcdBarrier bar = xcd_barrier_post((unsigned*)(X0.ws + WS_CTL), (volatile LAS unsigned*)auxw);
#define SEAM() do { unsigned long long t1_ = 0; if (PROBE_STAMP) { t1_ = __builtin_amdgcn_s_memrealtime(); if (ph_ >= 0 && ((PROBE_STAMP >> ph_) & 1)) st_acc += t1_ - st_t0; } \
        if (gp >= lo && gp + 1 < hi) { xcd_barrier(bar); if (PROBE_DUP == 17) xcd_barrier(bar); } \
        if (PROBE_STAMP) { st_t0 = __builtin_amdgcn_s_memrealtime(); if ((PROBE_STAMP >> 11) & 1) st_acc += st_t0 - t1_; ph_ = ph_ < 0 ? ph_ : (ph_ + 1) % 10; } ++gp; } while (0)
#else
#define SEAM() do { ++gp; } while (0)
#endif
    const int lo = P.ph_lo, hi = P.ph_hi; int gp = 0;
    unsigned long long st_acc = 0, st_t0 = PROBE_STAMP ? __builtin_amdgcn_s_memrealtime() : 0ull; int ph_ = -1;
#define IN() (gp >= lo && gp < hi)
    if (IN()) { REP(13) { FRESH(); phase_mod(X); } { FRESH(); __syncthreads(); phase_conv_dyn(X, 0, (unsigned*)(X.ws + WS_CTL + 14336) + 64 * 3, 1 << 30); } }
    SEAM();
    ph_ = 0;
#define LAYER_BODY(l) do { \
        if (IN()) { REP(19) { FRESH(); if (l == 0) phase_norm1(X, l, 0); else phase_norm1(X, l, 1, rep_ == 0 ? 1.f : 0.f); } } \
        SEAM(); \
        if (IN()) REP(3) { \
            FRESH(); \
            SchedStatic S{64, 30, X.G, X.c, (const char*)WSP(bf16_t, WS_H), (const char*)WSW(bf16_t, WS_WIN, l), (size_t)256 * 1024 * 2, (size_t)256 * 1024 * 2}; \
            EpiProj E{WSP(bf16_t, WS_PROJ), INP(18) + (size_t)(l) * 3072, WSP(unsigned char, WS_G8)}; \
            pg8::gemm_phase(X.lds, X.tid, 1024, 1024, 16, S, E); \
              \
            if ((l) + 1 < NL && (64 * 30) % X.G != 0 && X.c >= (64 * 30) % X.G) { __syncthreads(); phase_conv_dyn(X, (l) + 1, (unsigned*)(X.ws + WS_CTL + 14336) + 64 * (l), 4); } \
        } \
        SEAM(); \
        if (IN()) { { FRESH(); sub_qknorm(X, l); } REP(4) { FRESH(); sub_vtrans(X); } REP(5) { FRESH(); sub_gmlp(X, l); } REP(6) { FRESH(); sub_gla_local(X, l); } REP(7) { FRESH(); sub_dsa_select(X); } } \
        SEAM(); \
        if (IN()) { { FRESH(); sub_gla_scan(X); } if (PROBE_DUP == 16) { xcd_barrier(bar); { FRESH(); sub_gla_local(X, l); } xcd_barrier(bar); { FRESH(); sub_gla_scan(X); } } REP(8) { FRESH(); sub_dsa_attn(X, l); } } \
        SEAM(); \
        if (IN()) REP(9) { FRESH(); sub_gla_out(X, l); } \
        SEAM(); \
        if (IN()) REP(10) { \
            FRESH(); \
            SchedStatic S{64, 4, X.G, X.c, (const char*)WSP(bf16_t, WS_Y), (const char*)WSW(bf16_t, WS_WBR, l), (size_t)256 * YW * 2, (size_t)256 * YW * 2}; \
            EpiMerge E{WSP(unsigned char, WS_G8), WSP(bf16_t, WS_H)}; \
            pg8::gemm_phase(X.lds, X.tid, YW, YW, 24, S, E); \
        } \
        SEAM(); \
        if (IN()) REP(18) { \
            FRESH(); \
            SchedStatic S{64, 4, X.G, X.c, (const char*)WSP(bf16_t, WS_H), (const char*)WSW(bf16_t, WS_WOUT, l), (size_t)256 * 1024 * 2, (size_t)256 * 1024 * 2}; \
            EpiOut E{X.out, ((l) == 0 && rep_ == 0) ? INP(0) : (const float*)X.out, WSP(float, WS_MOD) + (size_t)l * NB * 6144 + 2048, rep_ == 0 ? 1.f : 0.f}; \
            pg8::gemm_phase(X.lds, X.tid, 1024, 1024, 16, S, E); \
        } \
        SEAM(); \
        if (IN()) REP(14) { FRESH(); phase_norm2(X, l); } \
        SEAM(); \
        if (IN()) REP(11) { \
            FRESH(); \
            LAS int* tb = (LAS int*)(X.lds + AUX_OFF + 2048); LAS int* myoff = (LAS int*)(X.lds + AUX_OFF + 1024); \
            LAS int* rows = (LAS int*)(X.lds + AUX_OFF + 12288); LAS float* lw = (LAS float*)(X.lds + AUX_OFF + 14336); \
            build_tiles(X, tb, myoff); \
            moe_lists(X, tb, rows, lw, (LAS int*)(X.lds + AUX_OFF + 16384)); \
            SchedMoeG S{X.G, X.c, tb[0], tb + 64, tb + 256, rows, (const char*)WSP(bf16_t, WS_H), (const char*)WSW(bf16_t, WS_WE1, l), (size_t)512 * 1024 * 2, (size_t)256 * 1024 * 2}; \
            EpiMoe1 E{WSP(bf16_t, WS_ACT), lw}; \
            pg8::gemm_phase(X.lds, X.tid, 1024, 1024, 16, S, E); \
            if ((l) + 1 < NL) { __syncthreads(); phase_conv_dyn(X, (l) + 1, (unsigned*)(X.ws + WS_CTL + 14336) + 64 * (l), 1 << 30); } \
        } \
        SEAM(); \
        if (IN()) REP(12) { \
            FRESH(); \
            LAS int* tb = (LAS int*)(X.lds + AUX_OFF + 2048); LAS int* myoff = (LAS int*)(X.lds + AUX_OFF + 1024); \
            build_tiles(X, tb, myoff); \
            SchedMoe S{X.G, X.c, 2, tb[0], tb + 64, tb + 256, (const char*)WSP(bf16_t, WS_ACT), (const char*)WSW(bf16_t, WS_WE2, l), (size_t)256 * 256 * 2, (size_t)1024 * 256 * 2, (size_t)256 * 256 * 2}; \
            EpiMoe2 E{WSP(bf16_t, WS_FFN)}; \
            pg8::gemm_phase(X.lds, X.tid, 256, 256, 4, S, E); \
        } \
        SEAM(); \
 \
    } while (0)
    LAYER_BODY(0); LAYER_BODY(1); LAYER_BODY(2); LAYER_BODY(3);
    if (IN()) { FRESH(); phase_norm1(X, NL, 2); }
    if (PROBE_STAMP) { if (blockIdx.x == 0) { const unsigned long long tb = __builtin_amdgcn_s_memrealtime(); while (__builtin_amdgcn_s_memrealtime() - tb < 4ull * st_acc) __builtin_amdgcn_s_sleep(8); } }
#undef IN
#undef SEAM
}

constexpr int N_PHASES = 1 + NL * 10 + 1;

extern "C" void kernel_launch(void* const* d_in, const int* in_sizes, int n_in, void* d_out, int out_size, void* d_ws, size_t ws_size, hipStream_t stream) {
    static int grid = 0;
    if (grid == 0) {
        if (n_in != 27 || out_size != T * D || ws_size < WS_END) { fprintf(stderr, "kernel_launch: unexpected problem (n_in %d, out %d, ws %zu, need %zu)\n", n_in, out_size, ws_size, (size_t)WS_END); grid = -1; return; }
        int dev = 0, cus = 0, per_cu = 0;
        if (hipGetDevice(&dev) != hipSuccess || hipDeviceGetAttribute(&cus, hipDeviceAttributeMultiprocessorCount, dev) != hipSuccess) { grid = -1; return; }
        if (hipFuncSetAttribute((const void*)fwd_kernel, hipFuncAttributeMaxDynamicSharedMemorySize, LDS_BYTES) != hipSuccess) { fprintf(stderr, "kernel_launch: hipFuncSetAttribute failed\n"); grid = -1; return; }
        if (hipOccupancyMaxActiveBlocksPerMultiprocessor(&per_cu, (const void*)fwd_kernel, 512, LDS_BYTES) != hipSuccess || per_cu < 1) fprintf(stderr, "kernel_launch: occupancy query says %d\n", per_cu);
        (void)hipGetLastError();
        grid = cus;
    }
    if (grid < 0) return;
    (void)hipMemsetAsync((char*)d_ws + WS_CTL, 0, 16384, stream);
    Params p{};
    for (int i = 0; i < 27; ++i) p.in[i] = (const float*)d_in[i];
    p.out = (float*)d_out; p.ws = (unsigned char*)d_ws;
#if N_LAUNCH_MODE == 1
    p.ph_lo = 0; p.ph_hi = N_PHASES;
    hipLaunchKernelGGL(fwd_kernel, dim3(grid), dim3(512), LDS_BYTES, stream, p);
#else
    for (int ph = 0; ph < N_PHASES; ++ph) { p.ph_lo = ph; p.ph_hi = ph + 1; hipLaunchKernelGGL(fwd_kernel, dim3(grid), dim3(512), LDS_BYTES, stream, p); }
#endif
}
```

```cpp
#include <hip/hip_runtime.h>
#include <stdint.h>
#include <stdio.h>

#ifndef N_LAUNCH_MODE
#define N_LAUNCH_MODE 1
#endif

#ifndef PROBE_DUP
#define PROBE_DUP 0
#endif
#ifndef PROBE_STAMP
#define PROBE_STAMP 0
#endif
#define REP(id) for (int rep_ = 0; rep_ < ((PROBE_DUP == (id)) ? 2 : 1); ++rep_)
#define LAS __attribute__((address_space(3)))
#define CAS __attribute__((address_space(4)))
#define GAS __attribute__((address_space(1)))
typedef unsigned short bf16_t;
typedef short bf16x8 __attribute__((ext_vector_type(8)));
typedef float f32x2 __attribute__((ext_vector_type(2)));
typedef float f32x4 __attribute__((ext_vector_type(4)));
typedef float f32x16 __attribute__((ext_vector_type(16)));
typedef unsigned u32x2 __attribute__((ext_vector_type(2)));
typedef unsigned u32x4 __attribute__((ext_vector_type(4)));

constexpr int NB = 4, SEQ = 4096, T = NB * SEQ, D = 1024, NL = 4;
constexpr int NIN = 7508, NP = 7680, PP = 4608;
constexpr int C_AU = 0, C_AV = 512, C_GQ = 1024, C_GK = 1280, C_GV = 1536, C_GR = 2048, C_DQ = 2560, C_DK = 3072, C_DV = 3584,
              C_IQ = 4096, C_IK = 4352, C_GA = 4416, C_IW = 4432, C_GATE = 4608;
constexpr int YW = 1536;
constexpr int MOE_ROWS = 32768 + 16 * 256;
constexpr float EPS = 1e-6f;

constexpr size_t WS_CTL = 0;
constexpr size_t WS_CNT = 16384;
constexpr size_t WS_MOD = 65536;
constexpr size_t WS_WIN = WS_MOD + 524288;
constexpr size_t WS_WBR = WS_WIN + (size_t)NP * 1024 * 2;
constexpr size_t WS_WOUT = WS_WBR + (size_t)1024 * 1536 * 2;
constexpr size_t WS_WE1 = WS_WOUT + (size_t)1024 * 1024 * 2;
constexpr size_t WS_WE2 = WS_WE1 + (size_t)16 * 512 * 1024 * 2;
constexpr size_t WS_WS = WS_WE2 + (size_t)16 * 1024 * 256 * 2;
constexpr size_t WS_W2 = WS_WS + (size_t)4 * 128 * 128 * 2;
constexpr size_t WSET = WS_W2 - WS_WIN;
constexpr size_t WS_H = WS_W2 + WSET;
constexpr size_t WS_PROJ = WS_H + (size_t)T * 1024 * 2;
constexpr size_t WS_Y = WS_PROJ + (size_t)T * PP * 2;
constexpr size_t WS_SCR = WS_Y + (size_t)T * YW * 2;
constexpr size_t WS_MASK = WS_SCR + (size_t)T * 1024 * 4;
constexpr size_t WS_VT = WS_MASK + (size_t)T * 64 * 8;
constexpr size_t WS_TOKE = WS_VT + (size_t)16 * 128 * 4096 * 2;
constexpr size_t WS_TOKW = WS_TOKE + (size_t)T * 8;
constexpr size_t WS_TOKS = WS_TOKW + (size_t)T * 8;
constexpr size_t WS_DEC = WS_TOKS + (size_t)T * 8;
constexpr size_t WS_SW = WS_DEC + (size_t)1024 * 64 * 4;
constexpr size_t WS_G8 = WS_SW + (size_t)MOE_ROWS * 4;
constexpr size_t WS_XB = WS_G8 + (size_t)T * 3072;
constexpr size_t WS_END = WS_XB + (size_t)T * 1024 * 2;
constexpr size_t WS_H2S = WS_PROJ;
constexpr size_t WS_ACT = WS_PROJ;
constexpr size_t WS_FFN = WS_ACT + (size_t)MOE_ROWS * 256 * 2;
static_assert(WS_FFN + (size_t)MOE_ROWS * 1024 * 2 <= WS_Y, "moe alias");

constexpr int LDS_BYTES = 158720;
constexpr int AUX_OFF = 132096;

__device__ __forceinline__ float bf2f(bf16_t v) { return __uint_as_float(((unsigned)v) << 16); }
__device__ __forceinline__ unsigned cvt_pk_bf16(float lo, float hi) { unsigned r; asm volatile("v_cvt_pk_bf16_f32 %0, %1, %2" : "=v"(r) : "v"(lo), "v"(hi)); return r; }
__device__ __forceinline__ bf16_t f2bf(float f) { return (bf16_t)(cvt_pk_bf16(f, 0.f) & 0xffffu); }
__device__ __forceinline__ float lo_bf(unsigned w) { return __uint_as_float(w << 16); }
__device__ __forceinline__ float hi_bf(unsigned w) { return __uint_as_float(w & 0xffff0000u); }
__device__ __forceinline__ f32x4 bf4(u32x2 w) { f32x4 f; f[0] = lo_bf(w.x); f[1] = hi_bf(w.x); f[2] = lo_bf(w.y); f[3] = hi_bf(w.y); return f; }
__device__ __forceinline__ float max_x32(float v) { const auto r = __builtin_amdgcn_permlane32_swap(__float_as_uint(v), __float_as_uint(v), false, false); return fmaxf(__uint_as_float(r[0]), __uint_as_float(r[1])); }
__device__ __forceinline__ float sum_x32(float v) { const auto r = __builtin_amdgcn_permlane32_swap(__float_as_uint(v), __float_as_uint(v), false, false); return __uint_as_float(r[0]) + __uint_as_float(r[1]); }
template <int CTRL> __device__ __forceinline__ float dpp_f(float v) { return __int_as_float(__builtin_amdgcn_update_dpp(0, __float_as_int(v), CTRL, 0xf, 0xf, true)); }
__device__ __forceinline__ float sum8(float v) { v += dpp_f<0xB1>(v); v += dpp_f<0x4E>(v); v += dpp_f<0x141>(v); return v; }
__device__ __forceinline__ float sum16(float v) { v = sum8(v); v += dpp_f<0x140>(v); return v; }
__device__ __forceinline__ float wave_sum(float v) {
    v = sum16(v);
    const float a = __int_as_float(__builtin_amdgcn_readlane(__float_as_int(v), 0)), b = __int_as_float(__builtin_amdgcn_readlane(__float_as_int(v), 16));
    const float c = __int_as_float(__builtin_amdgcn_readlane(__float_as_int(v), 32)), d = __int_as_float(__builtin_amdgcn_readlane(__float_as_int(v), 48));
    return (a + b) + (c + d);
}
__device__ __forceinline__ float fast_exp(float x) { return __builtin_amdgcn_exp2f(x * 1.4426950408889634f); }
__device__ __forceinline__ float sigmoidf_(float x) { return __builtin_amdgcn_rcpf(1.f + fast_exp(-x)); }
__device__ __forceinline__ float gelu_tanh(float x) { const float u = x + 0.044715f * x * x * x; return x * __builtin_amdgcn_rcpf(1.f + __builtin_amdgcn_exp2f(-2.3022082f * u)); }

#define XB_TMO      128
#define XB_XCNT(j)  (256  + 64 * (j))
#define XB_XSUB(j)  (1280 + 64 * (j))
#define XB_XGEN(j)  (2304 + 64 * (j))
#define XB_TOP      3328
#define XB_TOPGEN   3392
#define XCD_BAR_WORDS 3456
#define XB_SPIN_CAP (1u << 22)
__device__ __forceinline__ unsigned xb_ld(unsigned* p)              { return __hip_atomic_load(p, __ATOMIC_RELAXED, __HIP_MEMORY_SCOPE_AGENT); }
__device__ __forceinline__ unsigned xb_add(unsigned* p, unsigned v) { return __hip_atomic_fetch_add(p, v, __ATOMIC_RELAXED, __HIP_MEMORY_SCOPE_AGENT); }
__device__ __forceinline__ unsigned xb_xcc_id() { return (unsigned)__builtin_amdgcn_s_getreg((3 << 11) | 20) & 0xFu; }
#define XB_SPIN(cond, bar) do { unsigned _sp = 0; while (cond) { __builtin_amdgcn_s_sleep(1); \
    if ((++_sp & 255u) == 0u) { if (xb_ld(&(bar)[XB_TMO])) break; if (_sp > XB_SPIN_CAP) { atomicAdd(&(bar)[XB_TMO], 1u); break; } } } } while (0)
struct XcdBarrier { unsigned* bar; unsigned x; volatile LAS unsigned* st; };
__device__ __forceinline__ XcdBarrier xcd_barrier_post(unsigned* bar, volatile LAS unsigned* st) {
    XcdBarrier b; b.bar = bar; b.x = xb_xcc_id(); b.st = st;
    if (threadIdx.x == 0) (void)xb_add(&bar[XB_XCNT(b.x)], 1u);
    return b;
}
__device__ __forceinline__ void xcd_barrier_complete(unsigned* bar, unsigned x, unsigned& nloc, unsigned& nx) {
    const unsigned G = gridDim.x * gridDim.y * gridDim.z;
    unsigned sum, cnt, mine, sp = 0u;
    for (;;) {
        sum = 0u; cnt = 0u; mine = 0u;
#pragma unroll
        for (unsigned j = 0; j < 16; ++j) { const unsigned c = xb_ld(&bar[XB_XCNT(j)]); sum += c; cnt += (c > 0u) ? 1u : 0u; mine = (j == x) ? c : mine; }
        if (sum == G) break;
        __builtin_amdgcn_s_sleep(1);
        if ((++sp & 255u) == 0u) { if (xb_ld(&bar[XB_TMO])) break; if (sp > XB_SPIN_CAP) { atomicAdd(&bar[XB_TMO], 1u); break; } }
    }
    nloc = mine > 0u ? mine : 1u; nx = cnt > 0u ? cnt : 1u;
}
__device__ __forceinline__ void xcd_barrier(const XcdBarrier& b) {
    asm volatile("s_waitcnt vmcnt(0)" ::: "memory");
    __syncthreads();
    if (threadIdx.x == 0) {
        unsigned* bar = b.bar;
        __builtin_amdgcn_s_waitcnt(0);
        unsigned nloc = b.st[0], nx = b.st[1];
        if (nloc == 0u) { xcd_barrier_complete(bar, b.x, nloc, nx); b.st[0] = nloc; b.st[1] = nx; }
        const unsigned old = xb_add(&bar[XB_XSUB(b.x)], 1u);
        const unsigned gen = old / nloc;
        if (old + 1u == (gen + 1u) * nloc) {
            __builtin_amdgcn_fence(__ATOMIC_RELEASE, "agent");
            asm volatile("s_waitcnt vmcnt(0)" ::: "memory");
            const unsigned og = xb_add(&bar[XB_TOP], 1u);
            const unsigned tg = og / nx;
            if (og + 1u == (tg + 1u) * nx) xb_add(&bar[XB_TOPGEN], 1u);
            else XB_SPIN(xb_ld(&bar[XB_TOPGEN]) == tg, bar);
            __builtin_amdgcn_fence(__ATOMIC_ACQUIRE, "agent");
            xb_add(&bar[XB_XGEN(b.x)], 1u);
            asm volatile("s_waitcnt vmcnt(0)" ::: "memory");
        } else {
            XB_SPIN(xb_ld(&bar[XB_XGEN(b.x)]) == gen, bar);
            __builtin_amdgcn_fence(__ATOMIC_ACQUIRE, "agent");
            asm volatile("s_waitcnt vmcnt(0)" ::: "memory");
        }
    }
    __syncthreads();
}

namespace pg8 {
constexpr int BM = 256, BK = 64, HALF = 128, HTB = HALF * BK * 2, STAGE_BYTES = 8 * HTB, NXCD = 8, WGM = 8;
__device__ __forceinline__ int lds_byte(int r, int c) { const int st = (r >> 4) * 2 + (c >> 5), rr = r & 15, cc = c & 31, ob = rr * 64 + cc * 2; return st * 1024 + (ob ^ (((ob >> 9) & 1) << 5)); }
__device__ __forceinline__ void stage_rc(int b, int& R, int& C) { const int st = b / 1024, sb = b % 1024, swz = sb ^ (((sb >> 9) & 1) << 5); R = (st >> 1) * 16 + swz / 64; C = (st & 1) * 32 + (swz % 64) / 2; }
__device__ __forceinline__ int perm32(int rho) { const int n = rho >> 4, i = rho & 15; return 8 * (i >> 2) + 4 * n + (i & 3); }

struct Unit { int pm, pn, aux, ord; const char* A; const char* B; };
__device__ __forceinline__ void tile_of(int L, int nM, int nN, int& pm, int& pn) {
    const int nwg = nM * nN; int wgid = L;
    { const int q = nwg / NXCD, r = nwg % NXCD, xcd = wgid % NXCD, off = wgid / NXCD; wgid = (xcd < r ? xcd * (q + 1) : r * (q + 1) + (xcd - r) * q) + off; }
    const int nig = WGM * nN, gid = wgid / nig, fm = gid * WGM, gsz = (nM - fm) < WGM ? (nM - fm) : WGM;
    pm = fm + ((wgid % nig) % gsz); pn = (wgid % nig) / gsz;
}

template <class Epi, class Sched>
__device__ __forceinline__ void gemm_phase(LAS unsigned char* lds, const int tid, const int lda, const int ldb, const int nt, const Sched& S, const Epi& E) {
    const int wid = __builtin_amdgcn_readfirstlane(tid >> 6), lane = tid & 63, wr = wid >> 2, wc = wid & 3, fr = lane & 15, fq = lane >> 4;
    unsigned voffA[2], voffB[2]; int stR[2], stC[2];
#pragma unroll
    for (int i = 0; i < 2; ++i) { int R, C; stage_rc(tid * 16 + i * 8192, R, C); const int Rb = Epi::PERM ? ((R & ~31) + perm32(R & 31)) : R; stR[i] = R; stC[i] = C;
        voffA[i] = (unsigned)(R * lda + C) * 2u; voffB[i] = (unsigned)(Rb * ldb + C) * 2u; }
    unsigned gC[2][2], gN[2][2];
#define PG8_GROWS(dst, un) do { if constexpr (Sched::GATHER) { _Pragma("unroll") for (int _h = 0; _h < 2; ++_h) _Pragma("unroll") for (int _i = 0; _i < 2; ++_i) \
        dst[_h][_i] = (unsigned)(S.row(un, _h * HALF + stR[_i]) * lda + stC[_i]) * 2u; } } while (0)
#define PG8_STAGEA(bufoff, kidx, h, nx) do { if constexpr (Sched::GATHER) { const char* _b = cA + (size_t)(kidx) * kstep; if (nx) PG8_STAGE(bufoff, _b, gN[h]); else PG8_STAGE(bufoff, _b, gC[h]); } \
        else { const char* _b = ((nx) ? nA : cA) + (size_t)(kidx) * kstep + (size_t)(h) * hstepA; PG8_STAGE(bufoff, _b, voffA); } } while (0)
    const size_t kstep = (size_t)(BK * 2);
    const size_t hstepA = (size_t)HALF * lda * 2, hstepB = (size_t)HALF * ldb * 2;
    const unsigned ldsw = (unsigned)wid * 1024u;
    const int aoff = lds_byte(wr * 64 + fr, fq * 8), boff = lds_byte(wc * 32 + fr, fq * 8);
#define PG8_SA(b, h) (((b) * 2 + (h)) * HTB)
#define PG8_SB(b, h) ((4 + (b) * 2 + (h)) * HTB)
#define PG8_STAGE(bufoff, gbase, voff) do { _Pragma("unroll") for (int _i = 0; _i < 2; ++_i) \
        __builtin_amdgcn_global_load_lds((const unsigned*)((const char*)(gbase) + (voff)[_i]), (LAS unsigned*)(lds + (bufoff) + ldsw + _i * 8192), 16, 0, 0); } while (0)
#define PG8_LDA(dst, b, h) do { _Pragma("unroll") for (int m = 0; m < 4; ++m) _Pragma("unroll") for (int k = 0; k < 2; ++k) dst[m][k] = *(const LAS bf16x8*)(lds + PG8_SA(b, h) + aoff + m * 2048 + k * 1024); } while (0)
#define PG8_LDB(dst, b, h) do { _Pragma("unroll") for (int n = 0; n < 2; ++n) _Pragma("unroll") for (int k = 0; k < 2; ++k) dst[n][k] = *(const LAS bf16x8*)(lds + PG8_SB(b, h) + boff + n * 2048 + k * 1024); } while (0)
#define PG8_MMA(ai, bj, At, Bt) do { __builtin_amdgcn_s_setprio(1); _Pragma("unroll") for (int m = 0; m < 4; ++m) _Pragma("unroll") for (int n = 0; n < 2; ++n) _Pragma("unroll") for (int k = 0; k < 2; ++k) \
        acc[ai][bj][m][n] = __builtin_amdgcn_mfma_f32_16x16x32_bf16(Bt[n][k], At[m][k], acc[ai][bj][m][n], 0, 0, 0); __builtin_amdgcn_s_setprio(0); } while (0)
#define PG8_WAIT_V(n) asm volatile("s_waitcnt vmcnt(" #n ")" ::: "memory")
#define PG8_WAIT_L(n) asm volatile("s_waitcnt lgkmcnt(" #n ")" ::: "memory")
#define PG8_BAR __builtin_amdgcn_s_barrier()
#define PG8_SCHED __builtin_amdgcn_sched_barrier(0)
    Unit cur, nxt; int ui = 0;
    if (!S.next(0, cur)) return;
    f32x4 acc[2][2][4][2];
#pragma unroll
    for (int a = 0; a < 2; ++a)
#pragma unroll
        for (int b = 0; b < 2; ++b)
#pragma unroll
            for (int m = 0; m < 4; ++m)
#pragma unroll
                for (int n = 0; n < 2; ++n) acc[a][b][m][n] = (f32x4){0.f, 0.f, 0.f, 0.f};
    bf16x8 At[4][2], B0[2][2], B1[2][2];
    const char* cA = cur.A; const char* cB = cur.B; const char* nA = cA;
    PG8_GROWS(gC, cur);
    PG8_STAGE(PG8_SB(0, 0), cB, voffB); PG8_STAGEA(PG8_SA(0, 0), 0, 0, false); PG8_STAGE(PG8_SB(0, 1), cB + hstepB, voffB); PG8_STAGEA(PG8_SA(0, 1), 0, 1, false);
    if (wr == 1) PG8_BAR;
    PG8_WAIT_V(4); PG8_BAR;
    PG8_STAGE(PG8_SB(1, 0), cB + kstep, voffB); PG8_STAGEA(PG8_SA(1, 0), 1, 0, false); PG8_STAGE(PG8_SB(1, 1), cB + hstepB + kstep, voffB);
    PG8_WAIT_V(6); PG8_BAR;
    for (;;) {
        const bool has_next = S.next(ui + 1, nxt);
        nA = has_next ? nxt.A : cA; const char* nB = has_next ? nxt.B : cB;
        if constexpr (Sched::GATHER) { if (has_next) PG8_GROWS(gN, nxt); else { _Pragma("unroll") for (int _h = 0; _h < 2; ++_h) _Pragma("unroll") for (int _i = 0; _i < 2; ++_i) gN[_h][_i] = gC[_h][_i]; } }
        for (int t = 0; t < nt; t += 2) {
            const bool last = (t == nt - 2);
            const int k2 = last ? 0 : t + 2;
            const char* b2 = last ? nB : cB + (size_t)(t + 2) * kstep;
            const char* b3 = b2 + kstep;
            if constexpr (Epi::MID != 0) { if (t != 0 && (t % Epi::MID) == 0) E.mid(acc, cur, t / Epi::MID, wr, wc, fr, fq); }
            PG8_LDB(B0, 0, 0); PG8_SCHED; PG8_LDA(At, 0, 0); PG8_STAGEA(PG8_SA(1, 1), t + 1, 1, false);
            PG8_WAIT_L(8); PG8_BAR; PG8_WAIT_L(0); PG8_MMA(0, 0, At, B0); PG8_BAR; PG8_SCHED;
            PG8_LDB(B1, 0, 1); PG8_STAGE(PG8_SB(0, 0), b2, voffB);
            PG8_BAR; PG8_WAIT_L(0); PG8_MMA(0, 1, At, B1); PG8_BAR;
            PG8_LDA(At, 0, 1); PG8_STAGEA(PG8_SA(0, 0), k2, 0, last);
            PG8_BAR; PG8_WAIT_L(0); PG8_MMA(1, 0, At, B0); PG8_BAR; PG8_SCHED;
            PG8_STAGE(PG8_SB(0, 1), b2 + hstepB, voffB);
            PG8_WAIT_V(6); PG8_BAR; PG8_MMA(1, 1, At, B1); PG8_BAR;
            PG8_LDB(B0, 1, 0); PG8_SCHED; PG8_LDA(At, 1, 0); PG8_STAGEA(PG8_SA(0, 1), k2, 1, last);
            PG8_WAIT_L(8); PG8_BAR; PG8_WAIT_L(0); PG8_MMA(0, 0, At, B0); PG8_BAR; PG8_SCHED;
            PG8_LDB(B1, 1, 1); PG8_STAGE(PG8_SB(1, 0), b3, voffB);
            PG8_BAR; PG8_WAIT_L(0); PG8_MMA(0, 1, At, B1); PG8_BAR;
            PG8_LDA(At, 1, 1); PG8_STAGEA(PG8_SA(1, 0), k2 + 1, 0, last);
            PG8_BAR; PG8_WAIT_L(0); PG8_MMA(1, 0, At, B0); PG8_BAR; PG8_SCHED;
            PG8_STAGE(PG8_SB(1, 1), b3 + hstepB, voffB);
            PG8_WAIT_V(6); PG8_BAR; PG8_MMA(1, 1, At, B1); PG8_BAR;
        }
        E(acc, cur, wr, wc, fr, fq);
        if (!has_next) break;
#pragma unroll
        for (int a = 0; a < 2; ++a)
#pragma unroll
            for (int b = 0; b < 2; ++b)
#pragma unroll
                for (int m = 0; m < 4; ++m)
#pragma unroll
                    for (int n = 0; n < 2; ++n) acc[a][b][m][n] = (f32x4){0.f, 0.f, 0.f, 0.f};
        cur = nxt; cA = nA; cB = nB; ++ui;
        if constexpr (Sched::GATHER) { _Pragma("unroll") for (int _h = 0; _h < 2; ++_h) _Pragma("unroll") for (int _i = 0; _i < 2; ++_i) gC[_h][_i] = gN[_h][_i]; }
    }
    PG8_WAIT_V(0);
    if (wr == 0) PG8_BAR;
    PG8_BAR;
#undef PG8_SA
#undef PG8_SB
#undef PG8_STAGE
#undef PG8_STAGEA
#undef PG8_GROWS
#undef PG8_LDA
#undef PG8_LDB
#undef PG8_MMA
#undef PG8_WAIT_V
#undef PG8_WAIT_L
#undef PG8_BAR
#undef PG8_SCHED
}
}
using pg8::Unit;

struct Params { const float* in[27]; float* out; unsigned char* ws; int ph_lo, ph_hi; };
struct Ctx {
    const float* const CAS* in; float* out; unsigned char* ws; LAS unsigned char* lds;
    int tid, lane, wave, G, c;
};
#define INP(k_) ((const float*)(const GAS float*)X.in[k_])
#define WSP(T_, off) ((T_*)(X.ws + (off)))
#define WSW(T_, off, l_) ((T_*)(X.ws + (off) + (size_t)((l_) & 1) * WSET))

struct SchedStatic {
    static constexpr bool GATHER = false; __device__ __forceinline__ int row(const Unit&, int) const { return 0; }
    int nM, nN, G, c; const char* A; const char* B; size_t tA, tB;
    __device__ __forceinline__ bool next(int i, Unit& u) const {
        const long L = (long)i * G + c; if (L >= (long)nM * nN) return false;
        pg8::tile_of((int)L, nM, nN, u.pm, u.pn); u.aux = 0; u.ord = i; u.A = A + (size_t)u.pm * tA; u.B = B + (size_t)u.pn * tB; return true;
    }
};
struct SchedMoe {
    static constexpr bool GATHER = false; __device__ __forceinline__ int row(const Unit&, int) const { return 0; }
    int G, c, ncol_shift, nT; const LAS int* tile_e; const LAS int* tile_pm; const char* A; const char* B; size_t tA, eB, tB;
    __device__ __forceinline__ bool next(int i, Unit& u) const {
        const long L = (long)i * G + c; if (L >= ((long)nT << ncol_shift)) return false;
        const int rt = (int)(L >> ncol_shift); u.pn = (int)(L & ((1 << ncol_shift) - 1)); u.pm = tile_pm[rt]; u.aux = tile_e[rt]; u.ord = i;
        u.A = A + (size_t)u.pm * tA; u.B = B + (size_t)u.aux * eB + (size_t)u.pn * tB; return true;
    }
};

struct SchedMoeG {
    static constexpr bool GATHER = true;
    int G, c, nT; const LAS int* tile_e; const LAS int* tile_pm; const LAS int* rows; const char* A; const char* B; size_t eB, tB;
    __device__ __forceinline__ bool next(int i, Unit& u) const {
        const long L = (long)i * G + c; if (L >= ((long)nT << 1)) return false;
        const int rt = (int)(L >> 1); u.pn = (int)(L & 1); u.pm = tile_pm[rt]; u.aux = tile_e[rt]; u.ord = i;
        u.A = A; u.B = B + (size_t)u.aux * eB + (size_t)u.pn * tB; return true;
    }
    __device__ __forceinline__ int row(const Unit& u, int r) const { return rows[(u.ord & 1) * 256 + r]; }
};

struct EpiProj { static constexpr int MID = 0; static constexpr bool PERM = true; bf16_t* O; const float* bgate; unsigned char* g8;
    __device__ __forceinline__ void operator()(const f32x4 (&acc)[2][2][4][2], const Unit& u, int wr, int wc, int fr, int fq) const {
        const int row0 = u.pm * 256 + wr * 64 + fr, col0 = u.pn * 256 + wc * 32 + 8 * fq; const bool act = u.pn < 4, gate = u.pn >= 18;
        for (int rep_ = 0; rep_ < (PROBE_DUP == 22 ? 2 : 1); ++rep_) {
        f32x4 bv[2][2];
#pragma unroll
        for (int bj = 0; bj < 2; ++bj)
#pragma unroll
            for (int n = 0; n < 2; ++n) bv[bj][n] = gate ? *(const f32x4*)(bgate + (col0 - C_GATE) + bj * 128 + 4 * n) : (f32x4){0.f, 0.f, 0.f, 0.f};
#pragma unroll
        for (int ai = 0; ai < 2; ++ai)
#pragma unroll
            for (int m = 0; m < 4; ++m) { bf16_t* rowp = O + (size_t)(row0 + ai * 128 + m * 16) * PP + col0;
#pragma unroll
                for (int bj = 0; bj < 2; ++bj) { f32x4 v0 = acc[ai][bj][m][0], v1 = acc[ai][bj][m][1];
                    if (act) {
#pragma unroll
                        for (int j = 0; j < 4; ++j) { v0[j] = gelu_tanh(v0[j]); v1[j] = gelu_tanh(v1[j]); } }
                    if (gate) {
                        v0 += bv[bj][0]; v1 += bv[bj][1];
                        unsigned p0 = 0u, p1 = 0u;
#pragma unroll
                        for (int j = 0; j < 4; ++j) { const unsigned q0 = (unsigned)fminf(fmaxf(sigmoidf_(v0[j]) * 255.f + 0.5f, 1.f), 255.f), q1 = (unsigned)fminf(fmaxf(sigmoidf_(v1[j]) * 255.f + 0.5f, 1.f), 255.f);
                            p0 |= q0 << (8 * j); p1 |= q1 << (8 * j); }
                        *(u32x2*)(g8 + (size_t)(row0 + ai * 128 + m * 16) * 3072 + (col0 - C_GATE) + bj * 128) = (u32x2){p0, p1};
                        continue; }
                    u32x4 w; w.x = cvt_pk_bf16(v0[0], v0[1]); w.y = cvt_pk_bf16(v0[2], v0[3]); w.z = cvt_pk_bf16(v1[0], v1[1]); w.w = cvt_pk_bf16(v1[2], v1[3]);
                    *(u32x4*)(rowp + bj * 128) = w; } }
        }
    }
};
__device__ __forceinline__ float gq(unsigned w, int k) { return (float)((w >> (8 * k)) & 255u); }
struct EpiMerge { static constexpr int MID = 8; static constexpr bool PERM = true; const unsigned char* g8; bf16_t* mb;
    __device__ __forceinline__ void pre(const Unit&, int, LAS unsigned char*, int, int) const {}
    __device__ __forceinline__ void mid(f32x4 (&acc)[2][2][4][2], const Unit& u, int j, int wr, int wc, int fr, int fq) const {
        const int row0 = u.pm * 256 + wr * 64 + fr, col0 = u.pn * 256 + wc * 32 + 8 * fq;
        const unsigned char* gp = g8 + (size_t)row0 * 3072 + (j - 1) * 1024 + col0;
#pragma unroll
        for (int ai = 0; ai < 2; ++ai) {
            u32x2 gprev[4][2], gcur[4][2];
#pragma unroll
            for (int m = 0; m < 4; ++m)
#pragma unroll
                for (int bj = 0; bj < 2; ++bj) { const unsigned char* p = gp + (size_t)(ai * 128 + m * 16) * 3072 + bj * 128; gprev[m][bj] = *(const u32x2*)p; gcur[m][bj] = *(const u32x2*)(p + 1024); }
#pragma unroll
            for (int m = 0; m < 4; ++m)
#pragma unroll
                for (int bj = 0; bj < 2; ++bj)
#pragma unroll
                    for (int n = 0; n < 2; ++n) { const int pw = n ? (int)gprev[m][bj].y : (int)gprev[m][bj].x, cw = n ? (int)gcur[m][bj].y : (int)gcur[m][bj].x;
                        acc[ai][bj][m][n][0] *= gq((unsigned)pw, 0) * __builtin_amdgcn_rcpf(gq((unsigned)cw, 0));
                        acc[ai][bj][m][n][1] *= gq((unsigned)pw, 1) * __builtin_amdgcn_rcpf(gq((unsigned)cw, 1));
                        acc[ai][bj][m][n][2] *= gq((unsigned)pw, 2) * __builtin_amdgcn_rcpf(gq((unsigned)cw, 2));
                        acc[ai][bj][m][n][3] *= gq((unsigned)pw, 3) * __builtin_amdgcn_rcpf(gq((unsigned)cw, 3)); }
        }
    }
    __device__ __forceinline__ void operator()(const f32x4 (&acc)[2][2][4][2], const Unit& u, int wr, int wc, int fr, int fq) const {
        const int row0 = u.pm * 256 + wr * 64 + fr, col0 = u.pn * 256 + wc * 32 + 8 * fq;
        const unsigned char* gp = g8 + (size_t)row0 * 3072 + 2 * 1024 + col0;
#pragma unroll
        for (int ai = 0; ai < 2; ++ai) {
            u32x2 g2[4][2];
#pragma unroll
            for (int m = 0; m < 4; ++m)
#pragma unroll
                for (int bj = 0; bj < 2; ++bj) g2[m][bj] = *(const u32x2*)(gp + (size_t)(ai * 128 + m * 16) * 3072 + bj * 128);
#pragma unroll
            for (int m = 0; m < 4; ++m)
#pragma unroll
                for (int bj = 0; bj < 2; ++bj) { float o[8];
#pragma unroll
                    for (int n = 0; n < 2; ++n) { const int gw = n ? (int)g2[m][bj].y : (int)g2[m][bj].x;
                        o[4 * n + 0] = acc[ai][bj][m][n][0] * (gq((unsigned)gw, 0) * (1.f / 255.f)); o[4 * n + 1] = acc[ai][bj][m][n][1] * (gq((unsigned)gw, 1) * (1.f / 255.f));
                        o[4 * n + 2] = acc[ai][bj][m][n][2] * (gq((unsigned)gw, 2) * (1.f / 255.f)); o[4 * n + 3] = acc[ai][bj][m][n][3] * (gq((unsigned)gw, 3) * (1.f / 255.f)); }
                    u32x4 w; w.x = cvt_pk_bf16(o[0], o[1]); w.y = cvt_pk_bf16(o[2], o[3]); w.z = cvt_pk_bf16(o[4], o[5]); w.w = cvt_pk_bf16(o[6], o[7]);
                    *(u32x4*)(mb + (size_t)(row0 + ai * 128 + m * 16) * 1024 + col0 + bj * 128) = w; }
        }
    }
};
template <bool SRC_F32> struct EpiOut { static constexpr int MID = 0; static constexpr bool PERM = true; bf16_t* xb; const float* xin; const float* gt; float scl;
    __device__ __forceinline__ void operator()(const f32x4 (&acc)[2][2][4][2], const Unit& u, int wr, int wc, int fr, int fq) const {
        const int row0 = u.pm * 256 + wr * 64 + fr, col0 = u.pn * 256 + wc * 32 + 8 * fq; const float* g = gt + (size_t)(u.pm >> 4) * 6144;
        f32x4 gv[2][2];
#pragma unroll
        for (int bj = 0; bj < 2; ++bj)
#pragma unroll
            for (int n = 0; n < 2; ++n) gv[bj][n] = *(const f32x4*)(g + col0 + bj * 128 + 4 * n) * scl;
#pragma unroll
        for (int ai = 0; ai < 2; ++ai) {
            f32x4 xv[4][2][2]; u32x4 xw[4][2];
#pragma unroll
            for (int m = 0; m < 4; ++m)
#pragma unroll
                for (int bj = 0; bj < 2; ++bj) { const size_t o = (size_t)(row0 + ai * 128 + m * 16) * 1024 + col0 + bj * 128;
                    if (SRC_F32) { xv[m][bj][0] = *(const f32x4*)(xin + o); xv[m][bj][1] = *(const f32x4*)(xin + o + 4); } else xw[m][bj] = *(const u32x4*)(xb + o); }
#pragma unroll
            for (int m = 0; m < 4; ++m)
#pragma unroll
                for (int bj = 0; bj < 2; ++bj) { const size_t o = (size_t)(row0 + ai * 128 + m * 16) * 1024 + col0 + bj * 128;
                    if (!SRC_F32) { xv[m][bj][0] = bf4((u32x2){xw[m][bj].x, xw[m][bj].y}); xv[m][bj][1] = bf4((u32x2){xw[m][bj].z, xw[m][bj].w}); }
                    const f32x4 r0 = xv[m][bj][0] + gv[bj][0] * acc[ai][bj][m][0], r1 = xv[m][bj][1] + gv[bj][1] * acc[ai][bj][m][1];
                    u32x4 w; w.x = cvt_pk_bf16(r0[0], r0[1]); w.y = cvt_pk_bf16(r0[2], r0[3]); w.z = cvt_pk_bf16(r1[0], r1[1]); w.w = cvt_pk_bf16(r1[2], r1[3]);
                    *(u32x4*)(xb + o) = w; }
        }
    }
};
struct EpiMoe1 { static constexpr int MID = 0; static constexpr bool PERM = true; bf16_t* act; const LAS float* lw;
    __device__ __forceinline__ void operator()(const f32x4 (&acc)[2][2][4][2], const Unit& u, int wr, int wc, int fr, int fq) const {
        const int row0 = u.pm * 256 + wr * 64 + fr, col0 = u.pn * 128 + wc * 32 + 8 * fq;
        float wv[2][4];
#pragma unroll
        for (int ai = 0; ai < 2; ++ai)
#pragma unroll
            for (int m = 0; m < 4; ++m) wv[ai][m] = lw[(u.ord & 1) * 256 + wr * 64 + fr + ai * 128 + m * 16];
#pragma unroll
        for (int ai = 0; ai < 2; ++ai)
#pragma unroll
            for (int m = 0; m < 4; ++m) { const int r = row0 + ai * 128 + m * 16; const float w = wv[ai][m]; float o[8];
#pragma unroll
                for (int n = 0; n < 2; ++n)
#pragma unroll
                    for (int j = 0; j < 4; ++j) { const float g = acc[ai][0][m][n][j], up = acc[ai][1][m][n][j]; o[4 * n + j] = g * sigmoidf_(g) * up * w; }
                u32x4 pk; pk.x = cvt_pk_bf16(o[0], o[1]); pk.y = cvt_pk_bf16(o[2], o[3]); pk.z = cvt_pk_bf16(o[4], o[5]); pk.w = cvt_pk_bf16(o[6], o[7]);
                *(u32x4*)(act + (size_t)r * 256 + col0) = pk; }
    }
};
struct EpiMoe2 { static constexpr int MID = 0; static constexpr bool PERM = true; bf16_t* O;
    __device__ __forceinline__ void operator()(const f32x4 (&acc)[2][2][4][2], const Unit& u, int wr, int wc, int fr, int fq) const {
        const int row0 = u.pm * 256 + wr * 64 + fr, col0 = u.pn * 256 + wc * 32 + 8 * fq;
#pragma unroll
        for (int ai = 0; ai < 2; ++ai)
#pragma unroll
            for (int m = 0; m < 4; ++m) { bf16_t* rowp = O + (size_t)(row0 + ai * 128 + m * 16) * 1024 + col0;
#pragma unroll
                for (int bj = 0; bj < 2; ++bj) { const f32x4 v0 = acc[ai][bj][m][0], v1 = acc[ai][bj][m][1];
                    u32x4 w; w.x = cvt_pk_bf16(v0[0], v0[1]); w.y = cvt_pk_bf16(v0[2], v0[3]); w.z = cvt_pk_bf16(v1[0], v1[1]); w.w = cvt_pk_bf16(v1[2], v1[3]);
                    *(u32x4*)(rowp + bj * 128) = w; } }
    }
};

__device__ __forceinline__ void phase_mod(const Ctx& X) {
    LAS float* sc = (LAS float*)X.lds;
    LAS float* red = (LAS float*)(X.lds + 16384);
    const float* c = INP(1); const float* wm = INP(2); const float* bm = INP(3); float* mod = WSP(float, WS_MOD);
    for (int i = X.tid; i < 4096; i += 512) { const float v = c[i]; sc[i] = v * sigmoidf_(v); }
    __syncthreads();
    const int jj = X.tid & 63, ks = X.tid >> 6;
    for (int u = X.c; u < NL * 96; u += X.G) {
        const int l = u / 96, j0 = (u % 96) * 64;
        float a0 = 0.f, a1 = 0.f, a2 = 0.f, a3 = 0.f;
        const float* wp = wm + ((size_t)l * 1024 + ks * 128) * 6144 + j0 + jj;
        for (int k0 = 0; k0 < 128; k0 += 32) { float w[32];
#pragma unroll
            for (int k = 0; k < 32; ++k) w[k] = __builtin_nontemporal_load(wp + (size_t)(k0 + k) * 6144);
#pragma unroll
            for (int k = 0; k < 32; ++k) { const int kk = ks * 128 + k0 + k;
                a0 += sc[kk] * w[k]; a1 += sc[1024 + kk] * w[k]; a2 += sc[2048 + kk] * w[k]; a3 += sc[3072 + kk] * w[k]; } }
        red[(ks * 64 + jj) * 4 + 0] = a0; red[(ks * 64 + jj) * 4 + 1] = a1; red[(ks * 64 + jj) * 4 + 2] = a2; red[(ks * 64 + jj) * 4 + 3] = a3;
        __syncthreads();
        if (X.tid < 256) { const int b = X.tid >> 6; float s = bm[l * 6144 + j0 + jj];
#pragma unroll
            for (int q = 0; q < 8; ++q) s += red[(q * 64 + jj) * 4 + b];
            mod[((size_t)l * NB + b) * 6144 + j0 + jj] = s; }
        __syncthreads();
    }
}

__device__ __forceinline__ int wincol(int m) {
    if (m < 2560) return m;
    if (m < 4416) return m + 16;
    if (m < 4432) return 2560 + (m - 4416);
    if (m < 4436) return m;
    if (m < 4608) return -1;
    return 4436 + (m - 4608);
}
constexpr int CJ0 = 480, CJ1 = CJ0 + 96, CJ2 = CJ1 + 64, CJ3 = CJ2 + 512, CJ4 = CJ3 + 256, CJ5 = CJ4 + 16;
__device__ __forceinline__ void conv_job(const Ctx& X, int l, int j) {
    LAS float* tile = (LAS float*)X.lds;
    const int c = X.tid & 63, r0 = X.tid >> 6;
    if (j >= CJ4) {
        const int q = j - CJ4; const float* src = INP(9) + (size_t)l * 65536; bf16_t* dst = WSW(bf16_t, WS_WS, l);
        for (int i = X.tid; i < 4096; i += 512) { const int e = q * 4096 + i, t = (e >> 7) & 127, s = e & 127; dst[e] = f2bf(s <= t ? src[e] : 0.f); }
        return;
    }
    const float* sp; int sld, scol; bf16_t* dp; int dld;
    if (j < CJ0) { const int nt = j >> 2, kt = j & 3; sp = INP(6) + ((size_t)l * 1024 + kt * 256) * NIN; sld = NIN; scol = wincol(nt * 64 + c);
        dp = WSW(bf16_t, WS_WIN, l) + (size_t)(nt * 64) * 1024 + kt * 256; dld = 1024; }
    else if (j < CJ1) { const int q = j - CJ0, n = q >> 5, dt = (q >> 1) & 15, et = q & 1;
        sp = INP(17) + (((size_t)l * 3 + n) * 512 + et * 256) * 1024; sld = 1024; scol = dt * 64 + c;
        dp = WSW(bf16_t, WS_WBR, l) + (size_t)(dt * 64) * YW + n * 512 + et * 256; dld = YW; }
    else if (j < CJ2) { const int q = j - CJ1, nt = q >> 2, kt = q & 3;
        sp = INP(19) + ((size_t)l * 1024 + kt * 256) * 1024; sld = 1024; scol = nt * 64 + c;
        dp = WSW(bf16_t, WS_WOUT, l) + (size_t)(nt * 64) * 1024 + kt * 256; dld = 1024; }
    else if (j < CJ3) { const int q = j - CJ2, e = q >> 5, rt = (q >> 2) & 7, kt = q & 3; const int n0 = rt * 64, pn = n0 >> 8, half = (n0 >> 7) & 1;
        sp = (half ? INP(25) : INP(24)) + (((size_t)l * 16 + e) * 1024 + kt * 256) * 256; sld = 256; scol = 128 * pn + (n0 & 127) + c;
        dp = WSW(bf16_t, WS_WE1, l) + ((size_t)e * 512 + n0) * 1024 + kt * 256; dld = 1024; }
    else { const int q = j - CJ3, e = q >> 4, dt = q & 15;
        sp = INP(26) + ((size_t)l * 16 + e) * 256 * 1024; sld = 1024; scol = dt * 64 + c;
        dp = WSW(bf16_t, WS_WE2, l) + ((size_t)e * 1024 + dt * 64) * 256; dld = 256; }
#pragma unroll
    for (int i = 0; i < 32; ++i) { const int k = r0 + 8 * i; tile[k * 65 + c] = scol >= 0 ? __builtin_nontemporal_load(sp + (size_t)k * sld + scol) : 0.f; }
    __syncthreads();
    { const int kc = X.tid & 127, nr = X.tid >> 7;
#pragma unroll
      for (int i = 0; i < 16; ++i) { const int n = nr + 4 * i; *(unsigned*)(dp + (size_t)n * dld + 2 * kc) = cvt_pk_bf16(tile[(2 * kc) * 65 + n], tile[(2 * kc + 1) * 65 + n]); } }
    __syncthreads();
}
__device__ __forceinline__ void phase_conv(const Ctx& X, int l) {
    for (int j = X.c; j < CJ5; j += X.G) conv_job(X, l, j);
}
__device__ __forceinline__ void phase_conv_dyn(const Ctx& X, int l, unsigned* q, int maxjobs) {
    LAS int* jslot = (LAS int*)(X.lds + AUX_OFF + 64);
    for (int nj = 0; nj < maxjobs; ++nj) {
        if (X.tid == 0) *jslot = (int)__hip_atomic_fetch_add(q, 1u, __ATOMIC_RELAXED, __HIP_MEMORY_SCOPE_AGENT);
        __syncthreads();
        const int j = *jslot;
        __syncthreads();
        if (j >= CJ5) break;
        conv_job(X, l, j);
    }
}

__device__ __forceinline__ void phase_norm1(const Ctx& X, int l, int mode, float fscale = 1.f) {
    const float* xin = INP(0); float* out = X.out; bf16_t* xb = WSP(bf16_t, WS_XB); const float* mod = WSP(float, WS_MOD);
    const bf16_t* ffn = WSP(bf16_t, WS_FFN); const int* toks = WSP(int, WS_TOKS); bf16_t* h = WSP(bf16_t, WS_H);
    const float* g1 = INP(4) + (size_t)l * 1024;
    constexpr int NBATCH = 4;
    const int rstride = X.G * 8;
    for (int r0 = X.c * 8 + X.wave; r0 < T; r0 += rstride * NBATCH) {
        f32x4 xv[NBATCH][4]; u32x2 xw[NBATCH][4], fa[NBATCH][4], fb[NBATCH][4]; int sl[NBATCH][2];
        if (mode != 0) {
#pragma unroll
            for (int j = 0; j < NBATCH; ++j) { const int r = r0 + j * rstride; sl[j][0] = r < T ? toks[2 * r] : 0; sl[j][1] = r < T ? toks[2 * r + 1] : 0; }
        }
#pragma unroll
        for (int j = 0; j < NBATCH; ++j) { const int r = r0 + j * rstride < T ? r0 + j * rstride : r0;
#pragma unroll
            for (int i = 0; i < 4; ++i) { const int col = 4 * X.lane + 256 * i;
                if (mode == 0) xv[j][i] = *(const f32x4*)(xin + (size_t)r * 1024 + col);
                else { xw[j][i] = *(const u32x2*)(xb + (size_t)r * 1024 + col); fa[j][i] = *(const u32x2*)(ffn + (size_t)sl[j][0] * 1024 + col); fb[j][i] = *(const u32x2*)(ffn + (size_t)sl[j][1] * 1024 + col); } } }
#pragma unroll
        for (int j = 0; j < NBATCH; ++j) { const int r = r0 + j * rstride; if (r >= T) break;
            const int b = r >> 12;
            if (mode != 0) { const float* gt2 = mod + ((size_t)(l - 1) * NB + b) * 6144 + 5120;
#pragma unroll
                for (int i = 0; i < 4; ++i) { const int col = 4 * X.lane + 256 * i; const f32x4 g = *(const f32x4*)(gt2 + col);
                    xv[j][i] = bf4(xw[j][i]) + g * (bf4(fa[j][i]) + bf4(fb[j][i])) * fscale;
                    if (mode == 1) { u32x2 w; w.x = cvt_pk_bf16(xv[j][i][0], xv[j][i][1]); w.y = cvt_pk_bf16(xv[j][i][2], xv[j][i][3]); *(u32x2*)(xb + (size_t)r * 1024 + col) = w; xv[j][i] = bf4(w); }
                    else *(f32x4*)(out + (size_t)r * 1024 + col) = xv[j][i]; } }
            if (mode == 2) continue;
            float ss = 0.f;
#pragma unroll
            for (int i = 0; i < 4; ++i) ss += xv[j][i][0] * xv[j][i][0] + xv[j][i][1] * xv[j][i][1] + xv[j][i][2] * xv[j][i][2] + xv[j][i][3] * xv[j][i][3];
            ss = wave_sum(ss);
            const float rstd = __builtin_amdgcn_rsqf(ss * (1.f / 1024.f) + EPS);
            const float* md = mod + ((size_t)l * NB + b) * 6144;
#pragma unroll
            for (int i = 0; i < 4; ++i) { const int col = 4 * X.lane + 256 * i;
                const f32x4 g = *(const f32x4*)(g1 + col), sh = *(const f32x4*)(md + col), sc = *(const f32x4*)(md + 1024 + col);
                f32x4 yv = xv[j][i] * rstd * g * (sc + 1.f) + sh;
                u32x2 w; w.x = cvt_pk_bf16(yv[0], yv[1]); w.y = cvt_pk_bf16(yv[2], yv[3]); *(u32x2*)(h + (size_t)r * 1024 + col) = w; }
        }
    }
}

__device__ __forceinline__ void sub_qknorm(const Ctx& X, int l) {
    bf16_t* proj = WSP(bf16_t, WS_PROJ);
    const float* gp = INP(15) + (size_t)l * 128 + 8 * (X.lane & 15);
    float g[8];
#pragma unroll
    for (int i = 0; i < 8; ++i) g[i] = gp[i];
    const int rstride = X.G * 8;
    for (int r0 = X.c * 8 + X.wave; r0 < T; r0 += 4 * rstride) {
        u32x4 lk[4];
#pragma unroll
        for (int q = 0; q < 4; ++q) { const int r = r0 + q * rstride < T ? r0 + q * rstride : r0; lk[q] = *(const u32x4*)(proj + (size_t)r * PP + C_DK + 8 * X.lane); }
#pragma unroll
        for (int q = 0; q < 4; ++q) { const int r = r0 + q * rstride; if (r >= T) break;
            const u32x4 a = lk[q]; float v[8] = {lo_bf(a.x), hi_bf(a.x), lo_bf(a.y), hi_bf(a.y), lo_bf(a.z), hi_bf(a.z), lo_bf(a.w), hi_bf(a.w)};
            float ss = 0.f;
#pragma unroll
            for (int i = 0; i < 8; ++i) ss += v[i] * v[i];
            ss = sum16(ss);
            const float rstd = __builtin_amdgcn_rsqf(ss * (1.f / 128.f) + EPS);
#pragma unroll
            for (int i = 0; i < 8; ++i) v[i] = v[i] * rstd * g[i];
            u32x4 o; o.x = cvt_pk_bf16(v[0], v[1]); o.y = cvt_pk_bf16(v[2], v[3]); o.z = cvt_pk_bf16(v[4], v[5]); o.w = cvt_pk_bf16(v[6], v[7]);
            *(u32x4*)(proj + (size_t)r * PP + C_DK + 8 * X.lane) = o; }
    }
}
__device__ __forceinline__ void sub_vtrans(const Ctx& X) {
    const bf16_t* proj = WSP(bf16_t, WS_PROJ); bf16_t* vt = WSP(bf16_t, WS_VT);
    LAS bf16_t* tile = (LAS bf16_t*)X.lds;
    for (int j0 = X.c; j0 < 2048; j0 += 2 * X.G) {
        u32x4 v[2];
#pragma unroll
        for (int q = 0; q < 2; ++q) { const int j = j0 + q * X.G < 2048 ? j0 + q * X.G : j0; const int bh = j >> 7, et = (j >> 6) & 1, st = j & 63, b = bh >> 2, hh = bh & 3;
            v[q] = *(const u32x4*)(proj + ((size_t)b * SEQ + st * 64 + (X.tid >> 3)) * PP + C_DV + 128 * hh + et * 64 + (X.tid & 7) * 8); }
#pragma unroll
        for (int q = 0; q < 2; ++q) *(LAS u32x4*)(tile + q * 4608 + (X.tid >> 3) * 72 + (X.tid & 7) * 8) = v[q];
        __syncthreads();
#pragma unroll
        for (int q = 0; q < 2; ++q) { const int j = j0 + q * X.G; if (j >= 2048) break; const int bh = j >> 7, et = (j >> 6) & 1, st = j & 63;
          const int e = X.tid >> 3, s8 = (X.tid & 7) * 8; unsigned short w8[8];
#pragma unroll
          for (int i = 0; i < 8; ++i) w8[i] = tile[q * 4608 + ((s8 & ~15) + 4 * ((s8 >> 3) & 1) + (i & 3) + 8 * (i >> 2)) * 72 + e];
          u32x4 w; w.x = w8[0] | ((unsigned)w8[1] << 16); w.y = w8[2] | ((unsigned)w8[3] << 16); w.z = w8[4] | ((unsigned)w8[5] << 16); w.w = w8[6] | ((unsigned)w8[7] << 16);
          *(u32x4*)(vt + ((size_t)bh * 128 + et * 64 + e) * SEQ + st * 64 + s8) = w; }
        __syncthreads();
    }
}

__device__ __forceinline__ void sub_gmlp(const Ctx& X, int l) {
    const bf16_t* proj = WSP(bf16_t, WS_PROJ); bf16_t* y = WSP(bf16_t, WS_Y); const bf16_t* wsb = WSW(bf16_t, WS_WS, l);
    LAS unsigned char* Wg = X.lds; LAS unsigned char* Vn = X.lds + 34816; LAS float* st = (LAS float*)(X.lds + 69632);
    const float* lng = INP(7) + (size_t)l * 512; const float* lnb = INP(8) + (size_t)l * 512; const float* bs = INP(10) + (size_t)l * 512;
    const int r = X.lane & 31, hf = X.lane >> 5;
    for (int u = X.c; u < 512; u += X.G) {
        const int ch = u >> 2, g = u & 3; const size_t t0 = (size_t)ch * 128;
#pragma unroll
        for (int i = 0; i < 4; ++i) { const int q = X.tid + 512 * i, row = q >> 4, cc = q & 15;
            *(LAS u32x4*)(Wg + row * 272 + cc * 16) = *(const u32x4*)(wsb + ((size_t)g * 128 + row) * 128 + cc * 8); }
        { u32x4 av[16];
#pragma unroll
          for (int i = 0; i < 16; ++i) av[i] = *(const u32x4*)(proj + (t0 + X.wave * 16 + i) * PP + C_AV + 8 * X.lane);
#pragma unroll
          for (int i = 0; i < 16; ++i) { const int tt = X.wave * 16 + i; const u32x4 a = av[i];
            float v[8] = {lo_bf(a.x), hi_bf(a.x), lo_bf(a.y), hi_bf(a.y), lo_bf(a.z), hi_bf(a.z), lo_bf(a.w), hi_bf(a.w)};
            float s = 0.f;
#pragma unroll
            for (int k = 0; k < 8; ++k) s += v[k];
            const float mean = wave_sum(s) * (1.f / 512.f);
            float q2 = 0.f;
#pragma unroll
            for (int k = 0; k < 8; ++k) { const float d = v[k] - mean; q2 += d * d; }
            const float rstd = __builtin_amdgcn_rsqf(wave_sum(q2) * (1.f / 512.f) + EPS);
            if (X.lane == 0) { st[2 * tt] = mean; st[2 * tt + 1] = rstd; } } }
        __syncthreads();
#pragma unroll
        for (int i = 0; i < 4; ++i) { const int q = X.tid + 512 * i, tt = q & 127, jb = q >> 7;
            const u32x4 a = *(const u32x4*)(proj + (t0 + tt) * PP + C_AV + 128 * g + 8 * jb);
            const float mean = st[2 * tt], rstd = st[2 * tt + 1];
            float v[8] = {lo_bf(a.x), hi_bf(a.x), lo_bf(a.y), hi_bf(a.y), lo_bf(a.z), hi_bf(a.z), lo_bf(a.w), hi_bf(a.w)};
#pragma unroll
            for (int e = 0; e < 8; ++e) { const int d = 8 * jb + e; const float o = (v[e] - mean) * rstd * lng[128 * g + d] + lnb[128 * g + d];
                *(LAS bf16_t*)(Vn + d * 272 + tt * 2) = f2bf(o); } }
        __syncthreads();
        { const int tb = X.wave >> 1, dh = X.wave & 1;
          f32x16 acc[2]; bf16_t uu[2][16];
#pragma unroll
          for (int nb = 0; nb < 2; ++nb)
#pragma unroll
              for (int k = 0; k < 16; ++k) { acc[nb][k] = 0.f; uu[nb][k] = proj[(t0 + 32 * tb + (k & 3) + 8 * (k >> 2) + 4 * hf) * PP + C_AU + 128 * g + 64 * dh + 32 * nb + r]; }
          const int nks = 2 * (tb + 1);
          for (int ks = 0; ks < nks; ++ks) {
              const bf16x8 a = *(const LAS bf16x8*)(Wg + (32 * tb + r) * 272 + (16 * ks + 8 * hf) * 2);
#pragma unroll
              for (int nb = 0; nb < 2; ++nb) { const bf16x8 b = *(const LAS bf16x8*)(Vn + (64 * dh + 32 * nb + r) * 272 + (16 * ks + 8 * hf) * 2);
                  acc[nb] = __builtin_amdgcn_mfma_f32_32x32x16_bf16(a, b, acc[nb], 0, 0, 0); } }
#pragma unroll
          for (int nb = 0; nb < 2; ++nb)
#pragma unroll
              for (int k = 0; k < 16; ++k) { const int t = 32 * tb + (k & 3) + 8 * (k >> 2) + 4 * hf, d = 64 * dh + 32 * nb + r;
                  y[(t0 + t) * YW + 128 * g + d] = f2bf((acc[nb][k] + bs[g * 128 + t]) * bf2f(uu[nb][k])); } }
        __syncthreads();
    }
}

__device__ __forceinline__ float log_sigmoid_(float z) { return fminf(z, 0.f) - __logf(1.f + __expf(-fabsf(z))); }

__device__ __forceinline__ void sub_gla_local(const Ctx& X, int l) {
    const bf16_t* proj = WSP(bf16_t, WS_PROJ); float* U = WSP(float, WS_SCR); float* dec = WSP(float, WS_DEC);
    LAS float* ga = (LAS float*)X.lds; LAS float* seg = (LAS float*)(X.lds + 4096);
    LAS unsigned char* kkT = X.lds + 8192; LAS unsigned char* vT = X.lds + 17408; LAS unsigned char* kraw = X.lds + 36864;
    const int r = X.lane & 31, hf = X.lane >> 5;
    for (int u = X.c; u < 1024; u += X.G) {
        const int hh = u & 3, cch = (u >> 2) & 63, b = u >> 8; const size_t t0 = (size_t)b * SEQ + cch * 64;
        const int d = X.tid & 63, tq = X.tid >> 6;
        u32x4 lga = {0u, 0u, 0u, 0u}; if (X.tid < 128) lga = *(const u32x4*)(proj + (t0 + (X.tid >> 1)) * PP + C_GA + 8 * (X.tid & 1));
        u32x4 lv[2];
#pragma unroll
        for (int i = 0; i < 2; ++i) { const int q = X.tid + 512 * i, s = q & 63, eb = q >> 6; lv[i] = *(const u32x4*)(proj + (t0 + s) * PP + C_GV + 128 * hh + 8 * eb); }
        const u32x4 lk = *(const u32x4*)(proj + (t0 + (X.tid >> 3)) * PP + C_GK + 64 * hh + 8 * (X.tid & 7));
        float w2[16];
#pragma unroll
        for (int q = 0; q < 16; ++q) w2[q] = INP(11)[((size_t)l * 16 + q) * 256 + hh * 64 + d];
        const float bg = INP(12)[(size_t)l * 256 + hh * 64 + d];
        if (X.tid < 128) { LAS float* gp = ga + (X.tid >> 1) * 16 + 8 * (X.tid & 1);
            gp[0] = lo_bf(lga.x); gp[1] = hi_bf(lga.x); gp[2] = lo_bf(lga.y); gp[3] = hi_bf(lga.y); gp[4] = lo_bf(lga.z); gp[5] = hi_bf(lga.z); gp[6] = lo_bf(lga.w); gp[7] = hi_bf(lga.w); }
#pragma unroll
        for (int i = 0; i < 2; ++i) { const int q = X.tid + 512 * i, s = q & 63, eb = q >> 6; const unsigned w[4] = {lv[i].x, lv[i].y, lv[i].z, lv[i].w};
#pragma unroll
            for (int k = 0; k < 4; ++k) { *(LAS bf16_t*)(vT + (8 * eb + 2 * k) * 144 + s * 2) = (bf16_t)(w[k] & 0xffffu); *(LAS bf16_t*)(vT + (8 * eb + 2 * k + 1) * 144 + s * 2) = (bf16_t)(w[k] >> 16); } }
        *(LAS u32x4*)(kraw + (X.tid >> 3) * 144 + 16 * (X.tid & 7)) = lk;
        __syncthreads();
        float cum[8];
        { float run = 0.f;
#pragma unroll
          for (int i = 0; i < 8; ++i) { const int t = 8 * tq + i; float z = bg;
#pragma unroll
              for (int q = 0; q < 16; ++q) z += ga[t * 16 + q] * w2[q];
              run += log_sigmoid_(z) * (1.f / 16.f); cum[i] = run; }
          seg[tq * 64 + d] = run; }
        __syncthreads();
        { float pre = 0.f, tot = 0.f;
#pragma unroll
          for (int q = 0; q < 8; ++q) { const float s = seg[q * 64 + d]; tot += s; if (q < tq) pre += s; }
          float kk[8];
#pragma unroll
          for (int i = 0; i < 8; ++i) { const int t = 8 * tq + i; const float kv = bf2f(*(const LAS bf16_t*)(kraw + t * 144 + d * 2)); kk[i] = kv * __expf(tot - (pre + cum[i])); }
          u32x4 w; w.x = cvt_pk_bf16(kk[0], kk[1]); w.y = cvt_pk_bf16(kk[2], kk[3]); w.z = cvt_pk_bf16(kk[4], kk[5]); w.w = cvt_pk_bf16(kk[6], kk[7]);
          *(LAS u32x4*)(kkT + d * 144 + 16 * tq) = w;
          if (tq == 0) dec[(size_t)u * 64 + d] = __expf(tot); }
        __syncthreads();
        { const int db = X.wave >> 2, eb = X.wave & 3; f32x16 acc;
#pragma unroll
          for (int k = 0; k < 16; ++k) acc[k] = 0.f;
#pragma unroll
          for (int ks = 0; ks < 4; ++ks) { const bf16x8 a = *(const LAS bf16x8*)(kkT + (32 * db + r) * 144 + (16 * ks + 8 * hf) * 2);
              const bf16x8 bb = *(const LAS bf16x8*)(vT + (32 * eb + r) * 144 + (16 * ks + 8 * hf) * 2);
              acc = __builtin_amdgcn_mfma_f32_32x32x16_bf16(a, bb, acc, 0, 0, 0); }
#pragma unroll
          for (int k = 0; k < 16; ++k) { const int dd = 32 * db + (k & 3) + 8 * (k >> 2) + 4 * hf; U[((size_t)u * 64 + dd) * 128 + 32 * eb + r] = acc[k]; } }
        __syncthreads();
    }
}

__device__ __forceinline__ void sub_gla_scan(const Ctx& X) {
    const float* U = WSP(float, WS_SCR); bf16_t* Sb = WSP(bf16_t, WS_SCR + (size_t)T * 1024 * 2); const float* dec = WSP(float, WS_DEC);
    for (int gid = X.c * 512 + X.tid; gid < 16 * 8192; gid += X.G * 512) {
        const int bh = gid >> 13, de = gid & 8191, d = de >> 7, b = bh >> 2, hh = bh & 3;
        float S = 0.f;
        for (int cb = 0; cb < 4; ++cb) {
            float uv[16], dc[16];
#pragma unroll
            for (int j = 0; j < 16; ++j) { const size_t u = (size_t)b * 256 + (cb * 16 + j) * 4 + hh; uv[j] = U[u * 8192 + de]; dc[j] = dec[u * 64 + d]; }
#pragma unroll
            for (int j = 0; j < 16; ++j) { const size_t u = (size_t)b * 256 + (cb * 16 + j) * 4 + hh; Sb[u * 8192 + de] = f2bf(S); S = dc[j] * S + uv[j]; }
        }
    }
}

__device__ __forceinline__ void sub_gla_out(const Ctx& X, int l) {
    const bf16_t* proj = WSP(bf16_t, WS_PROJ); const bf16_t* Sg = WSP(bf16_t, WS_SCR + (size_t)T * 1024 * 2); bf16_t* y = WSP(bf16_t, WS_Y);
    LAS float* ga = (LAS float*)X.lds; LAS float* seg = (LAS float*)(X.lds + 4096);
    LAS unsigned char* qq = X.lds + 8192; LAS unsigned char* qS = X.lds + 17408; LAS unsigned char* kk2 = X.lds + 26624;
    LAS unsigned char* vT = X.lds + 35840; LAS unsigned char* ST = X.lds + 54272; LAS unsigned char* at = X.lds + 72704; LAS float* ob = (LAS float*)(X.lds + 81920);
    LAS unsigned char* qraw = at; LAS unsigned char* kraw = X.lds + 81920;
    const int r = X.lane & 31, hf = X.lane >> 5;
    for (int u = X.c; u < 1024; u += X.G) {
        const int hh = u & 3, cch = (u >> 2) & 63, b = u >> 8; const size_t t0 = (size_t)b * SEQ + cch * 64;
        const int d = X.tid & 63, tq = X.tid >> 6;
        u32x4 lga = {0u, 0u, 0u, 0u}; if (X.tid < 128) lga = *(const u32x4*)(proj + (t0 + (X.tid >> 1)) * PP + C_GA + 8 * (X.tid & 1));
        u32x4 lv[2]; u32x4 ls[2];
#pragma unroll
        for (int i = 0; i < 2; ++i) { const int q = X.tid + 512 * i, s = q & 63, eb = q >> 6; lv[i] = *(const u32x4*)(proj + (t0 + s) * PP + C_GV + 128 * hh + 8 * eb); }
#pragma unroll
        for (int i = 0; i < 2; ++i) ls[i] = *(const u32x4*)(Sg + (size_t)u * 8192 + 8 * X.tid + 4096 * i);
        const u32x4 lq = *(const u32x4*)(proj + (t0 + (X.tid >> 3)) * PP + C_GQ + 64 * hh + 8 * (X.tid & 7));
        const u32x4 lk = *(const u32x4*)(proj + (t0 + (X.tid >> 3)) * PP + C_GK + 64 * hh + 8 * (X.tid & 7));
        const bf16_t* rp = proj + (t0 + (X.tid >> 3)) * PP + C_GR + 128 * hh + 16 * (X.tid & 7);
        const u32x4 ra = *(const u32x4*)rp, rb = *(const u32x4*)(rp + 8);
        float w2[16];
#pragma unroll
        for (int q = 0; q < 16; ++q) w2[q] = INP(11)[((size_t)l * 16 + q) * 256 + hh * 64 + d];
        const float bg = INP(12)[(size_t)l * 256 + hh * 64 + d];
        if (X.tid < 128) { LAS float* gp = ga + (X.tid >> 1) * 16 + 8 * (X.tid & 1);
            gp[0] = lo_bf(lga.x); gp[1] = hi_bf(lga.x); gp[2] = lo_bf(lga.y); gp[3] = hi_bf(lga.y); gp[4] = lo_bf(lga.z); gp[5] = hi_bf(lga.z); gp[6] = lo_bf(lga.w); gp[7] = hi_bf(lga.w); }
#pragma unroll
        for (int i = 0; i < 2; ++i) { const int q = X.tid + 512 * i, s = q & 63, eb = q >> 6; const unsigned w[4] = {lv[i].x, lv[i].y, lv[i].z, lv[i].w};
#pragma unroll
            for (int k = 0; k < 4; ++k) { *(LAS bf16_t*)(vT + (8 * eb + 2 * k) * 144 + s * 2) = (bf16_t)(w[k] & 0xffffu); *(LAS bf16_t*)(vT + (8 * eb + 2 * k + 1) * 144 + s * 2) = (bf16_t)(w[k] >> 16); } }
#pragma unroll
        for (int i = 0; i < 2; ++i) { const int q = 8 * X.tid + 4096 * i, dd = q >> 7, e = q & 127; const unsigned w[4] = {ls[i].x, ls[i].y, ls[i].z, ls[i].w};
#pragma unroll
            for (int k = 0; k < 4; ++k) { *(LAS bf16_t*)(ST + (e + 2 * k) * 144 + dd * 2) = (bf16_t)(w[k] & 0xffffu); *(LAS bf16_t*)(ST + (e + 2 * k + 1) * 144 + dd * 2) = (bf16_t)(w[k] >> 16); } }
        *(LAS u32x4*)(qraw + (X.tid >> 3) * 144 + 16 * (X.tid & 7)) = lq; *(LAS u32x4*)(kraw + (X.tid >> 3) * 144 + 16 * (X.tid & 7)) = lk;
        __syncthreads();
        float cum[8];
        { float run = 0.f;
#pragma unroll
          for (int i = 0; i < 8; ++i) { const int t = 8 * tq + i; float z = bg;
#pragma unroll
              for (int q = 0; q < 16; ++q) z += ga[t * 16 + q] * w2[q];
              run += log_sigmoid_(z) * (1.f / 16.f); cum[i] = run; }
          seg[tq * 64 + d] = run; }
        __syncthreads();
        { float pre = 0.f, bref = 0.f;
#pragma unroll
          for (int q = 0; q < 8; ++q) { const float s = seg[q * 64 + d]; if (q < tq) pre += s; if (q < 4) bref += s; }
          float qv[8], kv[8];
#pragma unroll
          for (int i = 0; i < 8; ++i) { const int t = 8 * tq + i; qv[i] = bf2f(*(const LAS bf16_t*)(qraw + t * 144 + d * 2)) * 0.125f; kv[i] = bf2f(*(const LAS bf16_t*)(kraw + t * 144 + d * 2)); }
#pragma unroll
          for (int i = 0; i < 8; ++i) { const int t = 8 * tq + i; const float bt = pre + cum[i];
              *(LAS bf16_t*)(qq + t * 144 + d * 2) = f2bf(qv[i] * __expf(bt - bref));
              *(LAS bf16_t*)(qS + t * 144 + d * 2) = f2bf(qv[i] * __expf(bt));
              *(LAS bf16_t*)(kk2 + t * 144 + d * 2) = f2bf(kv[i] * __expf(bref - bt)); } }
        __syncthreads();
        if (X.wave < 4) { const int tb = X.wave >> 1, sb = X.wave & 1; f32x16 acc;
#pragma unroll
            for (int k = 0; k < 16; ++k) acc[k] = 0.f;
#pragma unroll
            for (int ks = 0; ks < 4; ++ks) { const bf16x8 a = *(const LAS bf16x8*)(qq + (32 * tb + r) * 144 + (16 * ks + 8 * hf) * 2);
                const bf16x8 bb = *(const LAS bf16x8*)(kk2 + (32 * sb + r) * 144 + (16 * ks + 8 * hf) * 2);
                acc = __builtin_amdgcn_mfma_f32_32x32x16_bf16(a, bb, acc, 0, 0, 0); }
#pragma unroll
            for (int k = 0; k < 16; ++k) { const int t = 32 * tb + (k & 3) + 8 * (k >> 2) + 4 * hf, s = 32 * sb + r;
                *(LAS bf16_t*)(at + t * 144 + s * 2) = f2bf(s <= t ? acc[k] : 0.f); } }
        __syncthreads();
        { const int tb = X.wave >> 2, eb = X.wave & 3; f32x16 acc;
#pragma unroll
          for (int k = 0; k < 16; ++k) acc[k] = 0.f;
#pragma unroll
          for (int ks = 0; ks < 4; ++ks) { const bf16x8 a = *(const LAS bf16x8*)(qS + (32 * tb + r) * 144 + (16 * ks + 8 * hf) * 2);
              const bf16x8 bb = *(const LAS bf16x8*)(ST + (32 * eb + r) * 144 + (16 * ks + 8 * hf) * 2);
              acc = __builtin_amdgcn_mfma_f32_32x32x16_bf16(a, bb, acc, 0, 0, 0); }
#pragma unroll
          for (int ks = 0; ks < 4; ++ks) { const bf16x8 a = *(const LAS bf16x8*)(at + (32 * tb + r) * 144 + (16 * ks + 8 * hf) * 2);
              const bf16x8 bb = *(const LAS bf16x8*)(vT + (32 * eb + r) * 144 + (16 * ks + 8 * hf) * 2);
              acc = __builtin_amdgcn_mfma_f32_32x32x16_bf16(a, bb, acc, 0, 0, 0); }
#pragma unroll
          for (int k = 0; k < 16; ++k) { const int t = 32 * tb + (k & 3) + 8 * (k >> 2) + 4 * hf; ob[t * 132 + 32 * eb + r] = acc[k]; } }
        __syncthreads();
        { const int t = X.tid >> 3, j = X.tid & 7; float o[16]; float ss = 0.f;
#pragma unroll
          for (int i = 0; i < 16; ++i) { o[i] = ob[t * 132 + 16 * j + i]; ss += o[i] * o[i]; }
          ss = sum8(ss);
          const float rstd = __builtin_amdgcn_rsqf(ss * (1.f / 128.f) + EPS);
          const float* gn = INP(13) + (size_t)l * 128 + 16 * j;
          const unsigned rw[8] = {ra.x, ra.y, ra.z, ra.w, rb.x, rb.y, rb.z, rb.w};
          unsigned pk[8];
#pragma unroll
          for (int i = 0; i < 8; ++i) { const float r0 = lo_bf(rw[i]), r1 = hi_bf(rw[i]);
              const float v0 = o[2 * i] * rstd * gn[2 * i] * (r0 * sigmoidf_(r0)), v1 = o[2 * i + 1] * rstd * gn[2 * i + 1] * (r1 * sigmoidf_(r1));
              pk[i] = cvt_pk_bf16(v0, v1); }
          bf16_t* yp = y + (t0 + t) * YW + 512 + 128 * hh + 16 * j;
          *(u32x4*)yp = (u32x4){pk[0], pk[1], pk[2], pk[3]}; *(u32x4*)(yp + 8) = (u32x4){pk[4], pk[5], pk[6], pk[7]}; }
        __syncthreads();
    }
}

__device__ __forceinline__ unsigned score_code(float sc) {
    const unsigned ub = __float_as_uint(sc); unsigned t = (ub & 0x7fffffffu) >> 13;
    t = t < (107u << 10) ? (107u << 10) : t; t -= (107u << 10); t = t > 32766u ? 32766u : t;
    return (ub >> 31) ? (0x7fffu - t) : (0x8000u | t);
}
template <bool PACKED16>
__device__ __forceinline__ void find_digit(const LAS unsigned* hist, int lane, unsigned K, unsigned& digit, unsigned& above) {
    unsigned hb[4];
    if (PACKED16) { const unsigned h0 = hist[(2 * lane) * 16], h1 = hist[(2 * lane + 1) * 16]; hb[0] = h0 & 0xffffu; hb[1] = h0 >> 16; hb[2] = h1 & 0xffffu; hb[3] = h1 >> 16; }
    else { const u32x4 h4 = *(const LAS u32x4*)(hist + 4 * lane); hb[0] = h4.x; hb[1] = h4.y; hb[2] = h4.z; hb[3] = h4.w; }
    const unsigned s = hb[0] + hb[1] + hb[2] + hb[3];
    int v = (int)s;
    v += __builtin_amdgcn_update_dpp(0, v, 0x111, 0xf, 0xf, true); v += __builtin_amdgcn_update_dpp(0, v, 0x112, 0xf, 0xf, true);
    v += __builtin_amdgcn_update_dpp(0, v, 0x114, 0xf, 0xf, true); v += __builtin_amdgcn_update_dpp(0, v, 0x118, 0xf, 0xf, true);
    v += __builtin_amdgcn_update_dpp(0, v, 0x142, 0xa, 0xf, false); v += __builtin_amdgcn_update_dpp(0, v, 0x143, 0xc, 0xf, false);
    const unsigned total = (unsigned)__builtin_amdgcn_readlane(v, 63);
    unsigned run = total - (unsigned)v, dg = 0, ab = 0; bool found = false;
#pragma unroll
    for (int bi = 3; bi >= 0; --bi) { if (!found && run < K && run + hb[bi] >= K) { found = true; dg = 4 * lane + bi; ab = run; } run += hb[bi]; }
    const unsigned long long m = __ballot(found);
    const int src = m ? (int)__builtin_ctzll(m) : 0;
    digit = (unsigned)__builtin_amdgcn_readlane((int)dg, src); above = (unsigned)__builtin_amdgcn_readlane((int)ab, src);
}
__device__ __forceinline__ void sub_dsa_select(const Ctx& X) {
    const bf16_t* proj = WSP(bf16_t, WS_PROJ); unsigned long long* mask = WSP(unsigned long long, WS_MASK);
    LAS bf16_t* keys = (LAS bf16_t*)X.lds;
    LAS unsigned* hist1 = (LAS unsigned*)(X.lds + AUX_OFF + 1024);
    LAS unsigned* hist2 = (LAS unsigned*)(X.lds + AUX_OFF + 1024 + 8192) + X.wave * 512;
    const int lane = X.lane;
    for (int u0 = X.c; u0 < 1024; u0 += X.G) {
        const int rnd = u0 / X.G, u = (rnd & 1) ? (rnd + 1) * X.G - 1 - (u0 - rnd * X.G) : u0;
        if (u >= 1024) continue;
        const int b = u & 3, qb = 255 - (u >> 2); const size_t tg0 = (size_t)b * SEQ;
        if (qb < 16) {
#pragma unroll
            for (int rr = 0; rr < 2; ++rr) { const int t = 16 * qb + 2 * X.wave + rr; const int rem = t - 64 * lane;
                const unsigned long long w = rem >= 63 ? ~0ull : (rem < 0 ? 0ull : ((2ull << rem) - 1ull));
                mask[(tg0 + t) * 64 + lane] = w; }
            continue;
        }
        const int nk = 16 * (qb + 1), nkp = (nk + 63) & ~63, ntile = nkp >> 4, nwords = nkp >> 6;
        REP(21) {
        *(LAS u32x4*)(hist1 + 4 * X.tid) = (u32x4){0u, 0u, 0u, 0u};
        __syncthreads();
        {
            const int q = lane & 15, kg = lane >> 4; const size_t qrow = (tg0 + 16 * qb + q) * PP;
            bf16x8 Bq[4][2]; float iw[4];
#pragma unroll
            for (int hh = 0; hh < 4; ++hh) { iw[hh] = bf2f(proj[qrow + C_IW + hh]);
#pragma unroll
                for (int ks = 0; ks < 2; ++ks) Bq[hh][ks] = *(const bf16x8*)(proj + qrow + C_IQ + 64 * hh + 32 * ks + 8 * kg); }
            const int tq = 16 * qb + q;
            const bf16_t* kbase = proj + (tg0 + q) * PP + C_IK + 8 * kg;
            for (int jb = X.wave; jb < ntile; jb += 64) {
                bf16x8 Ax[4][2], Ay[4][2];
#pragma unroll
                for (int i = 0; i < 4; ++i) { int j = jb + 8 * i; j = j > 255 ? 255 : j; Ax[i][0] = *(const bf16x8*)(kbase + (size_t)(16 * j) * PP); Ax[i][1] = *(const bf16x8*)(kbase + (size_t)(16 * j) * PP + 32); }
#pragma unroll
                for (int i = 0; i < 4; ++i) { int j = jb + 32 + 8 * i; j = j > 255 ? 255 : j; Ay[i][0] = *(const bf16x8*)(kbase + (size_t)(16 * j) * PP); Ay[i][1] = *(const bf16x8*)(kbase + (size_t)(16 * j) * PP + 32); }
#pragma unroll
                for (int i2 = 0; i2 < 8; ++i2) { const int i = i2 & 3; const int j = jb + 8 * i2;
                    {
                        const bf16x8 A0 = i2 < 4 ? Ax[i][0] : Ay[i][0], A1 = i2 < 4 ? Ax[i][1] : Ay[i][1];
                        f32x4 sc = {0.f, 0.f, 0.f, 0.f};
#pragma unroll
                        for (int hh = 0; hh < 4; ++hh) { f32x4 a = {0.f, 0.f, 0.f, 0.f};
                            a = __builtin_amdgcn_mfma_f32_16x16x32_bf16(A0, Bq[hh][0], a, 0, 0, 0);
                            a = __builtin_amdgcn_mfma_f32_16x16x32_bf16(A1, Bq[hh][1], a, 0, 0, 0);
#pragma unroll
                            for (int k = 0; k < 4; ++k) sc[k] += iw[hh] * fmaxf(a[k], 0.f); }
                        unsigned kk[4];
#pragma unroll
                        for (int k = 0; k < 4; ++k) { const int key = 16 * j + 4 * kg + k; const unsigned code = score_code(sc[k]);
                            const bool adm = key <= tq; kk[k] = adm ? code : 0u;
                            if (adm) atomicAdd((unsigned*)(hist1 + (code >> 9) * 16 + q), (code & 0x100u) ? 0x10000u : 1u); }
                        u32x2 w; w.x = kk[0] | (kk[1] << 16); w.y = kk[2] | (kk[3] << 16);
                        if (j < ntile) *(LAS u32x2*)(keys + q * 4104 + 16 * j + 4 * kg) = w; } }
            }
        }
        __syncthreads();
        }
        {
            const int t0r = 16 * qb + 2 * X.wave;
            const LAS bf16_t* krow[2] = {keys + (2 * X.wave) * 4104 + lane, keys + (2 * X.wave + 1) * 4104 + lane};
            LAS unsigned* h2[2] = {hist2, hist2 + 256};
            unsigned d1[2], ab1[2], d2[2], ab2[2];
#pragma unroll
            for (int q = 0; q < 2; ++q) { find_digit<true>(hist1 + 2 * X.wave + q, lane, 256u, d1[q], ab1[q]); *(LAS u32x4*)(h2[q] + 4 * lane) = (u32x4){0u, 0u, 0u, 0u}; }
            asm volatile("s_waitcnt lgkmcnt(0)" ::: "memory");
            for (int w0 = 0; w0 < nwords; w0 += 8) { unsigned k8[2][8];
#pragma unroll
                for (int i = 0; i < 8; ++i) { k8[0][i] = krow[0][64 * ((w0 + i) & 63)]; k8[1][i] = krow[1][64 * ((w0 + i) & 63)]; }
#pragma unroll
                for (int i = 0; i < 8; ++i)
#pragma unroll
                    for (int q = 0; q < 2; ++q) { const unsigned k = k8[q][i]; if (w0 + i < nwords && (k >> 8) == d1[q]) atomicAdd((unsigned*)(h2[q] + (k & 255u)), 1u); } }
            asm volatile("s_waitcnt lgkmcnt(0)" ::: "memory");
#pragma unroll
            for (int q = 0; q < 2; ++q) find_digit<false>(h2[q], lane, 256u - ab1[q], d2[q], ab2[q]);
            asm volatile("s_waitcnt lgkmcnt(0)" ::: "memory");
            unsigned vstar[2], need[2], mylo[2] = {0u, 0u}, myhi[2] = {0u, 0u};
#pragma unroll
            for (int q = 0; q < 2; ++q) { vstar[q] = (d1[q] << 8) | d2[q]; need[q] = 256u - ab1[q] - ab2[q]; }
            for (int w0 = 0; w0 < nwords; w0 += 8) { unsigned k8[2][8];
#pragma unroll
              for (int i = 0; i < 8; ++i) { k8[0][i] = krow[0][64 * ((w0 + i) & 63)]; k8[1][i] = krow[1][64 * ((w0 + i) & 63)]; }
#pragma unroll
              for (int i = 0; i < 8; ++i)
#pragma unroll
                for (int q = 0; q < 2; ++q) { const int w = w0 + i; const unsigned k = w < nwords ? k8[q][i] : 0u;
                  const unsigned long long gt = __ballot(k > vstar[q]); unsigned long long eq = __ballot(k == vstar[q]);
                  const unsigned ne = (unsigned)__builtin_popcountll(eq);
                  if (ne > need[q]) { unsigned long long e = eq, rsel = 0ull; for (unsigned ii = 0; ii < need[q]; ++ii) { const unsigned long long bbit = e & (0ull - e); rsel |= bbit; e ^= bbit; } eq = rsel; need[q] = 0u; }
                  else need[q] -= ne;
                  const unsigned long long sel = gt | eq;
                  if (lane == w) { mylo[q] = (unsigned)sel; myhi[q] = (unsigned)(sel >> 32); } } }
#pragma unroll
            for (int q = 0; q < 2; ++q) { const int t = t0r + q; const int rem = t - 64 * lane;
                const unsigned long long cm = rem >= 63 ? ~0ull : (rem < 0 ? 0ull : ((2ull << rem) - 1ull));
                mask[(tg0 + t) * 64 + lane] = lane < nwords ? ((((unsigned long long)myhi[q] << 32) | mylo[q]) & cm) : 0ull; }
        }
        __syncthreads();
    }
}

__device__ __forceinline__ void attn_dma(const int st, const int wave, const int lane, const bf16_t* kglob, const bf16_t* vglob, const unsigned long long* mglob, LAS unsigned char* kv, LAS unsigned char* mb) {
#pragma unroll
    for (int i = 0; i < 4; ++i) { const int L = (wave * 4 + i) * 64 + lane, row = L >> 4, c = (L & 15) ^ (row & 15);
        __builtin_amdgcn_global_load_lds((const unsigned*)(kglob + (size_t)(128 * st + row) * PP + 8 * c), (LAS unsigned*)(kv + (wave * 4 + i) * 1024), 16, 0, 0);
        __builtin_amdgcn_global_load_lds((const unsigned*)(vglob + (size_t)row * SEQ + 128 * st + 8 * c), (LAS unsigned*)(kv + 32768 + (wave * 4 + i) * 1024), 16, 0, 0); }
    if (wave < 2) __builtin_amdgcn_global_load_lds((const unsigned*)(mglob + (size_t)(wave * 64 + lane) * 64 + 2 * st), (LAS unsigned*)(mb + wave * 1024), 16, 0, 0);
}
template <bool FAR>
__device__ __forceinline__ void attn_tile(const int st, const int r, const int hf, const int g, const int wq, const int tq, const float scale2,
                                          const LAS unsigned char* Ks, const LAS unsigned char* Vs, const LAS unsigned char* mb, const LAS float* bt,
                                          const bf16x8 (&Qf)[8], f32x16 (&O)[4], float& mrun, float& lrun) {
    const unsigned long long mw = *(const LAS unsigned long long*)(mb + (32 * wq + r) * 16 + 8 * g) >> (4 * hf);
    const unsigned mlo = (unsigned)mw, mhi = (unsigned)(mw >> 32);
    f32x16 S[2];
#pragma unroll
    for (int kb = 0; kb < 2; ++kb) {
#pragma unroll
        for (int k = 0; k < 16; ++k) S[kb][k] = 0.f;
        const int row = 64 * g + 32 * kb + r;
#pragma unroll
        for (int ks = 0; ks < 8; ++ks) { const bf16x8 a = *(const LAS bf16x8*)(Ks + row * 256 + (((2 * ks + hf) ^ (row & 15)) << 4));
            S[kb] = __builtin_amdgcn_mfma_f32_32x32x16_bf16(a, Qf[ks], S[kb], 0, 0, 0); } }
    const int kg0 = 128 * st + 64 * g;
    float mx = -1e30f;
    const float bfar = bt[128];
#pragma unroll
    for (int kb = 0; kb < 2; ++kb)
#pragma unroll
        for (int k = 0; k < 16; ++k) { const int ko = 32 * kb + (k & 3) + 8 * (k >> 2); const int sel = __builtin_amdgcn_sbfe((int)(kb ? mhi : mlo), (k & 3) + 8 * (k >> 2), 1);
            float bias = bfar;
            if (!FAR) { int rel = tq - (kg0 + ko + 4 * hf); rel = rel < 0 ? 0 : (rel > 128 ? 128 : rel); bias = bt[rel]; }
            const float lg = __uint_as_float((__float_as_uint(S[kb][k] * scale2 + bias) & (unsigned)sel) | (~(unsigned)sel & 0xff800000u)); S[kb][k] = lg; mx = fmaxf(mx, lg); }
    mx = max_x32(mx);
    if (__ballot(mx > mrun + 8.f) != 0ull) {
        const float mnew = fmaxf(mrun, mx), alpha = __builtin_amdgcn_exp2f(mrun - mnew);
        lrun *= alpha; mrun = mnew;
#pragma unroll
        for (int eb = 0; eb < 4; ++eb)
#pragma unroll
            for (int k = 0; k < 16; ++k) O[eb][k] *= alpha;
    }
    float ps = 0.f;
#pragma unroll
    for (int kb = 0; kb < 2; ++kb)
#pragma unroll
        for (int k = 0; k < 16; ++k) { const float p = __builtin_amdgcn_exp2f(S[kb][k] - mrun); S[kb][k] = p; ps += p; }
    ps = sum_x32(ps);
    lrun += ps;
#pragma unroll
    for (int kb = 0; kb < 2; ++kb)
#pragma unroll
        for (int s = 0; s < 2; ++s) {
            union { bf16x8 v; unsigned w[4]; } P;
#pragma unroll
            for (int j = 0; j < 4; ++j) P.w[j] = cvt_pk_bf16(S[kb][8 * s + 2 * j], S[kb][8 * s + 2 * j + 1]);
#pragma unroll
            for (int eb = 0; eb < 4; ++eb) { const int row = 32 * eb + r;
                const bf16x8 a = *(const LAS bf16x8*)(Vs + row * 256 + (((8 * g + 4 * kb + 2 * s + hf) ^ (row & 15)) << 4));
                O[eb] = __builtin_amdgcn_mfma_f32_32x32x16_bf16(a, P.v, O[eb], 0, 0, 0); } }
}
__device__ __forceinline__ void sub_dsa_attn(const Ctx& X, int l) {
    const bf16_t* proj = WSP(bf16_t, WS_PROJ); const bf16_t* vtg = WSP(bf16_t, WS_VT); const unsigned long long* mask = WSP(unsigned long long, WS_MASK);
    bf16_t* y = WSP(bf16_t, WS_Y); const float* relb = INP(16);
    LAS unsigned char* KV = X.lds;
    LAS unsigned char* MB = X.lds + AUX_OFF + 1024;
    LAS float* bt = (LAS float*)(X.lds + AUX_OFF + 1024 + 4096);
    LAS float* Ox = (LAS float*)X.lds; LAS float* MLx = (LAS float*)(X.lds + 65536);
    const int lane = X.lane, r = lane & 31, hf = lane >> 5, g = X.wave >> 2, wq = X.wave & 3;
    const float scale2 = 0.08838834764831845f * 1.4426950408889634f;
    for (int u = X.c; u < 512; u += X.G) {
        const int bh = u & 15, qt = u < 256 ? 31 - (u >> 4) : ((u - 256) >> 4), b = bh >> 2, hh = bh & 3;
        const size_t tg0 = (size_t)b * SEQ; const int q0 = 128 * qt, tq = q0 + 32 * wq + r;
        if (X.tid < 129) { const int n = X.tid; int bk;
            if (n < 16) bk = n; else { bk = 16 + (int)(__logf((float)n * (1.f / 16.f)) / 2.0794415416798357f * 16.f); bk = bk > 31 ? 31 : bk; }
            bt[n] = relb[bk * 4 + hh] * 1.4426950408889634f; }
        bf16x8 Qf[8];
        {
            union { bf16x8 v; unsigned w[4]; } qr[8]; float ss = 0.f;
#pragma unroll
            for (int ks = 0; ks < 8; ++ks) { qr[ks].v = *(const bf16x8*)(proj + (tg0 + tq) * PP + C_DQ + 128 * hh + 16 * ks + 8 * hf);
#pragma unroll
                for (int j = 0; j < 4; ++j) { const float a = lo_bf(qr[ks].w[j]), bq = hi_bf(qr[ks].w[j]); ss += a * a + bq * bq; } }
            ss = sum_x32(ss);
            const float rstd = __builtin_amdgcn_rsqf(ss * (1.f / 128.f) + EPS);
            const float* qg = INP(14) + (size_t)l * 128 + 8 * hf;
#pragma unroll
            for (int ks = 0; ks < 8; ++ks) { const f32x4 g0 = *(const f32x4*)(qg + 16 * ks), g1 = *(const f32x4*)(qg + 16 * ks + 4);
                qr[ks].w[0] = cvt_pk_bf16(lo_bf(qr[ks].w[0]) * rstd * g0[0], hi_bf(qr[ks].w[0]) * rstd * g0[1]);
                qr[ks].w[1] = cvt_pk_bf16(lo_bf(qr[ks].w[1]) * rstd * g0[2], hi_bf(qr[ks].w[1]) * rstd * g0[3]);
                qr[ks].w[2] = cvt_pk_bf16(lo_bf(qr[ks].w[2]) * rstd * g1[0], hi_bf(qr[ks].w[2]) * rstd * g1[1]);
                qr[ks].w[3] = cvt_pk_bf16(lo_bf(qr[ks].w[3]) * rstd * g1[2], hi_bf(qr[ks].w[3]) * rstd * g1[3]);
                Qf[ks] = qr[ks].v; } }
        f32x16 O[4];
#pragma unroll
        for (int eb = 0; eb < 4; ++eb)
#pragma unroll
            for (int k = 0; k < 16; ++k) O[eb][k] = 0.f;
        float mrun = -1e30f, lrun = 0.f;
        const bf16_t* kglob = proj + tg0 * PP + C_DK + 128 * hh; const bf16_t* vglob = vtg + (size_t)bh * 128 * SEQ; const unsigned long long* mglob = mask + (tg0 + q0) * 64;
        const int nfar = qt - 1;
        attn_dma(0, X.wave, lane, kglob, vglob, mglob, KV, MB);
        for (int st = 0; st < nfar; ++st) {
            asm volatile("s_waitcnt vmcnt(0)" ::: "memory"); __syncthreads();
            attn_dma(st + 1, X.wave, lane, kglob, vglob, mglob, KV + ((st + 1) & 1) * 65536, MB + ((st + 1) & 1) * 2048);
            const LAS unsigned char* kvb = KV + (st & 1) * 65536;
            attn_tile<true>(st, r, hf, g, wq, tq, scale2, kvb, kvb + 32768, MB + (st & 1) * 2048, bt, Qf, O, mrun, lrun);
        }
        for (int st = nfar < 0 ? 0 : nfar; st <= qt; ++st) {
            asm volatile("s_waitcnt vmcnt(0)" ::: "memory"); __syncthreads();
            if (st < qt) attn_dma(st + 1, X.wave, lane, kglob, vglob, mglob, KV + ((st + 1) & 1) * 65536, MB + ((st + 1) & 1) * 2048);
            const LAS unsigned char* kvb = KV + (st & 1) * 65536;
            attn_tile<false>(st, r, hf, g, wq, tq, scale2, kvb, kvb + 32768, MB + (st & 1) * 2048, bt, Qf, O, mrun, lrun);
        }
        __syncthreads();
        if (g == 1) {
#pragma unroll
            for (int eb = 0; eb < 4; ++eb)
#pragma unroll
                for (int k = 0; k < 16; ++k) Ox[((wq * 4 + eb) * 16 + k) * 64 + lane] = O[eb][k];
            MLx[(wq * 64 + lane) * 2] = mrun; MLx[(wq * 64 + lane) * 2 + 1] = lrun; }
        __syncthreads();
        if (g == 0) {
            const float m1 = MLx[(wq * 64 + lane) * 2], l1 = MLx[(wq * 64 + lane) * 2 + 1];
            const float m = fmaxf(mrun, m1), a0 = __builtin_amdgcn_exp2f(mrun - m), a1 = __builtin_amdgcn_exp2f(m1 - m);
            const float inv = 1.f / (lrun * a0 + l1 * a1);
#pragma unroll
            for (int eb = 0; eb < 4; ++eb)
#pragma unroll
                for (int k4 = 0; k4 < 4; ++k4) { float o[4];
#pragma unroll
                    for (int j = 0; j < 4; ++j) { const int k = 4 * k4 + j; o[j] = (O[eb][k] * a0 + Ox[((wq * 4 + eb) * 16 + k) * 64 + lane] * a1) * inv; }
                    u32x2 w; w.x = cvt_pk_bf16(o[0], o[1]); w.y = cvt_pk_bf16(o[2], o[3]);
                    *(u32x2*)(y + (tg0 + tq) * YW + 1024 + 128 * hh + 32 * eb + 8 * k4 + 4 * hf) = w; } }
        __syncthreads();
    }
}

__device__ __forceinline__ void phase_norm2(const Ctx& X, int l) {
    const bf16_t* xb = WSP(bf16_t, WS_XB); const float* mod = WSP(float, WS_MOD); bf16_t* h = WSP(bf16_t, WS_H);
    int* toke = WSP(int, WS_TOKE); float* tokw = WSP(float, WS_TOKW); unsigned* cntb = WSP(unsigned, WS_CNT);
    LAS float* WT = (LAS float*)X.lds;
    LAS unsigned* cnt = (LAS unsigned*)(X.lds + AUX_OFF + 1024);
    const float* wg = INP(20) + (size_t)l * 4096; const float* wr = INP(22) + (size_t)l * 16384;
    { f32x4 a[2], b[8];
#pragma unroll
      for (int i = 0; i < 2; ++i) a[i] = *(const f32x4*)(wg + 4 * (X.tid + 512 * i));
#pragma unroll
      for (int i = 0; i < 8; ++i) b[i] = *(const f32x4*)(wr + 4 * (X.tid + 512 * i));
#pragma unroll
      for (int i = 0; i < 2; ++i) { const int e0 = 4 * (X.tid + 512 * i);
#pragma unroll
          for (int k = 0; k < 4; ++k) WT[((e0 + k) & 3) * 1024 + ((e0 + k) >> 2)] = a[i][k]; }
#pragma unroll
      for (int i = 0; i < 8; ++i) { const int e0 = 4 * (X.tid + 512 * i);
#pragma unroll
          for (int k = 0; k < 4; ++k) WT[(4 + ((e0 + k) & 15)) * 1024 + ((e0 + k) >> 4)] = b[i][k]; } }
    if (X.tid < 16) cnt[X.tid] = 0u;
    __syncthreads();
    const float* g2 = INP(5) + (size_t)l * 1024; const float* bgrp = INP(21) + l * 4; const float* brt = INP(23) + l * 16;
    const int rpb = (T + X.G - 1) / X.G;
  for (int i0 = X.wave; i0 < rpb; i0 += 8 * 8) {
#pragma unroll 1
    for (int jg = 0; jg < 8; jg += 2) {
        f32x4 xall[2][4];
#pragma unroll
        for (int q = 0; q < 2; ++q) { const int i = i0 + 8 * (jg + q); const int r = (i < rpb && X.c * rpb + i < T) ? X.c * rpb + i : X.c * rpb;
#pragma unroll
            for (int k = 0; k < 4; ++k) xall[q][k] = bf4(*(const u32x2*)(xb + (size_t)r * 1024 + 4 * X.lane + 256 * k)); }
        float rstd[2]; int rr[2]; bool ok[2];
#pragma unroll
        for (int q = 0; q < 2; ++q) { const int i = i0 + 8 * (jg + q); ok[q] = i < rpb && X.c * rpb + i < T; rr[q] = ok[q] ? X.c * rpb + i : X.c * rpb;
            float ss = 0.f;
#pragma unroll
            for (int k = 0; k < 4; ++k) { const f32x4 xv = xall[q][k]; ss += xv[0] * xv[0] + xv[1] * xv[1] + xv[2] * xv[2] + xv[3] * xv[3]; }
            rstd[q] = __builtin_amdgcn_rsqf(wave_sum(ss) * (1.f / 1024.f) + EPS); }
        float lg[2][20];
#pragma unroll
        for (int q = 0; q < 2; ++q)
#pragma unroll
            for (int o = 0; o < 20; ++o) lg[q][o] = 0.f;
#pragma unroll 1
        for (int k = 0; k < 4; ++k) { const int col = 4 * X.lane + 256 * k; const f32x4 g = *(const f32x4*)(g2 + col);
            f32x4 yv[2];
#pragma unroll
            for (int q = 0; q < 2; ++q) { const float* md = mod + ((size_t)l * NB + (rr[q] >> 12)) * 6144;
                const f32x4 sh = *(const f32x4*)(md + 3072 + col), sc = *(const f32x4*)(md + 4096 + col);
                yv[q] = xall[q][k] * rstd[q] * g * (sc + 1.f) + sh;
                if (ok[q]) { u32x2 w; w.x = cvt_pk_bf16(yv[q][0], yv[q][1]); w.y = cvt_pk_bf16(yv[q][2], yv[q][3]); *(u32x2*)(h + (size_t)rr[q] * 1024 + col) = w; } }
#pragma unroll
            for (int o = 0; o < 20; ++o) { const f32x4 wv = *(const LAS f32x4*)(WT + o * 1024 + col);
#pragma unroll
                for (int q = 0; q < 2; ++q) lg[q][o] += yv[q][0] * wv[0] + yv[q][1] * wv[1] + yv[q][2] * wv[2] + yv[q][3] * wv[3]; } }
#pragma unroll
        for (int q = 0; q < 2; ++q) {
#pragma unroll
            for (int o = 0; o < 20; ++o) lg[q][o] = wave_sum(lg[q][o]);
            if (X.lane == 0 && ok[q]) { const int r = rr[q];
                float gl[4];
#pragma unroll
                for (int k = 0; k < 4; ++k) gl[k] = lg[q][k] + bgrp[k];
                int gi = 0; float gm = gl[0];
#pragma unroll
                for (int k = 1; k < 4; ++k) if (gl[k] > gm) { gm = gl[k]; gi = k; }
                float se = 0.f;
#pragma unroll
                for (int k = 0; k < 4; ++k) se += __expf(gl[k] - gm);
                const float pg = 1.f / se;
                float sl[4];
#pragma unroll
                for (int k = 0; k < 4; ++k) { sl[k] = lg[q][4 + k] + brt[k];
#pragma unroll
                    for (int qq = 1; qq < 4; ++qq) if (gi == qq) sl[k] = lg[q][4 + 4 * qq + k] + brt[4 * qq + k]; }
                int i1 = 0; float v1 = sl[0];
#pragma unroll
                for (int k = 1; k < 4; ++k) if (sl[k] > v1) { v1 = sl[k]; i1 = k; }
                int i2 = -1; float v2 = -3.0e38f;
#pragma unroll
                for (int k = 0; k < 4; ++k) if (k != i1 && sl[k] > v2) { v2 = sl[k]; i2 = k; }
                const float w1 = 1.f / (1.f + __expf(v2 - v1));
                const int e1 = 4 * gi + i1, e2 = 4 * gi + i2;
                toke[2 * r] = e1; toke[2 * r + 1] = e2; tokw[2 * r] = pg * w1; tokw[2 * r + 1] = pg * (1.f - w1);
                atomicAdd((unsigned*)(cnt + e1), 1u); atomicAdd((unsigned*)(cnt + e2), 1u);
            }
        }
    }
  }
    __syncthreads();
    if (X.tid < 16) cntb[X.c * 16 + X.tid] = cnt[X.tid];
    __syncthreads();
}

__device__ __forceinline__ void build_tiles(const Ctx& X, LAS int* tb, LAS int* myoff  ) {
    const unsigned* cntb = WSP(unsigned, WS_CNT);
    LAS int* tot = tb + 32;
    LAS int* part = tb + 512;
    { const int e = X.tid & 15, p = X.tid >> 4, per = (X.G + 31) >> 5; int s = 0, mine = 0;
      for (int k = 0; k < per; ++k) { const int c = p * per + k; if (c < X.G) { const int v = (int)cntb[c * 16 + e]; s += v; if (c < X.c) mine += v; } }
      part[p * 16 + e] = s; if (X.c >= p * per && X.c < (p + 1) * per) part[512 + e] = mine; }
    __syncthreads();
    if (X.tid < 16) { const int per = (X.G + 31) >> 5, mp = X.c / per; int s = 0, mine = part[512 + X.tid];
        for (int p = 0; p < 32; ++p) { const int v = part[p * 16 + X.tid]; s += v; if (p < mp) mine += v; }
        tot[X.tid] = s; myoff[X.tid] = mine; }
    __syncthreads();
    if (X.tid == 0) { int row = 0, nT = 0;
        for (int e = 0; e < 16; ++e) { const int nt = (tot[e] + 255) >> 8; tb[16 + e] = row; for (int k = 0; k < nt; ++k) { tb[64 + nT] = e; tb[256 + nT] = (row >> 8) + k; ++nT; } row += nt * 256; }
        tb[0] = nT; }
    __syncthreads();
    if (X.tid < 16) myoff[X.tid] += tb[16 + X.tid];
    __syncthreads();
}

__device__ __forceinline__ void moe_lists(const Ctx& X, const LAS int* tb, LAS int* rows, LAS float* lw, LAS int* sc) {
    const unsigned* cntb = WSP(unsigned, WS_CNT); const int* toke = WSP(int, WS_TOKE); const float* tokw = WSP(float, WS_TOKW); int* toks = WSP(int, WS_TOKS);
    const int nT = tb[0], rpb = (T + X.G - 1) / X.G;
    for (int i = 0; i < 2; ++i) {
        const long L = (long)i * X.G + X.c; if (L >= ((long)nT << 1)) break;
        const int rt = (int)(L >> 1), e = tb[64 + rt], pm = tb[256 + rt], rbase = pm * 256 - tb[16 + e];
        const int v = X.tid < X.G ? (int)cntb[X.tid * 16 + e] : 0;
        sc[X.tid] = v; rows[i * 256 + (X.tid & 255)] = 0; lw[i * 256 + (X.tid & 255)] = 0.f;
        __syncthreads();
        for (int off = 1; off < 512; off <<= 1) { const int t = X.tid >= off ? sc[X.tid - off] : 0; __syncthreads(); sc[X.tid] += t; __syncthreads(); }
        sc[512 + X.tid] = v;
        __syncthreads();
        for (int cs = X.wave; cs < X.G; cs += 8) {
            const int cnt = sc[512 + cs], lo = sc[cs] - cnt;
            if (cnt == 0 || lo + cnt <= rbase || lo >= rbase + 256) continue;
            int run = lo;
            for (int n0 = 0; n0 < 2 * rpb; n0 += 64) { const int n = n0 + X.lane, tr = cs * rpb + (n >> 1), k = n & 1;
                const bool in = n < 2 * rpb && tr < T; const int ex = in ? toke[2 * tr + k] : -1; const bool match = ex == e;
                const unsigned long long bal = __ballot(match);
                const int rank = run + (int)__builtin_popcountll(bal & ((1ull << X.lane) - 1ull)) - rbase;
                if (match && rank >= 0 && rank < 256) { rows[i * 256 + rank] = tr; lw[i * 256 + rank] = tokw[2 * tr + k]; toks[2 * tr + k] = pm * 256 + rank; }
                run += (int)__builtin_popcountll(bal); }
        }
        __syncthreads();
    }
}

__global__ void __launch_bounds__(512, 2) fwd_kernel(Params P) {
    extern __shared__ __attribute__((aligned(16))) unsigned char lds_raw[];
    Ctx X0; X0.in = (const float* const CAS*)__builtin_amdgcn_kernarg_segment_ptr(); X0.out = P.out; X0.ws = P.ws; X0.lds = (LAS unsigned char*)lds_raw;
    X0.tid = threadIdx.x; X0.lane = X0.tid & 63; X0.wave = __builtin_amdgcn_readfirstlane(X0.tid >> 6); X0.G = gridDim.x; X0.c = blockIdx.x;
    LAS unsigned* auxw = (LAS unsigned*)(X0.lds + AUX_OFF);
    if (X0.tid < 4) auxw[X0.tid] = 0u;
    __syncthreads();
#define FRESH() Ctx X = X0; { int wv_ = X0.wave; asm volatile("" : "+s"(wv_)); unsigned m_ = ~0u; asm volatile("" : "+s"(m_)); const int ln_ = __builtin_amdgcn_mbcnt_hi(m_, __builtin_amdgcn_mbcnt_lo(m_, 0u)); \
        X.wave = wv_; X.lane = ln_; X.tid = wv_ * 64 + ln_; \
        size_t z_ = 0; asm volatile("" : "+s"(z_)); X.ws = X0.ws + z_; X.out = (float*)((unsigned char*)X0.out + z_); int c_ = X0.c; asm volatile("" : "+s"(c_)); X.c = c_; \
        const float* const CAS* i_ = X0.in; asm volatile("" : "+s"(i_)); X.in = i_; }
#if N_LAUNCH_MODE == 1
    XcdBarrier bar = xcd_barrier_post((unsigned*)(X0.ws + WS_CTL), (volatile LAS unsigned*)auxw);
#define SEAM() do { unsigned long long t1_ = 0; if (PROBE_STAMP) { t1_ = __builtin_amdgcn_s_memrealtime(); if (ph_ >= 0 && ((PROBE_STAMP >> ph_) & 1)) st_acc += t1_ - st_t0; } \
        if (gp >= lo && gp + 1 < hi) { xcd_barrier(bar); if (PROBE_DUP == 17) xcd_barrier(bar); } \
        if (PROBE_STAMP) { st_t0 = __builtin_amdgcn_s_memrealtime(); if ((PROBE_STAMP >> 11) & 1) st_acc += st_t0 - t1_; ph_ = ph_ < 0 ? ph_ : (ph_ + 1) % 10; } ++gp; } while (0)
#else
#define SEAM() do { ++gp; } while (0)
#endif
    const int lo = P.ph_lo, hi = P.ph_hi; int gp = 0;
    unsigned long long st_acc = 0, st_t0 = PROBE_STAMP ? __builtin_amdgcn_s_memrealtime() : 0ull; int ph_ = -1;
#define IN() (gp >= lo && gp < hi)
    if (IN()) { REP(13) { FRESH(); phase_mod(X); } { FRESH(); __syncthreads(); phase_conv_dyn(X, 0, (unsigned*)(X.ws + WS_CTL + 14336) + 64 * 3, 1 << 30); } }
    SEAM();
    ph_ = 0;
#define LAYER_BODY(l) do { \
        if (IN()) { REP(19) { FRESH(); if (l == 0) phase_norm1(X, l, 0); else phase_norm1(X, l, 1, rep_ == 0 ? 1.f : 0.f); } } \
        SEAM(); \
        if (IN()) REP(3) { \
            FRESH(); \
            SchedStatic S{64, 30, X.G, X.c, (const char*)WSP(bf16_t, WS_H), (const char*)WSW(bf16_t, WS_WIN, l), (size_t)256 * 1024 * 2, (size_t)256 * 1024 * 2}; \
            EpiProj E{WSP(bf16_t, WS_PROJ), INP(18) + (size_t)(l) * 3072, WSP(unsigned char, WS_G8)}; \
            pg8::gemm_phase(X.lds, X.tid, 1024, 1024, 16, S, E); \
              \
            if ((l) + 1 < NL && (64 * 30) % X.G != 0 && X.c >= (64 * 30) % X.G) { __syncthreads(); phase_conv_dyn(X, (l) + 1, (unsigned*)(X.ws + WS_CTL + 14336) + 64 * (l), 4); } \
        } \
        SEAM(); \
        if (IN()) { { FRESH(); sub_qknorm(X, l); } REP(4) { FRESH(); sub_vtrans(X); } REP(5) { FRESH(); sub_gmlp(X, l); } REP(6) { FRESH(); sub_gla_local(X, l); } REP(7) { FRESH(); sub_dsa_select(X); } } \
        SEAM(); \
        if (IN()) { { FRESH(); sub_gla_scan(X); } if (PROBE_DUP == 16) { xcd_barrier(bar); { FRESH(); sub_gla_local(X, l); } xcd_barrier(bar); { FRESH(); sub_gla_scan(X); } } REP(8) { FRESH(); sub_dsa_attn(X, l); } } \
        SEAM(); \
        if (IN()) REP(9) { FRESH(); sub_gla_out(X, l); } \
        SEAM(); \
        if (IN()) REP(10) { \
            FRESH(); \
            SchedStatic S{64, 4, X.G, X.c, (const char*)WSP(bf16_t, WS_Y), (const char*)WSW(bf16_t, WS_WBR, l), (size_t)256 * YW * 2, (size_t)256 * YW * 2}; \
            EpiMerge E{WSP(unsigned char, WS_G8), WSP(bf16_t, WS_H)}; \
            pg8::gemm_phase(X.lds, X.tid, YW, YW, 24, S, E); \
        } \
        SEAM(); \
        if (IN()) REP(18) { \
            FRESH(); \
            SchedStatic S{64, 4, X.G, X.c, (const char*)WSP(bf16_t, WS_H), (const char*)WSW(bf16_t, WS_WOUT, l), (size_t)256 * 1024 * 2, (size_t)256 * 1024 * 2}; \
            if ((l) == 0 && rep_ == 0) { EpiOut<true> E{WSP(bf16_t, WS_XB), INP(0), WSP(float, WS_MOD) + (size_t)l * NB * 6144 + 2048, 1.f}; pg8::gemm_phase(X.lds, X.tid, 1024, 1024, 16, S, E); } \
            else { EpiOut<false> E{WSP(bf16_t, WS_XB), INP(0), WSP(float, WS_MOD) + (size_t)l * NB * 6144 + 2048, rep_ == 0 ? 1.f : 0.f}; pg8::gemm_phase(X.lds, X.tid, 1024, 1024, 16, S, E); } \
        } \
        SEAM(); \
        if (IN()) REP(14) { FRESH(); phase_norm2(X, l); } \
        SEAM(); \
        if (IN()) REP(11) { \
            FRESH(); \
            LAS int* tb = (LAS int*)(X.lds + AUX_OFF + 2048); LAS int* myoff = (LAS int*)(X.lds + AUX_OFF + 1024); \
            LAS int* rows = (LAS int*)(X.lds + AUX_OFF + 12288); LAS float* lw = (LAS float*)(X.lds + AUX_OFF + 14336); \
            build_tiles(X, tb, myoff); \
            moe_lists(X, tb, rows, lw, (LAS int*)(X.lds + AUX_OFF + 16384)); \
            SchedMoeG S{X.G, X.c, tb[0], tb + 64, tb + 256, rows, (const char*)WSP(bf16_t, WS_H), (const char*)WSW(bf16_t, WS_WE1, l), (size_t)512 * 1024 * 2, (size_t)256 * 1024 * 2}; \
            EpiMoe1 E{WSP(bf16_t, WS_ACT), lw}; \
            pg8::gemm_phase(X.lds, X.tid, 1024, 1024, 16, S, E); \
            if ((l) + 1 < NL) { __syncthreads(); phase_conv_dyn(X, (l) + 1, (unsigned*)(X.ws + WS_CTL + 14336) + 64 * (l), 1 << 30); } \
        } \
        SEAM(); \
        if (IN()) REP(12) { \
            FRESH(); \
            LAS int* tb = (LAS int*)(X.lds + AUX_OFF + 2048); LAS int* myoff = (LAS int*)(X.lds + AUX_OFF + 1024); \
            build_tiles(X, tb, myoff); \
            SchedMoe S{X.G, X.c, 2, tb[0], tb + 64, tb + 256, (const char*)WSP(bf16_t, WS_ACT), (const char*)WSW(bf16_t, WS_WE2, l), (size_t)256 * 256 * 2, (size_t)1024 * 256 * 2, (size_t)256 * 256 * 2}; \
            EpiMoe2 E{WSP(bf16_t, WS_FFN)}; \
            pg8::gemm_phase(X.lds, X.tid, 256, 256, 4, S, E); \
        } \
        SEAM(); \
 \
    } while (0)
    LAYER_BODY(0); LAYER_BODY(1); LAYER_BODY(2); LAYER_BODY(3);
    if (IN()) { FRESH(); phase_norm1(X, NL, 2); }
    if (PROBE_STAMP) { if (blockIdx.x == 0) { const unsigned long long tb = __builtin_amdgcn_s_memrealtime(); while (__builtin_amdgcn_s_memrealtime() - tb < 4ull * st_acc) __builtin_amdgcn_s_sleep(8); } }
#undef IN
#undef SEAM
}

constexpr int N_PHASES = 1 + NL * 10 + 1;

extern "C" void kernel_launch(void* const* d_in, const int* in_sizes, int n_in, void* d_out, int out_size, void* d_ws, size_t ws_size, hipStream_t stream) {
    static int grid = 0;
    if (grid == 0) {
        if (n_in != 27 || out_size != T * D || ws_size < WS_END) { fprintf(stderr, "kernel_launch: unexpected problem (n_in %d, out %d, ws %zu, need %zu)\n", n_in, out_size, ws_size, (size_t)WS_END); grid = -1; return; }
        int dev = 0, cus = 0, per_cu = 0;
        if (hipGetDevice(&dev) != hipSuccess || hipDeviceGetAttribute(&cus, hipDeviceAttributeMultiprocessorCount, dev) != hipSuccess) { grid = -1; return; }
        if (hipFuncSetAttribute((const void*)fwd_kernel, hipFuncAttributeMaxDynamicSharedMemorySize, LDS_BYTES) != hipSuccess) { fprintf(stderr, "kernel_launch: hipFuncSetAttribute failed\n"); grid = -1; return; }
        if (hipOccupancyMaxActiveBlocksPerMultiprocessor(&per_cu, (const void*)fwd_kernel, 512, LDS_BYTES) != hipSuccess || per_cu < 1) fprintf(stderr, "kernel_launch: occupancy query says %d\n", per_cu);
        (void)hipGetLastError();
        grid = cus;
    }
    if (grid < 0) return;
    (void)hipMemsetAsync((char*)d_ws + WS_CTL, 0, 16384, stream);
    Params p{};
    for (int i = 0; i < 27; ++i) p.in[i] = (const float*)d_in[i];
    p.out = (float*)d_out; p.ws = (unsigned char*)d_ws;
#if N_LAUNCH_MODE == 1
    p.ph_lo = 0; p.ph_hi = N_PHASES;
    hipLaunchKernelGGL(fwd_kernel, dim3(grid), dim3(512), LDS_BYTES, stream, p);
#else
    for (int ph = 0; ph < N_PHASES; ++ph) { p.ph_lo = ph; p.ph_hi = ph + 1; hipLaunchKernelGGL(fwd_kernel, dim3(grid), dim3(512), LDS_BYTES, stream, p); }
#endif
}
```
